# Optimizing an MI355X kernel written in HIP

```python
import math
import jax
import jax.numpy as jnp
from jax import lax
import numpy as np

D_MODEL = 1024
BATCH = 8
SEQ = 2048
DEPTH = 2

CTX_LEN = 256
GRID_W = 64
D_MIX = D_MODEL
EPS = 1e-6
F32 = jnp.float32

LRU_WIDTH = D_MIX // 4
LRU_HEADS = 4
LRU_HD = LRU_WIDTH // LRU_HEADS
CONV_W = 4
RG_C = 8.0
DA_WIDTH = D_MIX // 4
DA_HEADS = 4
DA_VD = DA_WIDTH // DA_HEADS
DA_QD = DA_VD // 2
ROPE_THETA = 10000.0
Q_BLOCK = 128
SG_WIDTH = D_MIX // 4
SG_HEADS = 4
SG_HD = SG_WIDTH // SG_HEADS
SG_CHUNK = 128
HG_WIDTH = D_MIX // 4
HG_HEADS = 4
HG_HD = HG_WIDTH // HG_HEADS
HG_CHUNK = 64
N_EXPERTS = 16
N_GROUPS = 4
EXP_PER_GROUP = N_EXPERTS // N_GROUPS
TOP_K = 2
D_EXPERT = 512

IN_COLS = 2 * LRU_WIDTH + 3 * DA_WIDTH + 2 * SG_WIDTH + 5 * HG_WIDTH
SPLITS = (2 * LRU_WIDTH, 2 * LRU_WIDTH + 3 * DA_WIDTH, 2 * LRU_WIDTH + 3 * DA_WIDTH + 2 * SG_WIDTH)

kernel_name = 'hybrid_parallel_heads_diffusion_block'


def rms_norm(x, g):
    xf = x.astype(F32)
    y = xf * lax.rsqrt(jnp.mean(xf * xf, axis=-1, keepdims=True) + EPS)
    return (y * g.astype(F32)).astype(x.dtype)


def modulate(h, shift, scale):
    return h * (1.0 + scale) + shift


def tflip(t, rev):
    return jnp.flip(t, axis=1) if rev else t


def centred_dwconv(x, w, b):
    T = x.shape[1]
    left = CONV_W // 2
    xp = jnp.pad(x, ((0, 0), (left, CONV_W - 1 - left), (0, 0)))
    return sum(xp[:, j:j + T] * w[j] for j in range(CONV_W)) + b


def block_diag(x, w, b):
    B_, T, _ = x.shape
    xh = x.reshape(B_, T, LRU_HEADS, LRU_HD)
    return jnp.einsum('bthi,hij->bthj', xh, w).reshape(B_, T, LRU_WIDTH) + b


def rglru_coeffs(u, w_r, b_r, w_i, b_i, lam):
    r = jax.nn.sigmoid(block_diag(u, w_r, b_r).astype(F32))
    i = jax.nn.sigmoid(block_diag(u, w_i, b_i).astype(F32))
    log_a = -RG_C * r * jax.nn.softplus(-lam.astype(F32))
    b = jnp.sqrt(-jnp.expm1(2.0 * log_a)) * i * u.astype(F32)
    return log_a, b


def _lin_combine(e1, e2):
    a1, b1 = e1
    a2, b2 = e2
    return a1 * a2, a2 * b1 + b2


def lru_scan(log_a, b, h0):
    A, Bc = lax.associative_scan(_lin_combine, (jnp.exp(log_a), b), axis=1)
    return A * h0[:, None] + Bc


def lru_final(log_a, b):
    c = jnp.cumsum(log_a, axis=1)
    return jnp.sum(jnp.exp(c[:, -1:] - c) * b, axis=1)


def rglru_mixer(z, zc, conv_w, conv_b, w_r, b_r, w_i, b_i, lam, ctx_out):
    xa, ga = jnp.split(z, 2, axis=-1)
    xca, gca = jnp.split(zc, 2, axis=-1)
    u = centred_dwconv(xa, conv_w, conv_b)
    uc = centred_dwconv(xca, conv_w, conv_b)
    h_sum, hc_sum = 0.0, 0.0
    for d in range(2):
        rev = d == 1
        la_c, b_c = rglru_coeffs(tflip(uc, rev), w_r[d], b_r[d], w_i[d], b_i[d], lam[d])
        if ctx_out:
            hc = lru_scan(la_c, b_c, jnp.zeros_like(b_c[:, 0]))
            hc_last = hc[:, -1]
            hc_sum = hc_sum + tflip(hc, rev)
        else:
            hc_last = lru_final(la_c, b_c)
        la, b = rglru_coeffs(tflip(u, rev), w_r[d], b_r[d], w_i[d], b_i[d], lam[d])
        h_sum = h_sum + tflip(lru_scan(la, b, hc_last), rev)
    y = (h_sum * jax.nn.gelu(ga.astype(F32))).astype(z.dtype)
    yc = (hc_sum * jax.nn.gelu(gca.astype(F32))).astype(z.dtype) if ctx_out else None
    return y, yc


def rope_2d(t, cos, sin):
    sh = t.shape
    tr = t.reshape(sh[:-1] + (2, 2, DA_QD // 4))
    x1, x2 = tr[..., 0, :], tr[..., 1, :]
    c = cos[None, :, None, None]
    s = sin[None, :, None, None]
    out = jnp.stack([x1 * c - x2 * s, x2 * c + x1 * s], axis=-2)
    return out.reshape(sh)


def diff_attend(q, k, v, lam):
    s = jnp.einsum('bqhnd,bkhnd->bnhqk', q, k).astype(F32) * (DA_QD ** -0.5)
    p = jax.nn.softmax(s, axis=-1)
    pd = p[:, 0] - lam * p[:, 1]
    return jnp.einsum('bhqk,bkhe->bqhe', pd.astype(v.dtype), v)


def diff_attn_mixer(z, zc, lam_vecs, sub_g, lam_init, cos, sin, ctx_out):
    B_, T, _ = z.shape
    Tc = zc.shape[1]
    q, k, v = jnp.split(z, 3, axis=-1)
    qc, kc, vc = jnp.split(zc, 3, axis=-1)
    q = rope_2d(q.reshape(B_, T, DA_HEADS, 2, DA_QD), cos, sin)
    k = rope_2d(k.reshape(B_, T, DA_HEADS, 2, DA_QD), cos, sin)
    v = v.reshape(B_, T, DA_HEADS, DA_VD)
    kc = kc.reshape(B_, Tc, DA_HEADS, 2, DA_QD)
    vc = vc.reshape(B_, Tc, DA_HEADS, DA_VD)
    lf = lam_vecs.astype(F32)
    lam = jnp.exp(jnp.sum(lf[0] * lf[1])) - jnp.exp(jnp.sum(lf[2] * lf[3])) + lam_init
    K = jnp.concatenate([kc, k], axis=1)
    V = jnp.concatenate([vc, v], axis=1)
    nb = T // Q_BLOCK
    qb = jnp.moveaxis(q.reshape(B_, nb, Q_BLOCK, DA_HEADS, 2, DA_QD), 1, 0)
    o = lax.map(lambda blk: diff_attend(blk, K, V, lam), qb)
    o = jnp.moveaxis(o, 0, 1).reshape(B_, T, DA_HEADS, DA_VD)
    y = (rms_norm(o, sub_g) * (1.0 - lam_init)).reshape(B_, T, DA_WIDTH).astype(z.dtype)
    yc = None
    if ctx_out:
        oc = diff_attend(qc.reshape(B_, Tc, DA_HEADS, 2, DA_QD), kc, vc, lam)
        yc = (rms_norm(oc, sub_g) * (1.0 - lam_init)).reshape(B_, Tc, DA_WIDTH).astype(z.dtype)
    return y, yc


def spatial_gating(z, norm_g, w_sp, b_sp):
    B_, T, _ = z.shape
    u, v = jnp.split(jax.nn.gelu(z), 2, axis=-1)
    v = rms_norm(v, norm_g).reshape(B_, T // SG_CHUNK, SG_CHUNK, SG_HEADS, SG_HD)
    vm = jnp.einsum('hpq,bnqhc->bnphc', w_sp, v) + b_sp.T[None, None, :, :, None]
    return u * vm.reshape(B_, T, SG_WIDTH)


def hgrn_gates(f_pre, lb):
    f = lb + (1.0 - lb) * jax.nn.sigmoid(f_pre.astype(F32))
    return jnp.log(f), 1.0 - f


def gla_scan(q, k, v, log_f, S0):
    B_, T, H, Dk = q.shape
    nc = T // HG_CHUNK
    to_chunks = lambda t: jnp.transpose(t.reshape(B_, nc, HG_CHUNK, H, t.shape[-1]), (1, 0, 3, 2, 4))
    mask = jnp.tril(jnp.ones((HG_CHUNK, HG_CHUNK), dtype=bool))[:, :, None]

    def step(S, inp):
        qc, kc, vc, lfc = inp
        b = jnp.cumsum(lfc, axis=2)
        diff = b[:, :, :, None, :] - b[:, :, None, :, :]
        dec = jnp.exp(jnp.where(mask, diff, -jnp.inf))
        att = jnp.einsum('bhtd,bhsd,bhtsd->bhts', qc, kc, dec)
        o = att @ vc + jnp.einsum('bhtd,bhdv->bhtv', qc * jnp.exp(b), S)
        b_last = b[:, :, -1:]
        S_new = jnp.exp(b_last[:, :, 0])[..., None] * S + jnp.einsum('bhsd,bhsv->bhdv', kc * jnp.exp(b_last - b), vc)
        return S_new, o

    S_T, o = lax.scan(step, S0, (to_chunks(q), to_chunks(k), to_chunks(v), to_chunks(log_f)))
    o = jnp.transpose(o, (1, 0, 3, 2, 4)).reshape(B_, T, H, v.shape[-1])
    return o, S_T


def gla_final(k, v, log_f):
    c = jnp.cumsum(log_f, axis=1)
    return jnp.einsum('bthd,bthv->bhdv', k * jnp.exp(c[:, -1:] - c), v)


def hgrn2_mixer(z, zc, lb, norm_g, ctx_out):
    heads = lambda t: t.reshape(t.shape[0], t.shape[1], HG_HEADS, HG_HD).astype(F32)
    q, f_fw, f_bw, i, g = jnp.split(z, 5, axis=-1)
    qc, fc_fw, fc_bw, ic, gc = jnp.split(zc, 5, axis=-1)
    q = heads(q) * (HG_HD ** -0.5)
    i = heads(i)
    ic = heads(ic)
    B_ = z.shape[0]
    o_sum, oc_sum = 0.0, 0.0
    for d, (fl, fcl) in enumerate(((f_fw, fc_fw), (f_bw, fc_bw))):
        rev = d == 1
        lb_h = lb[d].reshape(HG_HEADS, HG_HD)
        lf_c, k_c = hgrn_gates(tflip(heads(fcl), rev), lb_h)
        v_c = tflip(ic, rev)
        if ctx_out:
            S0 = jnp.zeros((B_, HG_HEADS, HG_HD, HG_HD), F32)
            o_c, S_c = gla_scan(tflip(heads(qc) * (HG_HD ** -0.5), rev), k_c, v_c, lf_c, S0)
            oc_sum = oc_sum + tflip(o_c, rev)
        else:
            S_c = gla_final(k_c, v_c, lf_c)
        lf, k = hgrn_gates(tflip(heads(fl), rev), lb_h)
        o, _ = gla_scan(tflip(q, rev), k, tflip(i, rev), lf, S_c)
        o_sum = o_sum + tflip(o, rev)
    gn = norm_g.reshape(HG_HEADS, HG_HD)
    y = (rms_norm(o_sum, gn).reshape(z.shape[0], z.shape[1], HG_WIDTH) * jax.nn.silu(g.astype(F32))).astype(z.dtype)
    yc = None
    if ctx_out:
        yc = (rms_norm(oc_sum, gn).reshape(zc.shape[0], zc.shape[1], HG_WIDTH) * jax.nn.silu(gc.astype(F32))).astype(z.dtype)
    return y, yc


def moe(h, w_router, b_router, w1, w3, w2):
    logits = (h @ w_router).astype(F32) + b_router.astype(F32)
    scores = jax.nn.softmax(logits, axis=-1)
    grp = scores.reshape(scores.shape[:-1] + (N_GROUPS, EXP_PER_GROUP))
    grp_score = jnp.sum(lax.top_k(grp, TOP_K)[0], axis=-1)
    g_sel = jnp.argmax(grp_score, axis=-1)
    in_group = g_sel[..., None] == (jnp.arange(N_EXPERTS) // EXP_PER_GROUP)
    masked = jnp.where(in_group, scores, -jnp.inf)
    top_w, top_i = lax.top_k(masked, TOP_K)
    top_w = top_w / jnp.sum(top_w, axis=-1, keepdims=True)
    gate = jnp.sum(jax.nn.one_hot(top_i, N_EXPERTS, dtype=F32) * top_w[..., None], axis=-2)
    out = 0.0
    for e in range(N_EXPERTS):
        he = jax.nn.silu(h @ w1[e]) * (h @ w3[e])
        out = out + gate[..., e:e + 1].astype(h.dtype) * (he @ w2[e])
    return out


def setup_inputs(seed: int = 0) -> dict:
    key = jax.random.key(seed)
    ks = iter(jax.random.split(key, 40))
    nrm = lambda shape, s: s * jax.random.normal(next(ks), shape, F32)
    L = DEPTH
    a_pow = jax.random.uniform(next(ks), (L, 2, LRU_WIDTH), F32, minval=0.9, maxval=0.999)
    a0 = a_pow ** (1.0 / RG_C)
    lru_lam = jnp.log(a0) - jnp.log1p(-a0)
    return {
        'x': nrm((BATCH, SEQ, D_MODEL), 1.0),
        'c': nrm((BATCH, D_MODEL), 1.0),
        'ctx': nrm((BATCH, CTX_LEN, D_MODEL), 1.0),
        'c_ctx': nrm((D_MODEL,), 1.0),
        'w_ada': nrm((L, D_MODEL, 6 * D_MODEL), 0.5 * D_MODEL ** -0.5),
        'b_ada': nrm((L, 6 * D_MODEL), 0.02),
        'norm1_g': 1.0 + nrm((L, D_MODEL), 0.02),
        'norm2_g': 1.0 + nrm((L, D_MODEL), 0.02),
        'w_in': nrm((L, D_MODEL, IN_COLS), D_MODEL ** -0.5),
        'w_out': nrm((L, D_MIX, D_MODEL), D_MIX ** -0.5),
        'lru_conv_w': nrm((L, CONV_W, LRU_WIDTH), CONV_W ** -0.5),
        'lru_conv_b': nrm((L, LRU_WIDTH), 0.02),
        'lru_wr': nrm((L, 2, LRU_HEADS, LRU_HD, LRU_HD), LRU_HD ** -0.5),
        'lru_br': nrm((L, 2, LRU_WIDTH), 0.02),
        'lru_wi': nrm((L, 2, LRU_HEADS, LRU_HD, LRU_HD), LRU_HD ** -0.5),
        'lru_bi': nrm((L, 2, LRU_WIDTH), 0.02),
        'lru_lam': lru_lam,
        'da_lam': nrm((L, 4, DA_QD), 0.1),
        'da_subln_g': 1.0 + nrm((L, DA_VD), 0.02),
        'sg_norm_g': 1.0 + nrm((L, SG_WIDTH), 0.02),
        'sg_w': nrm((L, SG_HEADS, SG_CHUNK, SG_CHUNK), SG_CHUNK ** -0.5),
        'sg_b': 1.0 + nrm((L, SG_HEADS, SG_CHUNK), 0.02),
        'hg_lb': nrm((2, L, HG_WIDTH), 0.1),
        'hg_norm_g': 1.0 + nrm((L, HG_WIDTH), 0.02),
        'router_w': nrm((D_MODEL, N_EXPERTS), D_MODEL ** -0.5),
        'router_b': nrm((N_EXPERTS,), 0.01),
        'moe_w1': nrm((L, N_EXPERTS, D_MODEL, D_EXPERT), D_MODEL ** -0.5),
        'moe_w3': nrm((L, N_EXPERTS, D_MODEL, D_EXPERT), D_MODEL ** -0.5),
        'moe_w2': nrm((L, N_EXPERTS, D_EXPERT, D_MODEL), D_EXPERT ** -0.5),
        'final_norm_g': 1.0 + nrm((D_MODEL,), 0.02),
    }


def reference(x, c, ctx, c_ctx, w_ada, b_ada, norm1_g, norm2_g, w_in, w_out,
              lru_conv_w, lru_conv_b, lru_wr, lru_br, lru_wi, lru_bi, lru_lam,
              da_lam, da_subln_g, sg_norm_g, sg_w, sg_b, hg_lb, hg_norm_g,
              router_w, router_b, moe_w1, moe_w3, moe_w2, final_norm_g):
    seq = x.shape[1]
    rows = seq // GRID_W
    row_ids = jnp.repeat(jnp.arange(rows, dtype=F32), GRID_W)
    col_ids = jnp.tile(jnp.arange(GRID_W, dtype=F32), rows)
    n_freq = DA_QD // 4
    freqs = ROPE_THETA ** (-jnp.arange(n_freq, dtype=F32) / n_freq)
    ang = jnp.stack([row_ids[:, None] * freqs, col_ids[:, None] * freqs], axis=1)
    cos = jnp.cos(ang).astype(x.dtype)
    sin = jnp.sin(ang).astype(x.dtype)
    lb_cum = jnp.cumsum(jax.nn.softmax(hg_lb.astype(F32), axis=1), axis=1)
    lb_all = lb_cum - lb_cum[:, :1]
    silu_c = jax.nn.silu(c)
    silu_cc = jax.nn.silu(c_ctx)
    xc = ctx
    for l in range(DEPTH):
        ctx_out = l < DEPTH - 1
        mod = (silu_c @ w_ada[l] + b_ada[l])[:, None, :]
        mod_c = silu_cc @ w_ada[l] + b_ada[l]
        sh1, sc1, gt1, sh2, sc2, gt2 = jnp.split(mod, 6, axis=-1)
        shc1, scc1, gtc1, shc2, scc2, gtc2 = jnp.split(mod_c, 6, axis=-1)
        h = modulate(rms_norm(x, norm1_g[l]), sh1, sc1)
        hc = modulate(rms_norm(xc, norm1_g[l]), shc1, scc1)
        za, zb, zs, zh = jnp.split(h @ w_in[l], SPLITS, axis=-1)
        zca, zcb, zcs, zch = jnp.split(hc @ w_in[l], SPLITS, axis=-1)
        ya, yca = rglru_mixer(za, zca, lru_conv_w[l], lru_conv_b[l], lru_wr[l], lru_br[l],
                              lru_wi[l], lru_bi[l], lru_lam[l], ctx_out)
        lam_init = 0.8 - 0.6 * math.exp(-0.3 * l)
        yb, ycb = diff_attn_mixer(zb, zcb, da_lam[l], da_subln_g[l], lam_init, cos, sin, ctx_out)
        ys = spatial_gating(zs, sg_norm_g[l], sg_w[l], sg_b[l])
        yh, ych = hgrn2_mixer(zh, zch, lb_all[:, l], hg_norm_g[l], ctx_out)
        x = x + gt1 * (jnp.concatenate([ya, yb, ys, yh], axis=-1) @ w_out[l])
        h2 = modulate(rms_norm(x, norm2_g[l]), sh2, sc2)
        x = x + gt2 * moe(h2, router_w, router_b, moe_w1[l], moe_w3[l], moe_w2[l])
        if ctx_out:
            ycs = spatial_gating(zcs, sg_norm_g[l], sg_w[l], sg_b[l])
            xc = xc + gtc1 * (jnp.concatenate([yca, ycb, ycs, ych], axis=-1) @ w_out[l])
            hc2 = modulate(rms_norm(xc, norm2_g[l]), shc2, scc2)
            xc = xc + gtc2 * moe(hc2, router_w, router_b, moe_w1[l], moe_w3[l], moe_w2[l])
    return rms_norm(x, final_norm_g)
```

```cpp
#include <hip/hip_runtime.h>
#include <hip/hip_cooperative_groups.h>
#include <cstdio>
#include <cstdint>
namespace cg = cooperative_groups;

constexpr int D = 1024, NB = 8, T = 2048, TC = 256, LB = T + TC  , R = NB * LB  ;
constexpr int NZ = 3072, NE = 16, DE = 512;
constexpr float EPS = 1e-6f;
constexpr int ZA_X = 0, ZA_G = 256, ZB_Q = 512, ZB_K = 768, ZB_V = 1024, ZC_U = 1280, ZC_V = 1536, ZD_Q = 1792, ZD_FF = 2048, ZD_FB = 2304, ZD_I = 2560, ZD_G = 2816;
enum { I_X = 0, I_C, I_CTX, I_CCTX, I_WADA, I_BADA, I_N1G, I_N2G, I_WIN, I_WOUT, I_CONVW, I_CONVB, I_WR, I_BR, I_WI, I_BI, I_LAM,
       I_DALAM, I_DASUB, I_SGNG, I_SGW, I_SGB, I_HGLB, I_HGNG, I_RW, I_RB, I_W1, I_W3, I_W2, I_FNG, N_IN };

typedef unsigned short bf16_t;
constexpr size_t MiB = 1u << 20;
constexpr size_t WS_MOD = 0;
constexpr size_t WS_GATE = 1 * MiB;
constexpr size_t WS_X = 3 * MiB;
constexpr size_t WS_H = WS_X + (size_t)R * D * 4;
constexpr size_t WS_Z = WS_H + (size_t)R * D * 2;
constexpr size_t WS_Y = WS_Z + (size_t)R * NZ * 2;
constexpr size_t WS_S0 = WS_Y + (size_t)R * D * 2;
constexpr size_t WS_END = WS_S0 + 3 * (size_t)R * 256 * 4;

struct P { const float* in[N_IN]; float* out; unsigned char* ws; };

__device__ __forceinline__ float bf2f(bf16_t v) { return __uint_as_float(((unsigned)v) << 16); }
__device__ __forceinline__ bf16_t f2bf(float f) { unsigned u = __float_as_uint(f); return (bf16_t)((u + 0x7fffu + ((u >> 16) & 1u)) >> 16); }
__device__ __forceinline__ float sigmoidf_(float x) { return 1.f / (1.f + expf(-x)); }
__device__ __forceinline__ float siluf_(float x) { return x / (1.f + expf(-x)); }
__device__ __forceinline__ float geluf_(float x) { return 0.5f * x * (1.f + tanhf(0.7978845608028654f * (x + 0.044715f * x * x * x))); }
__device__ __forceinline__ float wave_sum(float v) {
#pragma unroll
    for (int o = 1; o < 64; o <<= 1) v += __shfl_xor(v, o);
    return v;
}
__device__ __forceinline__ int row_mi(int r) { const int b = r / LB, j = r - b * LB; return j < TC ? 8 : b; }

#define NT 512
#define NWV 8

__device__ __forceinline__ void ph_init(const P& p) {
    int tidx = threadIdx.x; asm volatile("" : "+v"(tidx));
    float* X = (float*)(p.ws + WS_X);
    const size_t n4 = (size_t)R * D / 4;
    for (size_t i = (size_t)blockIdx.x * NT + tidx; i < n4; i += (size_t)gridDim.x * NT) {
        const size_t e = i * 4; const int r = (int)(e / D), c = (int)(e % D); const int b = r / LB, j = r - b * LB;
        const float* src = (j < TC) ? p.in[I_CTX] + ((size_t)b * TC + j) * D + c : p.in[I_X] + ((size_t)b * T + (j - TC)) * D + c;
        *(float4*)(X + e) = *(const float4*)src;
    }
}

__device__ __forceinline__ void ph_mod(const P& p, float* sm) {
    int tidx = threadIdx.x; asm volatile("" : "+v"(tidx));
    float* MOD = (float*)(p.ws + WS_MOD);
    for (int i = tidx; i < 9 * D; i += NT) { const int mi = i / D, k = i % D; const float c = mi < 8 ? p.in[I_C][mi * D + k] : p.in[I_CCTX][k]; sm[i] = siluf_(c); }
    __syncthreads();
    for (int it = blockIdx.x * NT + tidx; it < 2 * 6 * D; it += gridDim.x * NT) {
        const int l = it / (6 * D), n = it % (6 * D);
        const float* W = p.in[I_WADA] + (size_t)l * D * 6 * D + n;
        float acc[9];
#pragma unroll
        for (int m = 0; m < 9; ++m) acc[m] = 0.f;
        for (int k = 0; k < D; ++k) { const float w = W[(size_t)k * 6 * D];
#pragma unroll
            for (int m = 0; m < 9; ++m) acc[m] += sm[m * D + k] * w; }
        const float bb = p.in[I_BADA][l * 6 * D + n];
#pragma unroll
        for (int m = 0; m < 9; ++m) MOD[((size_t)l * 9 + m) * 6 * D + n] = acc[m] + bb;
    }
    __syncthreads();
}

__device__ __forceinline__ void ph_norm1(const P& p, int l) {
    int tidx = threadIdx.x; asm volatile("" : "+v"(tidx));
    const float* X = (const float*)(p.ws + WS_X); bf16_t* H = (bf16_t*)(p.ws + WS_H);
    const float* MOD = (const float*)(p.ws + WS_MOD) + (size_t)l * 9 * 6 * D; const float* g = p.in[I_N1G] + l * D;
    const int lane = tidx & 63, wv = tidx >> 6;
    for (int r = blockIdx.x * NWV + wv; r < R; r += gridDim.x * NWV) {
        const float* m = MOD + (size_t)row_mi(r) * 6 * D;
        float4 v[4]; float ss = 0.f;
#pragma unroll
        for (int q = 0; q < 4; ++q) { v[q] = *(const float4*)(X + (size_t)r * D + (lane + 64 * q) * 4); ss += v[q].x * v[q].x + v[q].y * v[q].y + v[q].z * v[q].z + v[q].w * v[q].w; }
        const float rs = rsqrtf(wave_sum(ss) * (1.f / D) + EPS);
#pragma unroll
        for (int q = 0; q < 4; ++q) { const int c = (lane + 64 * q) * 4; const float xv[4] = {v[q].x, v[q].y, v[q].z, v[q].w}; bf16_t o[4];
#pragma unroll
            for (int i = 0; i < 4; ++i) o[i] = f2bf(xv[i] * rs * g[c + i] * (1.f + m[D + c + i]) + m[c + i]);
            *(uint2*)(H + (size_t)r * D + c) = make_uint2((unsigned)o[0] | ((unsigned)o[1] << 16), (unsigned)o[2] | ((unsigned)o[3] << 16)); }
    }
}

template <int mode> __device__ __forceinline__ void ph_gemm(const P& p, int l, const bf16_t* A, int lda, const float* B, const float* B2, int ldb, int N, int K, int e, bool skip_ctx, float* sm) {
    int tidx = threadIdx.x; asm volatile("" : "+v"(tidx));
    float* As = sm;
    float* Bs = sm + 16 * 132;
    float* Bs2 = Bs + 16 * 64;
    const int tid = tidx, ty = tid >> 4, tx = tid & 15;
    const int ntn = N / 64, ntiles = (R / 128) * ntn;
    float* X = (float*)(p.ws + WS_X); const float* MOD = (const float*)(p.ws + WS_MOD) + (size_t)l * 9 * 6 * D; const float* GATE = (const float*)(p.ws + WS_GATE);
    bf16_t* Zo = (bf16_t*)(p.ws + WS_Z);
    for (int tile = blockIdx.x; tile < ntiles; tile += gridDim.x) {
        const int tm = tile / ntn, tn = tile % ntn, r0 = tm * 128, n0 = tn * 64;
        if (skip_ctx && (r0 % LB) < TC) continue;
        float acc[4][4], acc2[4][4];
#pragma unroll
        for (int i = 0; i < 4; ++i)
#pragma unroll
            for (int j = 0; j < 4; ++j) { acc[i][j] = 0.f; acc2[i][j] = 0.f; }
        for (int k0 = 0; k0 < K; k0 += 16) {
            { const int row = tid >> 2, kq = (tid & 3) * 4; const uint2 v = *(const uint2*)(A + (size_t)(r0 + row) * lda + k0 + kq);
              As[(kq + 0) * 132 + row] = bf2f((bf16_t)(v.x & 0xffff)); As[(kq + 1) * 132 + row] = bf2f((bf16_t)(v.x >> 16));
              As[(kq + 2) * 132 + row] = bf2f((bf16_t)(v.y & 0xffff)); As[(kq + 3) * 132 + row] = bf2f((bf16_t)(v.y >> 16)); }
            { const int kk = tid >> 5, n = (tid & 31) * 2; const float2 v = *(const float2*)(B + (size_t)(k0 + kk) * ldb + n0 + n); Bs[kk * 64 + n] = v.x; Bs[kk * 64 + n + 1] = v.y;
              if (mode == 2) { const float2 w = *(const float2*)(B2 + (size_t)(k0 + kk) * ldb + n0 + n); Bs2[kk * 64 + n] = w.x; Bs2[kk * 64 + n + 1] = w.y; } }
            __syncthreads();
#pragma unroll 2
            for (int kk = 0; kk < 16; ++kk) {
                const float4 a = *(const float4*)(As + kk * 132 + ty * 4); const float4 b = *(const float4*)(Bs + kk * 64 + tx * 4);
                const float av[4] = {a.x, a.y, a.z, a.w}, bv[4] = {b.x, b.y, b.z, b.w};
#pragma unroll
                for (int i = 0; i < 4; ++i)
#pragma unroll
                    for (int j = 0; j < 4; ++j) acc[i][j] += av[i] * bv[j];
                if (mode == 2) { const float4 b2 = *(const float4*)(Bs2 + kk * 64 + tx * 4); const float b2v[4] = {b2.x, b2.y, b2.z, b2.w};
#pragma unroll
                    for (int i = 0; i < 4; ++i)
#pragma unroll
                        for (int j = 0; j < 4; ++j) acc2[i][j] += av[i] * b2v[j]; }
            }
            __syncthreads();
        }
#pragma unroll
        for (int i = 0; i < 4; ++i) {
            const int r = r0 + ty * 4 + i; const int mi = row_mi(r);
#pragma unroll
            for (int j = 0; j < 4; ++j) {
                const int n = n0 + tx * 4 + j;
                if (mode == 0) Zo[(size_t)r * NZ + n] = f2bf(acc[i][j]);
                else if (mode == 1) X[(size_t)r * D + n] += MOD[(size_t)mi * 6 * D + 2 * D + n] * acc[i][j];
                else if (mode == 2) Zo[(size_t)r * DE + n] = f2bf(siluf_(acc[i][j]) * acc2[i][j]);
                else X[(size_t)r * D + n] += MOD[(size_t)mi * 6 * D + 5 * D + n] * GATE[(size_t)r * NE + e] * acc[i][j];
            }
        }
    }
}

__device__ __forceinline__ void ph_rope(const P& p) {
    int tidx = threadIdx.x; asm volatile("" : "+v"(tidx));
    bf16_t* Z = (bf16_t*)(p.ws + WS_Z);
    const int total = NB * T * 256;
    for (int it = blockIdx.x * NT + tidx; it < total; it += gridDim.x * NT) {
        const int pr = it & 255, rt = it >> 8; const int b = rt / T, t = rt % T;
        const int f = pr & 7, a = (pr >> 3) & 1, n = (pr >> 4) & 1, h = (pr >> 5) & 3, qk = pr >> 7;
        const int col = (qk ? ZB_K : ZB_Q) + h * 64 + n * 32 + a * 16 + f;
        bf16_t* zp = Z + (size_t)(b * LB + TC + t) * NZ + col;
        const float pos = (float)(a == 0 ? (t / 64) : (t % 64));
        const float freq = expf(-(float)f * 0.125f * 9.210340371976184f);
        const float ang = pos * freq; const float c = cosf(ang), s = sinf(ang);
        const float x1 = bf2f(zp[0]), x2 = bf2f(zp[8]);
        zp[0] = f2bf(x1 * c - x2 * s); zp[8] = f2bf(x2 * c + x1 * s);
    }
}

__device__ __forceinline__ void ph_lru_gates(const P& p, int l, float* sm) {
    int tidx = threadIdx.x; asm volatile("" : "+v"(tidx));
    const bf16_t* Z = (const bf16_t*)(p.ws + WS_Z); bf16_t* G = (bf16_t*)(p.ws + WS_H);
    const float* cw = p.in[I_CONVW] + l * 4 * 256; const float* cb = p.in[I_CONVB] + l * 256;
    const int rr = tidx >> 8, w = tidx & 255, h = w >> 6, jw = w & 63;
    for (int it = blockIdx.x; it < R / 2; it += gridDim.x) {
        const int r = it * 2 + rr; const int j = r % LB; const int lo = j < TC ? 0 : TC, hi = j < TC ? TC : LB;
        float u = cb[w];
#pragma unroll
        for (int q = 0; q < 4; ++q) { const int jj = j + q - 2; if (jj >= lo && jj < hi) u += bf2f(Z[(size_t)(r + q - 2) * NZ + ZA_X + w]) * cw[q * 256 + w]; }
        sm[rr * 256 + w] = u;
        __syncthreads();
#pragma unroll 1
        for (int d = 0; d < 2; ++d) {
            const float* wr = p.in[I_WR] + (((size_t)(l * 2 + d) * 4 + h) * 64) * 64 + jw; const float* wi = p.in[I_WI] + (((size_t)(l * 2 + d) * 4 + h) * 64) * 64 + jw;
            float ar = p.in[I_BR][(l * 2 + d) * 256 + w], ai = p.in[I_BI][(l * 2 + d) * 256 + w];
#pragma unroll 4
            for (int i = 0; i < 64; ++i) { const float uu = sm[rr * 256 + h * 64 + i]; ar += uu * wr[i * 64]; ai += uu * wi[i * 64]; }
            G[((size_t)(d * 2 + 0) * R + r) * 256 + w] = f2bf(sigmoidf_(ar));
            G[((size_t)(d * 2 + 1) * R + r) * 256 + w] = f2bf(sigmoidf_(ai));
        }
        __syncthreads();
    }
}

__device__ __forceinline__ void ph_lru_scan(const P& p, int l) {
    int tidx = threadIdx.x; asm volatile("" : "+v"(tidx));
    const int vb = gridDim.x - 1 - blockIdx.x; const int gt = vb * NT + tidx;
    if (gt >= NB * 256) return;
    const int b = gt >> 8, w = gt & 255;
    const bf16_t* Z = (const bf16_t*)(p.ws + WS_Z); const bf16_t* G = (const bf16_t*)(p.ws + WS_H); bf16_t* Y = (bf16_t*)(p.ws + WS_Y);
    float* HF = (float*)(p.ws + WS_S0);
    const float* cw = p.in[I_CONVW] + l * 4 * 256; const float cbv = p.in[I_CONVB][l * 256 + w];
    const float c0 = cw[w], c1 = cw[256 + w], c2 = cw[512 + w], c3 = cw[768 + w];
    for (int d = 0; d < 2; ++d) {
        const float sp = log1pf(expf(-p.in[I_LAM][(l * 2 + d) * 256 + w]));
        float hst = 0.f;
        for (int s = 0; s < LB; ++s) {
            int j; if (d == 0) j = s; else j = s < TC ? (TC - 1 - s) : (LB - 1 - (s - TC));
            const int r = b * LB + j; const int lo = j < TC ? 0 : TC, hi = j < TC ? TC : LB;
            float u = cbv;
            if (j - 2 >= lo) u += bf2f(Z[(size_t)(r - 2) * NZ + ZA_X + w]) * c0;
            if (j - 1 >= lo) u += bf2f(Z[(size_t)(r - 1) * NZ + ZA_X + w]) * c1;
            u += bf2f(Z[(size_t)r * NZ + ZA_X + w]) * c2;
            if (j + 1 < hi) u += bf2f(Z[(size_t)(r + 1) * NZ + ZA_X + w]) * c3;
            const float rg = bf2f(G[((size_t)(d * 2 + 0) * R + r) * 256 + w]), ig = bf2f(G[((size_t)(d * 2 + 1) * R + r) * 256 + w]);
            const float la = -8.f * rg * sp; const float a = expf(la); const float bc = sqrtf(-expm1f(2.f * la)) * ig * u;
            hst = a * hst + bc;
            if (d == 0) HF[(size_t)r * 256 + w] = hst;
            else { const float hs = HF[(size_t)r * 256 + w] + hst; Y[(size_t)r * D + w] = f2bf(hs * geluf_(bf2f(Z[(size_t)r * NZ + ZA_G + w]))); }
        }
    }
}

__device__ __forceinline__ void ph_sg(const P& p, int l, float* sm) {
    int tidx = threadIdx.x; asm volatile("" : "+v"(tidx));
    const bf16_t* Z = (const bf16_t*)(p.ws + WS_Z); bf16_t* Y = (bf16_t*)(p.ws + WS_Y);
    float* vn = sm;
    const float* ng = p.in[I_SGNG] + l * 256;
    const int tid = tidx, q = tid >> 2, part = tid & 3;
    for (int unit = blockIdx.x; unit < NB * 18 * 4; unit += gridDim.x) {
        const int h = unit & 3, bc = unit >> 2, b = bc / 18, ck = bc % 18;
        if (l == 1 && ck < 2) continue;
        const int r0 = b * LB + ck * 128;
        { const bf16_t* zv = Z + (size_t)(r0 + q) * NZ + ZC_V; float ss = 0.f;
          for (int c = part * 64; c < part * 64 + 64; ++c) { const float gv = geluf_(bf2f(zv[c])); ss += gv * gv; }
          ss += __shfl_xor(ss, 1); ss += __shfl_xor(ss, 2);
          const float rs = rsqrtf(ss * (1.f / 256.f) + EPS);
          for (int i = 0; i < 16; ++i) { const int c = part * 16 + i; vn[q * 64 + c] = geluf_(bf2f(zv[h * 64 + c])) * rs * ng[h * 64 + c]; } }
        __syncthreads();
        { const int pp = q; const float* wsp = p.in[I_SGW] + ((size_t)(l * 4 + h) * 128 + pp) * 128; float acc[16];
#pragma unroll
          for (int i = 0; i < 16; ++i) acc[i] = 0.f;
          for (int qq = 0; qq < 128; ++qq) { const float wv = wsp[qq];
#pragma unroll
              for (int i = 0; i < 16; ++i) acc[i] += wv * vn[qq * 64 + part * 16 + i]; }
          const float bsp = p.in[I_SGB][(l * 4 + h) * 128 + pp];
          const bf16_t* zu = Z + (size_t)(r0 + pp) * NZ + ZC_U + h * 64 + part * 16; bf16_t* yo = Y + (size_t)(r0 + pp) * D + 512 + h * 64 + part * 16;
#pragma unroll
          for (int i = 0; i < 16; ++i) yo[i] = f2bf(geluf_(bf2f(zu[i])) * (acc[i] + bsp)); }
        __syncthreads();
    }
}

__device__ __forceinline__ void ph_attn(const P& p, int l) {
    int tidx = threadIdx.x; asm volatile("" : "+v"(tidx));
    const bf16_t* Z = (const bf16_t*)(p.ws + WS_Z); bf16_t* Y = (bf16_t*)(p.ws + WS_Y);
    const float lam_init = l == 0 ? 0.2f : (0.8f - 0.6f * 0.7408182206817179f);
    const float* dl = p.in[I_DALAM] + l * 4 * 32; float s01 = 0.f, s23 = 0.f;
    for (int i = 0; i < 32; ++i) { s01 += dl[i] * dl[32 + i]; s23 += dl[64 + i] * dl[96 + i]; }
    const float lam = expf(s01) - expf(s23) + lam_init;
    const float* subg = p.in[I_DASUB] + l * 64;
    const int nun = NB * 4 * 18;
    const int tid = tidx, qi = tid >> 2, sl = tid & 3;
    for (int unit = blockIdx.x; unit < nun; unit += gridDim.x) {
        const int qb = unit % 18, bh = unit / 18, h = bh & 3, b = bh >> 2;
        if (l == 1 && qb < 2) continue;
        const int j = qb * 128 + qi; const int nkeys = qb < 2 ? TC : LB;
        const int r = b * LB + j;
        float q[64];
        { const bf16_t* zq = Z + (size_t)r * NZ + ZB_Q + h * 64;
#pragma unroll
          for (int i = 0; i < 64; ++i) q[i] = bf2f(zq[i]) * 0.17677669529663687f; }
        float m1 = -1e30f, l1 = 0.f, m2 = -1e30f, l2 = 0.f, a1[16], a2[16];
#pragma unroll
        for (int i = 0; i < 16; ++i) { a1[i] = 0.f; a2[i] = 0.f; }
        for (int kj = 0; kj < nkeys; ++kj) {
            const bf16_t* zk = Z + (size_t)(b * LB + kj) * NZ + ZB_K + h * 64; const bf16_t* zv = Z + (size_t)(b * LB + kj) * NZ + ZB_V + h * 64 + sl * 16;
            float s1 = 0.f, s2 = 0.f;
#pragma unroll
            for (int i = 0; i < 32; ++i) { s1 += q[i] * bf2f(zk[i]); s2 += q[32 + i] * bf2f(zk[32 + i]); }
            const float m1n = fmaxf(m1, s1), m2n = fmaxf(m2, s2);
            const float c1 = expf(m1 - m1n), c2 = expf(m2 - m2n), p1 = expf(s1 - m1n), p2 = expf(s2 - m2n);
            l1 = l1 * c1 + p1; l2 = l2 * c2 + p2; m1 = m1n; m2 = m2n;
#pragma unroll
            for (int i = 0; i < 16; ++i) { const float v = bf2f(zv[i]); a1[i] = a1[i] * c1 + p1 * v; a2[i] = a2[i] * c2 + p2 * v; }
        }
        float o[16], ss = 0.f; const float i1 = 1.f / l1, i2 = lam / l2;
#pragma unroll
        for (int i = 0; i < 16; ++i) { o[i] = a1[i] * i1 - a2[i] * i2; ss += o[i] * o[i]; }
        ss += __shfl_xor(ss, 1); ss += __shfl_xor(ss, 2);
        const float rs = rsqrtf(ss * (1.f / 64.f) + EPS) * (1.f - lam_init);
        bf16_t* yo = Y + (size_t)r * D + 256 + h * 64 + sl * 16;
#pragma unroll
        for (int i = 0; i < 16; ++i) yo[i] = f2bf(o[i] * rs * subg[sl * 16 + i]);
    }
}

__device__ __forceinline__ void ph_hg_scan(const P& p, int l) {
    int tidx = threadIdx.x; asm volatile("" : "+v"(tidx));
    const int wv = tidx >> 6, lane = tidx & 63; const int gw = blockIdx.x * NWV + wv;
    if (gw >= NB * 4 * 2) return;
    const int d = gw & 1, h = (gw >> 1) & 3, b = gw >> 3;
    const bf16_t* Z = (const bf16_t*)(p.ws + WS_Z); float* O = (float*)(p.ws + WS_S0) + (size_t)(1 + d) * R * 256;
    float lb = 0.f;
    if (l == 1) { const float* hl = p.in[I_HGLB] + (size_t)d * 2 * 256 + h * 64 + lane; lb = sigmoidf_(hl[256] - hl[0]); }
    float S[64];
#pragma unroll
    for (int i = 0; i < 64; ++i) S[i] = 0.f;
    const int fcol = (d == 0 ? ZD_FF : ZD_FB) + h * 64 + lane;
    for (int s = 0; s < LB; ++s) {
        int j; if (d == 0) j = s; else j = s < TC ? (TC - 1 - s) : (LB - 1 - (s - TC));
        const bf16_t* zr = Z + (size_t)(b * LB + j) * NZ;
        const float f = lb + (1.f - lb) * sigmoidf_(bf2f(zr[fcol])); const float kk = 1.f - f;
        const float qv = bf2f(zr[ZD_Q + h * 64 + lane]) * 0.125f; const float vv = bf2f(zr[ZD_I + h * 64 + lane]);
        float o = 0.f;
#pragma unroll
        for (int i = 0; i < 64; ++i) {
            const float fd = __int_as_float(__builtin_amdgcn_readlane(__float_as_int(f), i)), kd = __int_as_float(__builtin_amdgcn_readlane(__float_as_int(kk), i)), qd = __int_as_float(__builtin_amdgcn_readlane(__float_as_int(qv), i));
            S[i] = fd * S[i] + kd * vv; o += S[i] * qd;
        }
        O[(size_t)(b * LB + j) * 256 + h * 64 + lane] = o;
    }
}

__device__ __forceinline__ void ph_hg_out(const P& p, int l) {
    int tidx = threadIdx.x; asm volatile("" : "+v"(tidx));
    const bf16_t* Z = (const bf16_t*)(p.ws + WS_Z); bf16_t* Y = (bf16_t*)(p.ws + WS_Y);
    const float* OF = (const float*)(p.ws + WS_S0) + (size_t)R * 256; const float* OB = OF + (size_t)R * 256;
    const float* gn = p.in[I_HGNG] + l * 256;
    const int lane = tidx & 63, wv = tidx >> 6;
    for (int it = blockIdx.x * NWV + wv; it < R * 4; it += gridDim.x * NWV) {
        const int r = it >> 2, h = it & 3; const size_t o = (size_t)r * 256 + h * 64 + lane;
        const float v = OF[o] + OB[o]; const float rs = rsqrtf(wave_sum(v * v) * (1.f / 64.f) + EPS);
        Y[(size_t)r * D + 768 + h * 64 + lane] = f2bf(v * rs * gn[h * 64 + lane] * siluf_(bf2f(Z[(size_t)r * NZ + ZD_G + h * 64 + lane])));
    }
}

__device__ __forceinline__ void ph_router(const P& p, int l) {
    int tidx = threadIdx.x; asm volatile("" : "+v"(tidx));
    const float* X = (const float*)(p.ws + WS_X); bf16_t* H = (bf16_t*)(p.ws + WS_H); float* GATE = (float*)(p.ws + WS_GATE);
    const float* MOD = (const float*)(p.ws + WS_MOD) + (size_t)l * 9 * 6 * D; const float* g = p.in[I_N2G] + l * D;
    const float* RW = p.in[I_RW]; const float* RB = p.in[I_RB];
    const int lane = tidx & 63, wv = tidx >> 6;
    for (int r = blockIdx.x * NWV + wv; r < R; r += gridDim.x * NWV) {
        if (l == 1 && (r % LB) < TC) continue;
        const float* m = MOD + (size_t)row_mi(r) * 6 * D;
        float4 v[4]; float ss = 0.f;
#pragma unroll
        for (int q = 0; q < 4; ++q) { v[q] = *(const float4*)(X + (size_t)r * D + (lane + 64 * q) * 4); ss += v[q].x * v[q].x + v[q].y * v[q].y + v[q].z * v[q].z + v[q].w * v[q].w; }
        const float rs = rsqrtf(wave_sum(ss) * (1.f / D) + EPS);
        float lg[16];
#pragma unroll
        for (int e = 0; e < 16; ++e) lg[e] = 0.f;
#pragma unroll
        for (int q = 0; q < 4; ++q) { const int c = (lane + 64 * q) * 4; const float xv[4] = {v[q].x, v[q].y, v[q].z, v[q].w}; bf16_t o[4];
#pragma unroll
            for (int i = 0; i < 4; ++i) { const float hv = xv[i] * rs * g[c + i] * (1.f + m[4 * D + c + i]) + m[3 * D + c + i]; o[i] = f2bf(hv);
                const float4* rw = (const float4*)(RW + (size_t)(c + i) * 16);
#pragma unroll
                for (int e4 = 0; e4 < 4; ++e4) { const float4 w4 = rw[e4]; lg[e4 * 4 + 0] += hv * w4.x; lg[e4 * 4 + 1] += hv * w4.y; lg[e4 * 4 + 2] += hv * w4.z; lg[e4 * 4 + 3] += hv * w4.w; } }
            *(uint2*)(H + (size_t)r * D + c) = make_uint2((unsigned)o[0] | ((unsigned)o[1] << 16), (unsigned)o[2] | ((unsigned)o[3] << 16)); }
#pragma unroll
        for (int e = 0; e < 16; ++e) lg[e] = wave_sum(lg[e]) + RB[e];
        float mx = lg[0];
#pragma unroll
        for (int e = 1; e < 16; ++e) mx = fmaxf(mx, lg[e]);
        float sc[16], sum = 0.f;
#pragma unroll
        for (int e = 0; e < 16; ++e) { sc[e] = expf(lg[e] - mx); sum += sc[e]; }
        const float inv = 1.f / sum;
#pragma unroll
        for (int e = 0; e < 16; ++e) sc[e] *= inv;
        int gsel = 0; float gbest = -1.f;
#pragma unroll
        for (int gI = 0; gI < 4; ++gI) { float t1 = -1.f, t2 = -1.f;
#pragma unroll
            for (int i = 0; i < 4; ++i) { const float s = sc[gI * 4 + i]; if (s > t1) { t2 = t1; t1 = s; } else if (s > t2) t2 = s; }
            const float gs = t1 + t2; if (gs > gbest) { gbest = gs; gsel = gI; } }
        float w1 = -1.f, w2 = -1.f; int i1 = 0, i2 = 0;
#pragma unroll
        for (int e = 0; e < 16; ++e) { if ((e >> 2) == gsel) { const float s = sc[e]; if (s > w1) { w2 = w1; i2 = i1; w1 = s; i1 = e; } else if (s > w2) { w2 = s; i2 = e; } } }
        const float wn = 1.f / (w1 + w2);
        if (lane < 16) GATE[(size_t)r * NE + lane] = lane == i1 ? w1 * wn : (lane == i2 ? w2 * wn : 0.f);
    }
}

__device__ __forceinline__ void ph_final(const P& p) {
    int tidx = threadIdx.x; asm volatile("" : "+v"(tidx));
    const float* X = (const float*)(p.ws + WS_X); const float* g = p.in[I_FNG];
    const int lane = tidx & 63, wv = tidx >> 6;
    for (int it = blockIdx.x * NWV + wv; it < NB * T; it += gridDim.x * NWV) {
        const int b = it / T, t = it % T; const int r = b * LB + TC + t;
        float4 v[4]; float ss = 0.f;
#pragma unroll
        for (int q = 0; q < 4; ++q) { v[q] = *(const float4*)(X + (size_t)r * D + (lane + 64 * q) * 4); ss += v[q].x * v[q].x + v[q].y * v[q].y + v[q].z * v[q].z + v[q].w * v[q].w; }
        const float rs = rsqrtf(wave_sum(ss) * (1.f / D) + EPS);
#pragma unroll
        for (int q = 0; q < 4; ++q) { const int c = (lane + 64 * q) * 4; const float4 gg = *(const float4*)(g + c);
            *(float4*)(p.out + (size_t)it * D + c) = make_float4(v[q].x * rs * gg.x, v[q].y * rs * gg.y, v[q].z * rs * gg.z, v[q].w * rs * gg.w); }
    }
}

__global__ void __launch_bounds__(NT) fwd_kernel(P p) {
    cg::grid_group grid = cg::this_grid();
    __shared__ __attribute__((aligned(16))) float sm[9 * 1024];
    ph_init(p);
    ph_mod(p, sm);
    grid.sync();
    const bf16_t* H = (const bf16_t*)(p.ws + WS_H); const bf16_t* Y = (const bf16_t*)(p.ws + WS_Y); const bf16_t* HE = (const bf16_t*)(p.ws + WS_Z);
#pragma unroll 1
    for (int l = 0; l < 2; ++l) {
        ph_norm1(p, l);
        grid.sync();
        ph_gemm<0>(p, l, H, D, p.in[I_WIN] + (size_t)l * D * NZ, nullptr, NZ, NZ, D, 0, false, sm);
        grid.sync();
        ph_rope(p); ph_lru_gates(p, l, sm); ph_sg(p, l, sm);
        grid.sync();
        ph_hg_scan(p, l); ph_lru_scan(p, l); ph_attn(p, l);
        grid.sync();
        ph_hg_out(p, l);
        grid.sync();
        ph_gemm<1>(p, l, Y, D, p.in[I_WOUT] + (size_t)l * D * D, nullptr, D, D, D, 0, l == 1, sm);
        grid.sync();
        ph_router(p, l);
        grid.sync();
#pragma unroll 1
        for (int e = 0; e < NE; ++e) {
            ph_gemm<2>(p, l, H, D, p.in[I_W1] + ((size_t)l * NE + e) * D * DE, p.in[I_W3] + ((size_t)l * NE + e) * D * DE, DE, DE, D, e, l == 1, sm);
            grid.sync();
            ph_gemm<3>(p, l, HE, DE, p.in[I_W2] + ((size_t)l * NE + e) * DE * D, nullptr, D, D, DE, e, l == 1, sm);
            grid.sync();
        }
    }
    ph_final(p);
}

extern "C" void kernel_launch(void* const* d_in, const int* in_sizes, int n_in, void* d_out, int out_size, void* d_ws, size_t ws_size, hipStream_t stream) {
    if (n_in != N_IN || ws_size < WS_END) { fprintf(stderr, "kernel_launch: bad n_in %d or ws %zu < %zu\n", n_in, ws_size, (size_t)WS_END); return; }
    P p{};
    for (int i = 0; i < N_IN; ++i) p.in[i] = (const float*)d_in[i];
    p.out = (float*)d_out; p.ws = (unsigned char*)d_ws;
    void* args[] = {&p};
    hipError_t e = hipLaunchCooperativeKernel((void*)fwd_kernel, dim3(256), dim3(NT), args, 0, stream);
    if (e != hipSuccess) fprintf(stderr, "cooperative launch failed: %s\n", hipGetErrorString(e));
}
```

```cpp
#include <hip/hip_runtime.h>
#include <hip/hip_cooperative_groups.h>
#include <cstdio>
#include <cstdint>
namespace cg = cooperative_groups;

constexpr int D = 1024, NB = 8, T = 2048, TC = 256, LB = T + TC  , R = NB * LB  ;
constexpr int NZ = 3072, NE = 16, DE = 512;
constexpr float EPS = 1e-6f;
constexpr int ZA_X = 0, ZA_G = 256, ZB_Q = 512, ZB_K = 768, ZB_V = 1024, ZC_U = 1280, ZC_V = 1536, ZD_Q = 1792, ZD_FF = 2048, ZD_FB = 2304, ZD_I = 2560, ZD_G = 2816;
enum { I_X = 0, I_C, I_CTX, I_CCTX, I_WADA, I_BADA, I_N1G, I_N2G, I_WIN, I_WOUT, I_CONVW, I_CONVB, I_WR, I_BR, I_WI, I_BI, I_LAM,
       I_DALAM, I_DASUB, I_SGNG, I_SGW, I_SGB, I_HGLB, I_HGNG, I_RW, I_RB, I_W1, I_W3, I_W2, I_FNG, N_IN };

typedef unsigned short bf16_t;
constexpr size_t MiB = 1u << 20;
constexpr size_t WS_MOD = 0;
constexpr size_t WS_CNT = 512 * 1024;
constexpr size_t WS_GP = 1 * MiB;
constexpr size_t WS_LISTP = WS_GP + (size_t)R * 8;
constexpr size_t WS_X = 3 * MiB;
constexpr size_t WS_H = WS_X + (size_t)R * D * 4;
constexpr size_t WS_Z = WS_H + (size_t)R * D * 2;
constexpr size_t WS_Y = WS_Z + (size_t)R * NZ * 2;
constexpr size_t WS_WIN = WS_Y + (size_t)R * D * 2;
constexpr size_t WS_WOUT = WS_WIN + 2 * (size_t)NZ * D * 2;
constexpr size_t WS_W13 = WS_WOUT + 2 * (size_t)D * D * 2;
constexpr size_t WS_W2 = WS_W13 + (size_t)NE * 1024 * D * 2;
constexpr size_t WS_END = WS_W2 + (size_t)NE * D * DE * 2;
constexpr int MPAD = R + 24 * 256;

struct P { const float* in[N_IN]; float* out; unsigned char* ws; int wid; int pad; };
__device__ __forceinline__ int fresh_lane() { int l_; asm volatile("v_mbcnt_lo_u32_b32 %0, -1, 0\n\tv_mbcnt_hi_u32_b32 %0, -1, %0" : "=v"(l_)); return l_; }
#define S0PTR(p) ((float*)(p).out)

__device__ __forceinline__ float bf2f(bf16_t v) { return __uint_as_float(((unsigned)v) << 16); }
__device__ __forceinline__ bf16_t f2bf(float f) { unsigned u = __float_as_uint(f); return (bf16_t)((u + 0x7fffu + ((u >> 16) & 1u)) >> 16); }
__device__ __forceinline__ float sigmoidf_(float x) { return 1.f / (1.f + expf(-x)); }
__device__ __forceinline__ float siluf_(float x) { return x / (1.f + expf(-x)); }
__device__ __forceinline__ float geluf_(float x) { return 0.5f * x * (1.f + tanhf(0.7978845608028654f * (x + 0.044715f * x * x * x))); }
__device__ __forceinline__ float wave_sum(float v) {
#pragma unroll
    for (int o = 1; o < 64; o <<= 1) v += __shfl_xor(v, o);
    return v;
}
__device__ __forceinline__ int row_mi(int r) { const int b = r / LB, j = r - b * LB; return j < TC ? 8 : b; }

#define NT 512
#define NWV 8

__device__ __forceinline__ void ph_init(const P& p) {
    const int tidx = p.wid * 64 + fresh_lane();
    float* X = (float*)(p.ws + WS_X);
    const size_t n4 = (size_t)R * D / 4;
    for (size_t i = (size_t)blockIdx.x * NT + tidx; i < n4; i += (size_t)gridDim.x * NT) {
        const size_t e = i * 4; const int r = (int)(e / D), c = (int)(e % D); const int b = r / LB, j = r - b * LB;
        const float* src = (j < TC) ? p.in[I_CTX] + ((size_t)b * TC + j) * D + c : p.in[I_X] + ((size_t)b * T + (j - TC)) * D + c;
        *(float4*)(X + e) = *(const float4*)src;
    }
}

__device__ __forceinline__ void ph_mod(const P& p, float* sm) {
    const int tidx = p.wid * 64 + fresh_lane();
    float* MOD = (float*)(p.ws + WS_MOD);
    for (int i = tidx; i < 9 * D; i += NT) { const int mi = i / D, k = i % D; const float c = mi < 8 ? p.in[I_C][mi * D + k] : p.in[I_CCTX][k]; sm[i] = siluf_(c); }
    __syncthreads();
    for (int it = blockIdx.x * NT + tidx; it < 2 * 6 * D; it += gridDim.x * NT) {
        const int l = it / (6 * D), n = it % (6 * D);
        const float* W = p.in[I_WADA] + (size_t)l * D * 6 * D + n;
        float acc[9];
#pragma unroll
        for (int m = 0; m < 9; ++m) acc[m] = 0.f;
        for (int k = 0; k < D; ++k) { const float w = W[(size_t)k * 6 * D];
#pragma unroll
            for (int m = 0; m < 9; ++m) acc[m] += sm[m * D + k] * w; }
        const float bb = p.in[I_BADA][l * 6 * D + n];
#pragma unroll
        for (int m = 0; m < 9; ++m) MOD[((size_t)l * 9 + m) * 6 * D + n] = acc[m] + bb;
    }
    __syncthreads();
}

__device__ __forceinline__ void ph_norm1(const P& p, int l) {
    const int tidx = p.wid * 64 + fresh_lane();
    const float* X = (const float*)(p.ws + WS_X); bf16_t* H = (bf16_t*)(p.ws + WS_H);
    const float* MOD = (const float*)(p.ws + WS_MOD) + (size_t)l * 9 * 6 * D; const float* g = p.in[I_N1G] + l * D;
    const int lane = tidx & 63, wv = tidx >> 6;
    for (int r = blockIdx.x * NWV + wv; r < R; r += gridDim.x * NWV) {
        const float* m = MOD + (size_t)row_mi(r) * 6 * D;
        float4 v[4]; float ss = 0.f;
#pragma unroll
        for (int q = 0; q < 4; ++q) { v[q] = *(const float4*)(X + (size_t)r * D + (lane + 64 * q) * 4); ss += v[q].x * v[q].x + v[q].y * v[q].y + v[q].z * v[q].z + v[q].w * v[q].w; }
        const float rs = rsqrtf(wave_sum(ss) * (1.f / D) + EPS);
#pragma unroll
        for (int q = 0; q < 4; ++q) { const int c = (lane + 64 * q) * 4; const float xv[4] = {v[q].x, v[q].y, v[q].z, v[q].w}; bf16_t o[4];
#pragma unroll
            for (int i = 0; i < 4; ++i) o[i] = f2bf(xv[i] * rs * g[c + i] * (1.f + m[D + c + i]) + m[c + i]);
            *(uint2*)(H + (size_t)r * D + c) = make_uint2((unsigned)o[0] | ((unsigned)o[1] << 16), (unsigned)o[2] | ((unsigned)o[3] << 16)); }
    }
}

__device__ __forceinline__ void ph_rope(const P& p) {
    const int tidx = p.wid * 64 + fresh_lane();
    bf16_t* Z = (bf16_t*)(p.ws + WS_Z);
    const int total = NB * T * 256;
    for (int it = blockIdx.x * NT + tidx; it < total; it += gridDim.x * NT) {
        const int pr = it & 255, rt = it >> 8; const int b = rt / T, t = rt % T;
        const int f = pr & 7, a = (pr >> 3) & 1, n = (pr >> 4) & 1, h = (pr >> 5) & 3, qk = pr >> 7;
        const int col = (qk ? ZB_K : ZB_Q) + h * 64 + n * 32 + a * 16 + f;
        bf16_t* zp = Z + (size_t)(b * LB + TC + t) * NZ + col;
        const float pos = (float)(a == 0 ? (t / 64) : (t % 64));
        const float freq = expf(-(float)f * 0.125f * 9.210340371976184f);
        const float ang = pos * freq; const float c = cosf(ang), s = sinf(ang);
        const float x1 = bf2f(zp[0]), x2 = bf2f(zp[8]);
        zp[0] = f2bf(x1 * c - x2 * s); zp[8] = f2bf(x2 * c + x1 * s);
    }
}

__device__ __forceinline__ void ph_lru_gates(const P& p, int l, float* sm) {
    const int tidx = p.wid * 64 + fresh_lane();
    const bf16_t* Z = (const bf16_t*)(p.ws + WS_Z); bf16_t* G = (bf16_t*)(p.ws + WS_H);
    const float* cw = p.in[I_CONVW] + l * 4 * 256; const float* cb = p.in[I_CONVB] + l * 256;
    const int rr = tidx >> 8, w = tidx & 255, h = w >> 6, jw = w & 63;
    for (int it = blockIdx.x; it < R / 2; it += gridDim.x) {
        const int r = it * 2 + rr; const int j = r % LB; const int lo = j < TC ? 0 : TC, hi = j < TC ? TC : LB;
        float u = cb[w];
#pragma unroll
        for (int q = 0; q < 4; ++q) { const int jj = j + q - 2; if (jj >= lo && jj < hi) u += bf2f(Z[(size_t)(r + q - 2) * NZ + ZA_X + w]) * cw[q * 256 + w]; }
        sm[rr * 256 + w] = u;
        __syncthreads();
#pragma unroll 1
        for (int d = 0; d < 2; ++d) {
            const float* wr = p.in[I_WR] + (((size_t)(l * 2 + d) * 4 + h) * 64) * 64 + jw; const float* wi = p.in[I_WI] + (((size_t)(l * 2 + d) * 4 + h) * 64) * 64 + jw;
            float ar = p.in[I_BR][(l * 2 + d) * 256 + w], ai = p.in[I_BI][(l * 2 + d) * 256 + w];
#pragma unroll 4
            for (int i = 0; i < 64; ++i) { const float uu = sm[rr * 256 + h * 64 + i]; ar += uu * wr[i * 64]; ai += uu * wi[i * 64]; }
            G[((size_t)(d * 2 + 0) * R + r) * 256 + w] = f2bf(sigmoidf_(ar));
            G[((size_t)(d * 2 + 1) * R + r) * 256 + w] = f2bf(sigmoidf_(ai));
        }
        __syncthreads();
    }
}

__device__ __forceinline__ void ph_lru_scan(const P& p, int l) {
    const int tidx = p.wid * 64 + fresh_lane();
    const int vb = gridDim.x - 1 - blockIdx.x; const int gt = vb * NT + tidx;
    if (gt >= NB * 256) return;
    const int b = gt >> 8, w = gt & 255;
    const bf16_t* Z = (const bf16_t*)(p.ws + WS_Z); const bf16_t* G = (const bf16_t*)(p.ws + WS_H); bf16_t* Y = (bf16_t*)(p.ws + WS_Y);
    float* HF = S0PTR(p);
    const float* cw = p.in[I_CONVW] + l * 4 * 256; const float cbv = p.in[I_CONVB][l * 256 + w];
    const float c0 = cw[w], c1 = cw[256 + w], c2 = cw[512 + w], c3 = cw[768 + w];
    for (int d = 0; d < 2; ++d) {
        const float sp = log1pf(expf(-p.in[I_LAM][(l * 2 + d) * 256 + w]));
        float hst = 0.f;
        for (int s = 0; s < LB; ++s) {
            int j; if (d == 0) j = s; else j = s < TC ? (TC - 1 - s) : (LB - 1 - (s - TC));
            const int r = b * LB + j; const int lo = j < TC ? 0 : TC, hi = j < TC ? TC : LB;
            float u = cbv;
            if (j - 2 >= lo) u += bf2f(Z[(size_t)(r - 2) * NZ + ZA_X + w]) * c0;
            if (j - 1 >= lo) u += bf2f(Z[(size_t)(r - 1) * NZ + ZA_X + w]) * c1;
            u += bf2f(Z[(size_t)r * NZ + ZA_X + w]) * c2;
            if (j + 1 < hi) u += bf2f(Z[(size_t)(r + 1) * NZ + ZA_X + w]) * c3;
            const float rg = bf2f(G[((size_t)(d * 2 + 0) * R + r) * 256 + w]), ig = bf2f(G[((size_t)(d * 2 + 1) * R + r) * 256 + w]);
            const float la = -8.f * rg * sp; const float a = expf(la); const float bc = sqrtf(-expm1f(2.f * la)) * ig * u;
            hst = a * hst + bc;
            if (d == 0) HF[(size_t)r * 256 + w] = hst;
            else { const float hs = HF[(size_t)r * 256 + w] + hst; Y[(size_t)r * D + w] = f2bf(hs * geluf_(bf2f(Z[(size_t)r * NZ + ZA_G + w]))); }
        }
    }
}

__device__ __forceinline__ void ph_sg(const P& p, int l, float* sm) {
    const int tidx = p.wid * 64 + fresh_lane();
    const bf16_t* Z = (const bf16_t*)(p.ws + WS_Z); bf16_t* Y = (bf16_t*)(p.ws + WS_Y);
    float* vn = sm;
    const float* ng = p.in[I_SGNG] + l * 256;
    const int tid = tidx, q = tid >> 2, part = tid & 3;
    for (int unit = blockIdx.x; unit < NB * 18 * 4; unit += gridDim.x) {
        const int h = unit & 3, bc = unit >> 2, b = bc / 18, ck = bc % 18;
        if (l == 1 && ck < 2) continue;
        const int r0 = b * LB + ck * 128;
        { const bf16_t* zv = Z + (size_t)(r0 + q) * NZ + ZC_V; float ss = 0.f;
          for (int c = part * 64; c < part * 64 + 64; ++c) { const float gv = geluf_(bf2f(zv[c])); ss += gv * gv; }
          ss += __shfl_xor(ss, 1); ss += __shfl_xor(ss, 2);
          const float rs = rsqrtf(ss * (1.f / 256.f) + EPS);
          for (int i = 0; i < 16; ++i) { const int c = part * 16 + i; vn[q * 64 + c] = geluf_(bf2f(zv[h * 64 + c])) * rs * ng[h * 64 + c]; } }
        __syncthreads();
        { const int pp = q; const float* wsp = p.in[I_SGW] + ((size_t)(l * 4 + h) * 128 + pp) * 128; float acc[16];
#pragma unroll
          for (int i = 0; i < 16; ++i) acc[i] = 0.f;
          for (int qq = 0; qq < 128; ++qq) { const float wv = wsp[qq];
#pragma unroll
              for (int i = 0; i < 16; ++i) acc[i] += wv * vn[qq * 64 + part * 16 + i]; }
          const float bsp = p.in[I_SGB][(l * 4 + h) * 128 + pp];
          const bf16_t* zu = Z + (size_t)(r0 + pp) * NZ + ZC_U + h * 64 + part * 16; bf16_t* yo = Y + (size_t)(r0 + pp) * D + 512 + h * 64 + part * 16;
#pragma unroll
          for (int i = 0; i < 16; ++i) yo[i] = f2bf(geluf_(bf2f(zu[i])) * (acc[i] + bsp)); }
        __syncthreads();
    }
}

__device__ __forceinline__ void ph_attn(const P& p, int l) {
    const int tidx = p.wid * 64 + fresh_lane();
    const bf16_t* Z = (const bf16_t*)(p.ws + WS_Z); bf16_t* Y = (bf16_t*)(p.ws + WS_Y);
    const float lam_init = l == 0 ? 0.2f : (0.8f - 0.6f * 0.7408182206817179f);
    const float* dl = p.in[I_DALAM] + l * 4 * 32; float s01 = 0.f, s23 = 0.f;
    for (int i = 0; i < 32; ++i) { s01 += dl[i] * dl[32 + i]; s23 += dl[64 + i] * dl[96 + i]; }
    const float lam = expf(s01) - expf(s23) + lam_init;
    const float* subg = p.in[I_DASUB] + l * 64;
    const int nun = NB * 4 * 18;
    const int tid = tidx, qi = tid >> 2, sl = tid & 3;
    for (int unit = blockIdx.x; unit < nun; unit += gridDim.x) {
        const int qb = unit % 18, bh = unit / 18, h = bh & 3, b = bh >> 2;
        if (l == 1 && qb < 2) continue;
        const int j = qb * 128 + qi; const int nkeys = qb < 2 ? TC : LB;
        const int r = b * LB + j;
        float q[64];
        { const bf16_t* zq = Z + (size_t)r * NZ + ZB_Q + h * 64;
#pragma unroll
          for (int i = 0; i < 64; ++i) q[i] = bf2f(zq[i]) * 0.17677669529663687f; }
        float m1 = -1e30f, l1 = 0.f, m2 = -1e30f, l2 = 0.f, a1[16], a2[16];
#pragma unroll
        for (int i = 0; i < 16; ++i) { a1[i] = 0.f; a2[i] = 0.f; }
        for (int kj = 0; kj < nkeys; ++kj) {
            const bf16_t* zk = Z + (size_t)(b * LB + kj) * NZ + ZB_K + h * 64; const bf16_t* zv = Z + (size_t)(b * LB + kj) * NZ + ZB_V + h * 64 + sl * 16;
            float s1 = 0.f, s2 = 0.f;
#pragma unroll
            for (int i = 0; i < 32; ++i) { s1 += q[i] * bf2f(zk[i]); s2 += q[32 + i] * bf2f(zk[32 + i]); }
            const float m1n = fmaxf(m1, s1), m2n = fmaxf(m2, s2);
            const float c1 = expf(m1 - m1n), c2 = expf(m2 - m2n), p1 = expf(s1 - m1n), p2 = expf(s2 - m2n);
            l1 = l1 * c1 + p1; l2 = l2 * c2 + p2; m1 = m1n; m2 = m2n;
#pragma unroll
            for (int i = 0; i < 16; ++i) { const float v = bf2f(zv[i]); a1[i] = a1[i] * c1 + p1 * v; a2[i] = a2[i] * c2 + p2 * v; }
        }
        float o[16], ss = 0.f; const float i1 = 1.f / l1, i2 = lam / l2;
#pragma unroll
        for (int i = 0; i < 16; ++i) { o[i] = a1[i] * i1 - a2[i] * i2; ss += o[i] * o[i]; }
        ss += __shfl_xor(ss, 1); ss += __shfl_xor(ss, 2);
        const float rs = rsqrtf(ss * (1.f / 64.f) + EPS) * (1.f - lam_init);
        bf16_t* yo = Y + (size_t)r * D + 256 + h * 64 + sl * 16;
#pragma unroll
        for (int i = 0; i < 16; ++i) yo[i] = f2bf(o[i] * rs * subg[sl * 16 + i]);
    }
}

__device__ __forceinline__ void ph_hg_scan(const P& p, int l) {
    const int tidx = p.wid * 64 + fresh_lane();
    const int wv = tidx >> 6, lane = tidx & 63; const int gw = blockIdx.x * NWV + wv;
    if (gw >= NB * 4 * 2) return;
    const int d = gw & 1, h = (gw >> 1) & 3, b = gw >> 3;
    const bf16_t* Z = (const bf16_t*)(p.ws + WS_Z); float* O = S0PTR(p) + (size_t)(1 + d) * R * 256;
    float lb = 0.f;
    if (l == 1) { const float* hl = p.in[I_HGLB] + (size_t)d * 2 * 256 + h * 64 + lane; lb = sigmoidf_(hl[256] - hl[0]); }
    float S[64];
#pragma unroll
    for (int i = 0; i < 64; ++i) S[i] = 0.f;
    const int fcol = (d == 0 ? ZD_FF : ZD_FB) + h * 64 + lane;
    for (int s = 0; s < LB; ++s) {
        int j; if (d == 0) j = s; else j = s < TC ? (TC - 1 - s) : (LB - 1 - (s - TC));
        const bf16_t* zr = Z + (size_t)(b * LB + j) * NZ;
        const float f = lb + (1.f - lb) * sigmoidf_(bf2f(zr[fcol])); const float kk = 1.f - f;
        const float qv = bf2f(zr[ZD_Q + h * 64 + lane]) * 0.125f; const float vv = bf2f(zr[ZD_I + h * 64 + lane]);
        float o = 0.f;
#pragma unroll
        for (int i = 0; i < 64; ++i) {
            const float fd = __int_as_float(__builtin_amdgcn_readlane(__float_as_int(f), i)), kd = __int_as_float(__builtin_amdgcn_readlane(__float_as_int(kk), i)), qd = __int_as_float(__builtin_amdgcn_readlane(__float_as_int(qv), i));
            S[i] = fd * S[i] + kd * vv; o += S[i] * qd;
        }
        O[(size_t)(b * LB + j) * 256 + h * 64 + lane] = o;
    }
}

__device__ __forceinline__ void ph_hg_out(const P& p, int l) {
    const int tidx = p.wid * 64 + fresh_lane();
    const bf16_t* Z = (const bf16_t*)(p.ws + WS_Z); bf16_t* Y = (bf16_t*)(p.ws + WS_Y);
    const float* OF = (const float*)S0PTR(p) + (size_t)R * 256; const float* OB = OF + (size_t)R * 256;
    const float* gn = p.in[I_HGNG] + l * 256;
    const int lane = tidx & 63, wv = tidx >> 6;
    for (int it = blockIdx.x * NWV + wv; it < R * 4; it += gridDim.x * NWV) {
        const int r = it >> 2, h = it & 3; const size_t o = (size_t)r * 256 + h * 64 + lane;
        const float v = OF[o] + OB[o]; const float rs = rsqrtf(wave_sum(v * v) * (1.f / 64.f) + EPS);
        Y[(size_t)r * D + 768 + h * 64 + lane] = f2bf(v * rs * gn[h * 64 + lane] * siluf_(bf2f(Z[(size_t)r * NZ + ZD_G + h * 64 + lane])));
    }
}

__device__ __forceinline__ void ph_router(const P& p, int l, unsigned char* ldsb) {
    const int tidx = p.wid * 64 + fresh_lane();
    const float* X = (const float*)(p.ws + WS_X); bf16_t* H = (bf16_t*)(p.ws + WS_H);
    float2* GP = (float2*)(p.ws + WS_GP); int* LISTP = (int*)(p.ws + WS_LISTP); unsigned* CNT = (unsigned*)(p.ws + WS_CNT) + l * 32;
    const float* MOD = (const float*)(p.ws + WS_MOD) + (size_t)l * 9 * 6 * D; const float* g = p.in[I_N2G] + l * D;
    const float* RW = p.in[I_RW]; const float* RB = p.in[I_RB];
    int* lc = (int*)ldsb; int* lbase = lc + 32; int* rpair = lc + 64; int* rrank = lc + 64 + 72;
    const int lane = tidx & 63, wv = tidx >> 6;
    for (int chunk = blockIdx.x; chunk < R / 72; chunk += gridDim.x) {
        if (tidx < 32) lc[tidx] = 0;
        __syncthreads();
        for (int k = 0; k < 9; ++k) {
            const int li = wv * 9 + k, r = chunk * 72 + li;
            if (l == 1 && (r % LB) < TC) { if (lane == 0) rpair[li] = -1; continue; }
            const float* m = MOD + (size_t)row_mi(r) * 6 * D;
            float4 v[4]; float ss = 0.f;
#pragma unroll
            for (int q = 0; q < 4; ++q) { v[q] = *(const float4*)(X + (size_t)r * D + (lane + 64 * q) * 4); ss += v[q].x * v[q].x + v[q].y * v[q].y + v[q].z * v[q].z + v[q].w * v[q].w; }
            const float rs = rsqrtf(wave_sum(ss) * (1.f / D) + EPS);
            float lg[16];
#pragma unroll
            for (int e = 0; e < 16; ++e) lg[e] = 0.f;
#pragma unroll
            for (int q = 0; q < 4; ++q) { const int c = (lane + 64 * q) * 4; const float xv[4] = {v[q].x, v[q].y, v[q].z, v[q].w}; bf16_t o[4];
#pragma unroll
                for (int i = 0; i < 4; ++i) { const float hv = xv[i] * rs * g[c + i] * (1.f + m[4 * D + c + i]) + m[3 * D + c + i]; o[i] = f2bf(hv);
                    const float4* rw = (const float4*)(RW + (size_t)(c + i) * 16);
#pragma unroll
                    for (int e4 = 0; e4 < 4; ++e4) { const float4 w4 = rw[e4]; lg[e4 * 4 + 0] += hv * w4.x; lg[e4 * 4 + 1] += hv * w4.y; lg[e4 * 4 + 2] += hv * w4.z; lg[e4 * 4 + 3] += hv * w4.w; } }
                *(uint2*)(H + (size_t)r * D + c) = make_uint2((unsigned)o[0] | ((unsigned)o[1] << 16), (unsigned)o[2] | ((unsigned)o[3] << 16)); }
#pragma unroll
            for (int e = 0; e < 16; ++e) lg[e] = wave_sum(lg[e]) + RB[e];
            float mx = lg[0];
#pragma unroll
            for (int e = 1; e < 16; ++e) mx = fmaxf(mx, lg[e]);
            float sc[16], sum = 0.f;
#pragma unroll
            for (int e = 0; e < 16; ++e) { sc[e] = expf(lg[e] - mx); sum += sc[e]; }
            const float inv = 1.f / sum;
#pragma unroll
            for (int e = 0; e < 16; ++e) sc[e] *= inv;
            int gsel = 0; float gbest = -1.f;
#pragma unroll
            for (int gI = 0; gI < 4; ++gI) { float t1 = -1.f, t2 = -1.f;
#pragma unroll
                for (int i = 0; i < 4; ++i) { const float sv = sc[gI * 4 + i]; if (sv > t1) { t2 = t1; t1 = sv; } else if (sv > t2) t2 = sv; }
                const float gs = t1 + t2; if (gs > gbest) { gbest = gs; gsel = gI; } }
            float w1 = -1.f, w2 = -1.f; int i1 = 0, i2 = 0;
#pragma unroll
            for (int e = 0; e < 16; ++e) { if ((e >> 2) == gsel) { const float sv = sc[e]; if (sv > w1) { w2 = w1; i2 = i1; w1 = sv; i1 = e; } else if (sv > w2) { w2 = sv; i2 = e; } } }
            const float wn = 1.f / (w1 + w2);
            if (lane == 0) {
                const int a = (i1 < i2 ? i1 : i2) & 3, b = (i1 < i2 ? i2 : i1) & 3;
                const int q = a == 0 ? b - 1 : (a == 1 ? b + 1 : 5);
                const int pr = gsel * 6 + q;
                GP[r] = i1 < i2 ? make_float2(w1 * wn, w2 * wn) : make_float2(w2 * wn, w1 * wn);
                rpair[li] = pr; rrank[li] = atomicAdd(&lc[pr], 1);
            }
        }
        __syncthreads();
        if (tidx < 24) lbase[tidx] = lc[tidx] ? (int)atomicAdd(&CNT[tidx], (unsigned)lc[tidx]) : 0;
        __syncthreads();
        if (tidx < 72) { const int pr = rpair[tidx]; if (pr >= 0) LISTP[(size_t)pr * R + lbase[pr] + rrank[tidx]] = chunk * 72 + tidx; }
        __syncthreads();
    }
}

__device__ __forceinline__ void ph_final(const P& p) {
    const int tidx = p.wid * 64 + fresh_lane();
    const float* X = (const float*)(p.ws + WS_X); const float* g = p.in[I_FNG];
    const int lane = tidx & 63, wv = tidx >> 6;
    for (int it = blockIdx.x * NWV + wv; it < NB * T; it += gridDim.x * NWV) {
        const int b = it / T, t = it % T; const int r = b * LB + TC + t;
        float4 v[4]; float ss = 0.f;
#pragma unroll
        for (int q = 0; q < 4; ++q) { v[q] = *(const float4*)(X + (size_t)r * D + (lane + 64 * q) * 4); ss += v[q].x * v[q].x + v[q].y * v[q].y + v[q].z * v[q].z + v[q].w * v[q].w; }
        const float rs = rsqrtf(wave_sum(ss) * (1.f / D) + EPS);
#pragma unroll
        for (int q = 0; q < 4; ++q) { const int c = (lane + 64 * q) * 4; const float4 gg = *(const float4*)(g + c);
            *(float4*)(p.out + (size_t)it * D + c) = make_float4(v[q].x * rs * gg.x, v[q].y * rs * gg.y, v[q].z * rs * gg.z, v[q].w * rs * gg.w); }
    }
}


namespace pg8 {
#define PG8_LAS __attribute__((address_space(3)))
typedef short bf16x8 __attribute__((ext_vector_type(8)));
typedef float f32x4 __attribute__((ext_vector_type(4)));
typedef unsigned u32x4 __attribute__((ext_vector_type(4)));
constexpr int BM = 256, BK = 64, HALF = 128, HTB = HALF * BK * 2, STAGE_BYTES = 8 * HTB, NXCD = 8, WGM = 8;
__host__ __device__ __forceinline__ int lds_byte(int r, int c) { const int st = (r >> 4) * 2 + (c >> 5), rr = r & 15, cc = c & 31, ob = rr * 64 + cc * 2; return st * 1024 + (ob ^ (((ob >> 9) & 1) << 5)); }
__host__ __device__ __forceinline__ void stage_rc(int b, int& R, int& C) { const int st = b / 1024, sb = b % 1024, swz = sb ^ (((sb >> 9) & 1) << 5); R = (st >> 1) * 16 + swz / 64; C = (st & 1) * 32 + (swz % 64) / 2; }
__host__ __device__ __forceinline__ int perm32(int rho) { const int n = rho >> 4, i = rho & 15; return 8 * (i >> 2) + 4 * n + (i & 3); }
__device__ __forceinline__ unsigned cvt_pk_bf16(float lo, float hi) { unsigned r; asm volatile("v_cvt_pk_bf16_f32 %0, %1, %2" : "=v"(r) : "v"(lo), "v"(hi)); return r; }
struct Unit { int pm, pn, aux; };
__device__ __forceinline__ bool static_next(int i, int G, int c, int nM, int nN, int& pm, int& pn) {
    const int nwg = nM * nN; const long L = (long)i * G + c; if (L >= nwg) return false;
    int wgid = (int)L; { const int q = nwg / NXCD, r = nwg % NXCD, xcd = wgid % NXCD, off = wgid / NXCD; wgid = (xcd < r ? xcd * (q + 1) : r * (q + 1) + (xcd - r) * q) + off; }
    const int nig = WGM * nN, gid = wgid / nig, fm = gid * WGM, gsz = (nM - fm) < WGM ? (nM - fm) : WGM;
    pm = fm + ((wgid % nig) % gsz); pn = (wgid % nig) / gsz; return true;
}
template <class PB, bool ALIGN_EPI>
__device__ __forceinline__ void gemm_phase(PG8_LAS unsigned char* lds, const PB& S, const int wid) {
    const int lane = fresh_lane(), tid = wid * 64 + lane, wr = wid >> 2, wc = wid & 3, fr = lane & 15, fq = lane >> 4;
    const int nt = S.nt;
    int Rst[2], Cst[2]; unsigned voffB[2];
#pragma unroll
    for (int i = 0; i < 2; ++i) { int R_, C_; stage_rc(tid * 16 + i * 8192, R_, C_); Rst[i] = R_; Cst[i] = C_; const int Rb = PB::PERM ? ((R_ & ~31) + perm32(R_ & 31)) : R_; voffB[i] = (unsigned)(Rb * S.ldb + C_) * 2u; }
    const size_t kstep = (size_t)(BK * 2);
    const size_t hstepB = (size_t)HALF * S.ldb * 2;
    const unsigned ldsw = (unsigned)wid * 1024u;
    const int aoff = lds_byte(wr * 64 + fr, fq * 8), boff = lds_byte(wc * 32 + fr, fq * 8);
#define PG8_SA(b, h) (((b) * 2 + (h)) * HTB)
#define PG8_SB(b, h) ((4 + (b) * 2 + (h)) * HTB)
#define PG8_STAGE(bufoff, gbase, voff) do { _Pragma("unroll") for (int _i = 0; _i < 2; ++_i) { unsigned _o = (voff)[_i]; asm volatile("" : "+v"(_o)); \
        __builtin_amdgcn_global_load_lds((const unsigned*)((const char*)(gbase) + _o), (PG8_LAS unsigned*)(lds + (bufoff) + ldsw + _i * 8192), 16, 0, 0); } } while (0)
#define PG8_LDA(dst, b, h) do { _Pragma("unroll") for (int m = 0; m < 4; ++m) _Pragma("unroll") for (int k = 0; k < 2; ++k) dst[m][k] = *(const PG8_LAS bf16x8*)(lds + PG8_SA(b, h) + aoff + m * 2048 + k * 1024); } while (0)
#define PG8_LDB(dst, b, h) do { _Pragma("unroll") for (int n = 0; n < 2; ++n) _Pragma("unroll") for (int k = 0; k < 2; ++k) dst[n][k] = *(const PG8_LAS bf16x8*)(lds + PG8_SB(b, h) + boff + n * 2048 + k * 1024); } while (0)
#define PG8_MMA(ai, bj, At, Bt) do { __builtin_amdgcn_s_setprio(1); _Pragma("unroll") for (int m = 0; m < 4; ++m) _Pragma("unroll") for (int n = 0; n < 2; ++n) _Pragma("unroll") for (int k = 0; k < 2; ++k) \
        acc[ai][bj][m][n] = __builtin_amdgcn_mfma_f32_16x16x32_bf16(Bt[n][k], At[m][k], acc[ai][bj][m][n], 0, 0, 0); __builtin_amdgcn_s_setprio(0); } while (0)
#define PG8_WAIT_V(n) asm volatile("s_waitcnt vmcnt(" #n ")" ::: "memory")
#define PG8_WAIT_L(n) asm volatile("s_waitcnt lgkmcnt(" #n ")" ::: "memory")
#define PG8_BAR __builtin_amdgcn_s_barrier()
#define PG8_SCHED __builtin_amdgcn_sched_barrier(0)
    Unit cur, nxt; int ui = 0;
    if (!S.next(0, cur)) return;
    f32x4 acc[2][2][4][2];
#pragma unroll
    for (int a = 0; a < 2; ++a)
#pragma unroll
        for (int b = 0; b < 2; ++b)
#pragma unroll
            for (int m = 0; m < 4; ++m)
#pragma unroll
                for (int n = 0; n < 2; ++n) acc[a][b][m][n] = (f32x4){0.f, 0.f, 0.f, 0.f};
    bf16x8 At[4][2], B0[2][2], B1[2][2];
    unsigned vc[2][2], vn[2][2];
    S.a_off(cur, Rst, Cst, vc); asm volatile("" : "+v"(vc[0][0]), "+v"(vc[0][1]), "+v"(vc[1][0]), "+v"(vc[1][1]));
    const char* gA = S.A;
    { const char* cB = S.b_ptr(cur, 0); const char* cB1 = S.b_ptr(cur, 1);
      PG8_STAGE(PG8_SB(0, 0), cB, voffB); PG8_STAGE(PG8_SB(0, 1), cB + hstepB, voffB); PG8_STAGE(PG8_SA(0, 0), gA, vc[0]); PG8_STAGE(PG8_SA(0, 1), gA, vc[1]);
      if (wr == 1) PG8_BAR;
      PG8_WAIT_V(2); PG8_BAR;
      PG8_STAGE(PG8_SB(1, 0), cB1, voffB); PG8_STAGE(PG8_SA(1, 0), gA + kstep, vc[0]); PG8_STAGE(PG8_SB(1, 1), cB1 + hstepB, voffB);
      PG8_WAIT_V(6); PG8_BAR; }
    for (;;) {
        const bool has_next = S.next(ui + 1, nxt);
        if (has_next) { S.a_off(nxt, Rst, Cst, vn); asm volatile("" : "+v"(vn[0][0]), "+v"(vn[0][1]), "+v"(vn[1][0]), "+v"(vn[1][1])); }
        else { vn[0][0] = vc[0][0]; vn[0][1] = vc[0][1]; vn[1][0] = vc[1][0]; vn[1][1] = vc[1][1]; nxt = cur; }
        for (int t = 0; t < nt; t += 2) {
            const bool last = (t == nt - 2);
            const char* a1 = gA + (size_t)(t + 1) * kstep;
            const char* a2 = last ? gA : gA + (size_t)(t + 2) * kstep; const char* a3 = a2 + kstep;
            const char* b2 = last ? S.b_ptr(nxt, 0) : S.b_ptr(cur, t + 2);
            const char* b3 = last ? S.b_ptr(nxt, 1) : S.b_ptr(cur, t + 3);
            unsigned o2a[2], o2b[2];
            o2a[0] = last ? vn[0][0] : vc[0][0]; o2a[1] = last ? vn[0][1] : vc[0][1]; o2b[0] = last ? vn[1][0] : vc[1][0]; o2b[1] = last ? vn[1][1] : vc[1][1];
            PG8_LDB(B0, 0, 0); PG8_LDB(B1, 0, 1); PG8_SCHED; PG8_LDA(At, 0, 0); PG8_STAGE(PG8_SA(1, 1), a1, vc[1]);
            PG8_WAIT_V(8); PG8_WAIT_L(0); PG8_BAR; PG8_MMA(0, 0, At, B0); PG8_MMA(0, 1, At, B1); PG8_BAR; PG8_SCHED;
            PG8_LDA(At, 0, 1); PG8_STAGE(PG8_SB(0, 0), b2, voffB); PG8_STAGE(PG8_SB(0, 1), b2 + hstepB, voffB); PG8_STAGE(PG8_SA(0, 0), a2, o2a);
            PG8_WAIT_V(8); PG8_WAIT_L(0); PG8_BAR; PG8_MMA(1, 0, At, B0); PG8_MMA(1, 1, At, B1); PG8_BAR; PG8_SCHED;
            PG8_LDB(B0, 1, 0); PG8_LDB(B1, 1, 1); PG8_SCHED; PG8_LDA(At, 1, 0); PG8_STAGE(PG8_SA(0, 1), a2, o2b);
            PG8_WAIT_V(8); PG8_WAIT_L(0); PG8_BAR; PG8_MMA(0, 0, At, B0); PG8_MMA(0, 1, At, B1); PG8_BAR; PG8_SCHED;
            PG8_LDA(At, 1, 1); PG8_STAGE(PG8_SB(1, 0), b3, voffB); PG8_STAGE(PG8_SB(1, 1), b3 + hstepB, voffB); PG8_STAGE(PG8_SA(1, 0), a3, o2a);
            PG8_WAIT_V(8); PG8_WAIT_L(0); PG8_BAR; PG8_MMA(1, 0, At, B0); PG8_MMA(1, 1, At, B1); PG8_BAR; PG8_SCHED;
        }
        if constexpr (ALIGN_EPI) { if (wr == 0) PG8_BAR; }
        S.epi(acc, cur, wr, wc, fr, fq);
        if (!has_next) break;
#pragma unroll
        for (int a = 0; a < 2; ++a)
#pragma unroll
            for (int b = 0; b < 2; ++b)
#pragma unroll
                for (int m = 0; m < 4; ++m)
#pragma unroll
                    for (int n = 0; n < 2; ++n) acc[a][b][m][n] = (f32x4){0.f, 0.f, 0.f, 0.f};
        cur = nxt; vc[0][0] = vn[0][0]; vc[0][1] = vn[0][1]; vc[1][0] = vn[1][0]; vc[1][1] = vn[1][1]; ++ui;
        if constexpr (ALIGN_EPI) { if (wr == 1) PG8_BAR; }
    }
    PG8_WAIT_V(0);
    if constexpr (!ALIGN_EPI) { if (wr == 0) PG8_BAR; }
    PG8_BAR;
#undef PG8_SA
#undef PG8_SB
#undef PG8_STAGE
#undef PG8_LDA
#undef PG8_LDB
#undef PG8_MMA
#undef PG8_WAIT_V
#undef PG8_WAIT_L
#undef PG8_BAR
#undef PG8_SCHED
}
}

struct PB_InProj {
    static constexpr bool PERM = true;
    const char* A; int ldb, nt; const char* Bt; bf16_t* Zo; int G, c;
    __device__ __forceinline__ bool next(int i, pg8::Unit& u) const { u.aux = 0; return pg8::static_next(i, G, c, R / 256, NZ / 256, u.pm, u.pn); }
    __device__ __forceinline__ void a_off(const pg8::Unit& u, const int (&Rs)[2], const int (&Cs)[2], unsigned (&off)[2][2]) const {
#pragma unroll
        for (int h = 0; h < 2; ++h)
#pragma unroll
            for (int i = 0; i < 2; ++i) off[h][i] = (unsigned)((u.pm * 256 + h * 128 + Rs[i]) * D + Cs[i]) * 2u; }
    __device__ __forceinline__ const char* b_ptr(const pg8::Unit& u, int t) const { return Bt + (size_t)u.pn * 256 * D * 2 + (size_t)t * 128; }
    __device__ __forceinline__ void epi(const pg8::f32x4 (&acc)[2][2][4][2], const pg8::Unit& u, int wr, int wc, int fr, int fq) const {
        const int row0 = u.pm * 256 + wr * 64 + fr, col0 = u.pn * 256 + wc * 32 + 8 * fq;
#pragma unroll
        for (int ai = 0; ai < 2; ++ai)
#pragma unroll
            for (int m = 0; m < 4; ++m) { bf16_t* rowp = Zo + (size_t)(row0 + ai * 128 + m * 16) * NZ + col0;
#pragma unroll
                for (int bj = 0; bj < 2; ++bj) { const pg8::f32x4 v0 = acc[ai][bj][m][0], v1 = acc[ai][bj][m][1]; pg8::u32x4 w;
                    w.x = pg8::cvt_pk_bf16(v0[0], v0[1]); w.y = pg8::cvt_pk_bf16(v0[2], v0[3]); w.z = pg8::cvt_pk_bf16(v1[0], v1[1]); w.w = pg8::cvt_pk_bf16(v1[2], v1[3]);
                    *(pg8::u32x4*)(rowp + bj * 128) = w; } }
    }
};


struct PB_OutProj {
    static constexpr bool PERM = false;
    const char* A; int ldb, nt; const char* Bt; float* X; const float* MODl; int G, c, skipctx;
    __device__ __forceinline__ bool next(int i, pg8::Unit& u) const { u.aux = 0; int pm, pn; if (!pg8::static_next(i, G, c, skipctx ? 64 : 72, 4, pm, pn)) return false; u.pm = skipctx ? (pm >> 3) * 9 + 1 + (pm & 7) : pm; u.pn = pn; return true; }
    __device__ __forceinline__ void a_off(const pg8::Unit& u, const int (&Rs)[2], const int (&Cs)[2], unsigned (&off)[2][2]) const {
#pragma unroll
        for (int h = 0; h < 2; ++h)
#pragma unroll
            for (int i = 0; i < 2; ++i) off[h][i] = (unsigned)((u.pm * 256 + h * 128 + Rs[i]) * D + Cs[i]) * 2u; }
    __device__ __forceinline__ const char* b_ptr(const pg8::Unit& u, int t) const { return Bt + (size_t)u.pn * 256 * D * 2 + (size_t)t * 128; }
    __device__ __forceinline__ void epi(const pg8::f32x4 (&acc)[2][2][4][2], const pg8::Unit& u, int wr, int wc, int fr, int fq) const {
        const int row0 = u.pm * 256 + wr * 64 + fr, col0 = u.pn * 256 + wc * 32 + 4 * fq;
        const float* gt = MODl + (size_t)row_mi(u.pm * 256) * 6 * D + 2 * D + col0;
        pg8::f32x4 gv[2][2];
#pragma unroll
        for (int bj = 0; bj < 2; ++bj)
#pragma unroll
            for (int n = 0; n < 2; ++n) gv[bj][n] = *(const pg8::f32x4*)(gt + bj * 128 + n * 16);
#pragma unroll
        for (int ai = 0; ai < 2; ++ai)
#pragma unroll
            for (int m = 0; m < 4; ++m) { float* rowp = X + (size_t)(row0 + ai * 128 + m * 16) * D + col0;
#pragma unroll
                for (int bj = 0; bj < 2; ++bj)
#pragma unroll
                    for (int n = 0; n < 2; ++n) { pg8::f32x4* xp = (pg8::f32x4*)(rowp + bj * 128 + n * 16); *xp = *xp + gv[bj][n] * acc[ai][bj][m][n]; } }
    }
};

__device__ __forceinline__ void moe_tiles_setup(const P& p, int l, int* tb) {
    const unsigned* CNT = (const unsigned*)(p.ws + WS_CNT) + l * 32;
    __syncthreads();
    if (p.wid == 0 && fresh_lane() == 0) { int acc = 0; for (int q = 0; q < 24; ++q) { const int c = (int)__hip_atomic_load(CNT + q, __ATOMIC_RELAXED, __HIP_MEMORY_SCOPE_AGENT); tb[q] = c; tb[32 + q] = acc; acc += (c + 255) >> 8; } tb[32 + 24] = acc; }
    __syncthreads();
}
__device__ __forceinline__ void pair_experts(int pr, int& e0, int& e1) { const int g4 = (pr / 6) * 4, q = pr % 6; const int a = q < 3 ? 0 : (q < 5 ? 1 : 2), b = q < 3 ? q + 1 : (q < 5 ? q - 1 : 3); e0 = g4 + a; e1 = g4 + b; }

struct PB_Moe1 {
    static constexpr bool PERM = false;
    const char* A; int ldb, nt; const char* W13; bf16_t* HE; const int* LISTP; const float2* GP; const int* tb; int G, c;
    __device__ __forceinline__ bool next(int i, pg8::Unit& u) const {
        if (!pg8::static_next(i, G, c, tb[32 + 24], 8, u.pm, u.pn)) return false;
        int pr = 0;
        for (int q = 1; q < 24; ++q) if (tb[32 + q] <= u.pm) pr = q;
        u.aux = pr; return true; }
    __device__ __forceinline__ void a_off(const pg8::Unit& u, const int (&Rs)[2], const int (&Cs)[2], unsigned (&off)[2][2]) const {
        const int pr = u.aux, cnt = tb[pr], r0 = (u.pm - tb[32 + pr]) * 256; const int* lp = LISTP + (size_t)pr * R;
#pragma unroll
        for (int h = 0; h < 2; ++h)
#pragma unroll
            for (int i = 0; i < 2; ++i) { int rk = r0 + h * 128 + Rs[i]; rk = rk < cnt ? rk : cnt - 1; off[h][i] = (unsigned)(lp[rk] * D + Cs[i]) * 2u; } }
    __device__ __forceinline__ const char* b_ptr(const pg8::Unit& u, int t) const { int e0, e1; pair_experts(u.aux, e0, e1); const int e = u.pn < 4 ? e0 : e1;
        return W13 + ((size_t)e * 1024 + (size_t)(u.pn & 3) * 256) * D * 2 + (size_t)t * 128; }
    __device__ __forceinline__ void epi(const pg8::f32x4 (&acc)[2][2][4][2], const pg8::Unit& u, int wr, int wc, int fr, int fq) const {
        const int pr = u.aux, cnt = tb[pr], r0 = (u.pm - tb[32 + pr]) * 256; const int* lp = LISTP + (size_t)pr * R;
        const int colh = (u.pn < 4 ? 0 : 512) + (u.pn & 3) * 128 + wc * 16 + 4 * fq;
#pragma unroll
        for (int ai = 0; ai < 2; ++ai)
#pragma unroll
            for (int m = 0; m < 4; ++m) { const int x = ai * 128 + wr * 64 + m * 16 + fr; int rk = r0 + x; rk = rk < cnt ? rk : cnt - 1;
                const float2 gg = GP[lp[rk]]; const float gate = u.pn < 4 ? gg.x : gg.y;
                bf16_t* rowp = HE + (size_t)(u.pm * 256 + x) * 1024 + colh;
#pragma unroll
                for (int bj = 0; bj < 2; ++bj) { const pg8::f32x4 a = acc[ai][bj][m][0], b = acc[ai][bj][m][1]; float o[4];
#pragma unroll
                    for (int j = 0; j < 4; ++j) o[j] = a[j] / (1.f + __expf(-a[j])) * b[j] * gate;
                    *(uint2*)(rowp + bj * 64) = make_uint2(pg8::cvt_pk_bf16(o[0], o[1]), pg8::cvt_pk_bf16(o[2], o[3])); } }
    }
};
struct PB_Moe2 {
    static constexpr bool PERM = false;
    const char* A; int ldb, nt; const char* W2; float* X; const float* MODl; const int* LISTP; const int* tb; int G, c;
    __device__ __forceinline__ bool next(int i, pg8::Unit& u) const {
        if (!pg8::static_next(i, G, c, tb[32 + 24], 4, u.pm, u.pn)) return false;
        int pr = 0;
        for (int q = 1; q < 24; ++q) if (tb[32 + q] <= u.pm) pr = q;
        u.aux = pr; return true; }
    __device__ __forceinline__ void a_off(const pg8::Unit& u, const int (&Rs)[2], const int (&Cs)[2], unsigned (&off)[2][2]) const {
#pragma unroll
        for (int h = 0; h < 2; ++h)
#pragma unroll
            for (int i = 0; i < 2; ++i) off[h][i] = (unsigned)((u.pm * 256 + h * 128 + Rs[i]) * 1024 + Cs[i]) * 2u; }
    __device__ __forceinline__ const char* b_ptr(const pg8::Unit& u, int t) const { int e0, e1; pair_experts(u.aux, e0, e1); const int e = t < 8 ? e0 : e1;
        return W2 + ((size_t)e * 1024 + (size_t)u.pn * 256) * DE * 2 + (size_t)(t & 7) * 128; }
    __device__ __forceinline__ void epi(const pg8::f32x4 (&acc)[2][2][4][2], const pg8::Unit& u, int wr, int wc, int fr, int fq) const {
        const int pr = u.aux, cnt = tb[pr], r0 = (u.pm - tb[32 + pr]) * 256; const int* lp = LISTP + (size_t)pr * R;
        const int col0 = u.pn * 256 + wc * 32 + 4 * fq;
#pragma unroll
        for (int ai = 0; ai < 2; ++ai)
#pragma unroll
            for (int m = 0; m < 4; ++m) { const int rk = r0 + ai * 128 + wr * 64 + m * 16 + fr;
                if (rk < cnt) { const int tok = lp[rk]; float* rowp = X + (size_t)tok * D + col0; const float* gt = MODl + (size_t)row_mi(tok) * 6 * D + 5 * D + col0;
#pragma unroll
                    for (int bj = 0; bj < 2; ++bj)
#pragma unroll
                        for (int n = 0; n < 2; ++n) { pg8::f32x4* xp = (pg8::f32x4*)(rowp + bj * 128 + n * 16); *xp = *xp + *(const pg8::f32x4*)(gt + bj * 128 + n * 16) * acc[ai][bj][m][n]; } } }
    }
};

template <int MAP  >
__device__ __forceinline__ void transpose_item(const float* W, int K, int N, bf16_t* WT, PG8_LAS float* scr, int item, int lane) {
    const int nblk = N / 32, kb = item / nblk, nb = item % nblk, k0 = 64 * kb, n0 = 32 * nb;
#pragma unroll 8
    for (int i = 0; i < 32; ++i) { const int kk = 2 * i + (lane >> 5); scr[kk * 33 + (lane & 31)] = W[(size_t)(k0 + kk) * N + n0 + (lane & 31)]; }
    asm volatile("s_waitcnt lgkmcnt(0)" ::: "memory");
    const int c = lane & 7;
#pragma unroll
    for (int j = 0; j < 4; ++j) { const int n = (lane >> 3) + 8 * j; const PG8_LAS float* sp = scr + (8 * c) * 33 + n;
        uint4 o; o.x = (unsigned)f2bf(sp[0 * 33]) | ((unsigned)f2bf(sp[1 * 33]) << 16); o.y = (unsigned)f2bf(sp[2 * 33]) | ((unsigned)f2bf(sp[3 * 33]) << 16);
        o.z = (unsigned)f2bf(sp[4 * 33]) | ((unsigned)f2bf(sp[5 * 33]) << 16); o.w = (unsigned)f2bf(sp[6 * 33]) | ((unsigned)f2bf(sp[7 * 33]) << 16);
        const int ng = n0 + n; const int row = MAP == 0 ? ng : (32 * (ng >> 4) + (ng & 15) + (MAP == 2 ? 16 : 0));
        *(uint4*)(WT + (size_t)row * K + k0 + 8 * c) = o; }
    asm volatile("s_waitcnt lgkmcnt(0)" ::: "memory");
}
__device__ __forceinline__ void ph_prep_weights(const P& p, unsigned char* lds) {
    const int tidx = p.wid * 64 + fresh_lane();
    const int lane = tidx & 63, wv = tidx >> 6;
    PG8_LAS float* scr = (PG8_LAS float*)((PG8_LAS unsigned char*)lds + wv * 16384);
    const int gw = blockIdx.x * NWV + wv, NGW = gridDim.x * NWV;
    constexpr int I_IN = (D / 64) * (NZ / 32), I_OUT = (D / 64) * (D / 32);
    for (int it = gw; it < 2 * (I_IN + I_OUT); it += NGW) { const int l = it / (I_IN + I_OUT), r = it % (I_IN + I_OUT);
        if (r < I_IN) transpose_item<0>(p.in[I_WIN] + (size_t)l * D * NZ, D, NZ, (bf16_t*)(p.ws + WS_WIN) + (size_t)l * NZ * D, scr, r, lane);
        else transpose_item<0>(p.in[I_WOUT] + (size_t)l * D * D, D, D, (bf16_t*)(p.ws + WS_WOUT) + (size_t)l * D * D, scr, r - I_IN, lane); }
}
__device__ __forceinline__ void ph_prep_moe(const P& p, int l, unsigned char* lds) {
    const int tidx = p.wid * 64 + fresh_lane();
    const int lane = tidx & 63, wv = tidx >> 6;
    PG8_LAS float* scr = (PG8_LAS float*)((PG8_LAS unsigned char*)lds + wv * 16384);
    const int gw = blockIdx.x * NWV + wv, NGW = gridDim.x * NWV;
    constexpr int I_13 = (D / 64) * (DE / 32), I_2 = (DE / 64) * (D / 32), PER_E = 2 * I_13 + I_2;
    for (int it = gw; it < NE * PER_E; it += NGW) { const int e = it / PER_E, r = it % PER_E;
        bf16_t* w13 = (bf16_t*)(p.ws + WS_W13) + (size_t)e * 1024 * D; bf16_t* w2 = (bf16_t*)(p.ws + WS_W2) + (size_t)e * D * DE;
        if (r < I_13) transpose_item<1>(p.in[I_W1] + ((size_t)l * NE + e) * D * DE, D, DE, w13, scr, r, lane);
        else if (r < 2 * I_13) transpose_item<2>(p.in[I_W3] + ((size_t)l * NE + e) * D * DE, D, DE, w13, scr, r - I_13, lane);
        else transpose_item<0>(p.in[I_W2] + ((size_t)l * NE + e) * DE * D, DE, D, w2, scr, r - 2 * I_13, lane); }
}
constexpr int LDS_BYTES = 147456;
__global__ void __launch_bounds__(NT, 2) fwd_kernel(P p_in) {
    cg::grid_group grid = cg::this_grid();
    P p = p_in; p.wid = __builtin_amdgcn_readfirstlane((int)(threadIdx.x >> 6));
    extern __shared__ __attribute__((aligned(16))) unsigned char lds[];
    float* sm = (float*)lds;
    ph_init(p);
    ph_mod(p, sm);
    ph_prep_weights(p, lds);
    grid.sync();
    const bf16_t* H = (const bf16_t*)(p.ws + WS_H); const bf16_t* Y = (const bf16_t*)(p.ws + WS_Y); const bf16_t* HE = (const bf16_t*)(p.ws + WS_Z);
#pragma unroll 1
    for (int l = 0; l < 2; ++l) {
        ph_norm1(p, l); ph_prep_moe(p, l, lds);
        grid.sync();
        { PB_InProj pb; pb.A = (const char*)H; pb.ldb = D; pb.nt = D / 64; pb.Bt = (const char*)(p.ws + WS_WIN) + (size_t)l * NZ * D * 2; pb.Zo = (bf16_t*)(p.ws + WS_Z); pb.G = gridDim.x; pb.c = blockIdx.x;
          pg8::gemm_phase<PB_InProj, true>((PG8_LAS unsigned char*)lds, pb, p.wid); }
        grid.sync();
        ph_rope(p); ph_lru_gates(p, l, sm); ph_sg(p, l, sm);
        grid.sync();
        ph_hg_scan(p, l); ph_lru_scan(p, l); ph_attn(p, l);
        grid.sync();
        ph_hg_out(p, l);
        grid.sync();
        { PB_OutProj pb; pb.A = (const char*)Y; pb.ldb = D; pb.nt = D / 64; pb.Bt = (const char*)(p.ws + WS_WOUT) + (size_t)l * D * D * 2; pb.X = (float*)(p.ws + WS_X);
          pb.MODl = (const float*)(p.ws + WS_MOD) + (size_t)l * 9 * 6 * D; pb.G = gridDim.x; pb.c = blockIdx.x; pb.skipctx = (l == 1);
          pg8::gemm_phase<PB_OutProj, true>((PG8_LAS unsigned char*)lds, pb, p.wid); }
        grid.sync();
        ph_router(p, l, lds + 131072);
        grid.sync();
        { int* tb = (int*)(lds + 131072 + 1024); moe_tiles_setup(p, l, tb);
          PB_Moe1 pb; pb.A = (const char*)H; pb.ldb = D; pb.nt = D / 64; pb.W13 = (const char*)(p.ws + WS_W13); pb.HE = (bf16_t*)(p.ws + WS_Z); pb.LISTP = (const int*)(p.ws + WS_LISTP);
          pb.GP = (const float2*)(p.ws + WS_GP); pb.tb = tb; pb.G = gridDim.x; pb.c = blockIdx.x;
          pg8::gemm_phase<PB_Moe1, true>((PG8_LAS unsigned char*)lds, pb, p.wid); }
        grid.sync();
        { int* tb = (int*)(lds + 131072 + 1024);
          PB_Moe2 pb; pb.A = (const char*)(p.ws + WS_Z); pb.ldb = DE; pb.nt = 16; pb.W2 = (const char*)(p.ws + WS_W2); pb.X = (float*)(p.ws + WS_X);
          pb.MODl = (const float*)(p.ws + WS_MOD) + (size_t)l * 9 * 6 * D; pb.LISTP = (const int*)(p.ws + WS_LISTP); pb.tb = tb; pb.G = gridDim.x; pb.c = blockIdx.x;
          pg8::gemm_phase<PB_Moe2, true>((PG8_LAS unsigned char*)lds, pb, p.wid); }
        grid.sync();
    }
    ph_final(p);
}

extern "C" void kernel_launch(void* const* d_in, const int* in_sizes, int n_in, void* d_out, int out_size, void* d_ws, size_t ws_size, hipStream_t stream) {
    if (n_in != N_IN || ws_size < WS_END) { fprintf(stderr, "kernel_launch: bad n_in %d or ws %zu < %zu\n", n_in, ws_size, (size_t)WS_END); return; }
    P p{};
    for (int i = 0; i < N_IN; ++i) p.in[i] = (const float*)d_in[i];
    p.out = (float*)d_out; p.ws = (unsigned char*)d_ws;
    (void)hipMemsetAsync((char*)d_ws + WS_CNT, 0, 4096, stream);
    void* args[] = {&p};
    static bool attr_set = false;
    if (!attr_set) { (void)hipFuncSetAttribute((const void*)fwd_kernel, hipFuncAttributeMaxDynamicSharedMemorySize, LDS_BYTES); attr_set = true; }
    hipError_t e = hipLaunchCooperativeKernel((void*)fwd_kernel, dim3(256), dim3(NT), args, LDS_BYTES, stream);
    if (e != hipSuccess) fprintf(stderr, "cooperative launch failed: %s\n", hipGetErrorString(e));
}
```

```cpp
#include <hip/hip_runtime.h>
#include <hip/hip_cooperative_groups.h>
#include <cstdio>
#include <cstdint>
namespace cg = cooperative_groups;

constexpr int D = 1024, NB = 8, T = 2048, TC = 256, LB = T + TC  , R = NB * LB  ;
constexpr int NZ = 3072, NE = 16, DE = 512;
constexpr float EPS = 1e-6f;
constexpr int ZA_X = 0, ZA_G = 256, ZB_Q = 512, ZB_K = 768, ZB_V = 1024, ZC_U = 1280, ZC_V = 1536, ZD_Q = 1792, ZD_FF = 2048, ZD_FB = 2304, ZD_I = 2560, ZD_G = 2816;
enum { I_X = 0, I_C, I_CTX, I_CCTX, I_WADA, I_BADA, I_N1G, I_N2G, I_WIN, I_WOUT, I_CONVW, I_CONVB, I_WR, I_BR, I_WI, I_BI, I_LAM,
       I_DALAM, I_DASUB, I_SGNG, I_SGW, I_SGB, I_HGLB, I_HGNG, I_RW, I_RB, I_W1, I_W3, I_W2, I_FNG, N_IN };

typedef unsigned short bf16_t;
#define ALAS __attribute__((address_space(3)))
constexpr size_t MiB = 1u << 20;
constexpr size_t WS_MOD = 0;
constexpr size_t WS_CNT = 512 * 1024;
constexpr size_t WS_GP = 1 * MiB;
constexpr size_t WS_LISTP = WS_GP + (size_t)R * 8;
constexpr size_t WS_LRUWT = 768 * 1024;
constexpr size_t WS_LRUAGG = 3 * MiB;
constexpr size_t WS_X = 8 * MiB;
constexpr size_t WS_H = WS_X + (size_t)R * D * 4;
constexpr size_t WS_Z = WS_H + (size_t)R * D * 2;
constexpr size_t WS_Y = WS_Z + (size_t)R * NZ * 2;
constexpr size_t WS_WIN = WS_Y + (size_t)R * D * 2;
constexpr size_t WS_WOUT = WS_WIN + 2 * (size_t)NZ * D * 2;
constexpr size_t WS_W13 = WS_WOUT + 2 * (size_t)D * D * 2;
constexpr size_t WS_W2 = WS_W13 + (size_t)NE * 1024 * D * 2;
constexpr size_t WS_END = WS_W2 + (size_t)NE * D * DE * 2;
constexpr int MPAD = R + 24 * 256;

struct P { const float* in[N_IN]; float* out; unsigned char* ws; int wid; int pad; };
__device__ __forceinline__ int fresh_lane() { int l_; asm volatile("v_mbcnt_lo_u32_b32 %0, -1, 0\n\tv_mbcnt_hi_u32_b32 %0, -1, %0" : "=v"(l_)); return l_; }


__device__ __forceinline__ float bf2f(bf16_t v) { return __uint_as_float(((unsigned)v) << 16); }
__device__ __forceinline__ bf16_t f2bf(float f) { unsigned u = __float_as_uint(f); return (bf16_t)((u + 0x7fffu + ((u >> 16) & 1u)) >> 16); }
__device__ __forceinline__ float sigmoidf_(float x) { return 1.f / (1.f + expf(-x)); }
__device__ __forceinline__ float siluf_(float x) { return x / (1.f + expf(-x)); }
__device__ __forceinline__ float geluf_(float x) { return 0.5f * x * (1.f + tanhf(0.7978845608028654f * (x + 0.044715f * x * x * x))); }
__device__ __forceinline__ float wave_sum(float v) {
#pragma unroll
    for (int o = 1; o < 64; o <<= 1) v += __shfl_xor(v, o);
    return v;
}
__device__ __forceinline__ int row_mi(int r) { const int b = r / LB, j = r - b * LB; return j < TC ? 8 : b; }

#define NT 512
#define NWV 8

__device__ __forceinline__ void ph_init(const P& p) {
    const int tidx = p.wid * 64 + fresh_lane();
    float* X = (float*)(p.ws + WS_X);
    const size_t n4 = (size_t)R * D / 4;
    for (size_t i = (size_t)blockIdx.x * NT + tidx; i < n4; i += (size_t)gridDim.x * NT) {
        const size_t e = i * 4; const int r = (int)(e / D), c = (int)(e % D); const int b = r / LB, j = r - b * LB;
        const float* src = (j < TC) ? p.in[I_CTX] + ((size_t)b * TC + j) * D + c : p.in[I_X] + ((size_t)b * T + (j - TC)) * D + c;
        *(float4*)(X + e) = *(const float4*)src;
    }
}

__device__ __forceinline__ void ph_mod(const P& p, float* sm) {
    const int tidx = p.wid * 64 + fresh_lane();
    float* MOD = (float*)(p.ws + WS_MOD);
    for (int i = tidx; i < 9 * D; i += NT) { const int mi = i / D, k = i % D; const float c = mi < 8 ? p.in[I_C][mi * D + k] : p.in[I_CCTX][k]; sm[i] = siluf_(c); }
    __syncthreads();
    for (int it = blockIdx.x * NT + tidx; it < 2 * 6 * D; it += gridDim.x * NT) {
        const int l = it / (6 * D), n = it % (6 * D);
        const float* W = p.in[I_WADA] + (size_t)l * D * 6 * D + n;
        float acc[9];
#pragma unroll
        for (int m = 0; m < 9; ++m) acc[m] = 0.f;
        for (int k = 0; k < D; ++k) { const float w = W[(size_t)k * 6 * D];
#pragma unroll
            for (int m = 0; m < 9; ++m) acc[m] += sm[m * D + k] * w; }
        const float bb = p.in[I_BADA][l * 6 * D + n];
#pragma unroll
        for (int m = 0; m < 9; ++m) MOD[((size_t)l * 9 + m) * 6 * D + n] = acc[m] + bb;
    }
    __syncthreads();
}

__device__ __forceinline__ void ph_norm1(const P& p, int l) {
    const int tidx = p.wid * 64 + fresh_lane();
    const float* X = (const float*)(p.ws + WS_X); bf16_t* H = (bf16_t*)(p.ws + WS_H);
    const float* MOD = (const float*)(p.ws + WS_MOD) + (size_t)l * 9 * 6 * D; const float* g = p.in[I_N1G] + l * D;
    const int lane = tidx & 63, wv = tidx >> 6;
    for (int r = blockIdx.x * NWV + wv; r < R; r += gridDim.x * NWV) {
        const float* m = MOD + (size_t)row_mi(r) * 6 * D;
        float4 v[4]; float ss = 0.f;
#pragma unroll
        for (int q = 0; q < 4; ++q) { v[q] = *(const float4*)(X + (size_t)r * D + (lane + 64 * q) * 4); ss += v[q].x * v[q].x + v[q].y * v[q].y + v[q].z * v[q].z + v[q].w * v[q].w; }
        const float rs = rsqrtf(wave_sum(ss) * (1.f / D) + EPS);
#pragma unroll
        for (int q = 0; q < 4; ++q) { const int c = (lane + 64 * q) * 4; const float xv[4] = {v[q].x, v[q].y, v[q].z, v[q].w}; bf16_t o[4];
#pragma unroll
            for (int i = 0; i < 4; ++i) o[i] = f2bf(xv[i] * rs * g[c + i] * (1.f + m[D + c + i]) + m[c + i]);
            *(uint2*)(H + (size_t)r * D + c) = make_uint2((unsigned)o[0] | ((unsigned)o[1] << 16), (unsigned)o[2] | ((unsigned)o[3] << 16)); }
    }
}

constexpr float QSCALE = 0.17677669529663687f * 1.4426950408889634f;
__device__ __forceinline__ void ph_rope(const P& p, int l) {
    const int tidx = p.wid * 64 + fresh_lane();
    bf16_t* Z = (bf16_t*)(p.ws + WS_Z);
    const int total = NB * T * 256;
    for (int it = blockIdx.x * NT + tidx; it < total; it += gridDim.x * NT) {
        const int pr = it & 255, rt = it >> 8; const int b = rt / T, t = rt % T;
        const int f = pr & 7, a = (pr >> 3) & 1, n = (pr >> 4) & 1, h = (pr >> 5) & 3, qk = pr >> 7;
        const int col = (qk ? ZB_K : ZB_Q) + h * 64 + n * 32 + a * 16 + f;
        bf16_t* zp = Z + (size_t)(b * LB + TC + t) * NZ + col;
        const float pos = (float)(a == 0 ? (t / 64) : (t % 64));
        const float freq = expf(-(float)f * 0.125f * 9.210340371976184f);
        const float ang = pos * freq; const float c = cosf(ang), sn = sinf(ang);
        const float x1 = bf2f(zp[0]), x2 = bf2f(zp[8]); const float sc = qk ? 1.f : QSCALE;
        zp[0] = f2bf((x1 * c - x2 * sn) * sc); zp[8] = f2bf((x2 * c + x1 * sn) * sc);
    }
    if (l == 0) {
        const int totc = NB * TC * 256;
        for (int it = blockIdx.x * NT + tidx; it < totc; it += gridDim.x * NT) {
            const int c = it & 255, rt = it >> 8; const int b = rt / TC, j = rt % TC;
            bf16_t* zp = Z + (size_t)(b * LB + j) * NZ + ZB_Q + c; zp[0] = f2bf(bf2f(zp[0]) * QSCALE);
        }
    }
}


namespace lru {
typedef short bf16x8 __attribute__((ext_vector_type(8)));
typedef float f32x4 __attribute__((ext_vector_type(4)));
constexpr int UROW = 264;
__device__ __forceinline__ void comp(float& A, float& B, float a, float b) { B = a * B + b; A = a * A; }
}
__device__ __forceinline__ void ph_lru_m1(const P& p, int l, unsigned char* ldsb) {
    using namespace lru;
    const int lane = fresh_lane(), wid = p.wid, tid = wid * 64 + lane;
    const bf16_t* Z = (const bf16_t*)(p.ws + WS_Z); bf16_t* G = (bf16_t*)(p.ws + WS_H); float2* AGG = (float2*)(p.ws + WS_LRUAGG);
    const bf16_t* WT = (const bf16_t*)(p.ws + WS_LRUWT);
    const float* cw = p.in[I_CONVW] + l * 4 * 256; const float* cb = p.in[I_CONVB] + l * 256;
    ALAS bf16_t* U = (ALAS bf16_t*)ldsb;
    const int h = wid & 3, d = wid >> 2, l15 = lane & 15, g4 = lane >> 4;
    float spv[4], brv[4], biv[4];
#pragma unroll
    for (int jt = 0; jt < 4; ++jt) { const int w = h * 64 + jt * 16 + l15; spv[jt] = log1pf(expf(-p.in[I_LAM][(l * 2 + d) * 256 + w])); brv[jt] = p.in[I_BR][(l * 2 + d) * 256 + w]; biv[jt] = p.in[I_BI][(l * 2 + d) * 256 + w]; }
    for (int unit = blockIdx.x; unit < NB * 36; unit += gridDim.x) {
        const int b = unit / 36, c = unit % 36, r0 = b * LB + c * 64; const int lo = c < 4 ? 0 : TC, hi = c < 4 ? TC : LB;
        for (int item = tid; item < 2048; item += NT) {
            const int t = item >> 5, cg = item & 31, j = c * 64 + t; float acc[8];
#pragma unroll
            for (int i = 0; i < 8; ++i) acc[i] = cb[cg * 8 + i];
#pragma unroll
            for (int q = 0; q < 4; ++q) { const int jj = j + q - 2; if (jj >= lo && jj < hi) { const uint4 zv = *(const uint4*)(Z + (size_t)(r0 + t + q - 2) * NZ + ZA_X + cg * 8); const unsigned zw[4] = {zv.x, zv.y, zv.z, zv.w};
#pragma unroll
                for (int i = 0; i < 4; ++i) { acc[2 * i] += __uint_as_float(zw[i] << 16) * cw[q * 256 + cg * 8 + 2 * i]; acc[2 * i + 1] += __uint_as_float(zw[i] & 0xffff0000u) * cw[q * 256 + cg * 8 + 2 * i + 1]; } } }
            uint4 o; o.x = (unsigned)f2bf(acc[0]) | ((unsigned)f2bf(acc[1]) << 16); o.y = (unsigned)f2bf(acc[2]) | ((unsigned)f2bf(acc[3]) << 16); o.z = (unsigned)f2bf(acc[4]) | ((unsigned)f2bf(acc[5]) << 16); o.w = (unsigned)f2bf(acc[6]) | ((unsigned)f2bf(acc[7]) << 16);
            { typedef unsigned u32x4_t __attribute__((ext_vector_type(4))); u32x4_t ov = {o.x, o.y, o.z, o.w}; *(ALAS u32x4_t*)(U + t * UROW + cg * 8) = ov; }
        }
        __syncthreads();
        bf16x8 af[4][2];
#pragma unroll
        for (int tt = 0; tt < 4; ++tt)
#pragma unroll
            for (int ks = 0; ks < 2; ++ks) af[tt][ks] = *(const ALAS bf16x8*)(U + (16 * tt + l15) * UROW + h * 64 + 32 * ks + 8 * g4);
#pragma unroll 1
        for (int jt = 0; jt < 4; ++jt) {
            const float spj = jt == 0 ? spv[0] : jt == 1 ? spv[1] : jt == 2 ? spv[2] : spv[3], brj = jt == 0 ? brv[0] : jt == 1 ? brv[1] : jt == 2 ? brv[2] : brv[3], bij = jt == 0 ? biv[0] : jt == 1 ? biv[1] : jt == 2 ? biv[2] : biv[3];
            f32x4 ar[4], ai[4];
#pragma unroll
            for (int tt = 0; tt < 4; ++tt) { ar[tt] = (f32x4){0.f, 0.f, 0.f, 0.f}; ai[tt] = (f32x4){0.f, 0.f, 0.f, 0.f}; }
#pragma unroll
            for (int ks = 0; ks < 2; ++ks) { const bf16_t* wp = WT + ((size_t)(((l * 2 + d) * 2 + 0) * 4 + h) * 64 + 16 * jt + l15) * 64 + 32 * ks + 8 * g4; const bf16x8 wr = *(const bf16x8*)wp, wi = *(const bf16x8*)(wp + 4 * 64 * 64);
#pragma unroll
                for (int tt = 0; tt < 4; ++tt) { ar[tt] = __builtin_amdgcn_mfma_f32_16x16x32_bf16(af[tt][ks], wr, ar[tt], 0, 0, 0); ai[tt] = __builtin_amdgcn_mfma_f32_16x16x32_bf16(af[tt][ks], wi, ai[tt], 0, 0, 0); } }
            const int w = h * 64 + jt * 16 + l15; float mA[4], mB[4];
#pragma unroll
            for (int tt = 0; tt < 4; ++tt) { float A = 1.f, Bv = 0.f; float av[4], bv[4];
#pragma unroll
                for (int rg = 0; rg < 4; ++rg) { const int t = 16 * tt + 4 * g4 + rg;
                    const float rgt = 1.f / (1.f + __expf(-(ar[tt][rg] + brj))), igt = 1.f / (1.f + __expf(-(ai[tt][rg] + bij)));
                    const float la = -8.f * rgt * spj; const float uu = bf2f(U[t * UROW + w]); const float bc = sqrtf(fmaxf(-expm1f(2.f * la), 0.f)) * igt * uu;
                    const bf16_t lab = f2bf(la), bcb = f2bf(bc);
                    G[((size_t)(d * 2 + 0) * R + r0 + t) * 256 + w] = lab; G[((size_t)(d * 2 + 1) * R + r0 + t) * 256 + w] = bcb;
                    av[rg] = __expf(bf2f(lab)); bv[rg] = bf2f(bcb); }
                if (d == 0) { comp(A, Bv, av[0], bv[0]); comp(A, Bv, av[1], bv[1]); comp(A, Bv, av[2], bv[2]); comp(A, Bv, av[3], bv[3]); }
                else { comp(A, Bv, av[3], bv[3]); comp(A, Bv, av[2], bv[2]); comp(A, Bv, av[1], bv[1]); comp(A, Bv, av[0], bv[0]); }
                mA[tt] = A; mB[tt] = Bv; }
            float A = 1.f, Bv = 0.f;
#pragma unroll
            for (int s4 = 0; s4 < 4; ++s4) { const int tt = d == 0 ? s4 : 3 - s4; const float ma = d == 0 ? mA[s4] : mA[3 - s4], mb = d == 0 ? mB[s4] : mB[3 - s4]; (void)tt;
#pragma unroll
                for (int gs = 0; gs < 4; ++gs) { const int gg = d == 0 ? gs : 3 - gs; const float a = __shfl(ma, gg * 16 + l15), bq = __shfl(mb, gg * 16 + l15); comp(A, Bv, a, bq); } }
            if (g4 == 0) AGG[((size_t)(b * 2 + d) * 36 + c) * 256 + w] = make_float2(A, Bv);
        }
        __syncthreads();
    }
}
__device__ __forceinline__ void ph_lru_m2(const P& p, int l, unsigned char* ldsb) {
    const int lane = fresh_lane(), wid = p.wid, tid = wid * 64 + lane;
    const bf16_t* Z = (const bf16_t*)(p.ws + WS_Z); const bf16_t* G = (const bf16_t*)(p.ws + WS_H); bf16_t* Y = (bf16_t*)(p.ws + WS_Y); const float2* AGG = (const float2*)(p.ws + WS_LRUAGG);
    float* HS = (float*)ldsb;
    const int d = tid >> 8, w = tid & 255;
    const int nun = NB * 36;
    for (int unit = nun - 1 - blockIdx.x; unit >= 0; unit -= gridDim.x) {
        const int b = unit / 36, c = unit % 36, r0 = b * LB + c * 64;
        if (l == 1 && c < 4) continue;
        float hst = 0.f; const float2* ag = AGG + (size_t)(b * 2 + d) * 36 * 256 + w;
        if (d == 0) { for (int cc = 0; cc < c; ++cc) { const float2 m = ag[cc * 256]; hst = m.x * hst + m.y; } }
        else { if (c < 4) { for (int cc = 3; cc > c; --cc) { const float2 m = ag[cc * 256]; hst = m.x * hst + m.y; } }
               else { for (int cc = 3; cc >= 0; --cc) { const float2 m = ag[cc * 256]; hst = m.x * hst + m.y; } for (int cc = 35; cc > c; --cc) { const float2 m = ag[cc * 256]; hst = m.x * hst + m.y; } } }
        const bf16_t* gl = G + ((size_t)(d * 2 + 0) * R + r0) * 256 + w; const bf16_t* gb = G + ((size_t)(d * 2 + 1) * R + r0) * 256 + w;
#pragma unroll 8
        for (int s = 0; s < 64; ++s) { const int t = d == 0 ? s : 63 - s; hst = __expf(bf2f(gl[t * 256])) * hst + bf2f(gb[t * 256]); HS[(d * 64 + t) * 256 + w] = hst; }
        __syncthreads();
        for (int it = tid; it < 64 * 256; it += NT) { const int t = it >> 8, ww = it & 255; const float hs = HS[t * 256 + ww] + HS[(64 + t) * 256 + ww];
            Y[(size_t)(r0 + t) * D + ww] = f2bf(hs * geluf_(bf2f(Z[(size_t)(r0 + t) * NZ + ZA_G + ww]))); }
        __syncthreads();
    }
}

__device__ __forceinline__ void ph_sg(const P& p, int l, float* sm) {
    const int tidx = p.wid * 64 + fresh_lane();
    const bf16_t* Z = (const bf16_t*)(p.ws + WS_Z); bf16_t* Y = (bf16_t*)(p.ws + WS_Y);
    float* vn = sm;
    const float* ng = p.in[I_SGNG] + l * 256;
    const int tid = tidx, q = tid >> 2, part = tid & 3;
    for (int unit = blockIdx.x; unit < NB * 18 * 4; unit += gridDim.x) {
        const int h = unit & 3, bc = unit >> 2, b = bc / 18, ck = bc % 18;
        if (l == 1 && ck < 2) continue;
        const int r0 = b * LB + ck * 128;
        { const bf16_t* zv = Z + (size_t)(r0 + q) * NZ + ZC_V; float ss = 0.f;
          for (int c = part * 64; c < part * 64 + 64; ++c) { const float gv = geluf_(bf2f(zv[c])); ss += gv * gv; }
          ss += __shfl_xor(ss, 1); ss += __shfl_xor(ss, 2);
          const float rs = rsqrtf(ss * (1.f / 256.f) + EPS);
          for (int i = 0; i < 16; ++i) { const int c = part * 16 + i; vn[q * 64 + c] = geluf_(bf2f(zv[h * 64 + c])) * rs * ng[h * 64 + c]; } }
        __syncthreads();
        { const int pp = q; const float* wsp = p.in[I_SGW] + ((size_t)(l * 4 + h) * 128 + pp) * 128; float acc[16];
#pragma unroll
          for (int i = 0; i < 16; ++i) acc[i] = 0.f;
          for (int qq = 0; qq < 128; ++qq) { const float wv = wsp[qq];
#pragma unroll
              for (int i = 0; i < 16; ++i) acc[i] += wv * vn[qq * 64 + part * 16 + i]; }
          const float bsp = p.in[I_SGB][(l * 4 + h) * 128 + pp];
          const bf16_t* zu = Z + (size_t)(r0 + pp) * NZ + ZC_U + h * 64 + part * 16; bf16_t* yo = Y + (size_t)(r0 + pp) * D + 512 + h * 64 + part * 16;
#pragma unroll
          for (int i = 0; i < 16; ++i) yo[i] = f2bf(geluf_(bf2f(zu[i])) * (acc[i] + bsp)); }
        __syncthreads();
    }
}

namespace att {
typedef short bf16x8 __attribute__((ext_vector_type(8)));
typedef short s16x4 __attribute__((ext_vector_type(4)));
typedef float f32x16 __attribute__((ext_vector_type(16)));
typedef float f32x2_t __attribute__((ext_vector_type(2))); typedef __bf16 bf16x2_t __attribute__((ext_vector_type(2)));
constexpr int SLOTB = 8192, NSLOT = 3, L_K = 0, L_V = NSLOT * SLOTB, L_WS = 2 * NSLOT * SLOTB, L_OST = L_WS + 8 * 2 * 32 * 4, OST_W = 32 * 66 * 4;
constexpr float THR = 8.f;
__device__ __forceinline__ int crow(int r, int hi) { return (r & 3) + 8 * (r >> 2) + 4 * hi; }
__device__ __forceinline__ unsigned cvtpk(float lo, float hi) { f32x2_t v = {lo, hi}; bf16x2_t b = __builtin_convertvector(v, bf16x2_t); return __builtin_bit_cast(unsigned, b); }
__device__ __forceinline__ float swapmax(float m) { auto rr = __builtin_amdgcn_permlane32_swap(__float_as_uint(m), __float_as_uint(m), false, false); return fmaxf(__uint_as_float(rr[0]), __uint_as_float(rr[1])); }
__device__ __forceinline__ float swapadd(float m) { auto rr = __builtin_amdgcn_permlane32_swap(__float_as_uint(m), __float_as_uint(m), false, false); return __uint_as_float(rr[0]) + __uint_as_float(rr[1]); }
typedef short v4i16_t __attribute__((ext_vector_type(4)));
__device__ __forceinline__ s16x4 vtr(const ALAS char* q) { return __builtin_bit_cast(s16x4, __builtin_amdgcn_ds_read_tr16_b64_v4i16((ALAS v4i16_t*)q)); }
}
__device__ __forceinline__ void ph_attn(const P& p, int l, unsigned char* ldsb) {
    using namespace att;
    const int lane = fresh_lane(), wid = p.wid, r32 = lane & 31, hi = lane >> 5;
    const bf16_t* Z = (const bf16_t*)(p.ws + WS_Z); bf16_t* Y = (bf16_t*)(p.ws + WS_Y);
    const float lam_init = l == 0 ? 0.2f : (0.8f - 0.6f * 0.7408182206817179f);
    const float* dl_ = p.in[I_DALAM] + l * 4 * 32; float s01 = 0.f, s23 = 0.f;
    for (int i = 0; i < 32; ++i) { s01 += dl_[i] * dl_[32 + i]; s23 += dl_[64 + i] * dl_[96 + i]; }
    const float lam = expf(s01) - expf(s23) + lam_init;
    const float* subg = p.in[I_DASUB] + l * 64;
    const int G = gridDim.x, bx = blockIdx.x, vcu = (G % 8 == 0) ? (bx % 8) * (G / 8) + bx / 8 : bx;
    const int nun = 256 + (l == 0 ? 32 : 0);
    ALAS char* L3 = (ALAS char*)ldsb;
    ALAS float* wsf = (ALAS float*)(L3 + L_WS) + wid * 64;
    ALAS float* stg = (ALAS float*)(L3 + L_OST + wid * OST_W);
    const ALAS char* kp0 = L3 + L_K + hi * 1024 + r32 * 16;
    const ALAS char* vp0 = L3 + L_V + ((lane >> 4) & 1) * 32 + (lane & 3) * 8 + (4 * hi + ((lane & 15) >> 2)) * 64;
    for (int u = vcu; u < nun; u += G) {
        int b, h, q0row, nt;
        if (u < 256) { b = u >> 5; h = (u >> 3) & 3; q0row = b * LB + TC + (u & 7) * 256; nt = LB / 64; } else { const int v = u - 256; b = v >> 2; h = v & 3; q0row = b * LB; nt = TC / 64; }
        const bf16_t* ksrc = Z + (size_t)(b * LB + lane) * NZ + ZB_K + h * 64 + wid * 8;
        const bf16_t* vsrc = Z + (size_t)(b * LB + 16 * (wid & 3) + (lane >> 2)) * NZ + ZB_V + h * 64 + (wid >> 2) * 32 + (lane & 3) * 8;
#define ATT_DMA(t, slot) do { __builtin_amdgcn_global_load_lds((const unsigned*)(ksrc + (size_t)(t) * 64 * NZ), (ALAS unsigned*)(L3 + L_K + (slot) * SLOTB + wid * 1024), 16, 0, 0); \
                              __builtin_amdgcn_global_load_lds((const unsigned*)(vsrc + (size_t)(t) * 64 * NZ), (ALAS unsigned*)(L3 + L_V + (slot) * SLOTB + wid * 1024), 16, 0, 0); } while (0)
        ATT_DMA(0, 0); ATT_DMA(1, 1);
        bf16x8 qr[4];
        { const bf16_t* qp = Z + (size_t)(q0row + wid * 32 + r32) * NZ + ZB_Q + h * 64 + hi * 8;
#pragma unroll
          for (int d0 = 0; d0 < 4; ++d0) qr[d0] = *(const bf16x8*)(qp + d0 * 16); }
        f32x16 o[2][2], negm[2]; float mrun[2] = {0.f, 0.f}, lsum[2] = {0.f, 0.f};
#pragma unroll
        for (int n = 0; n < 2; ++n) { negm[n] = f32x16{}; o[n][0] = f32x16{}; o[n][1] = f32x16{}; }
        __syncthreads();
        int slot = 0;
        for (int t = 0; t < nt; ++t) {
            if (t + 2 < nt) { const int s2 = slot == 0 ? 2 : slot - 1; ATT_DMA(t + 2, s2); }
            const int so = slot * SLOTB;
            bf16x8 pa[2][4];
#pragma unroll
            for (int n = 0; n < 2; ++n) {
                const bf16x8 k00 = *(const ALAS bf16x8*)(kp0 + so + (2 * n) * 2048), k01 = *(const ALAS bf16x8*)(kp0 + so + (2 * n) * 2048 + 512);
                const bf16x8 k10 = *(const ALAS bf16x8*)(kp0 + so + (2 * n + 1) * 2048), k11 = *(const ALAS bf16x8*)(kp0 + so + (2 * n + 1) * 2048 + 512);
                f32x16 c0 = __builtin_amdgcn_mfma_f32_32x32x16_bf16(k00, qr[2 * n], negm[n], 0, 0, 0);
                f32x16 c1 = __builtin_amdgcn_mfma_f32_32x32x16_bf16(k01, qr[2 * n], negm[n], 0, 0, 0);
                c0 = __builtin_amdgcn_mfma_f32_32x32x16_bf16(k10, qr[2 * n + 1], c0, 0, 0, 0);
                c1 = __builtin_amdgcn_mfma_f32_32x32x16_bf16(k11, qr[2 * n + 1], c1, 0, 0, 0);
                float rm = fmaxf(c0[0], c1[0]);
#pragma unroll
                for (int r = 1; r < 16; ++r) rm = fmaxf(rm, fmaxf(c0[r], c1[r]));
                rm = swapmax(rm);
                if (t == 0 || __any(rm > THR)) {
                    const float dl = t == 0 ? rm : fmaxf(rm, 0.f); mrun[n] += dl;
#pragma unroll
                    for (int r = 0; r < 16; ++r) { c0[r] -= dl; c1[r] -= dl; negm[n][r] = -mrun[n]; }
                    const float f = exp2f(-dl); lsum[n] *= f;
                    if (hi == 0) wsf[n * 32 + r32] = f;
#pragma unroll
                    for (int r = 0; r < 16; ++r) { const float ff = wsf[n * 32 + crow(r, hi)]; o[n][0][r] *= ff; o[n][1][r] *= ff; }
                }
                float sacc = 0.f;
#pragma unroll
                for (int r = 0; r < 16; ++r) { c0[r] = __builtin_amdgcn_exp2f(c0[r]); c1[r] = __builtin_amdgcn_exp2f(c1[r]); sacc += c0[r] + c1[r]; }
                lsum[n] += sacc;
#pragma unroll
                for (int k = 0; k < 2; ++k) {
                    uint4 q0 = make_uint4(cvtpk(c0[8 * k], c0[8 * k + 1]), cvtpk(c0[8 * k + 2], c0[8 * k + 3]), cvtpk(c0[8 * k + 4], c0[8 * k + 5]), cvtpk(c0[8 * k + 6], c0[8 * k + 7]));
                    uint4 q1 = make_uint4(cvtpk(c1[8 * k], c1[8 * k + 1]), cvtpk(c1[8 * k + 2], c1[8 * k + 3]), cvtpk(c1[8 * k + 4], c1[8 * k + 5]), cvtpk(c1[8 * k + 6], c1[8 * k + 7]));
                    pa[n][k] = __builtin_bit_cast(bf16x8, q0); pa[n][2 + k] = __builtin_bit_cast(bf16x8, q1); }
            }
#pragma unroll
            for (int d0 = 0; d0 < 2; ++d0) {
                bf16x8 vf[4];
#pragma unroll
                for (int k = 0; k < 4; ++k) { const s16x4 lo = vtr(vp0 + so + d0 * 4096 + k * 1024), hh = vtr(vp0 + so + d0 * 4096 + k * 1024 + 512);
                    vf[k] = (bf16x8){lo[0], lo[1], lo[2], lo[3], hh[0], hh[1], hh[2], hh[3]}; }
#pragma unroll
                for (int k = 0; k < 4; ++k) { o[0][d0] = __builtin_amdgcn_mfma_f32_32x32x16_bf16(pa[0][k], vf[k], o[0][d0], 0, 0, 0); o[1][d0] = __builtin_amdgcn_mfma_f32_32x32x16_bf16(pa[1][k], vf[k], o[1][d0], 0, 0, 0); }
            }
            __syncthreads();
            slot = slot == 2 ? 0 : slot + 1;
        }
        { const float l1 = swapadd(lsum[0]), l2 = swapadd(lsum[1]);
          if (hi == 0) { wsf[r32] = 1.f / l1; wsf[32 + r32] = lam / l2; }
#pragma unroll
          for (int r = 0; r < 16; ++r) { const int q = crow(r, hi); const float a = wsf[q], bb = wsf[32 + q];
              stg[q * 66 + r32] = o[0][0][r] * a - o[1][0][r] * bb; stg[q * 66 + 32 + r32] = o[0][1][r] * a - o[1][1][r] * bb; }
          const int row = lane >> 1, half = lane & 1; float ov[32]; float ss = 0.f;
#pragma unroll
          for (int i = 0; i < 32; ++i) { ov[i] = stg[row * 66 + half * 32 + i]; ss += ov[i] * ov[i]; }
          ss += __shfl_xor(ss, 1);
          const float rs = rsqrtf(ss * (1.f / 64.f) + EPS) * (1.f - lam_init);
          bf16_t* yo = Y + (size_t)(q0row + wid * 32 + row) * D + 256 + h * 64 + half * 32;
#pragma unroll
          for (int i = 0; i < 4; ++i) { unsigned w[4];
#pragma unroll
              for (int k = 0; k < 4; ++k) w[k] = cvtpk(ov[8 * i + 2 * k] * rs * subg[half * 32 + 8 * i + 2 * k], ov[8 * i + 2 * k + 1] * rs * subg[half * 32 + 8 * i + 2 * k + 1]);
              *(uint4*)(yo + 8 * i) = make_uint4(w[0], w[1], w[2], w[3]); } }
        __syncthreads();
#undef ATT_DMA
    }
}


namespace hg {
typedef short bf16x8 __attribute__((ext_vector_type(8)));
typedef short s16x4 __attribute__((ext_vector_type(4)));
typedef float f32x16 __attribute__((ext_vector_type(16)));
typedef float f32x4v __attribute__((ext_vector_type(4)));
constexpr int QROW = 72;
constexpr int W_Q = 0, W_K = 4608, W_KH = 9216, W_V = 13312, W_BYTES = 17408;
constexpr int L_ST = 8 * W_BYTES;
constexpr int STROW = 68, L_BS = L_ST + 64 * STROW * 4;
constexpr int AGG_FLOATS = 64 * 64 + 64;
__device__ __forceinline__ int img_off(int s, int col) { return ((col >> 5) * 2 + (s >> 4)) * 1024 + (s & 15) * 64 + (col & 31) * 2; }
}
constexpr int LDS_MISC = hg::L_BS + 256;
template <int PASS>
__device__ __forceinline__ void ph_hg(const P& p, int l, unsigned char* ldsb) {
    using namespace hg;
    const int wid = p.wid;
    const bf16_t* Z = (const bf16_t*)(p.ws + WS_Z); bf16_t* Y = (bf16_t*)(p.ws + WS_Y); float* AGG = (float*)p.out;
    ALAS char* L3 = (ALAS char*)ldsb; ALAS char* LW = L3 + wid * W_BYTES;
    ALAS float* ST = (ALAS float*)(L3 + L_ST); ALAS float* BS = (ALAS float*)(L3 + L_BS);
    const float* gn = p.in[I_HGNG] + l * 256;
    for (int unit = blockIdx.x; unit < NB * 4 * 9; unit += gridDim.x) {
        const int sc = unit % 9, bh = unit / 9, h = bh & 3, b = bh >> 2;
        if (PASS == 2 && l == 1 && sc == 0) continue;
        const int lane = fresh_lane();
        const int tid = wid * 64 + lane, r32 = lane & 31, hi = lane >> 5;
        const ALAS char* trb = LW + ((lane >> 4) & 1) * 32 + (lane & 3) * 8 + (4 * hi + ((lane & 15) >> 2)) * 64;
        float* OSG = (float*)p.out + (size_t)4 * 1024 * 1024 + (size_t)blockIdx.x * 16384;
#pragma unroll 1
        for (int d = 0; d < 2; ++d) {
            float lb = 0.f;
            if (l == 1) { const float* hl = p.in[I_HGLB] + (size_t)d * 2 * 256 + h * 64 + lane; lb = sigmoidf_(hl[256] - hl[0]); }
            const int fcol = (d == 0 ? ZD_FF : ZD_FB) + h * 64 + lane;
            const int jbase = b * LB + sc * 256;
            float Btot = 0.f;
#pragma unroll 4
            for (int tau = 0; tau < 32; ++tau) { const int jl = d == 0 ? (32 * wid + tau) : (255 - 32 * wid - tau); const bf16_t* zr = Z + (size_t)(jbase + jl) * NZ;
                const float f = lb + (1.f - lb) * sigmoidf_(bf2f(zr[fcol])); Btot += fmaxf(__logf(f), -80.f); }
            { float run = 0.f;
#pragma unroll 4
              for (int tau = 0; tau < 32; ++tau) { const int jl = d == 0 ? (32 * wid + tau) : (255 - 32 * wid - tau); const bf16_t* zr = Z + (size_t)(jbase + jl) * NZ;
                const float f = lb + (1.f - lb) * sigmoidf_(bf2f(zr[fcol])); run += fmaxf(__logf(f), -80.f); const float kk = 1.f - f;
                *(ALAS bf16_t*)(LW + W_KH + img_off(tau, lane)) = f2bf(kk * __expf(Btot - run));
                *(ALAS bf16_t*)(LW + W_V + img_off(tau, lane)) = zr[ZD_I + h * 64 + lane];
                if (PASS == 2) { *(ALAS bf16_t*)(LW + W_Q + (tau * QROW + lane) * 2) = f2bf(bf2f(zr[ZD_Q + h * 64 + lane]) * 0.125f * __expf(run));
                                 *(ALAS bf16_t*)(LW + W_K + (tau * QROW + lane) * 2) = f2bf(kk * __expf(fminf(-run, 80.f))); } } }
            f32x16 sl[2][2];
#pragma unroll
            for (int cv = 0; cv < 2; ++cv)
#pragma unroll
                for (int cd = 0; cd < 2; ++cd) sl[cv][cd] = f32x16{};
            bf16x8 vfr[2][2];
#pragma unroll
            for (int ks = 0; ks < 2; ++ks)
#pragma unroll
                for (int ch = 0; ch < 2; ++ch) { const s16x4 lo = att::vtr(trb + W_V + (ch * 2 + ks) * 1024), hh = att::vtr(trb + W_V + (ch * 2 + ks) * 1024 + 512);
                    vfr[ks][ch] = (bf16x8){lo[0], lo[1], lo[2], lo[3], hh[0], hh[1], hh[2], hh[3]}; }
#pragma unroll
            for (int ks = 0; ks < 2; ++ks)
#pragma unroll
                for (int cd = 0; cd < 2; ++cd) { const s16x4 lo = att::vtr(trb + W_KH + (cd * 2 + ks) * 1024), hh = att::vtr(trb + W_KH + (cd * 2 + ks) * 1024 + 512);
                    const bf16x8 kf = (bf16x8){lo[0], lo[1], lo[2], lo[3], hh[0], hh[1], hh[2], hh[3]};
#pragma unroll
                    for (int cv = 0; cv < 2; ++cv) sl[cv][cd] = __builtin_amdgcn_mfma_f32_32x32x16_bf16(vfr[ks][cv], kf, sl[cv][cd], 0, 0, 0); }
            f32x16 o[2]; o[0] = f32x16{}; o[1] = f32x16{};
            bf16x8 qf[4];
            if (PASS == 2) {
                f32x16 c = f32x16{};
#pragma unroll
                for (int d0 = 0; d0 < 4; ++d0) { qf[d0] = *(const ALAS bf16x8*)(LW + W_Q + (r32 * QROW + 16 * d0 + 8 * hi) * 2);
                    const bf16x8 kf = *(const ALAS bf16x8*)(LW + W_K + (r32 * QROW + 16 * d0 + 8 * hi) * 2);
                    c = __builtin_amdgcn_mfma_f32_32x32x16_bf16(kf, qf[d0], c, 0, 0, 0); }
#pragma unroll
                for (int r = 0; r < 16; ++r) { const int srow = att::crow(r, hi); if (srow > r32) c[r] = 0.f; }
#pragma unroll
                for (int ks = 0; ks < 2; ++ks) { const uint4 q4 = make_uint4(att::cvtpk(c[8 * ks], c[8 * ks + 1]), att::cvtpk(c[8 * ks + 2], c[8 * ks + 3]), att::cvtpk(c[8 * ks + 4], c[8 * ks + 5]), att::cvtpk(c[8 * ks + 6], c[8 * ks + 7]));
                    const bf16x8 pa = __builtin_bit_cast(bf16x8, q4);
                    o[0] = __builtin_amdgcn_mfma_f32_32x32x16_bf16(pa, vfr[ks][0], o[0], 0, 0, 0); o[1] = __builtin_amdgcn_mfma_f32_32x32x16_bf16(pa, vfr[ks][1], o[1], 0, 0, 0); }
            }
            { const float* ag = AGG + (size_t)((b * 4 + h) * 2 + d) * 9 * AGG_FLOATS;
              for (int e = tid; e < 4096; e += NT) { const int v = e >> 6, dd = e & 63; float sv = 0.f;
                  if (PASS == 2 && sc > 0) {
                      if (d == 0) { for (int s2 = 0; s2 < sc; ++s2) sv = __expf(ag[(size_t)s2 * AGG_FLOATS + 4096 + dd]) * sv + ag[(size_t)s2 * AGG_FLOATS + e]; }
                      else { sv = ag[e]; for (int s2 = 8; s2 > sc; --s2) sv = __expf(ag[(size_t)s2 * AGG_FLOATS + 4096 + dd]) * sv + ag[(size_t)s2 * AGG_FLOATS + e]; } }
                  ST[v * STROW + dd] = sv; }
              if (tid < 64) BS[tid] = 0.f; }
            __syncthreads();
#pragma unroll 1
            for (int step = 0; step < 8; ++step) {
                if (wid == step) {
                    if (PASS == 2) {
#pragma unroll
                        for (int cv = 0; cv < 2; ++cv)
#pragma unroll
                            for (int d0 = 0; d0 < 4; ++d0) { const ALAS float* sp = ST + (32 * cv + r32) * STROW + 16 * d0 + 8 * hi; const f32x4v s0 = *(const ALAS f32x4v*)sp, s1 = *(const ALAS f32x4v*)(sp + 4);
                                const uint4 q4 = make_uint4(att::cvtpk(s0[0], s0[1]), att::cvtpk(s0[2], s0[3]), att::cvtpk(s1[0], s1[1]), att::cvtpk(s1[2], s1[3]));
                                o[cv] = __builtin_amdgcn_mfma_f32_32x32x16_bf16(qf[d0], __builtin_bit_cast(bf16x8, q4), o[cv], 0, 0, 0); }
                    }
                    const float dk = __expf(Btot);
                    int sbase = (4 * hi) * STROW + r32; asm volatile("" : "+v"(sbase));
#pragma unroll
                    for (int cd = 0; cd < 2; ++cd) { const float dkd = __shfl(dk, 32 * cd + r32);
#pragma unroll
                        for (int cv = 0; cv < 2; ++cv)
#pragma unroll
                            for (int r = 0; r < 16; ++r) { ALAS float* sp = ST + sbase + (32 * cv + (r & 3) + 8 * (r >> 2)) * STROW + 32 * cd; *sp = dkd * *sp + sl[cv][cd][r]; } }
                    BS[lane] += Btot;
                }
                __syncthreads();
            }
            if (PASS == 1) {
                float* ag = AGG + ((size_t)((b * 4 + h) * 2 + d) * 9 + sc) * AGG_FLOATS;
                for (int e = tid; e < 4096; e += NT) ag[e] = ST[(e >> 6) * STROW + (e & 63)];
                if (tid < 64) ag[4096 + tid] = BS[tid];
                __syncthreads();
            } else {
                if (d == 0) {
                    int base = (32 * wid + 4 * hi) * 64 + r32; asm volatile("" : "+v"(base));
#pragma unroll
                    for (int r = 0; r < 16; ++r) { const int off = base + ((r & 3) + 8 * (r >> 2)) * 64; OSG[off] = o[0][r]; OSG[off + 32] = o[1][r]; }
                }
                else {
                    ALAS float* OS = (ALAS float*)L3;
                    int base = (255 - 32 * wid - 4 * hi) * 64 + r32; asm volatile("" : "+v"(base));
#pragma unroll
                    for (int r = 0; r < 16; ++r) { const int off = base - ((r & 3) + 8 * (r >> 2)) * 64; OS[off] = o[0][r] + OSG[off]; OS[off + 32] = o[1][r] + OSG[off + 32]; }
                    __syncthreads();
                    { int tl = 32 * wid + (lane >> 1); asm volatile("" : "+v"(tl)); const int half = lane & 1; float ov[32]; float ss = 0.f;
#pragma unroll
                      for (int i = 0; i < 32; ++i) { ov[i] = OS[tl * 64 + half * 32 + i]; ss += ov[i] * ov[i]; }
                      ss += __shfl_xor(ss, 1);
                      const float rs = rsqrtf(ss * (1.f / 64.f) + EPS);
                      const size_t row = (size_t)(jbase + tl); const bf16_t* zg = Z + row * NZ + ZD_G + h * 64 + half * 32; bf16_t* yo = Y + row * D + 768 + h * 64 + half * 32;
#pragma unroll
                      for (int i = 0; i < 4; ++i) { unsigned w4[4];
#pragma unroll
                          for (int k2 = 0; k2 < 4; ++k2) { const int c0 = 8 * i + 2 * k2; w4[k2] = att::cvtpk(ov[c0] * rs * gn[h * 64 + half * 32 + c0] * siluf_(bf2f(zg[c0])), ov[c0 + 1] * rs * gn[h * 64 + half * 32 + c0 + 1] * siluf_(bf2f(zg[c0 + 1]))); }
                          *(uint4*)(yo + 8 * i) = make_uint4(w4[0], w4[1], w4[2], w4[3]); } }
                    __syncthreads();
                }
            }
        }
    }
}

__device__ __forceinline__ void ph_router(const P& p, int l, unsigned char* ldsb) {
    const int tidx = p.wid * 64 + fresh_lane();
    const float* X = (const float*)(p.ws + WS_X); bf16_t* H = (bf16_t*)(p.ws + WS_H);
    float2* GP = (float2*)(p.ws + WS_GP); int* LISTP = (int*)(p.ws + WS_LISTP); unsigned* CNT = (unsigned*)(p.ws + WS_CNT) + l * 32;
    const float* MOD = (const float*)(p.ws + WS_MOD) + (size_t)l * 9 * 6 * D; const float* g = p.in[I_N2G] + l * D;
    const float* RW = p.in[I_RW]; const float* RB = p.in[I_RB];
    int* lc = (int*)ldsb; int* lbase = lc + 32; int* rpair = lc + 64; int* rrank = lc + 64 + 72;
    const int lane = tidx & 63, wv = tidx >> 6;
    for (int chunk = blockIdx.x; chunk < R / 72; chunk += gridDim.x) {
        if (tidx < 32) lc[tidx] = 0;
        __syncthreads();
        for (int k = 0; k < 9; ++k) {
            const int li = wv * 9 + k, r = chunk * 72 + li;
            if (l == 1 && (r % LB) < TC) { if (lane == 0) rpair[li] = -1; continue; }
            const float* m = MOD + (size_t)row_mi(r) * 6 * D;
            float4 v[4]; float ss = 0.f;
#pragma unroll
            for (int q = 0; q < 4; ++q) { v[q] = *(const float4*)(X + (size_t)r * D + (lane + 64 * q) * 4); ss += v[q].x * v[q].x + v[q].y * v[q].y + v[q].z * v[q].z + v[q].w * v[q].w; }
            const float rs = rsqrtf(wave_sum(ss) * (1.f / D) + EPS);
            float lg[16];
#pragma unroll
            for (int e = 0; e < 16; ++e) lg[e] = 0.f;
#pragma unroll
            for (int q = 0; q < 4; ++q) { const int c = (lane + 64 * q) * 4; const float xv[4] = {v[q].x, v[q].y, v[q].z, v[q].w}; bf16_t o[4];
#pragma unroll
                for (int i = 0; i < 4; ++i) { const float hv = xv[i] * rs * g[c + i] * (1.f + m[4 * D + c + i]) + m[3 * D + c + i]; o[i] = f2bf(hv);
                    const float4* rw = (const float4*)(RW + (size_t)(c + i) * 16);
#pragma unroll
                    for (int e4 = 0; e4 < 4; ++e4) { const float4 w4 = rw[e4]; lg[e4 * 4 + 0] += hv * w4.x; lg[e4 * 4 + 1] += hv * w4.y; lg[e4 * 4 + 2] += hv * w4.z; lg[e4 * 4 + 3] += hv * w4.w; } }
                *(uint2*)(H + (size_t)r * D + c) = make_uint2((unsigned)o[0] | ((unsigned)o[1] << 16), (unsigned)o[2] | ((unsigned)o[3] << 16)); }
#pragma unroll
            for (int e = 0; e < 16; ++e) lg[e] = wave_sum(lg[e]) + RB[e];
            float mx = lg[0];
#pragma unroll
            for (int e = 1; e < 16; ++e) mx = fmaxf(mx, lg[e]);
            float sc[16], sum = 0.f;
#pragma unroll
            for (int e = 0; e < 16; ++e) { sc[e] = expf(lg[e] - mx); sum += sc[e]; }
            const float inv = 1.f / sum;
#pragma unroll
            for (int e = 0; e < 16; ++e) sc[e] *= inv;
            int gsel = 0; float gbest = -1.f;
#pragma unroll
            for (int gI = 0; gI < 4; ++gI) { float t1 = -1.f, t2 = -1.f;
#pragma unroll
                for (int i = 0; i < 4; ++i) { const float sv = sc[gI * 4 + i]; if (sv > t1) { t2 = t1; t1 = sv; } else if (sv > t2) t2 = sv; }
                const float gs = t1 + t2; if (gs > gbest) { gbest = gs; gsel = gI; } }
            float w1 = -1.f, w2 = -1.f; int i1 = 0, i2 = 0;
#pragma unroll
            for (int e = 0; e < 16; ++e) { if ((e >> 2) == gsel) { const float sv = sc[e]; if (sv > w1) { w2 = w1; i2 = i1; w1 = sv; i1 = e; } else if (sv > w2) { w2 = sv; i2 = e; } } }
            const float wn = 1.f / (w1 + w2);
            if (lane == 0) {
                const int a = (i1 < i2 ? i1 : i2) & 3, b = (i1 < i2 ? i2 : i1) & 3;
                const int q = a == 0 ? b - 1 : (a == 1 ? b + 1 : 5);
                const int pr = gsel * 6 + q;
                GP[r] = i1 < i2 ? make_float2(w1 * wn, w2 * wn) : make_float2(w2 * wn, w1 * wn);
                rpair[li] = pr; rrank[li] = atomicAdd(&lc[pr], 1);
            }
        }
        __syncthreads();
        if (tidx < 24) lbase[tidx] = lc[tidx] ? (int)atomicAdd(&CNT[tidx], (unsigned)lc[tidx]) : 0;
        __syncthreads();
        if (tidx < 72) { const int pr = rpair[tidx]; if (pr >= 0) LISTP[(size_t)pr * R + lbase[pr] + rrank[tidx]] = chunk * 72 + tidx; }
        __syncthreads();
    }
}

__device__ __forceinline__ void ph_final(const P& p) {
    const int tidx = p.wid * 64 + fresh_lane();
    const float* X = (const float*)(p.ws + WS_X); const float* g = p.in[I_FNG];
    const int lane = tidx & 63, wv = tidx >> 6;
    for (int it = blockIdx.x * NWV + wv; it < NB * T; it += gridDim.x * NWV) {
        const int b = it / T, t = it % T; const int r = b * LB + TC + t;
        float4 v[4]; float ss = 0.f;
#pragma unroll
        for (int q = 0; q < 4; ++q) { v[q] = *(const float4*)(X + (size_t)r * D + (lane + 64 * q) * 4); ss += v[q].x * v[q].x + v[q].y * v[q].y + v[q].z * v[q].z + v[q].w * v[q].w; }
        const float rs = rsqrtf(wave_sum(ss) * (1.f / D) + EPS);
#pragma unroll
        for (int q = 0; q < 4; ++q) { const int c = (lane + 64 * q) * 4; const float4 gg = *(const float4*)(g + c);
            *(float4*)(p.out + (size_t)it * D + c) = make_float4(v[q].x * rs * gg.x, v[q].y * rs * gg.y, v[q].z * rs * gg.z, v[q].w * rs * gg.w); }
    }
}


namespace pg8 {
#define PG8_LAS __attribute__((address_space(3)))
typedef short bf16x8 __attribute__((ext_vector_type(8)));
typedef float f32x4 __attribute__((ext_vector_type(4)));
typedef unsigned u32x4 __attribute__((ext_vector_type(4)));
constexpr int BM = 256, BK = 64, HALF = 128, HTB = HALF * BK * 2, STAGE_BYTES = 8 * HTB, NXCD = 8, WGM = 8;
__host__ __device__ __forceinline__ int lds_byte(int r, int c) { const int st = (r >> 4) * 2 + (c >> 5), rr = r & 15, cc = c & 31, ob = rr * 64 + cc * 2; return st * 1024 + (ob ^ (((ob >> 9) & 1) << 5)); }
__host__ __device__ __forceinline__ void stage_rc(int b, int& R, int& C) { const int st = b / 1024, sb = b % 1024, swz = sb ^ (((sb >> 9) & 1) << 5); R = (st >> 1) * 16 + swz / 64; C = (st & 1) * 32 + (swz % 64) / 2; }
__host__ __device__ __forceinline__ int perm32(int rho) { const int n = rho >> 4, i = rho & 15; return 8 * (i >> 2) + 4 * n + (i & 3); }
__device__ __forceinline__ unsigned cvt_pk_bf16(float lo, float hi) { unsigned r; asm volatile("v_cvt_pk_bf16_f32 %0, %1, %2" : "=v"(r) : "v"(lo), "v"(hi)); return r; }
struct Unit { int pm, pn, aux; };
__device__ __forceinline__ bool static_next(int i, int G, int c, int nM, int nN, int& pm, int& pn) {
    const int nwg = nM * nN; const long L = (long)i * G + c; if (L >= nwg) return false;
    int wgid = (int)L; { const int q = nwg / NXCD, r = nwg % NXCD, xcd = wgid % NXCD, off = wgid / NXCD; wgid = (xcd < r ? xcd * (q + 1) : r * (q + 1) + (xcd - r) * q) + off; }
    const int nig = WGM * nN, gid = wgid / nig, fm = gid * WGM, gsz = (nM - fm) < WGM ? (nM - fm) : WGM;
    pm = fm + ((wgid % nig) % gsz); pn = (wgid % nig) / gsz; return true;
}
template <class PB, bool ALIGN_EPI>
__device__ __forceinline__ void gemm_phase(PG8_LAS unsigned char* lds, const PB& S, const int wid) {
    const int lane = fresh_lane(), tid = wid * 64 + lane, wr = wid >> 2, wc = wid & 3, fr = lane & 15, fq = lane >> 4;
    const int nt = S.nt;
    int Rst[2], Cst[2]; unsigned voffB[2];
#pragma unroll
    for (int i = 0; i < 2; ++i) { int R_, C_; stage_rc(tid * 16 + i * 8192, R_, C_); Rst[i] = R_; Cst[i] = C_; const int Rb = PB::PERM ? ((R_ & ~31) + perm32(R_ & 31)) : R_; voffB[i] = (unsigned)(Rb * S.ldb + C_) * 2u; }
    const size_t kstep = (size_t)(BK * 2);
    const size_t hstepB = (size_t)HALF * S.ldb * 2;
    const unsigned ldsw = (unsigned)wid * 1024u;
    const int aoff = lds_byte(wr * 64 + fr, fq * 8), boff = lds_byte(wc * 32 + fr, fq * 8);
#define PG8_SA(b, h) (((b) * 2 + (h)) * HTB)
#define PG8_SB(b, h) ((4 + (b) * 2 + (h)) * HTB)
#define PG8_STAGE(bufoff, gbase, voff) do { _Pragma("unroll") for (int _i = 0; _i < 2; ++_i) { unsigned _o = (voff)[_i]; asm volatile("" : "+v"(_o)); \
        __builtin_amdgcn_global_load_lds((const unsigned*)((const char*)(gbase) + _o), (PG8_LAS unsigned*)(lds + (bufoff) + ldsw + _i * 8192), 16, 0, 0); } } while (0)
#define PG8_LDA(dst, b, h) do { _Pragma("unroll") for (int m = 0; m < 4; ++m) _Pragma("unroll") for (int k = 0; k < 2; ++k) dst[m][k] = *(const PG8_LAS bf16x8*)(lds + PG8_SA(b, h) + aoff + m * 2048 + k * 1024); } while (0)
#define PG8_LDB(dst, b, h) do { _Pragma("unroll") for (int n = 0; n < 2; ++n) _Pragma("unroll") for (int k = 0; k < 2; ++k) dst[n][k] = *(const PG8_LAS bf16x8*)(lds + PG8_SB(b, h) + boff + n * 2048 + k * 1024); } while (0)
#define PG8_MMA(ai, bj, At, Bt) do { __builtin_amdgcn_s_setprio(1); _Pragma("unroll") for (int m = 0; m < 4; ++m) _Pragma("unroll") for (int n = 0; n < 2; ++n) _Pragma("unroll") for (int k = 0; k < 2; ++k) \
        acc[ai][bj][m][n] = __builtin_amdgcn_mfma_f32_16x16x32_bf16(Bt[n][k], At[m][k], acc[ai][bj][m][n], 0, 0, 0); __builtin_amdgcn_s_setprio(0); } while (0)
#define PG8_WAIT_V(n) asm volatile("s_waitcnt vmcnt(" #n ")" ::: "memory")
#define PG8_WAIT_L(n) asm volatile("s_waitcnt lgkmcnt(" #n ")" ::: "memory")
#define PG8_BAR __builtin_amdgcn_s_barrier()
#define PG8_SCHED __builtin_amdgcn_sched_barrier(0)
    Unit cur, nxt; int ui = 0;
    if (!S.next(0, cur)) return;
    f32x4 acc[2][2][4][2];
#pragma unroll
    for (int a = 0; a < 2; ++a)
#pragma unroll
        for (int b = 0; b < 2; ++b)
#pragma unroll
            for (int m = 0; m < 4; ++m)
#pragma unroll
                for (int n = 0; n < 2; ++n) acc[a][b][m][n] = (f32x4){0.f, 0.f, 0.f, 0.f};
    bf16x8 At[4][2], B0[2][2], B1[2][2];
    unsigned vc[2][2], vn[2][2];
    S.a_off(cur, Rst, Cst, vc); asm volatile("" : "+v"(vc[0][0]), "+v"(vc[0][1]), "+v"(vc[1][0]), "+v"(vc[1][1]));
    const char* gA = S.A;
    { const char* cB = S.b_ptr(cur, 0); const char* cB1 = S.b_ptr(cur, 1);
      PG8_STAGE(PG8_SB(0, 0), cB, voffB); PG8_STAGE(PG8_SB(0, 1), cB + hstepB, voffB); PG8_STAGE(PG8_SA(0, 0), gA, vc[0]); PG8_STAGE(PG8_SA(0, 1), gA, vc[1]);
      if (wr == 1) PG8_BAR;
      PG8_WAIT_V(2); PG8_BAR;
      PG8_STAGE(PG8_SB(1, 0), cB1, voffB); PG8_STAGE(PG8_SA(1, 0), gA + kstep, vc[0]); PG8_STAGE(PG8_SB(1, 1), cB1 + hstepB, voffB);
      PG8_WAIT_V(6); PG8_BAR; }
    for (;;) {
        const bool has_next = S.next(ui + 1, nxt);
        if (has_next) { S.a_off(nxt, Rst, Cst, vn); asm volatile("" : "+v"(vn[0][0]), "+v"(vn[0][1]), "+v"(vn[1][0]), "+v"(vn[1][1])); }
        else { vn[0][0] = vc[0][0]; vn[0][1] = vc[0][1]; vn[1][0] = vc[1][0]; vn[1][1] = vc[1][1]; nxt = cur; }
        for (int t = 0; t < nt; t += 2) {
            const bool last = (t == nt - 2);
            const char* a1 = gA + (size_t)(t + 1) * kstep;
            const char* a2 = last ? gA : gA + (size_t)(t + 2) * kstep; const char* a3 = a2 + kstep;
            const char* b2 = last ? S.b_ptr(nxt, 0) : S.b_ptr(cur, t + 2);
            const char* b3 = last ? S.b_ptr(nxt, 1) : S.b_ptr(cur, t + 3);
            unsigned o2a[2], o2b[2];
            o2a[0] = last ? vn[0][0] : vc[0][0]; o2a[1] = last ? vn[0][1] : vc[0][1]; o2b[0] = last ? vn[1][0] : vc[1][0]; o2b[1] = last ? vn[1][1] : vc[1][1];
            PG8_LDB(B0, 0, 0); PG8_LDB(B1, 0, 1); PG8_SCHED; PG8_LDA(At, 0, 0); PG8_STAGE(PG8_SA(1, 1), a1, vc[1]);
            PG8_WAIT_V(8); PG8_WAIT_L(0); PG8_BAR; PG8_MMA(0, 0, At, B0); PG8_MMA(0, 1, At, B1); PG8_BAR; PG8_SCHED;
            PG8_LDA(At, 0, 1); PG8_STAGE(PG8_SB(0, 0), b2, voffB); PG8_STAGE(PG8_SB(0, 1), b2 + hstepB, voffB); PG8_STAGE(PG8_SA(0, 0), a2, o2a);
            PG8_WAIT_V(8); PG8_WAIT_L(0); PG8_BAR; PG8_MMA(1, 0, At, B0); PG8_MMA(1, 1, At, B1); PG8_BAR; PG8_SCHED;
            PG8_LDB(B0, 1, 0); PG8_LDB(B1, 1, 1); PG8_SCHED; PG8_LDA(At, 1, 0); PG8_STAGE(PG8_SA(0, 1), a2, o2b);
            PG8_WAIT_V(8); PG8_WAIT_L(0); PG8_BAR; PG8_MMA(0, 0, At, B0); PG8_MMA(0, 1, At, B1); PG8_BAR; PG8_SCHED;
            PG8_LDA(At, 1, 1); PG8_STAGE(PG8_SB(1, 0), b3, voffB); PG8_STAGE(PG8_SB(1, 1), b3 + hstepB, voffB); PG8_STAGE(PG8_SA(1, 0), a3, o2a);
            PG8_WAIT_V(8); PG8_WAIT_L(0); PG8_BAR; PG8_MMA(1, 0, At, B0); PG8_MMA(1, 1, At, B1); PG8_BAR; PG8_SCHED;
        }
        if constexpr (ALIGN_EPI) { if (wr == 0) PG8_BAR; }
        S.epi(acc, cur, wr, wc, fr, fq);
        if (!has_next) break;
#pragma unroll
        for (int a = 0; a < 2; ++a)
#pragma unroll
            for (int b = 0; b < 2; ++b)
#pragma unroll
                for (int m = 0; m < 4; ++m)
#pragma unroll
                    for (int n = 0; n < 2; ++n) acc[a][b][m][n] = (f32x4){0.f, 0.f, 0.f, 0.f};
        cur = nxt; vc[0][0] = vn[0][0]; vc[0][1] = vn[0][1]; vc[1][0] = vn[1][0]; vc[1][1] = vn[1][1]; ++ui;
        if constexpr (ALIGN_EPI) { if (wr == 1) PG8_BAR; }
    }
    PG8_WAIT_V(0);
    if constexpr (!ALIGN_EPI) { if (wr == 0) PG8_BAR; }
    PG8_BAR;
#undef PG8_SA
#undef PG8_SB
#undef PG8_STAGE
#undef PG8_LDA
#undef PG8_LDB
#undef PG8_MMA
#undef PG8_WAIT_V
#undef PG8_WAIT_L
#undef PG8_BAR
#undef PG8_SCHED
}
}

struct PB_InProj {
    static constexpr bool PERM = true;
    const char* A; int ldb, nt; const char* Bt; bf16_t* Zo; int G, c;
    __device__ __forceinline__ bool next(int i, pg8::Unit& u) const { u.aux = 0; return pg8::static_next(i, G, c, R / 256, NZ / 256, u.pm, u.pn); }
    __device__ __forceinline__ void a_off(const pg8::Unit& u, const int (&Rs)[2], const int (&Cs)[2], unsigned (&off)[2][2]) const {
#pragma unroll
        for (int h = 0; h < 2; ++h)
#pragma unroll
            for (int i = 0; i < 2; ++i) off[h][i] = (unsigned)((u.pm * 256 + h * 128 + Rs[i]) * D + Cs[i]) * 2u; }
    __device__ __forceinline__ const char* b_ptr(const pg8::Unit& u, int t) const { return Bt + (size_t)u.pn * 256 * D * 2 + (size_t)t * 128; }
    __device__ __forceinline__ void epi(const pg8::f32x4 (&acc)[2][2][4][2], const pg8::Unit& u, int wr, int wc, int fr, int fq) const {
        const int row0 = u.pm * 256 + wr * 64 + fr, col0 = u.pn * 256 + wc * 32 + 8 * fq;
#pragma unroll
        for (int ai = 0; ai < 2; ++ai)
#pragma unroll
            for (int m = 0; m < 4; ++m) { bf16_t* rowp = Zo + (size_t)(row0 + ai * 128 + m * 16) * NZ + col0;
#pragma unroll
                for (int bj = 0; bj < 2; ++bj) { const pg8::f32x4 v0 = acc[ai][bj][m][0], v1 = acc[ai][bj][m][1]; pg8::u32x4 w;
                    w.x = pg8::cvt_pk_bf16(v0[0], v0[1]); w.y = pg8::cvt_pk_bf16(v0[2], v0[3]); w.z = pg8::cvt_pk_bf16(v1[0], v1[1]); w.w = pg8::cvt_pk_bf16(v1[2], v1[3]);
                    *(pg8::u32x4*)(rowp + bj * 128) = w; } }
    }
};


struct PB_OutProj {
    static constexpr bool PERM = false;
    const char* A; int ldb, nt; const char* Bt; float* X; const float* MODl; int G, c, skipctx;
    __device__ __forceinline__ bool next(int i, pg8::Unit& u) const { u.aux = 0; int pm, pn; if (!pg8::static_next(i, G, c, skipctx ? 64 : 72, 4, pm, pn)) return false; u.pm = skipctx ? (pm >> 3) * 9 + 1 + (pm & 7) : pm; u.pn = pn; return true; }
    __device__ __forceinline__ void a_off(const pg8::Unit& u, const int (&Rs)[2], const int (&Cs)[2], unsigned (&off)[2][2]) const {
#pragma unroll
        for (int h = 0; h < 2; ++h)
#pragma unroll
            for (int i = 0; i < 2; ++i) off[h][i] = (unsigned)((u.pm * 256 + h * 128 + Rs[i]) * D + Cs[i]) * 2u; }
    __device__ __forceinline__ const char* b_ptr(const pg8::Unit& u, int t) const { return Bt + (size_t)u.pn * 256 * D * 2 + (size_t)t * 128; }
    __device__ __forceinline__ void epi(const pg8::f32x4 (&acc)[2][2][4][2], const pg8::Unit& u, int wr, int wc, int fr, int fq) const {
        const int row0 = u.pm * 256 + wr * 64 + fr, col0 = u.pn * 256 + wc * 32 + 4 * fq;
        const float* gt = MODl + (size_t)row_mi(u.pm * 256) * 6 * D + 2 * D + col0;
        pg8::f32x4 gv[2][2];
#pragma unroll
        for (int bj = 0; bj < 2; ++bj)
#pragma unroll
            for (int n = 0; n < 2; ++n) gv[bj][n] = *(const pg8::f32x4*)(gt + bj * 128 + n * 16);
#pragma unroll
        for (int ai = 0; ai < 2; ++ai)
#pragma unroll
            for (int m = 0; m < 4; ++m) { float* rowp = X + (size_t)(row0 + ai * 128 + m * 16) * D + col0;
#pragma unroll
                for (int bj = 0; bj < 2; ++bj)
#pragma unroll
                    for (int n = 0; n < 2; ++n) { pg8::f32x4* xp = (pg8::f32x4*)(rowp + bj * 128 + n * 16); *xp = *xp + gv[bj][n] * acc[ai][bj][m][n]; } }
    }
};

__device__ __forceinline__ void moe_tiles_setup(const P& p, int l, int* tb) {
    const unsigned* CNT = (const unsigned*)(p.ws + WS_CNT) + l * 32;
    __syncthreads();
    if (p.wid == 0 && fresh_lane() == 0) { int acc = 0; for (int q = 0; q < 24; ++q) { const int c = (int)__hip_atomic_load(CNT + q, __ATOMIC_RELAXED, __HIP_MEMORY_SCOPE_AGENT); tb[q] = c; tb[32 + q] = acc; acc += (c + 255) >> 8; } tb[32 + 24] = acc; }
    __syncthreads();
}
__device__ __forceinline__ void pair_experts(int pr, int& e0, int& e1) { const int g4 = (pr / 6) * 4, q = pr % 6; const int a = q < 3 ? 0 : (q < 5 ? 1 : 2), b = q < 3 ? q + 1 : (q < 5 ? q - 1 : 3); e0 = g4 + a; e1 = g4 + b; }

struct PB_Moe1 {
    static constexpr bool PERM = false;
    const char* A; int ldb, nt; const char* W13; bf16_t* HE; const int* LISTP; const float2* GP; const int* tb; int G, c;
    __device__ __forceinline__ bool next(int i, pg8::Unit& u) const {
        if (!pg8::static_next(i, G, c, tb[32 + 24], 8, u.pm, u.pn)) return false;
        int pr = 0;
        for (int q = 1; q < 24; ++q) if (tb[32 + q] <= u.pm) pr = q;
        u.aux = pr; return true; }
    __device__ __forceinline__ void a_off(const pg8::Unit& u, const int (&Rs)[2], const int (&Cs)[2], unsigned (&off)[2][2]) const {
        const int pr = u.aux, cnt = tb[pr], r0 = (u.pm - tb[32 + pr]) * 256; const int* lp = LISTP + (size_t)pr * R;
#pragma unroll
        for (int h = 0; h < 2; ++h)
#pragma unroll
            for (int i = 0; i < 2; ++i) { int rk = r0 + h * 128 + Rs[i]; rk = rk < cnt ? rk : cnt - 1; off[h][i] = (unsigned)(lp[rk] * D + Cs[i]) * 2u; } }
    __device__ __forceinline__ const char* b_ptr(const pg8::Unit& u, int t) const { int e0, e1; pair_experts(u.aux, e0, e1); const int e = u.pn < 4 ? e0 : e1;
        return W13 + ((size_t)e * 1024 + (size_t)(u.pn & 3) * 256) * D * 2 + (size_t)t * 128; }
    __device__ __forceinline__ void epi(const pg8::f32x4 (&acc)[2][2][4][2], const pg8::Unit& u, int wr, int wc, int fr, int fq) const {
        const int pr = u.aux, cnt = tb[pr], r0 = (u.pm - tb[32 + pr]) * 256; const int* lp = LISTP + (size_t)pr * R;
        const int colh = (u.pn < 4 ? 0 : 512) + (u.pn & 3) * 128 + wc * 16 + 4 * fq;
#pragma unroll
        for (int ai = 0; ai < 2; ++ai)
#pragma unroll
            for (int m = 0; m < 4; ++m) { const int x = ai * 128 + wr * 64 + m * 16 + fr; int rk = r0 + x; rk = rk < cnt ? rk : cnt - 1;
                const float2 gg = GP[lp[rk]]; const float gate = u.pn < 4 ? gg.x : gg.y;
                bf16_t* rowp = HE + (size_t)(u.pm * 256 + x) * 1024 + colh;
#pragma unroll
                for (int bj = 0; bj < 2; ++bj) { const pg8::f32x4 a = acc[ai][bj][m][0], b = acc[ai][bj][m][1]; float o[4];
#pragma unroll
                    for (int j = 0; j < 4; ++j) o[j] = a[j] / (1.f + __expf(-a[j])) * b[j] * gate;
                    *(uint2*)(rowp + bj * 64) = make_uint2(pg8::cvt_pk_bf16(o[0], o[1]), pg8::cvt_pk_bf16(o[2], o[3])); } }
    }
};
struct PB_Moe2 {
    static constexpr bool PERM = false;
    const char* A; int ldb, nt; const char* W2; float* X; const float* MODl; const int* LISTP; const int* tb; int G, c;
    __device__ __forceinline__ bool next(int i, pg8::Unit& u) const {
        if (!pg8::static_next(i, G, c, tb[32 + 24], 4, u.pm, u.pn)) return false;
        int pr = 0;
        for (int q = 1; q < 24; ++q) if (tb[32 + q] <= u.pm) pr = q;
        u.aux = pr; return true; }
    __device__ __forceinline__ void a_off(const pg8::Unit& u, const int (&Rs)[2], const int (&Cs)[2], unsigned (&off)[2][2]) const {
#pragma unroll
        for (int h = 0; h < 2; ++h)
#pragma unroll
            for (int i = 0; i < 2; ++i) off[h][i] = (unsigned)((u.pm * 256 + h * 128 + Rs[i]) * 1024 + Cs[i]) * 2u; }
    __device__ __forceinline__ const char* b_ptr(const pg8::Unit& u, int t) const { int e0, e1; pair_experts(u.aux, e0, e1); const int e = t < 8 ? e0 : e1;
        return W2 + ((size_t)e * 1024 + (size_t)u.pn * 256) * DE * 2 + (size_t)(t & 7) * 128; }
    __device__ __forceinline__ void epi(const pg8::f32x4 (&acc)[2][2][4][2], const pg8::Unit& u, int wr, int wc, int fr, int fq) const {
        const int pr = u.aux, cnt = tb[pr], r0 = (u.pm - tb[32 + pr]) * 256; const int* lp = LISTP + (size_t)pr * R;
        const int col0 = u.pn * 256 + wc * 32 + 4 * fq;
#pragma unroll
        for (int ai = 0; ai < 2; ++ai)
#pragma unroll
            for (int m = 0; m < 4; ++m) { const int rk = r0 + ai * 128 + wr * 64 + m * 16 + fr;
                if (rk < cnt) { const int tok = lp[rk]; float* rowp = X + (size_t)tok * D + col0; const float* gt = MODl + (size_t)row_mi(tok) * 6 * D + 5 * D + col0;
#pragma unroll
                    for (int bj = 0; bj < 2; ++bj)
#pragma unroll
                        for (int n = 0; n < 2; ++n) { pg8::f32x4* xp = (pg8::f32x4*)(rowp + bj * 128 + n * 16); *xp = *xp + *(const pg8::f32x4*)(gt + bj * 128 + n * 16) * acc[ai][bj][m][n]; } } }
    }
};

template <int MAP  >
__device__ __forceinline__ void transpose_item(const float* W, int K, int N, bf16_t* WT, PG8_LAS float* scr, int item, int lane) {
    const int nblk = N / 32, kb = item / nblk, nb = item % nblk, k0 = 64 * kb, n0 = 32 * nb;
#pragma unroll 8
    for (int i = 0; i < 32; ++i) { const int kk = 2 * i + (lane >> 5); scr[kk * 33 + (lane & 31)] = W[(size_t)(k0 + kk) * N + n0 + (lane & 31)]; }
    asm volatile("s_waitcnt lgkmcnt(0)" ::: "memory");
    const int c = lane & 7;
#pragma unroll
    for (int j = 0; j < 4; ++j) { const int n = (lane >> 3) + 8 * j; const PG8_LAS float* sp = scr + (8 * c) * 33 + n;
        uint4 o; o.x = (unsigned)f2bf(sp[0 * 33]) | ((unsigned)f2bf(sp[1 * 33]) << 16); o.y = (unsigned)f2bf(sp[2 * 33]) | ((unsigned)f2bf(sp[3 * 33]) << 16);
        o.z = (unsigned)f2bf(sp[4 * 33]) | ((unsigned)f2bf(sp[5 * 33]) << 16); o.w = (unsigned)f2bf(sp[6 * 33]) | ((unsigned)f2bf(sp[7 * 33]) << 16);
        const int ng = n0 + n; const int row = MAP == 0 ? ng : (32 * (ng >> 4) + (ng & 15) + (MAP == 2 ? 16 : 0));
        *(uint4*)(WT + (size_t)row * K + k0 + 8 * c) = o; }
    asm volatile("s_waitcnt lgkmcnt(0)" ::: "memory");
}
__device__ __forceinline__ void ph_prep_weights(const P& p, unsigned char* lds) {
    const int tidx = p.wid * 64 + fresh_lane();
    const int lane = tidx & 63, wv = tidx >> 6;
    PG8_LAS float* scr = (PG8_LAS float*)((PG8_LAS unsigned char*)lds + wv * 16384);
    const int gw = blockIdx.x * NWV + wv, NGW = gridDim.x * NWV;
    constexpr int I_IN = (D / 64) * (NZ / 32), I_OUT = (D / 64) * (D / 32);
    for (int it = gw; it < 2 * (I_IN + I_OUT); it += NGW) { const int l = it / (I_IN + I_OUT), r = it % (I_IN + I_OUT);
        if (r < I_IN) transpose_item<0>(p.in[I_WIN] + (size_t)l * D * NZ, D, NZ, (bf16_t*)(p.ws + WS_WIN) + (size_t)l * NZ * D, scr, r, lane);
        else transpose_item<0>(p.in[I_WOUT] + (size_t)l * D * D, D, D, (bf16_t*)(p.ws + WS_WOUT) + (size_t)l * D * D, scr, r - I_IN, lane); }
    { bf16_t* WT = (bf16_t*)(p.ws + WS_LRUWT);
      for (int it = blockIdx.x * NT + tidx; it < 2 * 2 * 2 * 4 * 64 * 64; it += gridDim.x * NT) { const int i = it & 63, j = (it >> 6) & 63, hh = (it >> 12) & 3, gate = (it >> 14) & 1, ld = it >> 15;
          const float* src = (gate ? p.in[I_WI] : p.in[I_WR]) + (((size_t)ld * 4 + hh) * 64 + i) * 64 + j; WT[it] = f2bf(*src); } }
}
__device__ __forceinline__ void ph_prep_moe(const P& p, int l, unsigned char* lds) {
    const int tidx = p.wid * 64 + fresh_lane();
    const int lane = tidx & 63, wv = tidx >> 6;
    PG8_LAS float* scr = (PG8_LAS float*)((PG8_LAS unsigned char*)lds + wv * 16384);
    const int gw = blockIdx.x * NWV + wv, NGW = gridDim.x * NWV;
    constexpr int I_13 = (D / 64) * (DE / 32), I_2 = (DE / 64) * (D / 32), PER_E = 2 * I_13 + I_2;
    for (int it = gw; it < NE * PER_E; it += NGW) { const int e = it / PER_E, r = it % PER_E;
        bf16_t* w13 = (bf16_t*)(p.ws + WS_W13) + (size_t)e * 1024 * D; bf16_t* w2 = (bf16_t*)(p.ws + WS_W2) + (size_t)e * D * DE;
        if (r < I_13) transpose_item<1>(p.in[I_W1] + ((size_t)l * NE + e) * D * DE, D, DE, w13, scr, r, lane);
        else if (r < 2 * I_13) transpose_item<2>(p.in[I_W3] + ((size_t)l * NE + e) * D * DE, D, DE, w13, scr, r - I_13, lane);
        else transpose_item<0>(p.in[I_W2] + ((size_t)l * NE + e) * DE * D, DE, D, w2, scr, r - 2 * I_13, lane); }
}
constexpr int LDS_BYTES = 163840;
__global__ void __launch_bounds__(NT, 2) fwd_kernel(P p_in) {
    cg::grid_group grid = cg::this_grid();
    P p = p_in; p.wid = __builtin_amdgcn_readfirstlane((int)(threadIdx.x >> 6));
    extern __shared__ __attribute__((aligned(16))) unsigned char lds[];
    float* sm = (float*)lds;
    ph_init(p);
    ph_mod(p, sm);
    ph_prep_weights(p, lds);
    grid.sync();
    const bf16_t* H = (const bf16_t*)(p.ws + WS_H); const bf16_t* Y = (const bf16_t*)(p.ws + WS_Y); const bf16_t* HE = (const bf16_t*)(p.ws + WS_Z);
#pragma unroll 1
    for (int l = 0; l < 2; ++l) {
        ph_norm1(p, l); ph_prep_moe(p, l, lds);
        grid.sync();
        { PB_InProj pb; pb.A = (const char*)H; pb.ldb = D; pb.nt = D / 64; pb.Bt = (const char*)(p.ws + WS_WIN) + (size_t)l * NZ * D * 2; pb.Zo = (bf16_t*)(p.ws + WS_Z); pb.G = gridDim.x; pb.c = blockIdx.x;
          pg8::gemm_phase<PB_InProj, true>((PG8_LAS unsigned char*)lds, pb, p.wid); }
        grid.sync();
        ph_rope(p, l); ph_sg(p, l, sm); ph_lru_m1(p, l, lds); ph_hg<1>(p, l, lds);
        grid.sync();
        ph_attn(p, l, lds); ph_lru_m2(p, l, lds); ph_hg<2>(p, l, lds);
        grid.sync();
        { PB_OutProj pb; pb.A = (const char*)Y; pb.ldb = D; pb.nt = D / 64; pb.Bt = (const char*)(p.ws + WS_WOUT) + (size_t)l * D * D * 2; pb.X = (float*)(p.ws + WS_X);
          pb.MODl = (const float*)(p.ws + WS_MOD) + (size_t)l * 9 * 6 * D; pb.G = gridDim.x; pb.c = blockIdx.x; pb.skipctx = (l == 1);
          pg8::gemm_phase<PB_OutProj, true>((PG8_LAS unsigned char*)lds, pb, p.wid); }
        grid.sync();
        ph_router(p, l, lds + LDS_MISC);
        grid.sync();
        { int* tb = (int*)(lds + LDS_MISC + 1024); moe_tiles_setup(p, l, tb);
          PB_Moe1 pb; pb.A = (const char*)H; pb.ldb = D; pb.nt = D / 64; pb.W13 = (const char*)(p.ws + WS_W13); pb.HE = (bf16_t*)(p.ws + WS_Z); pb.LISTP = (const int*)(p.ws + WS_LISTP);
          pb.GP = (const float2*)(p.ws + WS_GP); pb.tb = tb; pb.G = gridDim.x; pb.c = blockIdx.x;
          pg8::gemm_phase<PB_Moe1, true>((PG8_LAS unsigned char*)lds, pb, p.wid); }
        grid.sync();
        { int* tb = (int*)(lds + LDS_MISC + 1024);
          PB_Moe2 pb; pb.A = (const char*)(p.ws + WS_Z); pb.ldb = DE; pb.nt = 16; pb.W2 = (const char*)(p.ws + WS_W2); pb.X = (float*)(p.ws + WS_X);
          pb.MODl = (const float*)(p.ws + WS_MOD) + (size_t)l * 9 * 6 * D; pb.LISTP = (const int*)(p.ws + WS_LISTP); pb.tb = tb; pb.G = gridDim.x; pb.c = blockIdx.x;
          pg8::gemm_phase<PB_Moe2, true>((PG8_LAS unsigned char*)lds, pb, p.wid); }
        grid.sync();
    }
    ph_final(p);
}

extern "C" void kernel_launch(void* const* d_in, const int* in_sizes, int n_in, void* d_out, int out_size, void* d_ws, size_t ws_size, hipStream_t stream) {
    if (n_in != N_IN || ws_size < WS_END) { fprintf(stderr, "kernel_launch: bad n_in %d or ws %zu < %zu\n", n_in, ws_size, (size_t)WS_END); return; }
    P p{};
    for (int i = 0; i < N_IN; ++i) p.in[i] = (const float*)d_in[i];
    p.out = (float*)d_out; p.ws = (unsigned char*)d_ws;
    (void)hipMemsetAsync((char*)d_ws + WS_CNT, 0, 4096, stream);
    void* args[] = {&p};
    static bool attr_set = false;
    if (!attr_set) { (void)hipFuncSetAttribute((const void*)fwd_kernel, hipFuncAttributeMaxDynamicSharedMemorySize, LDS_BYTES); attr_set = true; }
    hipError_t e = hipLaunchCooperativeKernel((void*)fwd_kernel, dim3(256), dim3(NT), args, LDS_BYTES, stream);
    if (e != hipSuccess) fprintf(stderr, "cooperative launch failed: %s\n", hipGetErrorString(e));
}
```

```cpp
#include <hip/hip_runtime.h>
#include <cstdio>
#include <cstdint>

constexpr int D = 1024, NB = 8, T = 2048, TC = 256, LB = T + TC  , R = NB * LB  ;
constexpr int NZ = 3072, NE = 16, DE = 512;
constexpr float EPS = 1e-6f;
constexpr int ZA_X = 0, ZA_G = 256, ZB_Q = 512, ZB_K = 768, ZB_V = 1024, ZC_U = 1280, ZC_V = 1536, ZD_Q = 1792, ZD_FF = 2048, ZD_FB = 2304, ZD_I = 2560, ZD_G = 2816;
enum { I_X = 0, I_C, I_CTX, I_CCTX, I_WADA, I_BADA, I_N1G, I_N2G, I_WIN, I_WOUT, I_CONVW, I_CONVB, I_WR, I_BR, I_WI, I_BI, I_LAM,
       I_DALAM, I_DASUB, I_SGNG, I_SGW, I_SGB, I_HGLB, I_HGNG, I_RW, I_RB, I_W1, I_W3, I_W2, I_FNG, N_IN };

typedef unsigned short bf16_t;
#define ALAS __attribute__((address_space(3)))
constexpr size_t MiB = 1u << 20;
constexpr size_t WS_MOD = 0;
constexpr size_t WS_CNT = 512 * 1024;
constexpr size_t WS_GP = 1 * MiB;
constexpr size_t WS_LISTP = WS_GP + (size_t)R * 8;
constexpr size_t WS_LRUWT = 768 * 1024;
constexpr size_t WS_ROPE = 4 * MiB + 512 * 1024;
constexpr size_t WS_SGW = 5 * MiB;
constexpr size_t WS_LRUAGG = 3 * MiB;
constexpr size_t WS_X = 8 * MiB;
constexpr size_t WS_H = WS_X + (size_t)R * D * 4;
constexpr size_t WS_Z = WS_H + (size_t)R * D * 2;
constexpr size_t WS_Y = WS_Z + (size_t)R * NZ * 2;
constexpr size_t WS_WIN = WS_Y + (size_t)R * D * 2;
constexpr size_t WS_WOUT = WS_WIN + 2 * (size_t)NZ * D * 2;
constexpr size_t WS_W13 = WS_WOUT + 2 * (size_t)D * D * 2;
constexpr size_t WS_W2 = WS_W13 + (size_t)NE * 1024 * D * 2;
constexpr size_t WS_END = WS_W2 + (size_t)NE * D * DE * 2;
constexpr int MPAD = R + 24 * 256;

struct P { const float* in[N_IN]; float* out; unsigned char* ws; int wid; int pad; };
__device__ __forceinline__ int fresh_lane() { int l_; asm volatile("v_mbcnt_lo_u32_b32 %0, -1, 0\n\tv_mbcnt_hi_u32_b32 %0, -1, %0" : "=v"(l_)); return l_; }


__device__ __forceinline__ float bf2f(bf16_t v) { return __uint_as_float(((unsigned)v) << 16); }
__device__ __forceinline__ bf16_t f2bf(float f) { unsigned u = __float_as_uint(f); return (bf16_t)((u + 0x7fffu + ((u >> 16) & 1u)) >> 16); }
__device__ __forceinline__ float sigmoidf_(float x) { return 1.f / (1.f + expf(-x)); }
__device__ __forceinline__ float siluf_(float x) { return x / (1.f + expf(-x)); }
__device__ __forceinline__ float geluf_(float x) { const float u = 1.5957691216057308f * (x + 0.044715f * x * x * x); return x / (1.f + __expf(-u)); }
__device__ __forceinline__ float wave_sum(float v) {
#pragma unroll
    for (int o = 1; o < 64; o <<= 1) v += __shfl_xor(v, o);
    return v;
}
__device__ __forceinline__ int row_mi(int r) { const int b = r / LB, j = r - b * LB; return j < TC ? 8 : b; }

#define NT 512
#define NWV 8

__device__ __forceinline__ void ph_init(const P& p) {
    const int tidx = p.wid * 64 + fresh_lane();
    float* X = (float*)(p.ws + WS_X);
    const size_t n4 = (size_t)R * D / 4;
    for (size_t i = (size_t)blockIdx.x * NT + tidx; i < n4; i += (size_t)gridDim.x * NT) {
        const size_t e = i * 4; const int r = (int)(e / D), c = (int)(e % D); const int b = r / LB, j = r - b * LB;
        const float* src = (j < TC) ? p.in[I_CTX] + ((size_t)b * TC + j) * D + c : p.in[I_X] + ((size_t)b * T + (j - TC)) * D + c;
        *(float4*)(X + e) = *(const float4*)src;
    }
}

__device__ __forceinline__ void ph_mod(const P& p, float* sm) {
    const int tidx = p.wid * 64 + fresh_lane();
    float* MOD = (float*)(p.ws + WS_MOD);
    float* red = sm + 9 * D;
    for (int i = tidx; i < 9 * D; i += NT) { const int mi = i / D, k = i % D; const float c = mi < 8 ? p.in[I_C][mi * D + k] : p.in[I_CCTX][k]; sm[i] = siluf_(c); }
    __syncthreads();
    const int col = tidx & 63, part = tidx >> 6;
    for (int it = blockIdx.x; it < 2 * 96; it += gridDim.x) {
        const int l = it / 96, n0 = (it % 96) * 64;
        const float* W = p.in[I_WADA] + (size_t)l * D * 6 * D + (size_t)(part * 128) * 6 * D + n0 + col;
        float acc[9];
#pragma unroll
        for (int m = 0; m < 9; ++m) acc[m] = 0.f;
#pragma unroll 8
        for (int k = 0; k < 128; ++k) { const float w = W[(size_t)k * 6 * D];
#pragma unroll
            for (int m = 0; m < 9; ++m) acc[m] += sm[m * D + part * 128 + k] * w; }
#pragma unroll
        for (int m = 0; m < 9; ++m) red[(part * 9 + m) * 64 + col] = acc[m];
        __syncthreads();
        for (int o = tidx; o < 9 * 64; o += NT) { const int m = o >> 6, cc = o & 63; float v = p.in[I_BADA][l * 6 * D + n0 + cc];
#pragma unroll
            for (int q = 0; q < 8; ++q) v += red[(q * 9 + m) * 64 + cc];
            MOD[((size_t)l * 9 + m) * 6 * D + n0 + cc] = v; }
        __syncthreads();
    }
}

__device__ __forceinline__ void ph_norm1(const P& p, int l) {
    const int tidx = p.wid * 64 + fresh_lane();
    const float* X = (const float*)(p.ws + WS_X); bf16_t* H = (bf16_t*)(p.ws + WS_H);
    const float* MOD = (const float*)(p.ws + WS_MOD) + (size_t)l * 9 * 6 * D; const float* g = p.in[I_N1G] + l * D;
    const int lane = tidx & 63, wv = tidx >> 6;
    for (int r = blockIdx.x * NWV + wv; r < R; r += gridDim.x * NWV) {
        const float* m = MOD + (size_t)row_mi(r) * 6 * D;
        float4 v[4]; float ss = 0.f;
#pragma unroll
        for (int q = 0; q < 4; ++q) { v[q] = *(const float4*)(X + (size_t)r * D + (lane + 64 * q) * 4); ss += v[q].x * v[q].x + v[q].y * v[q].y + v[q].z * v[q].z + v[q].w * v[q].w; }
        const float rs = rsqrtf(wave_sum(ss) * (1.f / D) + EPS);
#pragma unroll
        for (int q = 0; q < 4; ++q) { const int c = (lane + 64 * q) * 4; const float xv[4] = {v[q].x, v[q].y, v[q].z, v[q].w}; bf16_t o[4];
#pragma unroll
            for (int i = 0; i < 4; ++i) o[i] = f2bf(xv[i] * rs * g[c + i] * (1.f + m[D + c + i]) + m[c + i]);
            *(uint2*)(H + (size_t)r * D + c) = make_uint2((unsigned)o[0] | ((unsigned)o[1] << 16), (unsigned)o[2] | ((unsigned)o[3] << 16)); }
    }
}

constexpr float QSCALE = 0.17677669529663687f * 1.4426950408889634f;
__device__ __forceinline__ void ph_rope_table(const P& p) {
    const int tidx = p.wid * 64 + fresh_lane();
    float2* TAB = (float2*)(p.ws + WS_ROPE);
    for (int it = blockIdx.x * NT + tidx; it < T * 16; it += gridDim.x * NT) { const int f = it & 7, a = (it >> 3) & 1, t = it >> 4;
        const float pos = (float)(a == 0 ? (t / 64) : (t % 64)); const float freq = expf(-(float)f * 0.125f * 9.210340371976184f); const float ang = pos * freq;
        TAB[it] = make_float2(cosf(ang), sinf(ang)); }
}
__device__ __forceinline__ void ph_rope(const P& p, int l) {
    const int tidx = p.wid * 64 + fresh_lane();
    bf16_t* Z = (bf16_t*)(p.ws + WS_Z); const float2* TAB = (const float2*)(p.ws + WS_ROPE);
    const int total = NB * T * 32;
    for (int it = blockIdx.x * NT + tidx; it < total; it += gridDim.x * NT) {
        const int pr = it & 31, rt = it >> 5; const int b = rt / T, t = rt % T;
        const int a = pr & 1, n = (pr >> 1) & 1, h = (pr >> 2) & 3, qk = pr >> 4;
        bf16_t* zp = Z + (size_t)(b * LB + TC + t) * NZ + (qk ? ZB_K : ZB_Q) + h * 64 + n * 32 + a * 16;
        const uint4 v1 = *(const uint4*)zp, v2 = *(const uint4*)(zp + 8); const unsigned w1[4] = {v1.x, v1.y, v1.z, v1.w}, w2[4] = {v2.x, v2.y, v2.z, v2.w};
        const float2* tb = TAB + (size_t)(t * 2 + a) * 8; const float sc = qk ? 1.f : QSCALE; unsigned o1[4], o2[4];
#pragma unroll
        for (int i = 0; i < 4; ++i) { const float2 cs0 = tb[2 * i], cs1 = tb[2 * i + 1];
            const float x1a = __uint_as_float(w1[i] << 16), x1b = __uint_as_float(w1[i] & 0xffff0000u), x2a = __uint_as_float(w2[i] << 16), x2b = __uint_as_float(w2[i] & 0xffff0000u);
            o1[i] = (unsigned)f2bf((x1a * cs0.x - x2a * cs0.y) * sc) | ((unsigned)f2bf((x1b * cs1.x - x2b * cs1.y) * sc) << 16);
            o2[i] = (unsigned)f2bf((x2a * cs0.x + x1a * cs0.y) * sc) | ((unsigned)f2bf((x2b * cs1.x + x1b * cs1.y) * sc) << 16); }
        *(uint4*)zp = make_uint4(o1[0], o1[1], o1[2], o1[3]); *(uint4*)(zp + 8) = make_uint4(o2[0], o2[1], o2[2], o2[3]);
    }
    if (l == 0) {
        const int totc = NB * TC * 256;
        for (int it = blockIdx.x * NT + tidx; it < totc; it += gridDim.x * NT) {
            const int c = it & 255, rt = it >> 8; const int b = rt / TC, j = rt % TC;
            bf16_t* zp = Z + (size_t)(b * LB + j) * NZ + ZB_Q + c; zp[0] = f2bf(bf2f(zp[0]) * QSCALE);
        }
    }
}

namespace lru {
typedef short bf16x8 __attribute__((ext_vector_type(8)));
typedef float f32x4 __attribute__((ext_vector_type(4)));
constexpr int UROW = 264;
__device__ __forceinline__ void comp(float& A, float& B, float a, float b) { B = a * B + b; A = a * A; }
}
__device__ __forceinline__ void ph_lru_m1(const P& p, int l, unsigned char* ldsb) {
    using namespace lru;
    const int lane = fresh_lane(), wid = p.wid, tid = wid * 64 + lane;
    const bf16_t* Z = (const bf16_t*)(p.ws + WS_Z); bf16_t* G = (bf16_t*)(p.ws + WS_H); float2* AGG = (float2*)(p.ws + WS_LRUAGG);
    const bf16_t* WT = (const bf16_t*)(p.ws + WS_LRUWT);
    const float* cw = p.in[I_CONVW] + l * 4 * 256; const float* cb = p.in[I_CONVB] + l * 256;
    ALAS bf16_t* U = (ALAS bf16_t*)ldsb;
    const int h = wid & 3, d = wid >> 2, l15 = lane & 15, g4 = lane >> 4;
    float spv[4], brv[4], biv[4];
#pragma unroll
    for (int jt = 0; jt < 4; ++jt) { const int w = h * 64 + jt * 16 + l15; spv[jt] = log1pf(expf(-p.in[I_LAM][(l * 2 + d) * 256 + w])); brv[jt] = p.in[I_BR][(l * 2 + d) * 256 + w]; biv[jt] = p.in[I_BI][(l * 2 + d) * 256 + w]; }
    for (int unit = blockIdx.x; unit < NB * 36; unit += gridDim.x) {
        const int b = unit / 36, c = unit % 36, r0 = b * LB + c * 64; const int lo = c < 4 ? 0 : TC, hi = c < 4 ? TC : LB;
        for (int item = tid; item < 2048; item += NT) {
            const int t = item >> 5, cg = item & 31, j = c * 64 + t; float acc[8];
#pragma unroll
            for (int i = 0; i < 8; ++i) acc[i] = cb[cg * 8 + i];
#pragma unroll
            for (int q = 0; q < 4; ++q) { const int jj = j + q - 2; if (jj >= lo && jj < hi) { const uint4 zv = *(const uint4*)(Z + (size_t)(r0 + t + q - 2) * NZ + ZA_X + cg * 8); const unsigned zw[4] = {zv.x, zv.y, zv.z, zv.w};
#pragma unroll
                for (int i = 0; i < 4; ++i) { acc[2 * i] += __uint_as_float(zw[i] << 16) * cw[q * 256 + cg * 8 + 2 * i]; acc[2 * i + 1] += __uint_as_float(zw[i] & 0xffff0000u) * cw[q * 256 + cg * 8 + 2 * i + 1]; } } }
            uint4 o; o.x = (unsigned)f2bf(acc[0]) | ((unsigned)f2bf(acc[1]) << 16); o.y = (unsigned)f2bf(acc[2]) | ((unsigned)f2bf(acc[3]) << 16); o.z = (unsigned)f2bf(acc[4]) | ((unsigned)f2bf(acc[5]) << 16); o.w = (unsigned)f2bf(acc[6]) | ((unsigned)f2bf(acc[7]) << 16);
            { typedef unsigned u32x4_t __attribute__((ext_vector_type(4))); u32x4_t ov = {o.x, o.y, o.z, o.w}; *(ALAS u32x4_t*)(U + t * UROW + cg * 8) = ov; }
        }
        __syncthreads();
        bf16x8 af[4][2];
#pragma unroll
        for (int tt = 0; tt < 4; ++tt)
#pragma unroll
            for (int ks = 0; ks < 2; ++ks) af[tt][ks] = *(const ALAS bf16x8*)(U + (16 * tt + l15) * UROW + h * 64 + 32 * ks + 8 * g4);
#pragma unroll 1
        for (int jt = 0; jt < 4; ++jt) {
            const float spj = jt == 0 ? spv[0] : jt == 1 ? spv[1] : jt == 2 ? spv[2] : spv[3], brj = jt == 0 ? brv[0] : jt == 1 ? brv[1] : jt == 2 ? brv[2] : brv[3], bij = jt == 0 ? biv[0] : jt == 1 ? biv[1] : jt == 2 ? biv[2] : biv[3];
            f32x4 ar[4], ai[4];
#pragma unroll
            for (int tt = 0; tt < 4; ++tt) { ar[tt] = (f32x4){0.f, 0.f, 0.f, 0.f}; ai[tt] = (f32x4){0.f, 0.f, 0.f, 0.f}; }
#pragma unroll
            for (int ks = 0; ks < 2; ++ks) { const bf16_t* wp = WT + ((size_t)(((l * 2 + d) * 2 + 0) * 4 + h) * 64 + 16 * jt + l15) * 64 + 32 * ks + 8 * g4; const bf16x8 wr = *(const bf16x8*)wp, wi = *(const bf16x8*)(wp + 4 * 64 * 64);
#pragma unroll
                for (int tt = 0; tt < 4; ++tt) { ar[tt] = __builtin_amdgcn_mfma_f32_16x16x32_bf16(af[tt][ks], wr, ar[tt], 0, 0, 0); ai[tt] = __builtin_amdgcn_mfma_f32_16x16x32_bf16(af[tt][ks], wi, ai[tt], 0, 0, 0); } }
            const int w = h * 64 + jt * 16 + l15; float mA[4], mB[4];
#pragma unroll
            for (int tt = 0; tt < 4; ++tt) { float A = 1.f, Bv = 0.f; float av[4], bv[4];
#pragma unroll
                for (int rg = 0; rg < 4; ++rg) { const int t = 16 * tt + 4 * g4 + rg;
                    const float rgt = 1.f / (1.f + __expf(-(ar[tt][rg] + brj))), igt = 1.f / (1.f + __expf(-(ai[tt][rg] + bij)));
                    const float la = -8.f * rgt * spj; const float uu = bf2f(U[t * UROW + w]); const float bc = sqrtf(fmaxf(-expm1f(2.f * la), 0.f)) * igt * uu;
                    const bf16_t lab = f2bf(la), bcb = f2bf(bc);
                    G[((size_t)(d * 2 + 0) * R + r0 + t) * 256 + w] = lab; G[((size_t)(d * 2 + 1) * R + r0 + t) * 256 + w] = bcb;
                    av[rg] = __expf(bf2f(lab)); bv[rg] = bf2f(bcb); }
                if (d == 0) { comp(A, Bv, av[0], bv[0]); comp(A, Bv, av[1], bv[1]); comp(A, Bv, av[2], bv[2]); comp(A, Bv, av[3], bv[3]); }
                else { comp(A, Bv, av[3], bv[3]); comp(A, Bv, av[2], bv[2]); comp(A, Bv, av[1], bv[1]); comp(A, Bv, av[0], bv[0]); }
                mA[tt] = A; mB[tt] = Bv; }
            float A = 1.f, Bv = 0.f;
#pragma unroll
            for (int s4 = 0; s4 < 4; ++s4) { const int tt = d == 0 ? s4 : 3 - s4; const float ma = d == 0 ? mA[s4] : mA[3 - s4], mb = d == 0 ? mB[s4] : mB[3 - s4]; (void)tt;
#pragma unroll
                for (int gs = 0; gs < 4; ++gs) { const int gg = d == 0 ? gs : 3 - gs; const float a = __shfl(ma, gg * 16 + l15), bq = __shfl(mb, gg * 16 + l15); comp(A, Bv, a, bq); } }
            if (g4 == 0) AGG[((size_t)(b * 2 + d) * 36 + c) * 256 + w] = make_float2(A, Bv);
        }
        __syncthreads();
    }
}
__device__ __forceinline__ void ph_lru_m2(const P& p, int l, unsigned char* ldsb) {
    const int lane = fresh_lane(), wid = p.wid, tid = wid * 64 + lane;
    const bf16_t* Z = (const bf16_t*)(p.ws + WS_Z); const bf16_t* G = (const bf16_t*)(p.ws + WS_H); bf16_t* Y = (bf16_t*)(p.ws + WS_Y); const float2* AGG = (const float2*)(p.ws + WS_LRUAGG);
    float* HS = (float*)ldsb;
    const int d = tid >> 8, w = tid & 255;
    const int nun = NB * 36;
    for (int unit = nun - 1 - blockIdx.x; unit >= 0; unit -= gridDim.x) {
        const int b = unit / 36, c = unit % 36, r0 = b * LB + c * 64;
        if (l == 1 && c < 4) continue;
        float hst = 0.f; const float2* ag = AGG + (size_t)(b * 2 + d) * 36 * 256 + w;
        {
            const int pos = d == 0 ? c : (c < 4 ? 3 - c : 4 + (35 - c));
#pragma unroll 12
            for (int k = 0; k < 36; ++k) { const int cc = d == 0 ? k : (k < 4 ? 3 - k : 39 - k); const bool valid = k < pos; const float2 m = ag[(valid ? cc : 0) * 256]; hst = valid ? (m.x * hst + m.y) : hst; }
        }
        const bf16_t* gl = G + ((size_t)(d * 2 + 0) * R + r0) * 256 + w; const bf16_t* gb = G + ((size_t)(d * 2 + 1) * R + r0) * 256 + w;
#pragma unroll 16
        for (int s = 0; s < 64; ++s) { const int t = d == 0 ? s : 63 - s; hst = __expf(bf2f(gl[t * 256])) * hst + bf2f(gb[t * 256]); HS[(d * 64 + t) * 256 + w] = hst; }
        __syncthreads();
#pragma unroll
        for (int q = 0; q < 4; ++q) { const int it = tid + q * NT; const int t = it >> 5, c8 = (it & 31) * 8;
            const uint4 zv = *(const uint4*)(Z + (size_t)(r0 + t) * NZ + ZA_G + c8); const unsigned zw[4] = {zv.x, zv.y, zv.z, zv.w}; unsigned o[4];
#pragma unroll
            for (int i = 0; i < 4; ++i) { const float h0 = HS[t * 256 + c8 + 2 * i] + HS[(64 + t) * 256 + c8 + 2 * i], h1 = HS[t * 256 + c8 + 2 * i + 1] + HS[(64 + t) * 256 + c8 + 2 * i + 1];
                o[i] = (unsigned)f2bf(h0 * geluf_(__uint_as_float(zw[i] << 16))) | ((unsigned)f2bf(h1 * geluf_(__uint_as_float(zw[i] & 0xffff0000u))) << 16); }
            *(uint4*)(Y + (size_t)(r0 + t) * D + c8) = make_uint4(o[0], o[1], o[2], o[3]); }
        __syncthreads();
    }
}

__device__ __forceinline__ void ph_sg(const P& p, int l, unsigned char* ldsb) {
    typedef short bf16x8 __attribute__((ext_vector_type(8))); typedef float f32x16 __attribute__((ext_vector_type(16)));
    const int lane = fresh_lane(), wid = p.wid, tid = wid * 64 + lane, r32 = lane & 31, hi = lane >> 5;
    const bf16_t* Z = (const bf16_t*)(p.ws + WS_Z); bf16_t* Y = (bf16_t*)(p.ws + WS_Y); const bf16_t* SGW = (const bf16_t*)(p.ws + WS_SGW) + (size_t)l * 4 * 128 * 128;
    const float* ng = p.in[I_SGNG] + l * 256;
    ALAS bf16_t* VT = (ALAS bf16_t*)ldsb;
    constexpr int VROW = 136;
    const int q = tid >> 2, part = tid & 3, ptile = wid & 3, chalf = wid >> 2;
    for (int unit = blockIdx.x; unit < NB * 18 * 4; unit += gridDim.x) {
        const int h = unit & 3, bc = unit >> 2, b = bc / 18, ck = bc % 18;
        if (l == 1 && ck < 2) continue;
        const int r0 = b * LB + ck * 128;
        bf16x8 wf[8];
        { const bf16_t* wp = SGW + ((size_t)h * 128 + 32 * ptile + r32) * 128 + 8 * hi;
#pragma unroll
          for (int ks = 0; ks < 8; ++ks) wf[ks] = *(const bf16x8*)(wp + 16 * ks); }
        { const bf16_t* zv = Z + (size_t)(r0 + q) * NZ + ZC_V + part * 64; uint4 raw[8]; float ss = 0.f;
#pragma unroll
          for (int i = 0; i < 8; ++i) raw[i] = *(const uint4*)(zv + 8 * i);
#pragma unroll
          for (int i = 0; i < 8; ++i) { const unsigned w4[4] = {raw[i].x, raw[i].y, raw[i].z, raw[i].w};
#pragma unroll
              for (int k = 0; k < 4; ++k) { const float g0 = geluf_(__uint_as_float(w4[k] << 16)), g1 = geluf_(__uint_as_float(w4[k] & 0xffff0000u)); ss += g0 * g0 + g1 * g1; } }
          ss += __shfl_xor(ss, 1); ss += __shfl_xor(ss, 2);
          const float rs = rsqrtf(ss * (1.f / 256.f) + EPS);
          if (part == h) {
#pragma unroll
              for (int i = 0; i < 8; ++i) { const unsigned w4[4] = {raw[i].x, raw[i].y, raw[i].z, raw[i].w};
#pragma unroll
                  for (int k = 0; k < 4; ++k) { const int c = 8 * i + 2 * k;
                      VT[c * VROW + q] = f2bf(geluf_(__uint_as_float(w4[k] << 16)) * rs * ng[h * 64 + c]);
                      VT[(c + 1) * VROW + q] = f2bf(geluf_(__uint_as_float(w4[k] & 0xffff0000u)) * rs * ng[h * 64 + c + 1]); } } } }
        __syncthreads();
        f32x16 acc = f32x16{};
#pragma unroll
        for (int ks = 0; ks < 8; ++ks) { const bf16x8 vf = *(const ALAS bf16x8*)(VT + (32 * chalf + r32) * VROW + 16 * ks + 8 * hi); acc = __builtin_amdgcn_mfma_f32_32x32x16_bf16(wf[ks], vf, acc, 0, 0, 0); }
        { const float* bsp = p.in[I_SGB] + (l * 4 + h) * 128 + 32 * ptile + 4 * hi; bf16_t zu[16];
          const size_t rb = (size_t)(r0 + 32 * ptile + 4 * hi);
#pragma unroll
          for (int r = 0; r < 16; ++r) { const int pr = (r & 3) + 8 * (r >> 2); zu[r] = Z[(rb + pr) * NZ + ZC_U + h * 64 + 32 * chalf + r32]; }
#pragma unroll
          for (int r = 0; r < 16; ++r) { const int pr = (r & 3) + 8 * (r >> 2); Y[(rb + pr) * D + 512 + h * 64 + 32 * chalf + r32] = f2bf(geluf_(bf2f(zu[r])) * (acc[r] + bsp[pr])); } }
        __syncthreads();
    }
}

namespace att {
typedef short bf16x8 __attribute__((ext_vector_type(8)));
typedef short s16x4 __attribute__((ext_vector_type(4)));
typedef float f32x16 __attribute__((ext_vector_type(16)));
typedef float f32x2_t __attribute__((ext_vector_type(2))); typedef __bf16 bf16x2_t __attribute__((ext_vector_type(2)));
constexpr int SLOTB = 8192, NSLOT = 3, L_K = 0, L_V = NSLOT * SLOTB, L_WS = 2 * NSLOT * SLOTB, L_OST = L_WS + 8 * 2 * 32 * 4, OST_W = 32 * 66 * 4;
constexpr float THR = 8.f;
__device__ __forceinline__ int crow(int r, int hi) { return (r & 3) + 8 * (r >> 2) + 4 * hi; }
__device__ __forceinline__ unsigned cvtpk(float lo, float hi) { f32x2_t v = {lo, hi}; bf16x2_t b = __builtin_convertvector(v, bf16x2_t); return __builtin_bit_cast(unsigned, b); }
__device__ __forceinline__ float swapmax(float m) { auto rr = __builtin_amdgcn_permlane32_swap(__float_as_uint(m), __float_as_uint(m), false, false); return fmaxf(__uint_as_float(rr[0]), __uint_as_float(rr[1])); }
__device__ __forceinline__ float swapadd(float m) { auto rr = __builtin_amdgcn_permlane32_swap(__float_as_uint(m), __float_as_uint(m), false, false); return __uint_as_float(rr[0]) + __uint_as_float(rr[1]); }
typedef short v4i16_t __attribute__((ext_vector_type(4)));
__device__ __forceinline__ s16x4 vtr(const ALAS char* q) { return __builtin_bit_cast(s16x4, __builtin_amdgcn_ds_read_tr16_b64_v4i16((ALAS v4i16_t*)q)); }
}
__device__ __forceinline__ void ph_attn(const P& p, int l, unsigned char* ldsb) {
    using namespace att;
    const int lane = fresh_lane(), wid = p.wid, r32 = lane & 31, hi = lane >> 5;
    const bf16_t* Z = (const bf16_t*)(p.ws + WS_Z); bf16_t* Y = (bf16_t*)(p.ws + WS_Y);
    const float lam_init = l == 0 ? 0.2f : (0.8f - 0.6f * 0.7408182206817179f);
    const float* dl_ = p.in[I_DALAM] + l * 4 * 32; float s01 = 0.f, s23 = 0.f;
    for (int i = 0; i < 32; ++i) { s01 += dl_[i] * dl_[32 + i]; s23 += dl_[64 + i] * dl_[96 + i]; }
    const float lam = expf(s01) - expf(s23) + lam_init;
    const float* subg = p.in[I_DASUB] + l * 64;
    const int G = gridDim.x, bx = blockIdx.x, vcu = (G % 8 == 0) ? (bx % 8) * (G / 8) + bx / 8 : bx;
    const int nun = 256 + (l == 0 ? 32 : 0);
    ALAS char* L3 = (ALAS char*)ldsb;
    ALAS float* wsf = (ALAS float*)(L3 + L_WS) + wid * 64;
    ALAS float* stg = (ALAS float*)(L3 + L_OST + wid * OST_W);
    const ALAS char* kp0 = L3 + L_K + hi * 1024 + r32 * 16;
    const ALAS char* vp0 = L3 + L_V + ((lane >> 4) & 1) * 32 + (lane & 3) * 8 + (4 * hi + ((lane & 15) >> 2)) * 64;
    for (int u = vcu; u < nun; u += G) {
        int b, h, q0row, nt;
        if (u < 256) { b = u >> 5; h = (u >> 3) & 3; q0row = b * LB + TC + (u & 7) * 256; nt = LB / 64; } else { const int v = u - 256; b = v >> 2; h = v & 3; q0row = b * LB; nt = TC / 64; }
        const bf16_t* ksrc = Z + (size_t)(b * LB + lane) * NZ + ZB_K + h * 64 + wid * 8;
        const bf16_t* vsrc = Z + (size_t)(b * LB + 16 * (wid & 3) + (lane >> 2)) * NZ + ZB_V + h * 64 + (wid >> 2) * 32 + (lane & 3) * 8;
#define ATT_DMA(t, slot) do { __builtin_amdgcn_global_load_lds((const unsigned*)(ksrc + (size_t)(t) * 64 * NZ), (ALAS unsigned*)(L3 + L_K + (slot) * SLOTB + wid * 1024), 16, 0, 0); \
                              __builtin_amdgcn_global_load_lds((const unsigned*)(vsrc + (size_t)(t) * 64 * NZ), (ALAS unsigned*)(L3 + L_V + (slot) * SLOTB + wid * 1024), 16, 0, 0); } while (0)
        ATT_DMA(0, 0); ATT_DMA(1, 1);
        bf16x8 qr[4];
        { const bf16_t* qp = Z + (size_t)(q0row + wid * 32 + r32) * NZ + ZB_Q + h * 64 + hi * 8;
#pragma unroll
          for (int d0 = 0; d0 < 4; ++d0) qr[d0] = *(const bf16x8*)(qp + d0 * 16); }
        f32x16 o[2][2], negm[2]; float mrun[2] = {0.f, 0.f}, lsum[2] = {0.f, 0.f};
#pragma unroll
        for (int n = 0; n < 2; ++n) { negm[n] = f32x16{}; o[n][0] = f32x16{}; o[n][1] = f32x16{}; }
        __syncthreads();
        int slot = 0;
        for (int t = 0; t < nt; ++t) {
            if (t + 2 < nt) { const int s2 = slot == 0 ? 2 : slot - 1; ATT_DMA(t + 2, s2); }
            const int so = slot * SLOTB;
            bf16x8 pa[2][4];
#pragma unroll
            for (int n = 0; n < 2; ++n) {
                const bf16x8 k00 = *(const ALAS bf16x8*)(kp0 + so + (2 * n) * 2048), k01 = *(const ALAS bf16x8*)(kp0 + so + (2 * n) * 2048 + 512);
                const bf16x8 k10 = *(const ALAS bf16x8*)(kp0 + so + (2 * n + 1) * 2048), k11 = *(const ALAS bf16x8*)(kp0 + so + (2 * n + 1) * 2048 + 512);
                f32x16 c0 = __builtin_amdgcn_mfma_f32_32x32x16_bf16(k00, qr[2 * n], negm[n], 0, 0, 0);
                f32x16 c1 = __builtin_amdgcn_mfma_f32_32x32x16_bf16(k01, qr[2 * n], negm[n], 0, 0, 0);
                c0 = __builtin_amdgcn_mfma_f32_32x32x16_bf16(k10, qr[2 * n + 1], c0, 0, 0, 0);
                c1 = __builtin_amdgcn_mfma_f32_32x32x16_bf16(k11, qr[2 * n + 1], c1, 0, 0, 0);
                float rm = fmaxf(c0[0], c1[0]);
#pragma unroll
                for (int r = 1; r < 16; ++r) rm = fmaxf(rm, fmaxf(c0[r], c1[r]));
                rm = swapmax(rm);
                if (t == 0 || __any(rm > THR)) {
                    const float dl = t == 0 ? rm : fmaxf(rm, 0.f); mrun[n] += dl;
#pragma unroll
                    for (int r = 0; r < 16; ++r) { c0[r] -= dl; c1[r] -= dl; negm[n][r] = -mrun[n]; }
                    const float f = exp2f(-dl); lsum[n] *= f;
                    if (hi == 0) wsf[n * 32 + r32] = f;
#pragma unroll
                    for (int r = 0; r < 16; ++r) { const float ff = wsf[n * 32 + crow(r, hi)]; o[n][0][r] *= ff; o[n][1][r] *= ff; }
                }
                float sacc = 0.f;
#pragma unroll
                for (int r = 0; r < 16; ++r) { c0[r] = __builtin_amdgcn_exp2f(c0[r]); c1[r] = __builtin_amdgcn_exp2f(c1[r]); sacc += c0[r] + c1[r]; }
                lsum[n] += sacc;
#pragma unroll
                for (int k = 0; k < 2; ++k) {
                    uint4 q0 = make_uint4(cvtpk(c0[8 * k], c0[8 * k + 1]), cvtpk(c0[8 * k + 2], c0[8 * k + 3]), cvtpk(c0[8 * k + 4], c0[8 * k + 5]), cvtpk(c0[8 * k + 6], c0[8 * k + 7]));
                    uint4 q1 = make_uint4(cvtpk(c1[8 * k], c1[8 * k + 1]), cvtpk(c1[8 * k + 2], c1[8 * k + 3]), cvtpk(c1[8 * k + 4], c1[8 * k + 5]), cvtpk(c1[8 * k + 6], c1[8 * k + 7]));
                    pa[n][k] = __builtin_bit_cast(bf16x8, q0); pa[n][2 + k] = __builtin_bit_cast(bf16x8, q1); }
            }
#pragma unroll
            for (int d0 = 0; d0 < 2; ++d0) {
                bf16x8 vf[4];
#pragma unroll
                for (int k = 0; k < 4; ++k) { const s16x4 lo = vtr(vp0 + so + d0 * 4096 + k * 1024), hh = vtr(vp0 + so + d0 * 4096 + k * 1024 + 512);
                    vf[k] = (bf16x8){lo[0], lo[1], lo[2], lo[3], hh[0], hh[1], hh[2], hh[3]}; }
#pragma unroll
                for (int k = 0; k < 4; ++k) { o[0][d0] = __builtin_amdgcn_mfma_f32_32x32x16_bf16(pa[0][k], vf[k], o[0][d0], 0, 0, 0); o[1][d0] = __builtin_amdgcn_mfma_f32_32x32x16_bf16(pa[1][k], vf[k], o[1][d0], 0, 0, 0); }
            }
            __syncthreads();
            slot = slot == 2 ? 0 : slot + 1;
        }
        { const float l1 = swapadd(lsum[0]), l2 = swapadd(lsum[1]);
          if (hi == 0) { wsf[r32] = 1.f / l1; wsf[32 + r32] = lam / l2; }
#pragma unroll
          for (int r = 0; r < 16; ++r) { const int q = crow(r, hi); const float a = wsf[q], bb = wsf[32 + q];
              stg[q * 66 + r32] = o[0][0][r] * a - o[1][0][r] * bb; stg[q * 66 + 32 + r32] = o[0][1][r] * a - o[1][1][r] * bb; }
          const int row = lane >> 1, half = lane & 1; float ov[32]; float ss = 0.f;
#pragma unroll
          for (int i = 0; i < 32; ++i) { ov[i] = stg[row * 66 + half * 32 + i]; ss += ov[i] * ov[i]; }
          ss += __shfl_xor(ss, 1);
          const float rs = rsqrtf(ss * (1.f / 64.f) + EPS) * (1.f - lam_init);
          bf16_t* yo = Y + (size_t)(q0row + wid * 32 + row) * D + 256 + h * 64 + half * 32;
#pragma unroll
          for (int i = 0; i < 4; ++i) { unsigned w[4];
#pragma unroll
              for (int k = 0; k < 4; ++k) w[k] = cvtpk(ov[8 * i + 2 * k] * rs * subg[half * 32 + 8 * i + 2 * k], ov[8 * i + 2 * k + 1] * rs * subg[half * 32 + 8 * i + 2 * k + 1]);
              *(uint4*)(yo + 8 * i) = make_uint4(w[0], w[1], w[2], w[3]); } }
        __syncthreads();
#undef ATT_DMA
    }
}


namespace hg {
typedef short bf16x8 __attribute__((ext_vector_type(8)));
typedef short s16x4 __attribute__((ext_vector_type(4)));
typedef float f32x16 __attribute__((ext_vector_type(16)));
typedef float f32x4v __attribute__((ext_vector_type(4)));
constexpr int QROW = 72;
constexpr int W_Q = 0, W_K = 4608, W_KH = 9216, W_V = 13312, W_BYTES = 17408;
constexpr int L_ST = 8 * W_BYTES;
constexpr int STROW = 68, L_BS = L_ST + 64 * STROW * 4;
constexpr int AGG_FLOATS = 64 * 64 + 64;
__device__ __forceinline__ int img_off(int s, int col) { return ((col >> 5) * 2 + (s >> 4)) * 1024 + (s & 15) * 64 + (col & 31) * 2; }
}
constexpr int LDS_MISC = hg::L_BS + 256;
template <int PASS>
__device__ __forceinline__ void ph_hg(const P& p, int l, unsigned char* ldsb) {
    using namespace hg;
    const int wid = p.wid;
    const bf16_t* Z = (const bf16_t*)(p.ws + WS_Z); bf16_t* Y = (bf16_t*)(p.ws + WS_Y); float* AGG = (float*)p.out;
    ALAS char* L3 = (ALAS char*)ldsb; ALAS char* LW = L3 + wid * W_BYTES;
    ALAS float* ST = (ALAS float*)(L3 + L_ST); ALAS float* BS = (ALAS float*)(L3 + L_BS);
    const float* gn = p.in[I_HGNG] + l * 256;
    for (int unit = blockIdx.x; unit < NB * 4 * 9; unit += gridDim.x) {
        const int sc = unit % 9, bh = unit / 9, h = bh & 3, b = bh >> 2;
        if (PASS == 2 && l == 1 && sc == 0) continue;
        const int lane = fresh_lane();
        const int tid = wid * 64 + lane, r32 = lane & 31, hi = lane >> 5;
        const ALAS char* trb = LW + ((lane >> 4) & 1) * 32 + (lane & 3) * 8 + (4 * hi + ((lane & 15) >> 2)) * 64;
        float* OSG = (float*)p.out + (size_t)4 * 1024 * 1024 + (size_t)blockIdx.x * 16384;
#pragma unroll 1
        for (int d = 0; d < 2; ++d) {
            float lb = 0.f;
            if (l == 1) { const float* hl = p.in[I_HGLB] + (size_t)d * 2 * 256 + h * 64 + lane; lb = sigmoidf_(hl[256] - hl[0]); }
            const int fcol = (d == 0 ? ZD_FF : ZD_FB) + h * 64 + lane;
            const int jbase = b * LB + sc * 256;
            { const float* ag = AGG + (size_t)((b * 4 + h) * 2 + d) * 9 * AGG_FLOATS; const int dd = tid & 63;
              float sv[8];
#pragma unroll
              for (int i = 0; i < 8; ++i) sv[i] = 0.f;
              if (PASS == 2) {
#pragma unroll
                  for (int k = 0; k < 8; ++k) { const int ai = d == 0 ? k : (k == 0 ? 0 : 9 - k); const bool valid = d == 0 ? (k < sc) : (k == 0 ? (sc > 0) : (ai > sc)); const int ac = valid ? ai : 0;
                      const float dv = valid ? __expf(ag[(size_t)ac * AGG_FLOATS + 4096 + dd]) : 1.f;
#pragma unroll
                      for (int i = 0; i < 8; ++i) { const float s_ = ag[(size_t)ac * AGG_FLOATS + tid + 512 * i]; sv[i] = dv * sv[i] + (valid ? s_ : 0.f); } } }
#pragma unroll
              for (int i = 0; i < 8; ++i) { const int e = tid + 512 * i; ST[(e >> 6) * STROW + (e & 63)] = sv[i]; }
              if (tid < 64) BS[tid] = 0.f; }
            bf16_t fpv[32], ivv[32], qvv[32];
#pragma unroll
            for (int tau = 0; tau < 32; ++tau) { const int jl = d == 0 ? (32 * wid + tau) : (255 - 32 * wid - tau); const bf16_t* zr = Z + (size_t)(jbase + jl) * NZ;
                fpv[tau] = zr[fcol]; ivv[tau] = zr[ZD_I + h * 64 + lane]; qvv[tau] = PASS == 2 ? zr[ZD_Q + h * 64 + lane] : (bf16_t)0; }
#pragma unroll
            for (int tau = 0; tau < 32; ++tau) *(ALAS bf16_t*)(LW + W_V + img_off(tau, lane)) = ivv[tau];
            float gl[32]; float Btot = 0.f;
#pragma unroll
            for (int tau = 0; tau < 32; ++tau) { const float f = lb + (1.f - lb) * sigmoidf_(bf2f(fpv[tau])); gl[tau] = fmaxf(__logf(f), -80.f); Btot += gl[tau]; }
            { float run = 0.f;
#pragma unroll
              for (int tau = 0; tau < 32; ++tau) { run += gl[tau]; const float kk = 1.f - __expf(gl[tau]);
                *(ALAS bf16_t*)(LW + W_KH + img_off(tau, lane)) = f2bf(kk * __expf(Btot - run));
                if (PASS == 2) { *(ALAS bf16_t*)(LW + W_Q + (tau * QROW + lane) * 2) = f2bf(bf2f(qvv[tau]) * 0.125f * __expf(run));
                                 *(ALAS bf16_t*)(LW + W_K + (tau * QROW + lane) * 2) = f2bf(kk * __expf(fminf(-run, 80.f))); } } }
            f32x16 sl[2][2];
#pragma unroll
            for (int cv = 0; cv < 2; ++cv)
#pragma unroll
                for (int cd = 0; cd < 2; ++cd) sl[cv][cd] = f32x16{};
            bf16x8 vfr[2][2];
#pragma unroll
            for (int ks = 0; ks < 2; ++ks)
#pragma unroll
                for (int ch = 0; ch < 2; ++ch) { const s16x4 lo = att::vtr(trb + W_V + (ch * 2 + ks) * 1024), hh = att::vtr(trb + W_V + (ch * 2 + ks) * 1024 + 512);
                    vfr[ks][ch] = (bf16x8){lo[0], lo[1], lo[2], lo[3], hh[0], hh[1], hh[2], hh[3]}; }
#pragma unroll
            for (int ks = 0; ks < 2; ++ks)
#pragma unroll
                for (int cd = 0; cd < 2; ++cd) { const s16x4 lo = att::vtr(trb + W_KH + (cd * 2 + ks) * 1024), hh = att::vtr(trb + W_KH + (cd * 2 + ks) * 1024 + 512);
                    const bf16x8 kf = (bf16x8){lo[0], lo[1], lo[2], lo[3], hh[0], hh[1], hh[2], hh[3]};
#pragma unroll
                    for (int cv = 0; cv < 2; ++cv) sl[cv][cd] = __builtin_amdgcn_mfma_f32_32x32x16_bf16(vfr[ks][cv], kf, sl[cv][cd], 0, 0, 0); }
            f32x16 o[2]; o[0] = f32x16{}; o[1] = f32x16{};
            bf16x8 qf[4];
            if (PASS == 2) {
                f32x16 c = f32x16{};
#pragma unroll
                for (int d0 = 0; d0 < 4; ++d0) { qf[d0] = *(const ALAS bf16x8*)(LW + W_Q + (r32 * QROW + 16 * d0 + 8 * hi) * 2);
                    const bf16x8 kf = *(const ALAS bf16x8*)(LW + W_K + (r32 * QROW + 16 * d0 + 8 * hi) * 2);
                    c = __builtin_amdgcn_mfma_f32_32x32x16_bf16(kf, qf[d0], c, 0, 0, 0); }
#pragma unroll
                for (int r = 0; r < 16; ++r) { const int srow = att::crow(r, hi); if (srow > r32) c[r] = 0.f; }
#pragma unroll
                for (int ks = 0; ks < 2; ++ks) { const uint4 q4 = make_uint4(att::cvtpk(c[8 * ks], c[8 * ks + 1]), att::cvtpk(c[8 * ks + 2], c[8 * ks + 3]), att::cvtpk(c[8 * ks + 4], c[8 * ks + 5]), att::cvtpk(c[8 * ks + 6], c[8 * ks + 7]));
                    const bf16x8 pa = __builtin_bit_cast(bf16x8, q4);
                    o[0] = __builtin_amdgcn_mfma_f32_32x32x16_bf16(pa, vfr[ks][0], o[0], 0, 0, 0); o[1] = __builtin_amdgcn_mfma_f32_32x32x16_bf16(pa, vfr[ks][1], o[1], 0, 0, 0); }
            }
            __syncthreads();
#pragma unroll 1
            for (int step = 0; step < 8; ++step) {
                if (wid == step) {
                    if (PASS == 2) {
#pragma unroll
                        for (int cv = 0; cv < 2; ++cv)
#pragma unroll
                            for (int d0 = 0; d0 < 4; ++d0) { const ALAS float* sp = ST + (32 * cv + r32) * STROW + 16 * d0 + 8 * hi; const f32x4v s0 = *(const ALAS f32x4v*)sp, s1 = *(const ALAS f32x4v*)(sp + 4);
                                const uint4 q4 = make_uint4(att::cvtpk(s0[0], s0[1]), att::cvtpk(s0[2], s0[3]), att::cvtpk(s1[0], s1[1]), att::cvtpk(s1[2], s1[3]));
                                o[cv] = __builtin_amdgcn_mfma_f32_32x32x16_bf16(qf[d0], __builtin_bit_cast(bf16x8, q4), o[cv], 0, 0, 0); }
                    }
                    const float dk = __expf(Btot);
                    int sbase = (4 * hi) * STROW + r32; asm volatile("" : "+v"(sbase));
#pragma unroll
                    for (int cd = 0; cd < 2; ++cd) { const float dkd = __shfl(dk, 32 * cd + r32);
#pragma unroll
                        for (int cv = 0; cv < 2; ++cv)
#pragma unroll
                            for (int r = 0; r < 16; ++r) { ALAS float* sp = ST + sbase + (32 * cv + (r & 3) + 8 * (r >> 2)) * STROW + 32 * cd; *sp = dkd * *sp + sl[cv][cd][r]; } }
                    BS[lane] += Btot;
                }
                __syncthreads();
            }
            if (PASS == 1) {
                float* ag = AGG + ((size_t)((b * 4 + h) * 2 + d) * 9 + sc) * AGG_FLOATS;
                for (int e = tid; e < 4096; e += NT) ag[e] = ST[(e >> 6) * STROW + (e & 63)];
                if (tid < 64) ag[4096 + tid] = BS[tid];
                __syncthreads();
            } else {
                if (d == 0) {
                    int base = (32 * wid + 4 * hi) * 64 + r32; asm volatile("" : "+v"(base));
#pragma unroll
                    for (int r = 0; r < 16; ++r) { const int off = base + ((r & 3) + 8 * (r >> 2)) * 64; OSG[off] = o[0][r]; OSG[off + 32] = o[1][r]; }
                }
                else {
                    ALAS float* OS = (ALAS float*)L3;
                    int base = (255 - 32 * wid - 4 * hi) * 64 + r32; asm volatile("" : "+v"(base));
#pragma unroll
                    for (int r = 0; r < 16; ++r) { const int off = base - ((r & 3) + 8 * (r >> 2)) * 64; OS[off] = o[0][r] + OSG[off]; OS[off + 32] = o[1][r] + OSG[off + 32]; }
                    __syncthreads();
                    { int tl = 32 * wid + (lane >> 1); asm volatile("" : "+v"(tl)); const int half = lane & 1; float ov[32]; float ss = 0.f;
#pragma unroll
                      for (int i = 0; i < 32; ++i) { ov[i] = OS[tl * 64 + half * 32 + i]; ss += ov[i] * ov[i]; }
                      ss += __shfl_xor(ss, 1);
                      const float rs = rsqrtf(ss * (1.f / 64.f) + EPS);
                      const size_t row = (size_t)(jbase + tl); const bf16_t* zg = Z + row * NZ + ZD_G + h * 64 + half * 32; bf16_t* yo = Y + row * D + 768 + h * 64 + half * 32;
#pragma unroll
                      for (int i = 0; i < 4; ++i) { unsigned w4[4];
#pragma unroll
                          for (int k2 = 0; k2 < 4; ++k2) { const int c0 = 8 * i + 2 * k2; w4[k2] = att::cvtpk(ov[c0] * rs * gn[h * 64 + half * 32 + c0] * siluf_(bf2f(zg[c0])), ov[c0 + 1] * rs * gn[h * 64 + half * 32 + c0 + 1] * siluf_(bf2f(zg[c0 + 1]))); }
                          *(uint4*)(yo + 8 * i) = make_uint4(w4[0], w4[1], w4[2], w4[3]); } }
                    __syncthreads();
                }
            }
        }
    }
}

__device__ __forceinline__ void ph_router(const P& p, int l, unsigned char* ldsb) {
    const int tidx = p.wid * 64 + fresh_lane();
    const float* X = (const float*)(p.ws + WS_X); bf16_t* H = (bf16_t*)(p.ws + WS_H);
    float2* GP = (float2*)(p.ws + WS_GP); int* LISTP = (int*)(p.ws + WS_LISTP); unsigned* CNT = (unsigned*)(p.ws + WS_CNT) + l * 32;
    const float* MOD = (const float*)(p.ws + WS_MOD) + (size_t)l * 9 * 6 * D; const float* g = p.in[I_N2G] + l * D;
    const float* RW = p.in[I_RW]; const float* RB = p.in[I_RB];
    int* lc = (int*)ldsb; int* lbase = lc + 32; int* rpair = lc + 64; int* rrank = lc + 64 + 72;
    const int lane = tidx & 63, wv = tidx >> 6;
    float4* RWs = (float4*)(ldsb - LDS_MISC);
    for (int idx = tidx; idx < 4096; idx += NT) { const int ln = idx & 63, e4 = (idx >> 6) & 3, i = (idx >> 8) & 3, q = idx >> 10; RWs[idx] = *(const float4*)(RW + (size_t)((ln + 64 * q) * 4 + i) * 16 + e4 * 4); }
    __syncthreads();
    for (int chunk = blockIdx.x; chunk < R / 72; chunk += gridDim.x) {
        if (tidx < 32) lc[tidx] = 0;
        __syncthreads();
        for (int k = 0; k < 9; ++k) {
            const int li = wv * 9 + k, r = chunk * 72 + li;
            if (l == 1 && (r % LB) < TC) { if (lane == 0) rpair[li] = -1; continue; }
            const float* m = MOD + (size_t)row_mi(r) * 6 * D;
            float4 v[4]; float ss = 0.f;
#pragma unroll
            for (int q = 0; q < 4; ++q) { v[q] = *(const float4*)(X + (size_t)r * D + (lane + 64 * q) * 4); ss += v[q].x * v[q].x + v[q].y * v[q].y + v[q].z * v[q].z + v[q].w * v[q].w; }
            const float rs = rsqrtf(wave_sum(ss) * (1.f / D) + EPS);
            float lg[16];
#pragma unroll
            for (int e = 0; e < 16; ++e) lg[e] = 0.f;
#pragma unroll
            for (int q = 0; q < 4; ++q) { const int c = (lane + 64 * q) * 4; const float xv[4] = {v[q].x, v[q].y, v[q].z, v[q].w}; bf16_t o[4];
#pragma unroll
                for (int i = 0; i < 4; ++i) { const float hv = xv[i] * rs * g[c + i] * (1.f + m[4 * D + c + i]) + m[3 * D + c + i]; o[i] = f2bf(hv);
#pragma unroll
                    for (int e4 = 0; e4 < 4; ++e4) { const float4 w4 = RWs[((q * 4 + i) * 4 + e4) * 64 + lane]; lg[e4 * 4 + 0] += hv * w4.x; lg[e4 * 4 + 1] += hv * w4.y; lg[e4 * 4 + 2] += hv * w4.z; lg[e4 * 4 + 3] += hv * w4.w; } }
                *(uint2*)(H + (size_t)r * D + c) = make_uint2((unsigned)o[0] | ((unsigned)o[1] << 16), (unsigned)o[2] | ((unsigned)o[3] << 16)); }
#pragma unroll
            for (int e = 0; e < 16; ++e) lg[e] = wave_sum(lg[e]) + RB[e];
            float mx = lg[0];
#pragma unroll
            for (int e = 1; e < 16; ++e) mx = fmaxf(mx, lg[e]);
            float sc[16], sum = 0.f;
#pragma unroll
            for (int e = 0; e < 16; ++e) { sc[e] = expf(lg[e] - mx); sum += sc[e]; }
            const float inv = 1.f / sum;
#pragma unroll
            for (int e = 0; e < 16; ++e) sc[e] *= inv;
            int gsel = 0; float gbest = -1.f;
#pragma unroll
            for (int gI = 0; gI < 4; ++gI) { float t1 = -1.f, t2 = -1.f;
#pragma unroll
                for (int i = 0; i < 4; ++i) { const float sv = sc[gI * 4 + i]; if (sv > t1) { t2 = t1; t1 = sv; } else if (sv > t2) t2 = sv; }
                const float gs = t1 + t2; if (gs > gbest) { gbest = gs; gsel = gI; } }
            float w1 = -1.f, w2 = -1.f; int i1 = 0, i2 = 0;
#pragma unroll
            for (int e = 0; e < 16; ++e) { if ((e >> 2) == gsel) { const float sv = sc[e]; if (sv > w1) { w2 = w1; i2 = i1; w1 = sv; i1 = e; } else if (sv > w2) { w2 = sv; i2 = e; } } }
            const float wn = 1.f / (w1 + w2);
            if (lane == 0) {
                const int a = (i1 < i2 ? i1 : i2) & 3, b = (i1 < i2 ? i2 : i1) & 3;
                const int q = a == 0 ? b - 1 : (a == 1 ? b + 1 : 5);
                const int pr = gsel * 6 + q;
                GP[r] = i1 < i2 ? make_float2(w1 * wn, w2 * wn) : make_float2(w2 * wn, w1 * wn);
                rpair[li] = pr; rrank[li] = atomicAdd(&lc[pr], 1);
            }
        }
        __syncthreads();
        if (tidx < 24) lbase[tidx] = lc[tidx] ? (int)atomicAdd(&CNT[tidx], (unsigned)lc[tidx]) : 0;
        __syncthreads();
        if (tidx < 72) { const int pr = rpair[tidx]; if (pr >= 0) LISTP[(size_t)pr * R + lbase[pr] + rrank[tidx]] = chunk * 72 + tidx; }
        __syncthreads();
    }
}

__device__ __forceinline__ void ph_final(const P& p) {
    const int tidx = p.wid * 64 + fresh_lane();
    const float* X = (const float*)(p.ws + WS_X); const float* g = p.in[I_FNG];
    const int lane = tidx & 63, wv = tidx >> 6;
    for (int it = blockIdx.x * NWV + wv; it < NB * T; it += gridDim.x * NWV) {
        const int b = it / T, t = it % T; const int r = b * LB + TC + t;
        float4 v[4]; float ss = 0.f;
#pragma unroll
        for (int q = 0; q < 4; ++q) { v[q] = *(const float4*)(X + (size_t)r * D + (lane + 64 * q) * 4); ss += v[q].x * v[q].x + v[q].y * v[q].y + v[q].z * v[q].z + v[q].w * v[q].w; }
        const float rs = rsqrtf(wave_sum(ss) * (1.f / D) + EPS);
#pragma unroll
        for (int q = 0; q < 4; ++q) { const int c = (lane + 64 * q) * 4; const float4 gg = *(const float4*)(g + c);
            *(float4*)(p.out + (size_t)it * D + c) = make_float4(v[q].x * rs * gg.x, v[q].y * rs * gg.y, v[q].z * rs * gg.z, v[q].w * rs * gg.w); }
    }
}


namespace pg8 {
#define PG8_LAS __attribute__((address_space(3)))
typedef short bf16x8 __attribute__((ext_vector_type(8)));
typedef float f32x4 __attribute__((ext_vector_type(4)));
typedef unsigned u32x4 __attribute__((ext_vector_type(4)));
constexpr int BM = 256, BK = 64, HALF = 128, HTB = HALF * BK * 2, STAGE_BYTES = 8 * HTB, NXCD = 8, WGM = 8;
__host__ __device__ __forceinline__ int lds_byte(int r, int c) { const int st = (r >> 4) * 2 + (c >> 5), rr = r & 15, cc = c & 31, ob = rr * 64 + cc * 2; return st * 1024 + (ob ^ (((ob >> 9) & 1) << 5)); }
__host__ __device__ __forceinline__ void stage_rc(int b, int& R, int& C) { const int st = b / 1024, sb = b % 1024, swz = sb ^ (((sb >> 9) & 1) << 5); R = (st >> 1) * 16 + swz / 64; C = (st & 1) * 32 + (swz % 64) / 2; }
__host__ __device__ __forceinline__ int perm32(int rho) { const int n = rho >> 4, i = rho & 15; return 8 * (i >> 2) + 4 * n + (i & 3); }
__device__ __forceinline__ unsigned cvt_pk_bf16(float lo, float hi) { unsigned r; asm volatile("v_cvt_pk_bf16_f32 %0, %1, %2" : "=v"(r) : "v"(lo), "v"(hi)); return r; }
struct Unit { int pm, pn, aux; };
__device__ __forceinline__ bool static_next(int i, int G, int c, int nM, int nN, int& pm, int& pn) {
    const int nwg = nM * nN; const long L = (long)i * G + c; if (L >= nwg) return false;
    int wgid = (int)L; { const int q = nwg / NXCD, r = nwg % NXCD, xcd = wgid % NXCD, off = wgid / NXCD; wgid = (xcd < r ? xcd * (q + 1) : r * (q + 1) + (xcd - r) * q) + off; }
    const int nig = WGM * nN, gid = wgid / nig, fm = gid * WGM, gsz = (nM - fm) < WGM ? (nM - fm) : WGM;
    pm = fm + ((wgid % nig) % gsz); pn = (wgid % nig) / gsz; return true;
}
template <class PB, bool ALIGN_EPI>
__device__ __forceinline__ void gemm_phase(PG8_LAS unsigned char* lds, const PB& S, const int wid) {
    const int lane = fresh_lane(), tid = wid * 64 + lane, wr = wid >> 2, wc = wid & 3, fr = lane & 15, fq = lane >> 4;
    const int nt = S.nt;
    int Rst[2], Cst[2]; unsigned voffB[2];
#pragma unroll
    for (int i = 0; i < 2; ++i) { int R_, C_; stage_rc(tid * 16 + i * 8192, R_, C_); Rst[i] = R_; Cst[i] = C_; const int Rb = PB::PERM ? ((R_ & ~31) + perm32(R_ & 31)) : R_; voffB[i] = (unsigned)(Rb * S.ldb + C_) * 2u; }
    const size_t kstep = (size_t)(BK * 2);
    const size_t hstepB = (size_t)HALF * S.ldb * 2;
    const unsigned ldsw = (unsigned)wid * 1024u;
    const int aoff = lds_byte(wr * 64 + fr, fq * 8), boff = lds_byte(wc * 32 + fr, fq * 8);
#define PG8_SA(b, h) (((b) * 2 + (h)) * HTB)
#define PG8_SB(b, h) ((4 + (b) * 2 + (h)) * HTB)
#define PG8_STAGE(bufoff, gbase, voff) do { _Pragma("unroll") for (int _i = 0; _i < 2; ++_i) { unsigned _o = (voff)[_i]; asm volatile("" : "+v"(_o)); \
        __builtin_amdgcn_global_load_lds((const unsigned*)((const char*)(gbase) + _o), (PG8_LAS unsigned*)(lds + (bufoff) + ldsw + _i * 8192), 16, 0, 0); } } while (0)
#define PG8_LDA(dst, b, h) do { _Pragma("unroll") for (int m = 0; m < 4; ++m) _Pragma("unroll") for (int k = 0; k < 2; ++k) dst[m][k] = *(const PG8_LAS bf16x8*)(lds + PG8_SA(b, h) + aoff + m * 2048 + k * 1024); } while (0)
#define PG8_LDB(dst, b, h) do { _Pragma("unroll") for (int n = 0; n < 2; ++n) _Pragma("unroll") for (int k = 0; k < 2; ++k) dst[n][k] = *(const PG8_LAS bf16x8*)(lds + PG8_SB(b, h) + boff + n * 2048 + k * 1024); } while (0)
#define PG8_MMA(ai, bj, At, Bt) do { __builtin_amdgcn_s_setprio(1); _Pragma("unroll") for (int m = 0; m < 4; ++m) _Pragma("unroll") for (int n = 0; n < 2; ++n) _Pragma("unroll") for (int k = 0; k < 2; ++k) \
        acc[ai][bj][m][n] = __builtin_amdgcn_mfma_f32_16x16x32_bf16(Bt[n][k], At[m][k], acc[ai][bj][m][n], 0, 0, 0); __builtin_amdgcn_s_setprio(0); } while (0)
#define PG8_WAIT_V(n) asm volatile("s_waitcnt vmcnt(" #n ")" ::: "memory")
#define PG8_WAIT_L(n) asm volatile("s_waitcnt lgkmcnt(" #n ")" ::: "memory")
#define PG8_BAR __builtin_amdgcn_s_barrier()
#define PG8_SCHED __builtin_amdgcn_sched_barrier(0)
    Unit cur, nxt; int ui = 0;
    if (!S.next(0, cur)) return;
    f32x4 acc[2][2][4][2];
#pragma unroll
    for (int a = 0; a < 2; ++a)
#pragma unroll
        for (int b = 0; b < 2; ++b)
#pragma unroll
            for (int m = 0; m < 4; ++m)
#pragma unroll
                for (int n = 0; n < 2; ++n) acc[a][b][m][n] = (f32x4){0.f, 0.f, 0.f, 0.f};
    bf16x8 At[4][2], B0[2][2], B1[2][2];
    unsigned vc[2][2], vn[2][2];
    S.a_off(cur, Rst, Cst, vc); asm volatile("" : "+v"(vc[0][0]), "+v"(vc[0][1]), "+v"(vc[1][0]), "+v"(vc[1][1]));
    const char* gA = S.A;
    { const char* cB = S.b_ptr(cur, 0); const char* cB1 = S.b_ptr(cur, 1);
      PG8_STAGE(PG8_SB(0, 0), cB, voffB); PG8_STAGE(PG8_SB(0, 1), cB + hstepB, voffB); PG8_STAGE(PG8_SA(0, 0), gA, vc[0]); PG8_STAGE(PG8_SA(0, 1), gA, vc[1]);
      if (wr == 1) PG8_BAR;
      PG8_WAIT_V(2); PG8_BAR;
      PG8_STAGE(PG8_SB(1, 0), cB1, voffB); PG8_STAGE(PG8_SA(1, 0), gA + kstep, vc[0]); PG8_STAGE(PG8_SB(1, 1), cB1 + hstepB, voffB);
      PG8_WAIT_V(6); PG8_BAR; }
    for (;;) {
        const bool has_next = S.next(ui + 1, nxt);
        if (has_next) { S.a_off(nxt, Rst, Cst, vn); asm volatile("" : "+v"(vn[0][0]), "+v"(vn[0][1]), "+v"(vn[1][0]), "+v"(vn[1][1])); }
        else { vn[0][0] = vc[0][0]; vn[0][1] = vc[0][1]; vn[1][0] = vc[1][0]; vn[1][1] = vc[1][1]; nxt = cur; }
        for (int t = 0; t < nt; t += 2) {
            const bool last = (t == nt - 2);
            const char* a1 = gA + (size_t)(t + 1) * kstep;
            const char* a2 = last ? gA : gA + (size_t)(t + 2) * kstep; const char* a3 = a2 + kstep;
            const char* b2 = last ? S.b_ptr(nxt, 0) : S.b_ptr(cur, t + 2);
            const char* b3 = last ? S.b_ptr(nxt, 1) : S.b_ptr(cur, t + 3);
            unsigned o2a[2], o2b[2];
            o2a[0] = last ? vn[0][0] : vc[0][0]; o2a[1] = last ? vn[0][1] : vc[0][1]; o2b[0] = last ? vn[1][0] : vc[1][0]; o2b[1] = last ? vn[1][1] : vc[1][1];
            PG8_LDB(B0, 0, 0); PG8_LDB(B1, 0, 1); PG8_SCHED; PG8_LDA(At, 0, 0); PG8_STAGE(PG8_SA(1, 1), a1, vc[1]);
            PG8_WAIT_V(8); PG8_WAIT_L(0); PG8_BAR; PG8_MMA(0, 0, At, B0); PG8_MMA(0, 1, At, B1); PG8_BAR; PG8_SCHED;
            PG8_LDA(At, 0, 1); PG8_STAGE(PG8_SB(0, 0), b2, voffB); PG8_STAGE(PG8_SB(0, 1), b2 + hstepB, voffB); PG8_STAGE(PG8_SA(0, 0), a2, o2a);
            PG8_WAIT_V(8); PG8_WAIT_L(0); PG8_BAR; PG8_MMA(1, 0, At, B0); PG8_MMA(1, 1, At, B1); PG8_BAR; PG8_SCHED;
            PG8_LDB(B0, 1, 0); PG8_LDB(B1, 1, 1); PG8_SCHED; PG8_LDA(At, 1, 0); PG8_STAGE(PG8_SA(0, 1), a2, o2b);
            PG8_WAIT_V(8); PG8_WAIT_L(0); PG8_BAR; PG8_MMA(0, 0, At, B0); PG8_MMA(0, 1, At, B1); PG8_BAR; PG8_SCHED;
            PG8_LDA(At, 1, 1); PG8_STAGE(PG8_SB(1, 0), b3, voffB); PG8_STAGE(PG8_SB(1, 1), b3 + hstepB, voffB); PG8_STAGE(PG8_SA(1, 0), a3, o2a);
            PG8_WAIT_V(8); PG8_WAIT_L(0); PG8_BAR; PG8_MMA(1, 0, At, B0); PG8_MMA(1, 1, At, B1); PG8_BAR; PG8_SCHED;
        }
        if constexpr (ALIGN_EPI) { if (wr == 0) PG8_BAR; }
        S.epi(acc, cur, wr, wc, fr, fq);
        if (!has_next) break;
#pragma unroll
        for (int a = 0; a < 2; ++a)
#pragma unroll
            for (int b = 0; b < 2; ++b)
#pragma unroll
                for (int m = 0; m < 4; ++m)
#pragma unroll
                    for (int n = 0; n < 2; ++n) acc[a][b][m][n] = (f32x4){0.f, 0.f, 0.f, 0.f};
        cur = nxt; vc[0][0] = vn[0][0]; vc[0][1] = vn[0][1]; vc[1][0] = vn[1][0]; vc[1][1] = vn[1][1]; ++ui;
        if constexpr (ALIGN_EPI) { if (wr == 1) PG8_BAR; }
    }
    PG8_WAIT_V(0);
    if constexpr (!ALIGN_EPI) { if (wr == 0) PG8_BAR; }
    PG8_BAR;
#undef PG8_SA
#undef PG8_SB
#undef PG8_STAGE
#undef PG8_LDA
#undef PG8_LDB
#undef PG8_MMA
#undef PG8_WAIT_V
#undef PG8_WAIT_L
#undef PG8_BAR
#undef PG8_SCHED
}
}

struct PB_InProj {
    static constexpr bool PERM = true;
    const char* A; int ldb, nt; const char* Bt; bf16_t* Zo; int G, c;
    __device__ __forceinline__ bool next(int i, pg8::Unit& u) const { u.aux = 0; return pg8::static_next(i, G, c, R / 256, NZ / 256, u.pm, u.pn); }
    __device__ __forceinline__ void a_off(const pg8::Unit& u, const int (&Rs)[2], const int (&Cs)[2], unsigned (&off)[2][2]) const {
#pragma unroll
        for (int h = 0; h < 2; ++h)
#pragma unroll
            for (int i = 0; i < 2; ++i) off[h][i] = (unsigned)((u.pm * 256 + h * 128 + Rs[i]) * D + Cs[i]) * 2u; }
    __device__ __forceinline__ const char* b_ptr(const pg8::Unit& u, int t) const { return Bt + (size_t)u.pn * 256 * D * 2 + (size_t)t * 128; }
    __device__ __forceinline__ void epi(const pg8::f32x4 (&acc)[2][2][4][2], const pg8::Unit& u, int wr, int wc, int fr, int fq) const {
        const int row0 = u.pm * 256 + wr * 64 + fr, col0 = u.pn * 256 + wc * 32 + 8 * fq;
#pragma unroll
        for (int ai = 0; ai < 2; ++ai)
#pragma unroll
            for (int m = 0; m < 4; ++m) { bf16_t* rowp = Zo + (size_t)(row0 + ai * 128 + m * 16) * NZ + col0;
#pragma unroll
                for (int bj = 0; bj < 2; ++bj) { const pg8::f32x4 v0 = acc[ai][bj][m][0], v1 = acc[ai][bj][m][1]; pg8::u32x4 w;
                    w.x = pg8::cvt_pk_bf16(v0[0], v0[1]); w.y = pg8::cvt_pk_bf16(v0[2], v0[3]); w.z = pg8::cvt_pk_bf16(v1[0], v1[1]); w.w = pg8::cvt_pk_bf16(v1[2], v1[3]);
                    *(pg8::u32x4*)(rowp + bj * 128) = w; } }
    }
};


struct PB_OutProj {
    static constexpr bool PERM = false;
    const char* A; int ldb, nt; const char* Bt; float* X; const float* MODl; int G, c, skipctx;
    __device__ __forceinline__ bool next(int i, pg8::Unit& u) const { u.aux = 0; int pm, pn; if (!pg8::static_next(i, G, c, skipctx ? 64 : 72, 4, pm, pn)) return false; u.pm = skipctx ? (pm >> 3) * 9 + 1 + (pm & 7) : pm; u.pn = pn; return true; }
    __device__ __forceinline__ void a_off(const pg8::Unit& u, const int (&Rs)[2], const int (&Cs)[2], unsigned (&off)[2][2]) const {
#pragma unroll
        for (int h = 0; h < 2; ++h)
#pragma unroll
            for (int i = 0; i < 2; ++i) off[h][i] = (unsigned)((u.pm * 256 + h * 128 + Rs[i]) * D + Cs[i]) * 2u; }
    __device__ __forceinline__ const char* b_ptr(const pg8::Unit& u, int t) const { return Bt + (size_t)u.pn * 256 * D * 2 + (size_t)t * 128; }
    __device__ __forceinline__ void epi(const pg8::f32x4 (&acc)[2][2][4][2], const pg8::Unit& u, int wr, int wc, int fr, int fq) const {
        const int row0 = u.pm * 256 + wr * 64 + fr, col0 = u.pn * 256 + wc * 32 + 4 * fq;
        const float* gt = MODl + (size_t)row_mi(u.pm * 256) * 6 * D + 2 * D + col0;
        pg8::f32x4 gv[2][2];
#pragma unroll
        for (int bj = 0; bj < 2; ++bj)
#pragma unroll
            for (int n = 0; n < 2; ++n) gv[bj][n] = *(const pg8::f32x4*)(gt + bj * 128 + n * 16);
#pragma unroll
        for (int ai = 0; ai < 2; ++ai)
#pragma unroll
            for (int m = 0; m < 4; ++m) { float* rowp = X + (size_t)(row0 + ai * 128 + m * 16) * D + col0;
#pragma unroll
                for (int bj = 0; bj < 2; ++bj)
#pragma unroll
                    for (int n = 0; n < 2; ++n) { pg8::f32x4* xp = (pg8::f32x4*)(rowp + bj * 128 + n * 16); *xp = *xp + gv[bj][n] * acc[ai][bj][m][n]; } }
    }
};

__device__ __forceinline__ void moe_tiles_setup(const P& p, int l, int* tb) {
    const unsigned* CNT = (const unsigned*)(p.ws + WS_CNT) + l * 32;
    __syncthreads();
    if (p.wid == 0 && fresh_lane() == 0) { int acc = 0; for (int q = 0; q < 24; ++q) { const int c = (int)__hip_atomic_load(CNT + q, __ATOMIC_RELAXED, __HIP_MEMORY_SCOPE_AGENT); tb[q] = c; tb[32 + q] = acc; acc += (c + 255) >> 8; } tb[32 + 24] = acc; }
    __syncthreads();
}
__device__ __forceinline__ void pair_experts(int pr, int& e0, int& e1) { const int g4 = (pr / 6) * 4, q = pr % 6; const int a = q < 3 ? 0 : (q < 5 ? 1 : 2), b = q < 3 ? q + 1 : (q < 5 ? q - 1 : 3); e0 = g4 + a; e1 = g4 + b; }

struct PB_Moe1 {
    static constexpr bool PERM = false;
    const char* A; int ldb, nt; const char* W13; bf16_t* HE; const int* LISTP; const float2* GP; const int* tb; int G, c;
    __device__ __forceinline__ bool next(int i, pg8::Unit& u) const {
        if (!pg8::static_next(i, G, c, tb[32 + 24], 8, u.pm, u.pn)) return false;
        int pr = 0;
        for (int q = 1; q < 24; ++q) if (tb[32 + q] <= u.pm) pr = q;
        u.aux = pr; return true; }
    __device__ __forceinline__ void a_off(const pg8::Unit& u, const int (&Rs)[2], const int (&Cs)[2], unsigned (&off)[2][2]) const {
        const int pr = u.aux, cnt = tb[pr], r0 = (u.pm - tb[32 + pr]) * 256; const int* lp = LISTP + (size_t)pr * R;
#pragma unroll
        for (int h = 0; h < 2; ++h)
#pragma unroll
            for (int i = 0; i < 2; ++i) { int rk = r0 + h * 128 + Rs[i]; rk = rk < cnt ? rk : cnt - 1; off[h][i] = (unsigned)(lp[rk] * D + Cs[i]) * 2u; } }
    __device__ __forceinline__ const char* b_ptr(const pg8::Unit& u, int t) const { int e0, e1; pair_experts(u.aux, e0, e1); const int e = u.pn < 4 ? e0 : e1;
        return W13 + ((size_t)e * 1024 + (size_t)(u.pn & 3) * 256) * D * 2 + (size_t)t * 128; }
    __device__ __forceinline__ void epi(const pg8::f32x4 (&acc)[2][2][4][2], const pg8::Unit& u, int wr, int wc, int fr, int fq) const {
        const int pr = u.aux, cnt = tb[pr], r0 = (u.pm - tb[32 + pr]) * 256; const int* lp = LISTP + (size_t)pr * R;
        const int colh = (u.pn < 4 ? 0 : 512) + (u.pn & 3) * 128 + wc * 16 + 4 * fq;
#pragma unroll
        for (int ai = 0; ai < 2; ++ai)
#pragma unroll
            for (int m = 0; m < 4; ++m) { const int x = ai * 128 + wr * 64 + m * 16 + fr; int rk = r0 + x; rk = rk < cnt ? rk : cnt - 1;
                const float2 gg = GP[lp[rk]]; const float gate = u.pn < 4 ? gg.x : gg.y;
                bf16_t* rowp = HE + (size_t)(u.pm * 256 + x) * 1024 + colh;
#pragma unroll
                for (int bj = 0; bj < 2; ++bj) { const pg8::f32x4 a = acc[ai][bj][m][0], b = acc[ai][bj][m][1]; float o[4];
#pragma unroll
                    for (int j = 0; j < 4; ++j) o[j] = a[j] / (1.f + __expf(-a[j])) * b[j] * gate;
                    *(uint2*)(rowp + bj * 64) = make_uint2(pg8::cvt_pk_bf16(o[0], o[1]), pg8::cvt_pk_bf16(o[2], o[3])); } }
    }
};
struct PB_Moe2 {
    static constexpr bool PERM = false;
    const char* A; int ldb, nt; const char* W2; float* X; const float* MODl; const int* LISTP; const int* tb; int G, c;
    __device__ __forceinline__ bool next(int i, pg8::Unit& u) const {
        if (!pg8::static_next(i, G, c, tb[32 + 24], 4, u.pm, u.pn)) return false;
        int pr = 0;
        for (int q = 1; q < 24; ++q) if (tb[32 + q] <= u.pm) pr = q;
        u.aux = pr; return true; }
    __device__ __forceinline__ void a_off(const pg8::Unit& u, const int (&Rs)[2], const int (&Cs)[2], unsigned (&off)[2][2]) const {
#pragma unroll
        for (int h = 0; h < 2; ++h)
#pragma unroll
            for (int i = 0; i < 2; ++i) off[h][i] = (unsigned)((u.pm * 256 + h * 128 + Rs[i]) * 1024 + Cs[i]) * 2u; }
    __device__ __forceinline__ const char* b_ptr(const pg8::Unit& u, int t) const { int e0, e1; pair_experts(u.aux, e0, e1); const int e = t < 8 ? e0 : e1;
        return W2 + ((size_t)e * 1024 + (size_t)u.pn * 256) * DE * 2 + (size_t)(t & 7) * 128; }
    __device__ __forceinline__ void epi(const pg8::f32x4 (&acc)[2][2][4][2], const pg8::Unit& u, int wr, int wc, int fr, int fq) const {
        const int pr = u.aux, cnt = tb[pr], r0 = (u.pm - tb[32 + pr]) * 256; const int* lp = LISTP + (size_t)pr * R;
        const int col0 = u.pn * 256 + wc * 32 + 4 * fq;
#pragma unroll
        for (int ai = 0; ai < 2; ++ai)
#pragma unroll
            for (int m = 0; m < 4; ++m) { const int rk = r0 + ai * 128 + wr * 64 + m * 16 + fr;
                if (rk < cnt) { const int tok = lp[rk]; float* rowp = X + (size_t)tok * D + col0; const float* gt = MODl + (size_t)row_mi(tok) * 6 * D + 5 * D + col0;
#pragma unroll
                    for (int bj = 0; bj < 2; ++bj)
#pragma unroll
                        for (int n = 0; n < 2; ++n) { pg8::f32x4* xp = (pg8::f32x4*)(rowp + bj * 128 + n * 16); *xp = *xp + *(const pg8::f32x4*)(gt + bj * 128 + n * 16) * acc[ai][bj][m][n]; } } }
    }
};

template <int MAP  >
__device__ __forceinline__ void transpose_item(const float* W, int K, int N, bf16_t* WT, PG8_LAS float* scr, int item, int lane) {
    const int nblk = N / 32, kb = item / nblk, nb = item % nblk, k0 = 64 * kb, n0 = 32 * nb;
#pragma unroll 8
    for (int i = 0; i < 32; ++i) { const int kk = 2 * i + (lane >> 5); scr[kk * 33 + (lane & 31)] = W[(size_t)(k0 + kk) * N + n0 + (lane & 31)]; }
    asm volatile("s_waitcnt lgkmcnt(0)" ::: "memory");
    const int c = lane & 7;
#pragma unroll
    for (int j = 0; j < 4; ++j) { const int n = (lane >> 3) + 8 * j; const PG8_LAS float* sp = scr + (8 * c) * 33 + n;
        uint4 o; o.x = (unsigned)f2bf(sp[0 * 33]) | ((unsigned)f2bf(sp[1 * 33]) << 16); o.y = (unsigned)f2bf(sp[2 * 33]) | ((unsigned)f2bf(sp[3 * 33]) << 16);
        o.z = (unsigned)f2bf(sp[4 * 33]) | ((unsigned)f2bf(sp[5 * 33]) << 16); o.w = (unsigned)f2bf(sp[6 * 33]) | ((unsigned)f2bf(sp[7 * 33]) << 16);
        const int ng = n0 + n; const int row = MAP == 0 ? ng : (32 * (ng >> 4) + (ng & 15) + (MAP == 2 ? 16 : 0));
        *(uint4*)(WT + (size_t)row * K + k0 + 8 * c) = o; }
    asm volatile("s_waitcnt lgkmcnt(0)" ::: "memory");
}
__device__ __forceinline__ void ph_prep_weights(const P& p, unsigned char* lds) {
    const int tidx = p.wid * 64 + fresh_lane();
    const int lane = tidx & 63, wv = tidx >> 6;
    PG8_LAS float* scr = (PG8_LAS float*)((PG8_LAS unsigned char*)lds + wv * 16384);
    const int gw = blockIdx.x * NWV + wv, NGW = gridDim.x * NWV;
    constexpr int I_IN = (D / 64) * (NZ / 32), I_OUT = (D / 64) * (D / 32);
    for (int it = gw; it < 2 * (I_IN + I_OUT); it += NGW) { const int l = it / (I_IN + I_OUT), r = it % (I_IN + I_OUT);
        if (r < I_IN) transpose_item<0>(p.in[I_WIN] + (size_t)l * D * NZ, D, NZ, (bf16_t*)(p.ws + WS_WIN) + (size_t)l * NZ * D, scr, r, lane);
        else transpose_item<0>(p.in[I_WOUT] + (size_t)l * D * D, D, D, (bf16_t*)(p.ws + WS_WOUT) + (size_t)l * D * D, scr, r - I_IN, lane); }
    { bf16_t* SGWo = (bf16_t*)(p.ws + WS_SGW); for (int it = blockIdx.x * NT + tidx; it < 2 * 4 * 128 * 128; it += gridDim.x * NT) SGWo[it] = f2bf(p.in[I_SGW][it]); }
    { bf16_t* WT = (bf16_t*)(p.ws + WS_LRUWT);
      for (int it = blockIdx.x * NT + tidx; it < 2 * 2 * 2 * 4 * 64 * 64; it += gridDim.x * NT) { const int i = it & 63, j = (it >> 6) & 63, hh = (it >> 12) & 3, gate = (it >> 14) & 1, ld = it >> 15;
          const float* src = (gate ? p.in[I_WI] : p.in[I_WR]) + (((size_t)ld * 4 + hh) * 64 + i) * 64 + j; WT[it] = f2bf(*src); } }
}
__device__ __forceinline__ void ph_prep_moe(const P& p, int l, unsigned char* lds) {
    const int tidx = p.wid * 64 + fresh_lane();
    const int lane = tidx & 63, wv = tidx >> 6;
    PG8_LAS float* scr = (PG8_LAS float*)((PG8_LAS unsigned char*)lds + wv * 16384);
    const int gw = blockIdx.x * NWV + wv, NGW = gridDim.x * NWV;
    constexpr int I_13 = (D / 64) * (DE / 32), I_2 = (DE / 64) * (D / 32), PER_E = 2 * I_13 + I_2;
    for (int it = gw; it < NE * PER_E; it += NGW) { const int e = it / PER_E, r = it % PER_E;
        bf16_t* w13 = (bf16_t*)(p.ws + WS_W13) + (size_t)e * 1024 * D; bf16_t* w2 = (bf16_t*)(p.ws + WS_W2) + (size_t)e * D * DE;
        if (r < I_13) transpose_item<1>(p.in[I_W1] + ((size_t)l * NE + e) * D * DE, D, DE, w13, scr, r, lane);
        else if (r < 2 * I_13) transpose_item<2>(p.in[I_W3] + ((size_t)l * NE + e) * D * DE, D, DE, w13, scr, r - I_13, lane);
        else transpose_item<0>(p.in[I_W2] + ((size_t)l * NE + e) * DE * D, DE, D, w2, scr, r - 2 * I_13, lane); }
}

#define XB_TMO      128
#define XB_XCNT(j)  (256  + 64 * (j))
#define XB_XSUB(j)  (1280 + 64 * (j))
#define XB_XGEN(j)  (2304 + 64 * (j))
#define XB_TOP      3328
#define XB_TOPGEN   3392
#define XCD_BAR_WORDS 3456
#define XB_SPIN_CAP (1u << 18)
__device__ __forceinline__ unsigned xb_ld(unsigned* q) { return __hip_atomic_load(q, __ATOMIC_RELAXED, __HIP_MEMORY_SCOPE_AGENT); }
__device__ __forceinline__ unsigned xb_add(unsigned* q, unsigned v) { return __hip_atomic_fetch_add(q, v, __ATOMIC_RELAXED, __HIP_MEMORY_SCOPE_AGENT); }
__device__ __forceinline__ unsigned xb_xcc_id() { return (unsigned)__builtin_amdgcn_s_getreg((3 << 11) | 20) & 0xFu; }
#define XB_SPIN(cond, bar) do { unsigned _sp = 0; while (cond) { __builtin_amdgcn_s_sleep(1); \
    if ((++_sp & 255u) == 0u) { if (xb_ld(&(bar)[XB_TMO])) break; if (_sp > XB_SPIN_CAP) { atomicAdd(&(bar)[XB_TMO], 1u); break; } } } } while (0)
struct XcdBarrier { unsigned* bar; unsigned x; volatile ALAS unsigned* st; int wid; };
__device__ __forceinline__ XcdBarrier xcd_barrier_post(unsigned* bar, volatile ALAS unsigned* st, int wid) {
    XcdBarrier b; b.bar = bar; b.x = xb_xcc_id(); b.st = st; b.wid = wid;
    if (wid == 0 && fresh_lane() == 0) (void)xb_add(&bar[XB_XCNT(b.x)], 1u);
    return b;
}
__device__ __forceinline__ void xcd_barrier_complete(unsigned* bar, unsigned x, unsigned& nloc, unsigned& nx) {
    const unsigned G = gridDim.x * gridDim.y * gridDim.z;
    unsigned sum, cnt, mine, sp = 0u;
    for (;;) {
        sum = 0u; cnt = 0u; mine = 0u;
#pragma unroll
        for (unsigned j = 0; j < 16; ++j) { const unsigned c = xb_ld(&bar[XB_XCNT(j)]); sum += c; cnt += (c > 0u) ? 1u : 0u; mine = (j == x) ? c : mine; }
        if (sum == G) break;
        __builtin_amdgcn_s_sleep(1);
        if ((++sp & 255u) == 0u) { if (xb_ld(&bar[XB_TMO])) break; if (sp > XB_SPIN_CAP) { atomicAdd(&bar[XB_TMO], 1u); break; } }
    }
    nloc = mine > 0u ? mine : 1u; nx = cnt > 0u ? cnt : 1u;
}
__device__ __forceinline__ void xcd_barrier(const XcdBarrier& b) {
    asm volatile("s_waitcnt vmcnt(0)" ::: "memory");
    __syncthreads();
    if (b.wid == 0 && fresh_lane() == 0) {
        unsigned* bar = b.bar;
        __builtin_amdgcn_s_waitcnt(0);
        unsigned nloc = b.st[0], nx = b.st[1];
        if (nloc == 0u) { xcd_barrier_complete(bar, b.x, nloc, nx); b.st[0] = nloc; b.st[1] = nx; }
        const unsigned old = xb_add(&bar[XB_XSUB(b.x)], 1u);
        const unsigned gen = old / nloc;
        if (old + 1u == (gen + 1u) * nloc) {
            __builtin_amdgcn_fence(__ATOMIC_RELEASE, "agent");
            asm volatile("s_waitcnt vmcnt(0)" ::: "memory");
            const unsigned og = xb_add(&bar[XB_TOP], 1u);
            const unsigned tg = og / nx;
            if (og + 1u == (tg + 1u) * nx) xb_add(&bar[XB_TOPGEN], 1u);
            else XB_SPIN(xb_ld(&bar[XB_TOPGEN]) == tg, bar);
            __builtin_amdgcn_fence(__ATOMIC_ACQUIRE, "agent");
            xb_add(&bar[XB_XGEN(b.x)], 1u);
            asm volatile("s_waitcnt vmcnt(0)" ::: "memory");
        } else {
            XB_SPIN(xb_ld(&bar[XB_XGEN(b.x)]) == gen, bar);
            __builtin_amdgcn_fence(__ATOMIC_ACQUIRE, "agent");
            asm volatile("s_waitcnt vmcnt(0)" ::: "memory");
        }
    }
    __syncthreads();
}

#define PROBE_DUP 0
constexpr int LDS_BYTES = 163840;
typedef const __attribute__((address_space(4))) P* kargp_t;
#define GETP() P p; { kargp_t kq_ = kp; asm volatile("" : "+s"(kq_)); p = *(const P*)kq_; p.wid = wid; }
__global__ void __launch_bounds__(NT, 2) fwd_kernel(P p_in) {
    const int wid = __builtin_amdgcn_readfirstlane((int)(threadIdx.x >> 6));
    kargp_t kp = (kargp_t)__builtin_amdgcn_kernarg_segment_ptr();
    extern __shared__ __attribute__((aligned(16))) unsigned char lds[];
    float* sm = (float*)lds;
    { volatile ALAS unsigned* stw = (volatile ALAS unsigned*)((ALAS unsigned char*)lds + LDS_MISC + 2048); if (threadIdx.x < 2) stw[threadIdx.x] = 0u; }
    __syncthreads();
    XcdBarrier gbar; { GETP(); gbar = xcd_barrier_post((unsigned*)(p.ws + WS_CNT + 1024), (volatile ALAS unsigned*)((ALAS unsigned char*)lds + LDS_MISC + 2048), wid); }
    { GETP(); ph_init(p); }
    { GETP(); ph_mod(p, sm); }
    { GETP(); ph_rope_table(p); }
    { GETP(); ph_prep_weights(p, lds); }
    xcd_barrier(gbar);
#pragma unroll 1
    for (int l = 0; l < 2; ++l) {
        { GETP(); ph_norm1(p, l); }
        { GETP(); ph_prep_moe(p, l, lds); }
        xcd_barrier(gbar);
        { GETP(); PB_InProj pb; pb.A = (const char*)(p.ws + WS_H); pb.ldb = D; pb.nt = D / 64; pb.Bt = (const char*)(p.ws + WS_WIN) + (size_t)l * NZ * D * 2; pb.Zo = (bf16_t*)(p.ws + WS_Z); pb.G = gridDim.x; pb.c = blockIdx.x;
          pg8::gemm_phase<PB_InProj, true>((PG8_LAS unsigned char*)lds, pb, wid);
          if (PROBE_DUP == 3) pg8::gemm_phase<PB_InProj, true>((PG8_LAS unsigned char*)lds, pb, wid); }
        xcd_barrier(gbar);
        { GETP(); ph_rope(p, l); }
        { GETP(); ph_sg(p, l, lds); if (PROBE_DUP == 4) ph_sg(p, l, lds); }
        { GETP(); ph_lru_m1(p, l, lds); if (PROBE_DUP == 7) ph_lru_m1(p, l, lds); }
        { GETP(); ph_hg<1>(p, l, lds); if (PROBE_DUP == 9) ph_hg<1>(p, l, lds); }
        xcd_barrier(gbar);
        { GETP(); ph_attn(p, l, lds); if (PROBE_DUP == 5) ph_attn(p, l, lds); }
        { GETP(); ph_lru_m2(p, l, lds); if (PROBE_DUP == 6) ph_lru_m2(p, l, lds); }
        { GETP(); ph_hg<2>(p, l, lds); if (PROBE_DUP == 10) ph_hg<2>(p, l, lds); }
        xcd_barrier(gbar);
        { GETP(); PB_OutProj pb; pb.A = (const char*)(p.ws + WS_Y); pb.ldb = D; pb.nt = D / 64; pb.Bt = (const char*)(p.ws + WS_WOUT) + (size_t)l * D * D * 2; pb.X = (float*)(p.ws + WS_X);
          pb.MODl = (const float*)(p.ws + WS_MOD) + (size_t)l * 9 * 6 * D; pb.G = gridDim.x; pb.c = blockIdx.x; pb.skipctx = (l == 1);
          pg8::gemm_phase<PB_OutProj, true>((PG8_LAS unsigned char*)lds, pb, wid); }
        xcd_barrier(gbar);
        { GETP(); ph_router(p, l, lds + LDS_MISC); if (PROBE_DUP == 11) ph_final(p); }
        xcd_barrier(gbar);
        { GETP(); int* tb = (int*)(lds + LDS_MISC + 1024); moe_tiles_setup(p, l, tb);
          PB_Moe1 pb; pb.A = (const char*)(p.ws + WS_H); pb.ldb = D; pb.nt = D / 64; pb.W13 = (const char*)(p.ws + WS_W13); pb.HE = (bf16_t*)(p.ws + WS_Z); pb.LISTP = (const int*)(p.ws + WS_LISTP);
          pb.GP = (const float2*)(p.ws + WS_GP); pb.tb = tb; pb.G = gridDim.x; pb.c = blockIdx.x;
          pg8::gemm_phase<PB_Moe1, true>((PG8_LAS unsigned char*)lds, pb, wid);
          if (PROBE_DUP == 8) pg8::gemm_phase<PB_Moe1, true>((PG8_LAS unsigned char*)lds, pb, wid); }
        xcd_barrier(gbar);
        { GETP(); int* tb = (int*)(lds + LDS_MISC + 1024);
          PB_Moe2 pb; pb.A = (const char*)(p.ws + WS_Z); pb.ldb = DE; pb.nt = 16; pb.W2 = (const char*)(p.ws + WS_W2); pb.X = (float*)(p.ws + WS_X);
          pb.MODl = (const float*)(p.ws + WS_MOD) + (size_t)l * 9 * 6 * D; pb.LISTP = (const int*)(p.ws + WS_LISTP); pb.tb = tb; pb.G = gridDim.x; pb.c = blockIdx.x;
          pg8::gemm_phase<PB_Moe2, true>((PG8_LAS unsigned char*)lds, pb, wid); }
        xcd_barrier(gbar);
    }
    { GETP(); ph_final(p); }
}

extern "C" void kernel_launch(void* const* d_in, const int* in_sizes, int n_in, void* d_out, int out_size, void* d_ws, size_t ws_size, hipStream_t stream) {
    if (n_in != N_IN || ws_size < WS_END) { fprintf(stderr, "kernel_launch: bad n_in %d or ws %zu < %zu\n", n_in, ws_size, (size_t)WS_END); return; }
    P p{};
    for (int i = 0; i < N_IN; ++i) p.in[i] = (const float*)d_in[i];
    p.out = (float*)d_out; p.ws = (unsigned char*)d_ws;
    (void)hipMemsetAsync((char*)d_ws + WS_CNT, 0, 16384, stream);
    void* args[] = {&p};
    static bool attr_set = false;
    if (!attr_set) { (void)hipFuncSetAttribute((const void*)fwd_kernel, hipFuncAttributeMaxDynamicSharedMemorySize, LDS_BYTES); attr_set = true; }
    hipError_t e = hipLaunchCooperativeKernel((void*)fwd_kernel, dim3(256), dim3(NT), args, LDS_BYTES, stream);
    if (e != hipSuccess) fprintf(stderr, "cooperative launch failed: %s\n", hipGetErrorString(e));
}
```

```cpp
#include <hip/hip_runtime.h>
#include <cstdio>
#include <cstdint>

constexpr int D = 1024, NB = 8, T = 2048, TC = 256, LB = T + TC  , R = NB * LB  ;
constexpr int NZ = 3072, NE = 16, DE = 512;
constexpr float EPS = 1e-6f;
constexpr int ZA_X = 0, ZA_G = 256, ZB_Q = 512, ZB_K = 768, ZB_V = 1024, ZC_U = 1280, ZC_V = 1536, ZD_Q = 1792, ZD_FF = 2048, ZD_FB = 2304, ZD_I = 2560, ZD_G = 2816;
enum { I_X = 0, I_C, I_CTX, I_CCTX, I_WADA, I_BADA, I_N1G, I_N2G, I_WIN, I_WOUT, I_CONVW, I_CONVB, I_WR, I_BR, I_WI, I_BI, I_LAM,
       I_DALAM, I_DASUB, I_SGNG, I_SGW, I_SGB, I_HGLB, I_HGNG, I_RW, I_RB, I_W1, I_W3, I_W2, I_FNG, N_IN };

typedef unsigned short bf16_t;
#define ALAS __attribute__((address_space(3)))
constexpr size_t MiB = 1u << 20;
constexpr size_t WS_MOD = 0;
constexpr size_t WS_CNT = 512 * 1024;
constexpr size_t WS_GP = 1 * MiB;
constexpr size_t WS_LISTP = WS_GP + (size_t)R * 8;
constexpr size_t WS_LRUWT = 768 * 1024;
constexpr size_t WS_ROPE = 4 * MiB + 512 * 1024;
constexpr size_t WS_SGW = 5 * MiB;
constexpr size_t WS_LRUAGG = 3 * MiB;
constexpr size_t WS_X = 8 * MiB;
constexpr size_t WS_H = WS_X + (size_t)R * D * 4;
constexpr size_t WS_Z = WS_H + (size_t)R * D * 2;
constexpr size_t WS_Y = WS_Z + (size_t)R * NZ * 2;
constexpr size_t WS_WIN = WS_Y + (size_t)R * D * 2;
constexpr size_t WS_WOUT = WS_WIN + 2 * (size_t)NZ * D * 2;
constexpr size_t WS_W13 = WS_WOUT + 2 * (size_t)D * D * 2;
constexpr size_t WS_W2 = WS_W13 + (size_t)NE * 1024 * D * 2;
constexpr size_t WS_END = WS_W2 + (size_t)NE * D * DE * 2;
constexpr int MPAD = R + 24 * 256;

struct P { const float* in[N_IN]; float* out; unsigned char* ws; int wid; int pad; };
__device__ __forceinline__ int fresh_lane() { int l_; asm volatile("v_mbcnt_lo_u32_b32 %0, -1, 0\n\tv_mbcnt_hi_u32_b32 %0, -1, %0" : "=v"(l_)); return l_; }


__device__ __forceinline__ float bf2f(bf16_t v) { return __uint_as_float(((unsigned)v) << 16); }
__device__ __forceinline__ bf16_t f2bf(float f) { unsigned u = __float_as_uint(f); return (bf16_t)((u + 0x7fffu + ((u >> 16) & 1u)) >> 16); }
__device__ __forceinline__ float sigmoidf_(float x) { return 1.f / (1.f + expf(-x)); }
__device__ __forceinline__ float siluf_(float x) { return x / (1.f + expf(-x)); }
__device__ __forceinline__ float geluf_(float x) { const float u = 1.5957691216057308f * (x + 0.044715f * x * x * x); return x / (1.f + __expf(-u)); }
__device__ __forceinline__ float wave_sum(float v) {
#pragma unroll
    for (int o = 1; o < 64; o <<= 1) v += __shfl_xor(v, o);
    return v;
}
__device__ __forceinline__ int row_mi(int r) { const int b = r / LB, j = r - b * LB; return j < TC ? 8 : b; }

#define NT 512
__device__ __forceinline__ int ustart(int off) { const int G = gridDim.x, b = blockIdx.x; const int v = (G % 8 == 0) ? (b % 8) * (G / 8) + b / 8 : b; return (v + off) % G; }
#define NWV 8

__device__ __forceinline__ void ph_init(const P& p) {
    const int tidx = p.wid * 64 + fresh_lane();
    float* X = (float*)(p.ws + WS_X);
    const size_t n4 = (size_t)R * D / 4;
    const size_t stride = (size_t)gridDim.x * NT;
    const float* xin = p.in[I_X]; const float* cin = p.in[I_CTX];
#define INIT_SRC(i_) ({ const size_t e_ = (i_) * 4; const int r_ = (int)(e_ / D), c_ = (int)(e_ % D); const int b_ = r_ / LB, j_ = r_ - b_ * LB; \
        const size_t oc_ = ((size_t)b_ * TC + j_) * D + c_, ox_ = ((size_t)b_ * T + (j_ - TC)) * D + c_; (const float4*)((j_ < TC) ? (cin + oc_) : (xin + ox_)); })
    size_t i = (size_t)blockIdx.x * NT + tidx;
    for (; i + 3 * stride < n4; i += 4 * stride) {
        const float4 v0 = *INIT_SRC(i), v1 = *INIT_SRC(i + stride), v2 = *INIT_SRC(i + 2 * stride), v3 = *INIT_SRC(i + 3 * stride);
        *(float4*)(X + i * 4) = v0; *(float4*)(X + (i + stride) * 4) = v1; *(float4*)(X + (i + 2 * stride) * 4) = v2; *(float4*)(X + (i + 3 * stride) * 4) = v3;
    }
    for (; i < n4; i += stride) *(float4*)(X + i * 4) = *INIT_SRC(i);
#undef INIT_SRC
}

__device__ __forceinline__ void ph_mod(const P& p, float* sm_) {
    const int tidx = p.wid * 64 + fresh_lane();
    float* MOD = (float*)(p.ws + WS_MOD);
    ALAS float* sm = (ALAS float*)sm_; ALAS float* red = sm + 9 * D;
    for (int i = tidx; i < 9 * D; i += NT) { const int mi = i / D, k = i % D; const float c = mi < 8 ? p.in[I_C][mi * D + k] : p.in[I_CCTX][k]; sm[i] = siluf_(c); }
    __syncthreads();
    const int col = tidx & 63, part = tidx >> 6;
    for (int it = blockIdx.x; it < 2 * 96; it += gridDim.x) {
        const int l = it / 96, n0 = (it % 96) * 64;
        const float* W = p.in[I_WADA] + (size_t)l * D * 6 * D + (size_t)(part * 128) * 6 * D + n0 + col;
        float acc[9];
#pragma unroll
        for (int m = 0; m < 9; ++m) acc[m] = 0.f;
#pragma unroll 8
        for (int k = 0; k < 128; ++k) { const float w = W[(size_t)k * 6 * D];
#pragma unroll
            for (int m = 0; m < 9; ++m) acc[m] += sm[m * D + part * 128 + k] * w; }
#pragma unroll
        for (int m = 0; m < 9; ++m) red[(part * 9 + m) * 64 + col] = acc[m];
        __syncthreads();
        for (int o = tidx; o < 9 * 64; o += NT) { const int m = o >> 6, cc = o & 63; float v = p.in[I_BADA][l * 6 * D + n0 + cc];
#pragma unroll
            for (int q = 0; q < 8; ++q) v += red[(q * 9 + m) * 64 + cc];
            MOD[((size_t)l * 9 + m) * 6 * D + n0 + cc] = v; }
        __syncthreads();
    }
}

__device__ __forceinline__ void ph_norm1(const P& p, int l) {
    const int tidx = p.wid * 64 + fresh_lane();
    const float* X = (const float*)(p.ws + WS_X); bf16_t* H = (bf16_t*)(p.ws + WS_H);
    const float* MOD = (const float*)(p.ws + WS_MOD) + (size_t)l * 9 * 6 * D; const float* g = p.in[I_N1G] + l * D;
    const int lane = tidx & 63, wv = tidx >> 6;
    for (int r = blockIdx.x * NWV + wv; r < R; r += gridDim.x * NWV) {
        const float* m = MOD + (size_t)row_mi(r) * 6 * D;
        float4 v[4]; float ss = 0.f;
#pragma unroll
        for (int q = 0; q < 4; ++q) { v[q] = *(const float4*)(X + (size_t)r * D + (lane + 64 * q) * 4); ss += v[q].x * v[q].x + v[q].y * v[q].y + v[q].z * v[q].z + v[q].w * v[q].w; }
        const float rs = rsqrtf(wave_sum(ss) * (1.f / D) + EPS);
#pragma unroll
        for (int q = 0; q < 4; ++q) { const int c = (lane + 64 * q) * 4; const float xv[4] = {v[q].x, v[q].y, v[q].z, v[q].w}; bf16_t o[4];
#pragma unroll
            for (int i = 0; i < 4; ++i) o[i] = f2bf(xv[i] * rs * g[c + i] * (1.f + m[D + c + i]) + m[c + i]);
            *(uint2*)(H + (size_t)r * D + c) = make_uint2((unsigned)o[0] | ((unsigned)o[1] << 16), (unsigned)o[2] | ((unsigned)o[3] << 16)); }
    }
}

constexpr float QSCALE = 0.17677669529663687f * 1.4426950408889634f;
__device__ __forceinline__ void ph_rope_table(const P& p) {
    const int tidx = p.wid * 64 + fresh_lane();
    float2* TAB = (float2*)(p.ws + WS_ROPE);
    for (int it = blockIdx.x * NT + tidx; it < T * 16; it += gridDim.x * NT) { const int f = it & 7, a = (it >> 3) & 1, t = it >> 4;
        const float pos = (float)(a == 0 ? (t / 64) : (t % 64)); const float freq = expf(-(float)f * 0.125f * 9.210340371976184f); const float ang = pos * freq;
        TAB[it] = make_float2(cosf(ang), sinf(ang)); }
}
__device__ __forceinline__ void ph_rope(const P& p, int l) {
    const int tidx = p.wid * 64 + fresh_lane();
    bf16_t* Z = (bf16_t*)(p.ws + WS_Z); const float2* TAB = (const float2*)(p.ws + WS_ROPE);
    const int total = NB * T * 32;
    for (int it = blockIdx.x * NT + tidx; it < total; it += gridDim.x * NT) {
        const int pr = it & 31, rt = it >> 5; const int b = rt / T, t = rt % T;
        const int a = pr & 1, n = (pr >> 1) & 1, h = (pr >> 2) & 3, qk = pr >> 4;
        bf16_t* zp = Z + (size_t)(b * LB + TC + t) * NZ + (qk ? ZB_K : ZB_Q) + h * 64 + n * 32 + a * 16;
        const uint4 v1 = *(const uint4*)zp, v2 = *(const uint4*)(zp + 8); const unsigned w1[4] = {v1.x, v1.y, v1.z, v1.w}, w2[4] = {v2.x, v2.y, v2.z, v2.w};
        const float2* tb = TAB + (size_t)(t * 2 + a) * 8; const float sc = qk ? 1.f : QSCALE; unsigned o1[4], o2[4];
#pragma unroll
        for (int i = 0; i < 4; ++i) { const float2 cs0 = tb[2 * i], cs1 = tb[2 * i + 1];
            const float x1a = __uint_as_float(w1[i] << 16), x1b = __uint_as_float(w1[i] & 0xffff0000u), x2a = __uint_as_float(w2[i] << 16), x2b = __uint_as_float(w2[i] & 0xffff0000u);
            o1[i] = (unsigned)f2bf((x1a * cs0.x - x2a * cs0.y) * sc) | ((unsigned)f2bf((x1b * cs1.x - x2b * cs1.y) * sc) << 16);
            o2[i] = (unsigned)f2bf((x2a * cs0.x + x1a * cs0.y) * sc) | ((unsigned)f2bf((x2b * cs1.x + x1b * cs1.y) * sc) << 16); }
        *(uint4*)zp = make_uint4(o1[0], o1[1], o1[2], o1[3]); *(uint4*)(zp + 8) = make_uint4(o2[0], o2[1], o2[2], o2[3]);
    }
    if (l == 0) {
        const int totc = NB * TC * 256;
        for (int it = blockIdx.x * NT + tidx; it < totc; it += gridDim.x * NT) {
            const int c = it & 255, rt = it >> 8; const int b = rt / TC, j = rt % TC;
            bf16_t* zp = Z + (size_t)(b * LB + j) * NZ + ZB_Q + c; zp[0] = f2bf(bf2f(zp[0]) * QSCALE);
        }
    }
}

namespace lru {
typedef short bf16x8 __attribute__((ext_vector_type(8)));
typedef float f32x4 __attribute__((ext_vector_type(4)));
constexpr int UROW = 264;
__device__ __forceinline__ void comp(float& A, float& B, float a, float b) { B = a * B + b; A = a * A; }
}
__device__ __forceinline__ void ph_lru_m1(const P& p, int l, unsigned char* ldsb) {
    using namespace lru;
    const int lane = fresh_lane(), wid = p.wid, tid = wid * 64 + lane;
    const bf16_t* Z = (const bf16_t*)(p.ws + WS_Z); bf16_t* G = (bf16_t*)(p.ws + WS_H); float2* AGG = (float2*)(p.ws + WS_LRUAGG);
    const bf16_t* WT = (const bf16_t*)(p.ws + WS_LRUWT);
    const float* cw = p.in[I_CONVW] + l * 4 * 256; const float* cb = p.in[I_CONVB] + l * 256;
    ALAS bf16_t* U = (ALAS bf16_t*)ldsb;
    const int h = wid & 3, d = wid >> 2, l15 = lane & 15, g4 = lane >> 4;
    float spv[4], brv[4], biv[4];
#pragma unroll
    for (int jt = 0; jt < 4; ++jt) { const int w = h * 64 + jt * 16 + l15; spv[jt] = log1pf(expf(-p.in[I_LAM][(l * 2 + d) * 256 + w])); brv[jt] = p.in[I_BR][(l * 2 + d) * 256 + w]; biv[jt] = p.in[I_BI][(l * 2 + d) * 256 + w]; }
    for (int unit = ustart(192); unit < NB * 36; unit += gridDim.x) {
        const int b = unit / 36, c = unit % 36, r0 = b * LB + c * 64; const int lo = c < 4 ? 0 : TC, hi = c < 4 ? TC : LB;
        for (int item = tid; item < 2048; item += NT) {
            const int t = item >> 5, cg = item & 31, j = c * 64 + t; float acc[8];
#pragma unroll
            for (int i = 0; i < 8; ++i) acc[i] = cb[cg * 8 + i];
#pragma unroll
            for (int q = 0; q < 4; ++q) { const int jj = j + q - 2; if (jj >= lo && jj < hi) { const uint4 zv = *(const uint4*)(Z + (size_t)(r0 + t + q - 2) * NZ + ZA_X + cg * 8); const unsigned zw[4] = {zv.x, zv.y, zv.z, zv.w};
#pragma unroll
                for (int i = 0; i < 4; ++i) { acc[2 * i] += __uint_as_float(zw[i] << 16) * cw[q * 256 + cg * 8 + 2 * i]; acc[2 * i + 1] += __uint_as_float(zw[i] & 0xffff0000u) * cw[q * 256 + cg * 8 + 2 * i + 1]; } } }
            uint4 o; o.x = (unsigned)f2bf(acc[0]) | ((unsigned)f2bf(acc[1]) << 16); o.y = (unsigned)f2bf(acc[2]) | ((unsigned)f2bf(acc[3]) << 16); o.z = (unsigned)f2bf(acc[4]) | ((unsigned)f2bf(acc[5]) << 16); o.w = (unsigned)f2bf(acc[6]) | ((unsigned)f2bf(acc[7]) << 16);
            { typedef unsigned u32x4_t __attribute__((ext_vector_type(4))); u32x4_t ov = {o.x, o.y, o.z, o.w}; *(ALAS u32x4_t*)(U + t * UROW + cg * 8) = ov; }
        }
        __syncthreads();
        bf16x8 af[4][2];
#pragma unroll
        for (int tt = 0; tt < 4; ++tt)
#pragma unroll
            for (int ks = 0; ks < 2; ++ks) af[tt][ks] = *(const ALAS bf16x8*)(U + (16 * tt + l15) * UROW + h * 64 + 32 * ks + 8 * g4);
#pragma unroll 1
        for (int jt = 0; jt < 4; ++jt) {
            const float spj = jt == 0 ? spv[0] : jt == 1 ? spv[1] : jt == 2 ? spv[2] : spv[3], brj = jt == 0 ? brv[0] : jt == 1 ? brv[1] : jt == 2 ? brv[2] : brv[3], bij = jt == 0 ? biv[0] : jt == 1 ? biv[1] : jt == 2 ? biv[2] : biv[3];
            f32x4 ar[4], ai[4];
#pragma unroll
            for (int tt = 0; tt < 4; ++tt) { ar[tt] = (f32x4){0.f, 0.f, 0.f, 0.f}; ai[tt] = (f32x4){0.f, 0.f, 0.f, 0.f}; }
#pragma unroll
            for (int ks = 0; ks < 2; ++ks) { const bf16_t* wp = WT + ((size_t)(((l * 2 + d) * 2 + 0) * 4 + h) * 64 + 16 * jt + l15) * 64 + 32 * ks + 8 * g4; const bf16x8 wr = *(const bf16x8*)wp, wi = *(const bf16x8*)(wp + 4 * 64 * 64);
#pragma unroll
                for (int tt = 0; tt < 4; ++tt) { ar[tt] = __builtin_amdgcn_mfma_f32_16x16x32_bf16(af[tt][ks], wr, ar[tt], 0, 0, 0); ai[tt] = __builtin_amdgcn_mfma_f32_16x16x32_bf16(af[tt][ks], wi, ai[tt], 0, 0, 0); } }
            const int w = h * 64 + jt * 16 + l15; float mA[4], mB[4];
#pragma unroll
            for (int tt = 0; tt < 4; ++tt) { float A = 1.f, Bv = 0.f; float av[4], bv[4];
#pragma unroll
                for (int rg = 0; rg < 4; ++rg) { const int t = 16 * tt + 4 * g4 + rg;
                    const float rgt = 1.f / (1.f + __expf(-(ar[tt][rg] + brj))), igt = 1.f / (1.f + __expf(-(ai[tt][rg] + bij)));
                    const float la = -8.f * rgt * spj; const float uu = bf2f(U[t * UROW + w]); const float bc = sqrtf(fmaxf(-expm1f(2.f * la), 0.f)) * igt * uu;
                    const bf16_t lab = f2bf(la), bcb = f2bf(bc);
                    G[((size_t)(d * 2 + 0) * R + r0 + t) * 256 + w] = lab; G[((size_t)(d * 2 + 1) * R + r0 + t) * 256 + w] = bcb;
                    av[rg] = __expf(bf2f(lab)); bv[rg] = bf2f(bcb); }
                if (d == 0) { comp(A, Bv, av[0], bv[0]); comp(A, Bv, av[1], bv[1]); comp(A, Bv, av[2], bv[2]); comp(A, Bv, av[3], bv[3]); }
                else { comp(A, Bv, av[3], bv[3]); comp(A, Bv, av[2], bv[2]); comp(A, Bv, av[1], bv[1]); comp(A, Bv, av[0], bv[0]); }
                mA[tt] = A; mB[tt] = Bv; }
            float A = 1.f, Bv = 0.f;
#pragma unroll
            for (int s4 = 0; s4 < 4; ++s4) { const int tt = d == 0 ? s4 : 3 - s4; const float ma = d == 0 ? mA[s4] : mA[3 - s4], mb = d == 0 ? mB[s4] : mB[3 - s4]; (void)tt;
#pragma unroll
                for (int gs = 0; gs < 4; ++gs) { const int gg = d == 0 ? gs : 3 - gs; const float a = __shfl(ma, gg * 16 + l15), bq = __shfl(mb, gg * 16 + l15); comp(A, Bv, a, bq); } }
            if (g4 == 0) AGG[((size_t)(b * 2 + d) * 36 + c) * 256 + w] = make_float2(A, Bv);
        }
        __syncthreads();
    }
}
__device__ __forceinline__ void ph_lru_m2(const P& p, int l, unsigned char* ldsb) {
    const int lane = fresh_lane(), wid = p.wid, tid = wid * 64 + lane;
    const bf16_t* Z = (const bf16_t*)(p.ws + WS_Z); const bf16_t* G = (const bf16_t*)(p.ws + WS_H); bf16_t* Y = (bf16_t*)(p.ws + WS_Y); const float2* AGG = (const float2*)(p.ws + WS_LRUAGG);
    ALAS float* HS = (ALAS float*)ldsb;
    const int d = tid >> 8, w = tid & 255;
    const int ncb = l == 1 ? 32 : 36, nun = NB * ncb;
    for (int unit = ustart(224); unit < nun; unit += gridDim.x) {
        const int b = unit / ncb, c = (36 - ncb) + unit % ncb, r0 = b * LB + c * 64;
        float hst = 0.f; const float2* ag = AGG + (size_t)(b * 2 + d) * 36 * 256 + w;
        {
            const int pos = d == 0 ? c : (c < 4 ? 3 - c : 4 + (35 - c));
            float mx[36], my[36];
#pragma unroll
            for (int k = 0; k < 36; ++k) { const int cc = d == 0 ? k : (k < 4 ? 3 - k : 39 - k); const float2 m = ag[cc * 256]; mx[k] = m.x; my[k] = m.y; }
#pragma unroll
            for (int k = 0; k < 36; ++k) { const bool vf = k < pos; const float a = vf ? mx[k] : 1.f, bq = vf ? my[k] : 0.f; hst = __builtin_fmaf(a, hst, bq); }
        }
        const bf16_t* gl = G + ((size_t)(d * 2 + 0) * R + r0) * 256 + w; const bf16_t* gb = G + ((size_t)(d * 2 + 1) * R + r0) * 256 + w;
#pragma unroll 1
        for (int s0 = 0; s0 < 64; s0 += 32) {
            bf16_t la[32], lb[32];
#pragma unroll
            for (int i = 0; i < 32; ++i) { const int t = d == 0 ? (s0 + i) : 63 - (s0 + i); la[i] = gl[t * 256]; lb[i] = gb[t * 256]; }
#pragma unroll
            for (int i = 0; i < 32; ++i) { const int t = d == 0 ? (s0 + i) : 63 - (s0 + i); hst = __expf(bf2f(la[i])) * hst + bf2f(lb[i]); HS[(d * 64 + t) * 256 + w] = hst; }
        }
        __syncthreads();
#pragma unroll
        for (int q = 0; q < 4; ++q) { const int it = tid + q * NT; const int t = it >> 5, c8 = (it & 31) * 8;
            const uint4 zv = *(const uint4*)(Z + (size_t)(r0 + t) * NZ + ZA_G + c8); const unsigned zw[4] = {zv.x, zv.y, zv.z, zv.w}; unsigned o[4];
#pragma unroll
            for (int i = 0; i < 4; ++i) { const float h0 = HS[t * 256 + c8 + 2 * i] + HS[(64 + t) * 256 + c8 + 2 * i], h1 = HS[t * 256 + c8 + 2 * i + 1] + HS[(64 + t) * 256 + c8 + 2 * i + 1];
                o[i] = (unsigned)f2bf(h0 * geluf_(__uint_as_float(zw[i] << 16))) | ((unsigned)f2bf(h1 * geluf_(__uint_as_float(zw[i] & 0xffff0000u))) << 16); }
            *(uint4*)(Y + (size_t)(r0 + t) * D + c8) = make_uint4(o[0], o[1], o[2], o[3]); }
        __syncthreads();
    }
}

__device__ __forceinline__ void ph_sg(const P& p, int l, unsigned char* ldsb) {
    typedef short bf16x8 __attribute__((ext_vector_type(8))); typedef float f32x16 __attribute__((ext_vector_type(16)));
    const int lane = fresh_lane(), wid = p.wid, tid = wid * 64 + lane, r32 = lane & 31, hi = lane >> 5;
    const bf16_t* Z = (const bf16_t*)(p.ws + WS_Z); bf16_t* Y = (bf16_t*)(p.ws + WS_Y); const bf16_t* SGW = (const bf16_t*)(p.ws + WS_SGW) + (size_t)l * 4 * 128 * 128;
    const float* ng = p.in[I_SGNG] + l * 256;
    ALAS bf16_t* VT = (ALAS bf16_t*)ldsb;
    constexpr int VROW = 136;
    const int q = tid >> 2, part = tid & 3, ptile = wid & 3, chalf = wid >> 2;
    const int nck = l == 1 ? 16 : 18;
    for (int unit = ustart(0); unit < NB * nck * 4; unit += gridDim.x) {
        const int h = unit & 3, bc = unit >> 2, b = bc / nck, ck = (18 - nck) + bc % nck;
        const int r0 = b * LB + ck * 128;
        bf16x8 wf[8];
        { const bf16_t* wp = SGW + ((size_t)h * 128 + 32 * ptile + r32) * 128 + 8 * hi;
#pragma unroll
          for (int ks = 0; ks < 8; ++ks) wf[ks] = *(const bf16x8*)(wp + 16 * ks); }
        { const bf16_t* zv = Z + (size_t)(r0 + q) * NZ + ZC_V + part * 64; uint4 raw[8]; float ss = 0.f;
#pragma unroll
          for (int i = 0; i < 8; ++i) raw[i] = *(const uint4*)(zv + 8 * i);
#pragma unroll
          for (int i = 0; i < 8; ++i) { const unsigned w4[4] = {raw[i].x, raw[i].y, raw[i].z, raw[i].w};
#pragma unroll
              for (int k = 0; k < 4; ++k) { const float g0 = geluf_(__uint_as_float(w4[k] << 16)), g1 = geluf_(__uint_as_float(w4[k] & 0xffff0000u)); ss += g0 * g0 + g1 * g1; } }
          ss += __shfl_xor(ss, 1); ss += __shfl_xor(ss, 2);
          const float rs = rsqrtf(ss * (1.f / 256.f) + EPS);
          if (part == h) {
#pragma unroll
              for (int i = 0; i < 8; ++i) { const unsigned w4[4] = {raw[i].x, raw[i].y, raw[i].z, raw[i].w};
#pragma unroll
                  for (int k = 0; k < 4; ++k) { const int c = 8 * i + 2 * k;
                      VT[c * VROW + q] = f2bf(geluf_(__uint_as_float(w4[k] << 16)) * rs * ng[h * 64 + c]);
                      VT[(c + 1) * VROW + q] = f2bf(geluf_(__uint_as_float(w4[k] & 0xffff0000u)) * rs * ng[h * 64 + c + 1]); } } } }
        __syncthreads();
        f32x16 acc = f32x16{};
#pragma unroll
        for (int ks = 0; ks < 8; ++ks) { const bf16x8 vf = *(const ALAS bf16x8*)(VT + (32 * chalf + r32) * VROW + 16 * ks + 8 * hi); acc = __builtin_amdgcn_mfma_f32_32x32x16_bf16(wf[ks], vf, acc, 0, 0, 0); }
        { const float* bsp = p.in[I_SGB] + (l * 4 + h) * 128 + 32 * ptile + 4 * hi; bf16_t zu[16];
          const size_t rb = (size_t)(r0 + 32 * ptile + 4 * hi);
#pragma unroll
          for (int r = 0; r < 16; ++r) { const int pr = (r & 3) + 8 * (r >> 2); zu[r] = Z[(rb + pr) * NZ + ZC_U + h * 64 + 32 * chalf + r32]; }
#pragma unroll
          for (int r = 0; r < 16; ++r) { const int pr = (r & 3) + 8 * (r >> 2); Y[(rb + pr) * D + 512 + h * 64 + 32 * chalf + r32] = f2bf(geluf_(bf2f(zu[r])) * (acc[r] + bsp[pr])); } }
        __syncthreads();
    }
}

namespace att {
typedef short bf16x8 __attribute__((ext_vector_type(8)));
typedef short s16x4 __attribute__((ext_vector_type(4)));
typedef float f32x16 __attribute__((ext_vector_type(16)));
typedef float f32x2_t __attribute__((ext_vector_type(2))); typedef __bf16 bf16x2_t __attribute__((ext_vector_type(2)));
constexpr int SLOTB = 8192, NSLOT = 3, L_K = 0, L_V = NSLOT * SLOTB, L_WS = 2 * NSLOT * SLOTB, L_OST = L_WS + 8 * 2 * 32 * 4, OST_W = 32 * 66 * 4;
constexpr float THR = 8.f;
__device__ __forceinline__ int crow(int r, int hi) { return (r & 3) + 8 * (r >> 2) + 4 * hi; }
__device__ __forceinline__ unsigned cvtpk(float lo, float hi) { f32x2_t v = {lo, hi}; bf16x2_t b = __builtin_convertvector(v, bf16x2_t); return __builtin_bit_cast(unsigned, b); }
__device__ __forceinline__ float swapmax(float m) { auto rr = __builtin_amdgcn_permlane32_swap(__float_as_uint(m), __float_as_uint(m), false, false); return fmaxf(__uint_as_float(rr[0]), __uint_as_float(rr[1])); }
__device__ __forceinline__ float swapadd(float m) { auto rr = __builtin_amdgcn_permlane32_swap(__float_as_uint(m), __float_as_uint(m), false, false); return __uint_as_float(rr[0]) + __uint_as_float(rr[1]); }
typedef short v4i16_t __attribute__((ext_vector_type(4)));
__device__ __forceinline__ void glds16(const void* gsrc, unsigned lds_dst) { unsigned keep;
  asm volatile("s_mov_b32 %0, m0\n\ts_mov_b32 m0, %2\n\ts_nop 0\n\tglobal_load_lds_dwordx4 %1, off\n\ts_mov_b32 m0, %0" : "=&s"(keep) : "v"(gsrc), "s"(lds_dst) : "memory"); }
__device__ __forceinline__ s16x4 vtr(const ALAS char* q) { return __builtin_bit_cast(s16x4, __builtin_amdgcn_ds_read_tr16_b64_v4i16((ALAS v4i16_t*)q)); }
}
__device__ __forceinline__ void ph_attn(const P& p, int l, unsigned char* ldsb) {
    using namespace att;
    const int lane = fresh_lane(), wid = p.wid, r32 = lane & 31, hi = lane >> 5;
    const bf16_t* Z = (const bf16_t*)(p.ws + WS_Z); bf16_t* Y = (bf16_t*)(p.ws + WS_Y);
    const float lam_init = l == 0 ? 0.2f : (0.8f - 0.6f * 0.7408182206817179f);
    const float* dl_ = p.in[I_DALAM] + l * 4 * 32; float s01 = 0.f, s23 = 0.f;
    for (int i = 0; i < 32; ++i) { s01 += dl_[i] * dl_[32 + i]; s23 += dl_[64 + i] * dl_[96 + i]; }
    const float lam = expf(s01) - expf(s23) + lam_init;
    const float* subg = p.in[I_DASUB] + l * 64;
    const int G = gridDim.x, bx = blockIdx.x, vcu = (G % 8 == 0) ? (bx % 8) * (G / 8) + bx / 8 : bx;
    const int nun = 256 + (l == 0 ? 32 : 0);
    ALAS char* L3 = (ALAS char*)ldsb; const unsigned lds0 = (unsigned)(size_t)L3;
    ALAS float* wsf = (ALAS float*)(L3 + L_WS) + wid * 64;
    ALAS float* stg = (ALAS float*)(L3 + L_OST + wid * OST_W);
    const ALAS char* kp0 = L3 + L_K + hi * 1024 + r32 * 16;
    const ALAS char* vp0 = L3 + L_V + ((lane >> 4) & 1) * 32 + (lane & 3) * 8 + (4 * hi + ((lane & 15) >> 2)) * 64;
    for (int u = vcu; u < nun; u += G) {
        int b, h, q0row, nt;
        if (u < 256) { b = u >> 5; h = (u >> 3) & 3; q0row = b * LB + TC + (u & 7) * 256; nt = LB / 64; } else { const int v = u - 256; b = v >> 2; h = v & 3; q0row = b * LB; nt = TC / 64; }
        const bf16_t* ksrc = Z + (size_t)(b * LB + lane) * NZ + ZB_K + h * 64 + wid * 8;
        const bf16_t* vsrc = Z + (size_t)(b * LB + 16 * (wid & 3) + (lane >> 2)) * NZ + ZB_V + h * 64 + (wid >> 2) * 32 + (lane & 3) * 8;
#define ATT_DMA(t, slot) do { att::glds16(ksrc + (size_t)(t) * 64 * NZ, (unsigned)__builtin_amdgcn_readfirstlane((int)(lds0 + L_K + (slot) * SLOTB + wid * 1024))); \
                              att::glds16(vsrc + (size_t)(t) * 64 * NZ, (unsigned)__builtin_amdgcn_readfirstlane((int)(lds0 + L_V + (slot) * SLOTB + wid * 1024))); } while (0)
        ATT_DMA(0, 0); ATT_DMA(1, 1);
        bf16x8 qr[4];
        { const bf16_t* qp = Z + (size_t)(q0row + wid * 32 + r32) * NZ + ZB_Q + h * 64 + hi * 8;
#pragma unroll
          for (int d0 = 0; d0 < 4; ++d0) qr[d0] = *(const bf16x8*)(qp + d0 * 16); }
        f32x16 o[2][2], negm[2]; float mrun[2] = {0.f, 0.f}, lsum[2] = {0.f, 0.f};
#pragma unroll
        for (int n = 0; n < 2; ++n) { negm[n] = f32x16{}; o[n][0] = f32x16{}; o[n][1] = f32x16{}; }
        asm volatile("s_waitcnt vmcnt(0)" : "+v"(qr[0]), "+v"(qr[1]), "+v"(qr[2]), "+v"(qr[3]) :: "memory"); __syncthreads();
        int slot = 0;
        for (int t = 0; t < nt; ++t) {
            if (t + 2 < nt) { const int s2 = slot == 0 ? 2 : slot - 1; ATT_DMA(t + 2, s2); }
            const int so = slot * SLOTB;
#pragma unroll
            for (int n = 0; n < 2; ++n) {
                bf16x8 pa[4];
                const bf16x8 k00 = *(const ALAS bf16x8*)(kp0 + so + (2 * n) * 2048), k01 = *(const ALAS bf16x8*)(kp0 + so + (2 * n) * 2048 + 512);
                const bf16x8 k10 = *(const ALAS bf16x8*)(kp0 + so + (2 * n + 1) * 2048), k11 = *(const ALAS bf16x8*)(kp0 + so + (2 * n + 1) * 2048 + 512);
                f32x16 c0 = __builtin_amdgcn_mfma_f32_32x32x16_bf16(k00, qr[2 * n], negm[n], 0, 0, 0);
                f32x16 c1 = __builtin_amdgcn_mfma_f32_32x32x16_bf16(k01, qr[2 * n], negm[n], 0, 0, 0);
                c0 = __builtin_amdgcn_mfma_f32_32x32x16_bf16(k10, qr[2 * n + 1], c0, 0, 0, 0);
                c1 = __builtin_amdgcn_mfma_f32_32x32x16_bf16(k11, qr[2 * n + 1], c1, 0, 0, 0);
                float rm = fmaxf(c0[0], c1[0]);
#pragma unroll
                for (int r = 1; r < 16; ++r) rm = fmaxf(rm, fmaxf(c0[r], c1[r]));
                rm = swapmax(rm);
                if (t == 0 || __any(rm > THR)) {
                    const float dl = t == 0 ? rm : fmaxf(rm, 0.f); mrun[n] += dl;
#pragma unroll
                    for (int r = 0; r < 16; ++r) { c0[r] -= dl; c1[r] -= dl; negm[n][r] = -mrun[n]; }
                    const float f = exp2f(-dl); lsum[n] *= f;
                    if (hi == 0) wsf[n * 32 + r32] = f;
#pragma unroll
                    for (int r = 0; r < 16; ++r) { const float ff = wsf[n * 32 + crow(r, hi)]; o[n][0][r] *= ff; o[n][1][r] *= ff; }
                }
                float sacc = 0.f;
#pragma unroll
                for (int r = 0; r < 16; ++r) { c0[r] = __builtin_amdgcn_exp2f(c0[r]); c1[r] = __builtin_amdgcn_exp2f(c1[r]); sacc += c0[r] + c1[r]; }
                lsum[n] += sacc;
#pragma unroll
                for (int k = 0; k < 2; ++k) {
                    uint4 q0 = make_uint4(cvtpk(c0[8 * k], c0[8 * k + 1]), cvtpk(c0[8 * k + 2], c0[8 * k + 3]), cvtpk(c0[8 * k + 4], c0[8 * k + 5]), cvtpk(c0[8 * k + 6], c0[8 * k + 7]));
                    uint4 q1 = make_uint4(cvtpk(c1[8 * k], c1[8 * k + 1]), cvtpk(c1[8 * k + 2], c1[8 * k + 3]), cvtpk(c1[8 * k + 4], c1[8 * k + 5]), cvtpk(c1[8 * k + 6], c1[8 * k + 7]));
                    pa[k] = __builtin_bit_cast(bf16x8, q0); pa[2 + k] = __builtin_bit_cast(bf16x8, q1); }
#pragma unroll
            for (int d0 = 0; d0 < 2; ++d0) {
                bf16x8 vf[4];
#pragma unroll
                for (int k = 0; k < 4; ++k) { const s16x4 lo = vtr(vp0 + so + d0 * 4096 + k * 1024), hh = vtr(vp0 + so + d0 * 4096 + k * 1024 + 512);
                    vf[k] = (bf16x8){lo[0], lo[1], lo[2], lo[3], hh[0], hh[1], hh[2], hh[3]}; }
#pragma unroll
                for (int k = 0; k < 4; ++k) o[n][d0] = __builtin_amdgcn_mfma_f32_32x32x16_bf16(pa[k], vf[k], o[n][d0], 0, 0, 0);
            }
            __builtin_amdgcn_sched_barrier(0);
            }
            if (t + 2 < nt) asm volatile("s_waitcnt vmcnt(2)" ::: "memory"); else asm volatile("s_waitcnt vmcnt(0)" ::: "memory");
            __builtin_amdgcn_s_barrier(); asm volatile("" ::: "memory");
            slot = slot == 2 ? 0 : slot + 1;
        }
        { const float l1 = swapadd(lsum[0]), l2 = swapadd(lsum[1]);
          const int lane_e = fresh_lane(); const int r32 = lane_e & 31, hi = lane_e >> 5, lane = lane_e;
          ALAS float* wsf = (ALAS float*)(L3 + L_WS) + wid * 64; ALAS float* stg = (ALAS float*)(L3 + L_OST + wid * OST_W);
          if (hi == 0) { wsf[r32] = 1.f / l1; wsf[32 + r32] = lam / l2; }
#pragma unroll
          for (int r = 0; r < 16; ++r) { const int q = crow(r, hi); const float a = wsf[q], bb = wsf[32 + q];
              stg[q * 66 + r32] = o[0][0][r] * a - o[1][0][r] * bb; stg[q * 66 + 32 + r32] = o[0][1][r] * a - o[1][1][r] * bb; }
          const int row = lane >> 1, half = lane & 1; float ov[32]; float ss = 0.f;
#pragma unroll
          for (int i = 0; i < 32; ++i) { ov[i] = stg[row * 66 + half * 32 + i]; ss += ov[i] * ov[i]; }
          ss += __shfl_xor(ss, 1);
          const float rs = rsqrtf(ss * (1.f / 64.f) + EPS) * (1.f - lam_init);
          bf16_t* yo = Y + (size_t)(q0row + wid * 32 + row) * D + 256 + h * 64 + half * 32;
#pragma unroll
          for (int i = 0; i < 4; ++i) { unsigned w[4];
#pragma unroll
              for (int k = 0; k < 4; ++k) w[k] = cvtpk(ov[8 * i + 2 * k] * rs * subg[half * 32 + 8 * i + 2 * k], ov[8 * i + 2 * k + 1] * rs * subg[half * 32 + 8 * i + 2 * k + 1]);
              *(uint4*)(yo + 8 * i) = make_uint4(w[0], w[1], w[2], w[3]); } }
        __syncthreads();
#undef ATT_DMA
    }
}


namespace hg {
typedef short bf16x8 __attribute__((ext_vector_type(8)));
typedef short s16x4 __attribute__((ext_vector_type(4)));
typedef float f32x16 __attribute__((ext_vector_type(16)));
typedef float f32x4v __attribute__((ext_vector_type(4)));
constexpr int QROW = 72;
constexpr int W_Q = 0, W_K = 4608, W_KH = 9216, W_V = 13312, W_BYTES = 17408;
constexpr int L_ST = 8 * W_BYTES;
constexpr int STROW = 68, L_BS = L_ST + 64 * STROW * 4;
constexpr int AGG_FLOATS = 64 * 64 + 64;
__device__ __forceinline__ int img_off(int s, int col) { return ((col >> 5) * 2 + (s >> 4)) * 1024 + (s & 15) * 64 + (col & 31) * 2; }
}
constexpr int LDS_MISC = hg::L_BS + 256;
template <int PASS>
__device__ __forceinline__ void ph_hg(const P& p, int l, unsigned char* ldsb) {
    using namespace hg;
    const int wid = p.wid;
    const bf16_t* Z = (const bf16_t*)(p.ws + WS_Z); bf16_t* Y = (bf16_t*)(p.ws + WS_Y); float* AGG = (float*)p.out;
    ALAS char* L3 = (ALAS char*)ldsb; ALAS char* LW = L3 + wid * W_BYTES;
    ALAS float* ST = (ALAS float*)(L3 + L_ST); ALAS float* BS = (ALAS float*)(L3 + L_BS);
    const float* gn = p.in[I_HGNG] + l * 256;
    const int nsc = (PASS == 2 && l == 1) ? 8 : 9;
    for (int unit = ustart(PASS == 1 ? 160 : 192); unit < NB * 4 * nsc; unit += gridDim.x) {
        const int sc = (9 - nsc) + unit % nsc, bh = unit / nsc, h = bh & 3, b = bh >> 2;
        const int lane = fresh_lane();
        const int tid = wid * 64 + lane, r32 = lane & 31, hi = lane >> 5;
        const ALAS char* trb = LW + ((lane >> 4) & 1) * 32 + (lane & 3) * 8 + (4 * hi + ((lane & 15) >> 2)) * 64;
        float* OSG = (float*)p.out + (size_t)4 * 1024 * 1024 + (size_t)blockIdx.x * 16384;
#pragma unroll 1
        for (int d = 0; d < 2; ++d) {
            float lb = 0.f;
            if (l == 1) { const float* hl = p.in[I_HGLB] + (size_t)d * 2 * 256 + h * 64 + lane; lb = sigmoidf_(hl[256] - hl[0]); }
            const int fcol = (d == 0 ? ZD_FF : ZD_FB) + h * 64 + lane;
            const int jbase = b * LB + sc * 256;
            { const float* ag = AGG + (size_t)((b * 4 + h) * 2 + d) * 9 * AGG_FLOATS; const int dd = tid & 63;
              float sv[8];
#pragma unroll
              for (int i = 0; i < 8; ++i) sv[i] = 0.f;
              if (PASS == 2) {
#pragma unroll
                  for (int k = 0; k < 8; ++k) { const int ai = d == 0 ? k : (k == 0 ? 0 : 9 - k); const bool valid = d == 0 ? (k < sc) : (k == 0 ? (sc > 0) : (ai > sc)); const int ac = valid ? ai : 0;
                      const float dv = valid ? __expf(ag[(size_t)ac * AGG_FLOATS + 4096 + dd]) : 1.f;
#pragma unroll
                      for (int i = 0; i < 8; ++i) { const float s_ = ag[(size_t)ac * AGG_FLOATS + tid + 512 * i]; sv[i] = dv * sv[i] + (valid ? s_ : 0.f); } } }
#pragma unroll
              for (int i = 0; i < 8; ++i) { const int e = tid + 512 * i; ST[(e >> 6) * STROW + (e & 63)] = sv[i]; }
              if (tid < 64) BS[tid] = 0.f; }
            bf16_t fpv[32], ivv[32], qvv[32];
#pragma unroll
            for (int tau = 0; tau < 32; ++tau) { const int jl = d == 0 ? (32 * wid + tau) : (255 - 32 * wid - tau); const bf16_t* zr = Z + (size_t)(jbase + jl) * NZ;
                fpv[tau] = zr[fcol]; ivv[tau] = zr[ZD_I + h * 64 + lane]; qvv[tau] = PASS == 2 ? zr[ZD_Q + h * 64 + lane] : (bf16_t)0; }
#pragma unroll
            for (int tau = 0; tau < 32; ++tau) *(ALAS bf16_t*)(LW + W_V + img_off(tau, lane)) = ivv[tau];
            float gl[32]; float Btot = 0.f;
#pragma unroll
            for (int tau = 0; tau < 32; ++tau) { const float f = lb + (1.f - lb) * sigmoidf_(bf2f(fpv[tau])); gl[tau] = fmaxf(__logf(f), -80.f); Btot += gl[tau]; }
            { float run = 0.f;
#pragma unroll
              for (int tau = 0; tau < 32; ++tau) { run += gl[tau]; const float kk = 1.f - __expf(gl[tau]);
                *(ALAS bf16_t*)(LW + W_KH + img_off(tau, lane)) = f2bf(kk * __expf(Btot - run));
                if (PASS == 2) { *(ALAS bf16_t*)(LW + W_Q + (tau * QROW + lane) * 2) = f2bf(bf2f(qvv[tau]) * 0.125f * __expf(run));
                                 *(ALAS bf16_t*)(LW + W_K + (tau * QROW + lane) * 2) = f2bf(kk * __expf(fminf(-run, 80.f))); } } }
            f32x16 sl[2][2];
#pragma unroll
            for (int cv = 0; cv < 2; ++cv)
#pragma unroll
                for (int cd = 0; cd < 2; ++cd) sl[cv][cd] = f32x16{};
            bf16x8 vfr[2][2];
#pragma unroll
            for (int ks = 0; ks < 2; ++ks)
#pragma unroll
                for (int ch = 0; ch < 2; ++ch) { const s16x4 lo = att::vtr(trb + W_V + (ch * 2 + ks) * 1024), hh = att::vtr(trb + W_V + (ch * 2 + ks) * 1024 + 512);
                    vfr[ks][ch] = (bf16x8){lo[0], lo[1], lo[2], lo[3], hh[0], hh[1], hh[2], hh[3]}; }
#pragma unroll
            for (int ks = 0; ks < 2; ++ks)
#pragma unroll
                for (int cd = 0; cd < 2; ++cd) { const s16x4 lo = att::vtr(trb + W_KH + (cd * 2 + ks) * 1024), hh = att::vtr(trb + W_KH + (cd * 2 + ks) * 1024 + 512);
                    const bf16x8 kf = (bf16x8){lo[0], lo[1], lo[2], lo[3], hh[0], hh[1], hh[2], hh[3]};
#pragma unroll
                    for (int cv = 0; cv < 2; ++cv) sl[cv][cd] = __builtin_amdgcn_mfma_f32_32x32x16_bf16(vfr[ks][cv], kf, sl[cv][cd], 0, 0, 0); }
            f32x16 o[2]; o[0] = f32x16{}; o[1] = f32x16{};
            bf16x8 qf[4];
            if (PASS == 2) {
                f32x16 c = f32x16{};
#pragma unroll
                for (int d0 = 0; d0 < 4; ++d0) { qf[d0] = *(const ALAS bf16x8*)(LW + W_Q + (r32 * QROW + 16 * d0 + 8 * hi) * 2);
                    const bf16x8 kf = *(const ALAS bf16x8*)(LW + W_K + (r32 * QROW + 16 * d0 + 8 * hi) * 2);
                    c = __builtin_amdgcn_mfma_f32_32x32x16_bf16(kf, qf[d0], c, 0, 0, 0); }
#pragma unroll
                for (int r = 0; r < 16; ++r) { const int srow = att::crow(r, hi); if (srow > r32) c[r] = 0.f; }
#pragma unroll
                for (int ks = 0; ks < 2; ++ks) { const uint4 q4 = make_uint4(att::cvtpk(c[8 * ks], c[8 * ks + 1]), att::cvtpk(c[8 * ks + 2], c[8 * ks + 3]), att::cvtpk(c[8 * ks + 4], c[8 * ks + 5]), att::cvtpk(c[8 * ks + 6], c[8 * ks + 7]));
                    const bf16x8 pa = __builtin_bit_cast(bf16x8, q4);
                    o[0] = __builtin_amdgcn_mfma_f32_32x32x16_bf16(pa, vfr[ks][0], o[0], 0, 0, 0); o[1] = __builtin_amdgcn_mfma_f32_32x32x16_bf16(pa, vfr[ks][1], o[1], 0, 0, 0); }
            }
            __syncthreads();
#pragma unroll 1
            for (int step = 0; step < 8; ++step) {
                if (wid == step) {
                    if (PASS == 2) {
#pragma unroll
                        for (int cv = 0; cv < 2; ++cv)
#pragma unroll
                            for (int d0 = 0; d0 < 4; ++d0) { const ALAS float* sp = ST + (32 * cv + r32) * STROW + 16 * d0 + 8 * hi; const f32x4v s0 = *(const ALAS f32x4v*)sp, s1 = *(const ALAS f32x4v*)(sp + 4);
                                const uint4 q4 = make_uint4(att::cvtpk(s0[0], s0[1]), att::cvtpk(s0[2], s0[3]), att::cvtpk(s1[0], s1[1]), att::cvtpk(s1[2], s1[3]));
                                o[cv] = __builtin_amdgcn_mfma_f32_32x32x16_bf16(qf[d0], __builtin_bit_cast(bf16x8, q4), o[cv], 0, 0, 0); }
                    }
                    const float dk = __expf(Btot);
                    int sbase = (4 * hi) * STROW + r32; asm volatile("" : "+v"(sbase));
#pragma unroll
                    for (int cd = 0; cd < 2; ++cd) { const float dkd = __shfl(dk, 32 * cd + r32);
#pragma unroll
                        for (int cv = 0; cv < 2; ++cv)
#pragma unroll
                            for (int r = 0; r < 16; ++r) { ALAS float* sp = ST + sbase + (32 * cv + (r & 3) + 8 * (r >> 2)) * STROW + 32 * cd; *sp = dkd * *sp + sl[cv][cd][r]; } }
                    BS[lane] += Btot;
                }
                __syncthreads();
            }
            if (PASS == 1) {
                float* ag = AGG + ((size_t)((b * 4 + h) * 2 + d) * 9 + sc) * AGG_FLOATS;
                for (int e = tid; e < 4096; e += NT) ag[e] = ST[(e >> 6) * STROW + (e & 63)];
                if (tid < 64) ag[4096 + tid] = BS[tid];
                __syncthreads();
            } else {
                if (d == 0) {
                    int base = (32 * wid + 4 * hi) * 64 + r32; asm volatile("" : "+v"(base));
#pragma unroll
                    for (int r = 0; r < 16; ++r) { const int off = base + ((r & 3) + 8 * (r >> 2)) * 64; OSG[off] = o[0][r]; OSG[off + 32] = o[1][r]; }
                }
                else {
                    ALAS float* OS = (ALAS float*)L3;
                    int base = (255 - 32 * wid - 4 * hi) * 64 + r32; asm volatile("" : "+v"(base));
                    float g0[16], g1[16];
#pragma unroll
                    for (int r = 0; r < 16; ++r) { const int off = base - ((r & 3) + 8 * (r >> 2)) * 64; g0[r] = OSG[off]; g1[r] = OSG[off + 32]; }
#pragma unroll
                    for (int r = 0; r < 16; ++r) { const int off = base - ((r & 3) + 8 * (r >> 2)) * 64; OS[off] = o[0][r] + g0[r]; OS[off + 32] = o[1][r] + g1[r]; }
                    __syncthreads();
                    { int tl = 32 * wid + (lane >> 1); asm volatile("" : "+v"(tl)); const int half = lane & 1; float ov[32]; float ss = 0.f;
#pragma unroll
                      for (int i = 0; i < 32; ++i) { ov[i] = OS[tl * 64 + half * 32 + i]; ss += ov[i] * ov[i]; }
                      ss += __shfl_xor(ss, 1);
                      const float rs = rsqrtf(ss * (1.f / 64.f) + EPS);
                      const size_t row = (size_t)(jbase + tl); const bf16_t* zg = Z + row * NZ + ZD_G + h * 64 + half * 32; bf16_t* yo = Y + row * D + 768 + h * 64 + half * 32;
#pragma unroll
                      for (int i = 0; i < 4; ++i) { unsigned w4[4];
#pragma unroll
                          for (int k2 = 0; k2 < 4; ++k2) { const int c0 = 8 * i + 2 * k2; w4[k2] = att::cvtpk(ov[c0] * rs * gn[h * 64 + half * 32 + c0] * siluf_(bf2f(zg[c0])), ov[c0 + 1] * rs * gn[h * 64 + half * 32 + c0 + 1] * siluf_(bf2f(zg[c0 + 1]))); }
                          *(uint4*)(yo + 8 * i) = make_uint4(w4[0], w4[1], w4[2], w4[3]); } }
                    __syncthreads();
                }
            }
        }
    }
}

__device__ __forceinline__ void ph_router(const P& p, int l, unsigned char* ldsb, bool dry = false) {
    const int tidx = p.wid * 64 + fresh_lane();
    const float* X = (const float*)(p.ws + WS_X); bf16_t* H = (bf16_t*)(p.ws + WS_H);
    float2* GP = (float2*)(p.ws + WS_GP); int* LISTP = (int*)(p.ws + WS_LISTP); unsigned* CNT = (unsigned*)(p.ws + WS_CNT) + l * 32;
    const float* MOD = (const float*)(p.ws + WS_MOD) + (size_t)l * 9 * 6 * D; const float* g = p.in[I_N2G] + l * D;
    const float* RW = p.in[I_RW]; const float* RB = p.in[I_RB];
    ALAS int* lc = (ALAS int*)ldsb; ALAS int* lbase = lc + 32; ALAS int* rpair = lc + 64; ALAS int* rrank = lc + 64 + 72;
    const int lane = tidx & 63, wv = tidx >> 6;
    typedef float f32x4r __attribute__((ext_vector_type(4))); ALAS f32x4r* RWs = (ALAS f32x4r*)(ldsb - LDS_MISC);
    for (int idx = tidx; idx < 4096; idx += NT) { const int ln = idx & 63, e4 = (idx >> 6) & 3, i = (idx >> 8) & 3, q = idx >> 10; RWs[idx] = *(const f32x4r*)(RW + (size_t)((ln + 64 * q) * 4 + i) * 16 + e4 * 4); }
    __syncthreads();
    ALAS float* LG = (ALAS float*)(ldsb - LDS_MISC + 65536);
    for (int chunk = blockIdx.x; chunk < R / 72; chunk += gridDim.x) {
        if (tidx < 32) lc[tidx] = 0;
        const int rbase = chunk * 72 + wv * 9;
        float4 vn[4];
#pragma unroll
        for (int q = 0; q < 4; ++q) vn[q] = *(const float4*)(X + (size_t)rbase * D + (lane + 64 * q) * 4);
#pragma unroll 1
        for (int k = 0; k < 9; ++k) {
            const int li = wv * 9 + k, r = rbase + k;
            float4 v[4];
#pragma unroll
            for (int q = 0; q < 4; ++q) v[q] = vn[q];
            { const int rn = rbase + (k < 8 ? k + 1 : 8);
#pragma unroll
              for (int q = 0; q < 4; ++q) vn[q] = *(const float4*)(X + (size_t)rn * D + (lane + 64 * q) * 4); }
            const float* m = MOD + (size_t)row_mi(r) * 6 * D;
            float ss = 0.f;
#pragma unroll
            for (int q = 0; q < 4; ++q) ss += v[q].x * v[q].x + v[q].y * v[q].y + v[q].z * v[q].z + v[q].w * v[q].w;
            const float rs = rsqrtf(wave_sum(ss) * (1.f / D) + EPS);
            float lg[16];
#pragma unroll
            for (int e = 0; e < 16; ++e) lg[e] = 0.f;
#pragma unroll
            for (int q = 0; q < 4; ++q) { const int c = (lane + 64 * q) * 4; const float xv[4] = {v[q].x, v[q].y, v[q].z, v[q].w};
                const float4 g4 = *(const float4*)(g + c), sc4 = *(const float4*)(m + 4 * D + c), sh4 = *(const float4*)(m + 3 * D + c);
                const float gv[4] = {g4.x, g4.y, g4.z, g4.w}, scv[4] = {sc4.x, sc4.y, sc4.z, sc4.w}, shv[4] = {sh4.x, sh4.y, sh4.z, sh4.w}; bf16_t o[4];
#pragma unroll
                for (int i = 0; i < 4; ++i) { const float hv = xv[i] * rs * gv[i] * (1.f + scv[i]) + shv[i]; o[i] = f2bf(hv);
#pragma unroll
                    for (int e4 = 0; e4 < 4; ++e4) { const f32x4r w4 = RWs[((q * 4 + i) * 4 + e4) * 64 + lane]; lg[e4 * 4 + 0] += hv * w4[0]; lg[e4 * 4 + 1] += hv * w4[1]; lg[e4 * 4 + 2] += hv * w4[2]; lg[e4 * 4 + 3] += hv * w4[3]; } }
                *(uint2*)(H + (size_t)r * D + c) = make_uint2((unsigned)o[0] | ((unsigned)o[1] << 16), (unsigned)o[2] | ((unsigned)o[3] << 16));
                __builtin_amdgcn_sched_barrier(0); }
            float a8[8], a4[4], a2[2], a1;
            { const bool hb = (lane & 32) != 0;
#pragma unroll
              for (int i = 0; i < 8; ++i) { const float snd = hb ? lg[i] : lg[8 + i], kp = hb ? lg[8 + i] : lg[i]; a8[i] = kp + __shfl_xor(snd, 32); } }
            { const bool hb = (lane & 16) != 0;
#pragma unroll
              for (int i = 0; i < 4; ++i) { const float snd = hb ? a8[i] : a8[4 + i], kp = hb ? a8[4 + i] : a8[i]; a4[i] = kp + __shfl_xor(snd, 16); } }
            { const bool hb = (lane & 8) != 0;
#pragma unroll
              for (int i = 0; i < 2; ++i) { const float snd = hb ? a4[i] : a4[2 + i], kp = hb ? a4[2 + i] : a4[i]; a2[i] = kp + __shfl_xor(snd, 8); } }
            { const bool hb = (lane & 4) != 0; const float snd = hb ? a2[0] : a2[1], kp = hb ? a2[1] : a2[0]; a1 = kp + __shfl_xor(snd, 4); }
            a1 += __shfl_xor(a1, 2); a1 += __shfl_xor(a1, 1);
            if ((lane & 3) == 0) LG[li * 16 + (lane >> 2)] = a1 + RB[lane >> 2];
        }
        __syncthreads();
        if (tidx < 72) {
            const int r = chunk * 72 + tidx; float lg[16];
#pragma unroll
            for (int e = 0; e < 16; ++e) lg[e] = LG[tidx * 16 + e];
            float mx = lg[0];
#pragma unroll
            for (int e = 1; e < 16; ++e) mx = fmaxf(mx, lg[e]);
            float sc[16], sum = 0.f;
#pragma unroll
            for (int e = 0; e < 16; ++e) { sc[e] = expf(lg[e] - mx); sum += sc[e]; }
            const float inv = 1.f / sum;
#pragma unroll
            for (int e = 0; e < 16; ++e) sc[e] *= inv;
            int gsel = 0; float gbest = -1.f;
#pragma unroll
            for (int gI = 0; gI < 4; ++gI) { const float s0 = sc[gI * 4], s1 = sc[gI * 4 + 1], s2 = sc[gI * 4 + 2], s3 = sc[gI * 4 + 3];
                const float m1 = fmaxf(s0, s1), n1 = fminf(s0, s1), m2 = fmaxf(s2, s3), n2 = fminf(s2, s3);
                const float gs = fmaxf(m1, m2) + fmaxf(fminf(m1, m2), fmaxf(n1, n2)); const bool c = gs > gbest; gbest = c ? gs : gbest; gsel = c ? gI : gsel; }
            float s4[4];
#pragma unroll
            for (int i = 0; i < 4; ++i) s4[i] = gsel == 0 ? sc[i] : (gsel == 1 ? sc[4 + i] : (gsel == 2 ? sc[8 + i] : sc[12 + i]));
            float w1 = s4[0]; int i1 = 0;
#pragma unroll
            for (int i = 1; i < 4; ++i) { const bool c = s4[i] > w1; w1 = c ? s4[i] : w1; i1 = c ? i : i1; }
            float w2 = -1.f; int i2 = 0;
#pragma unroll
            for (int i = 0; i < 4; ++i) { const bool c = (i != i1) && (s4[i] > w2); w2 = c ? s4[i] : w2; i2 = c ? i : i2; }
            const float wn = 1.f / (w1 + w2);
            const int a = i1 < i2 ? i1 : i2, bq = i1 < i2 ? i2 : i1;
            const int q = a == 0 ? bq - 1 : (a == 1 ? bq + 1 : 5);
            const int pr = gsel * 6 + q; const bool skip = (l == 1 && (r % LB) < TC);
            GP[r] = i1 < i2 ? make_float2(w1 * wn, w2 * wn) : make_float2(w2 * wn, w1 * wn);
            rpair[tidx] = skip ? -1 : pr;
            if (!skip) rrank[tidx] = __hip_atomic_fetch_add(&lc[pr], 1, __ATOMIC_RELAXED, __HIP_MEMORY_SCOPE_WORKGROUP);
        }
        __syncthreads();
        if (tidx < 24) lbase[tidx] = (lc[tidx] && !dry) ? (int)atomicAdd(&CNT[tidx], (unsigned)lc[tidx]) : 0;
        __syncthreads();
        if (tidx < 72 && !dry) { const int pr = rpair[tidx]; if (pr >= 0) LISTP[(size_t)pr * R + lbase[pr] + rrank[tidx]] = chunk * 72 + tidx; }
        __syncthreads();
    }
}

__device__ __forceinline__ void ph_final(const P& p) {
    const int tidx = p.wid * 64 + fresh_lane();
    const float* X = (const float*)(p.ws + WS_X); const float* g = p.in[I_FNG];
    const int lane = tidx & 63, wv = tidx >> 6;
    for (int it = blockIdx.x * NWV + wv; it < NB * T; it += gridDim.x * NWV) {
        const int b = it / T, t = it % T; const int r = b * LB + TC + t;
        float4 v[4]; float ss = 0.f;
#pragma unroll
        for (int q = 0; q < 4; ++q) { v[q] = *(const float4*)(X + (size_t)r * D + (lane + 64 * q) * 4); ss += v[q].x * v[q].x + v[q].y * v[q].y + v[q].z * v[q].z + v[q].w * v[q].w; }
        const float rs = rsqrtf(wave_sum(ss) * (1.f / D) + EPS);
#pragma unroll
        for (int q = 0; q < 4; ++q) { const int c = (lane + 64 * q) * 4; const float4 gg = *(const float4*)(g + c);
            *(float4*)(p.out + (size_t)it * D + c) = make_float4(v[q].x * rs * gg.x, v[q].y * rs * gg.y, v[q].z * rs * gg.z, v[q].w * rs * gg.w); }
    }
}


namespace pg8 {
#define PG8_LAS __attribute__((address_space(3)))
typedef short bf16x8 __attribute__((ext_vector_type(8)));
typedef float f32x4 __attribute__((ext_vector_type(4)));
typedef unsigned u32x4 __attribute__((ext_vector_type(4)));
constexpr int BM = 256, BK = 64, HALF = 128, HTB = HALF * BK * 2, STAGE_BYTES = 8 * HTB, NXCD = 8, WGM = 8;
__host__ __device__ __forceinline__ int lds_byte(int r, int c) { const int st = (r >> 4) * 2 + (c >> 5), rr = r & 15, cc = c & 31, ob = rr * 64 + cc * 2; return st * 1024 + (ob ^ (((ob >> 9) & 1) << 5)); }
__host__ __device__ __forceinline__ void stage_rc(int b, int& R, int& C) { const int st = b / 1024, sb = b % 1024, swz = sb ^ (((sb >> 9) & 1) << 5); R = (st >> 1) * 16 + swz / 64; C = (st & 1) * 32 + (swz % 64) / 2; }
__host__ __device__ __forceinline__ int perm32(int rho) { const int n = rho >> 4, i = rho & 15; return 8 * (i >> 2) + 4 * n + (i & 3); }
__device__ __forceinline__ unsigned cvt_pk_bf16(float lo, float hi) { unsigned r; asm volatile("v_cvt_pk_bf16_f32 %0, %1, %2" : "=v"(r) : "v"(lo), "v"(hi)); return r; }
struct Unit { int pm, pn, aux; };
__device__ __forceinline__ bool static_next(int i, int G, int c, int nM, int nN, int& pm, int& pn) {
    const int nwg = nM * nN; const long L = (long)i * G + c; if (L >= nwg) return false;
    int wgid = (int)L; { const int q = nwg / NXCD, r = nwg % NXCD, xcd = wgid % NXCD, off = wgid / NXCD; wgid = (xcd < r ? xcd * (q + 1) : r * (q + 1) + (xcd - r) * q) + off; }
    const int nig = WGM * nN, gid = wgid / nig, fm = gid * WGM, gsz = (nM - fm) < WGM ? (nM - fm) : WGM;
    pm = fm + ((wgid % nig) % gsz); pn = (wgid % nig) / gsz; return true;
}
template <class PB, bool ALIGN_EPI>
__device__ __forceinline__ void gemm_phase(PG8_LAS unsigned char* lds, const PB& S, const int wid) {
    const int lane = fresh_lane(), tid = wid * 64 + lane, wr = wid >> 2, wc = wid & 3, fr = lane & 15, fq = lane >> 4;
    const int nt = S.nt;
    int Rst[2], Cst[2]; unsigned voffB[2];
#pragma unroll
    for (int i = 0; i < 2; ++i) { int R_, C_; stage_rc(tid * 16 + i * 8192, R_, C_); Rst[i] = R_; Cst[i] = C_; const int Rb = PB::PERM ? ((R_ & ~31) + perm32(R_ & 31)) : R_; voffB[i] = (unsigned)(Rb * S.ldb + C_) * 2u; }
    const size_t kstep = (size_t)(BK * 2);
    const size_t hstepB = (size_t)HALF * S.ldb * 2;
    const unsigned ldsw = (unsigned)wid * 1024u;
    const int aoff = lds_byte(wr * 64 + fr, fq * 8), boff = lds_byte(wc * 32 + fr, fq * 8);
#define PG8_SA(b, h) (((b) * 2 + (h)) * HTB)
#define PG8_SB(b, h) ((4 + (b) * 2 + (h)) * HTB)
#define PG8_STAGE(bufoff, gbase, voff) do { _Pragma("unroll") for (int _i = 0; _i < 2; ++_i) { unsigned _o = (voff)[_i]; asm volatile("" : "+v"(_o)); \
        __builtin_amdgcn_global_load_lds((const unsigned*)((const char*)(gbase) + _o), (PG8_LAS unsigned*)(lds + (bufoff) + ldsw + _i * 8192), 16, 0, 0); } } while (0)
#define PG8_LDA(dst, b, h) do { _Pragma("unroll") for (int m = 0; m < 4; ++m) _Pragma("unroll") for (int k = 0; k < 2; ++k) dst[m][k] = *(const PG8_LAS bf16x8*)(lds + PG8_SA(b, h) + aoff + m * 2048 + k * 1024); } while (0)
#define PG8_LDB(dst, b, h) do { _Pragma("unroll") for (int n = 0; n < 2; ++n) _Pragma("unroll") for (int k = 0; k < 2; ++k) dst[n][k] = *(const PG8_LAS bf16x8*)(lds + PG8_SB(b, h) + boff + n * 2048 + k * 1024); } while (0)
#define PG8_MMA(ai, bj, At, Bt) do { __builtin_amdgcn_s_setprio(1); _Pragma("unroll") for (int m = 0; m < 4; ++m) _Pragma("unroll") for (int n = 0; n < 2; ++n) _Pragma("unroll") for (int k = 0; k < 2; ++k) \
        acc[ai][bj][m][n] = __builtin_amdgcn_mfma_f32_16x16x32_bf16(Bt[n][k], At[m][k], acc[ai][bj][m][n], 0, 0, 0); __builtin_amdgcn_s_setprio(0); } while (0)
#define PG8_WAIT_V(n) asm volatile("s_waitcnt vmcnt(" #n ")" ::: "memory")
#define PG8_WAIT_L(n) asm volatile("s_waitcnt lgkmcnt(" #n ")" ::: "memory")
#define PG8_BAR __builtin_amdgcn_s_barrier()
#define PG8_SCHED __builtin_amdgcn_sched_barrier(0)
    Unit cur, nxt; int ui = 0;
    if (!S.next(0, cur)) return;
    f32x4 acc[2][2][4][2];
#pragma unroll
    for (int a = 0; a < 2; ++a)
#pragma unroll
        for (int b = 0; b < 2; ++b)
#pragma unroll
            for (int m = 0; m < 4; ++m)
#pragma unroll
                for (int n = 0; n < 2; ++n) acc[a][b][m][n] = (f32x4){0.f, 0.f, 0.f, 0.f};
    bf16x8 At[4][2], B0[2][2], B1[2][2];
    unsigned vc[2][2], vn[2][2];
    S.a_off(cur, Rst, Cst, vc); asm volatile("" : "+v"(vc[0][0]), "+v"(vc[0][1]), "+v"(vc[1][0]), "+v"(vc[1][1]));
    const char* gA = S.A;
    { const char* cB = S.b_ptr(cur, 0); const char* cB1 = S.b_ptr(cur, 1);
      PG8_STAGE(PG8_SB(0, 0), cB, voffB); PG8_STAGE(PG8_SB(0, 1), cB + hstepB, voffB); PG8_STAGE(PG8_SA(0, 0), gA, vc[0]); PG8_STAGE(PG8_SA(0, 1), gA, vc[1]);
      if (wr == 1) PG8_BAR;
      PG8_WAIT_V(2); PG8_BAR;
      PG8_STAGE(PG8_SB(1, 0), cB1, voffB); PG8_STAGE(PG8_SA(1, 0), gA + kstep, vc[0]); PG8_STAGE(PG8_SB(1, 1), cB1 + hstepB, voffB);
      PG8_WAIT_V(6); PG8_BAR; }
    for (;;) {
        const bool has_next = S.next(ui + 1, nxt);
        if (has_next) { S.a_off(nxt, Rst, Cst, vn); asm volatile("" : "+v"(vn[0][0]), "+v"(vn[0][1]), "+v"(vn[1][0]), "+v"(vn[1][1])); }
        else { vn[0][0] = vc[0][0]; vn[0][1] = vc[0][1]; vn[1][0] = vc[1][0]; vn[1][1] = vc[1][1]; nxt = cur; }
        for (int t = 0; t < nt; t += 2) {
            const bool last = (t == nt - 2);
            const char* a1 = gA + (size_t)(t + 1) * kstep;
            const char* a2 = last ? gA : gA + (size_t)(t + 2) * kstep; const char* a3 = a2 + kstep;
            const char* b2 = last ? S.b_ptr(nxt, 0) : S.b_ptr(cur, t + 2);
            const char* b3 = last ? S.b_ptr(nxt, 1) : S.b_ptr(cur, t + 3);
            unsigned o2a[2], o2b[2];
            o2a[0] = last ? vn[0][0] : vc[0][0]; o2a[1] = last ? vn[0][1] : vc[0][1]; o2b[0] = last ? vn[1][0] : vc[1][0]; o2b[1] = last ? vn[1][1] : vc[1][1];
            PG8_LDB(B0, 0, 0); PG8_LDB(B1, 0, 1); PG8_SCHED; PG8_LDA(At, 0, 0); PG8_STAGE(PG8_SA(1, 1), a1, vc[1]);
            PG8_WAIT_V(8); PG8_WAIT_L(0); PG8_BAR; PG8_MMA(0, 0, At, B0); PG8_MMA(0, 1, At, B1); PG8_BAR; PG8_SCHED;
            PG8_LDA(At, 0, 1); PG8_STAGE(PG8_SB(0, 0), b2, voffB); PG8_STAGE(PG8_SB(0, 1), b2 + hstepB, voffB); PG8_STAGE(PG8_SA(0, 0), a2, o2a);
            PG8_WAIT_V(8); PG8_WAIT_L(0); PG8_BAR; PG8_MMA(1, 0, At, B0); PG8_MMA(1, 1, At, B1); PG8_BAR; PG8_SCHED;
            PG8_LDB(B0, 1, 0); PG8_LDB(B1, 1, 1); PG8_SCHED; PG8_LDA(At, 1, 0); PG8_STAGE(PG8_SA(0, 1), a2, o2b);
            PG8_WAIT_V(8); PG8_WAIT_L(0); PG8_BAR; PG8_MMA(0, 0, At, B0); PG8_MMA(0, 1, At, B1); PG8_BAR; PG8_SCHED;
            PG8_LDA(At, 1, 1); PG8_STAGE(PG8_SB(1, 0), b3, voffB); PG8_STAGE(PG8_SB(1, 1), b3 + hstepB, voffB); PG8_STAGE(PG8_SA(1, 0), a3, o2a);
            PG8_WAIT_V(8); PG8_WAIT_L(0); PG8_BAR; PG8_MMA(1, 0, At, B0); PG8_MMA(1, 1, At, B1); PG8_BAR; PG8_SCHED;
        }
        if constexpr (ALIGN_EPI) { if (wr == 0) PG8_BAR; }
        S.epi(acc, cur, wr, wc, fr, fq);
        if (!has_next) break;
#pragma unroll
        for (int a = 0; a < 2; ++a)
#pragma unroll
            for (int b = 0; b < 2; ++b)
#pragma unroll
                for (int m = 0; m < 4; ++m)
#pragma unroll
                    for (int n = 0; n < 2; ++n) acc[a][b][m][n] = (f32x4){0.f, 0.f, 0.f, 0.f};
        cur = nxt; vc[0][0] = vn[0][0]; vc[0][1] = vn[0][1]; vc[1][0] = vn[1][0]; vc[1][1] = vn[1][1]; ++ui;
        if constexpr (ALIGN_EPI) { if (wr == 1) PG8_BAR; }
    }
    PG8_WAIT_V(0);
    if constexpr (!ALIGN_EPI) { if (wr == 0) PG8_BAR; }
    PG8_BAR;
#undef PG8_SA
#undef PG8_SB
#undef PG8_STAGE
#undef PG8_LDA
#undef PG8_LDB
#undef PG8_MMA
#undef PG8_WAIT_V
#undef PG8_WAIT_L
#undef PG8_BAR
#undef PG8_SCHED
}
}

struct PB_InProj {
    static constexpr bool PERM = true;
    const char* A; int ldb, nt; const char* Bt; bf16_t* Zo; int G, c;
    __device__ __forceinline__ bool next(int i, pg8::Unit& u) const { u.aux = 0; return pg8::static_next(i, G, c, R / 256, NZ / 256, u.pm, u.pn); }
    __device__ __forceinline__ void a_off(const pg8::Unit& u, const int (&Rs)[2], const int (&Cs)[2], unsigned (&off)[2][2]) const {
#pragma unroll
        for (int h = 0; h < 2; ++h)
#pragma unroll
            for (int i = 0; i < 2; ++i) off[h][i] = (unsigned)((u.pm * 256 + h * 128 + Rs[i]) * D + Cs[i]) * 2u; }
    __device__ __forceinline__ const char* b_ptr(const pg8::Unit& u, int t) const { return Bt + (size_t)u.pn * 256 * D * 2 + (size_t)t * 128; }
    __device__ __forceinline__ void epi(const pg8::f32x4 (&acc)[2][2][4][2], const pg8::Unit& u, int wr, int wc, int fr, int fq) const {
        const int row0 = u.pm * 256 + wr * 64 + fr, col0 = u.pn * 256 + wc * 32 + 8 * fq;
#pragma unroll
        for (int ai = 0; ai < 2; ++ai)
#pragma unroll
            for (int m = 0; m < 4; ++m) { bf16_t* rowp = Zo + (size_t)(row0 + ai * 128 + m * 16) * NZ + col0;
#pragma unroll
                for (int bj = 0; bj < 2; ++bj) { const pg8::f32x4 v0 = acc[ai][bj][m][0], v1 = acc[ai][bj][m][1]; pg8::u32x4 w;
                    w.x = pg8::cvt_pk_bf16(v0[0], v0[1]); w.y = pg8::cvt_pk_bf16(v0[2], v0[3]); w.z = pg8::cvt_pk_bf16(v1[0], v1[1]); w.w = pg8::cvt_pk_bf16(v1[2], v1[3]);
                    *(pg8::u32x4*)(rowp + bj * 128) = w; } }
    }
};


struct PB_OutProj {
    static constexpr bool PERM = false;
    const char* A; int ldb, nt; const char* Bt; float* X; const float* MODl; int G, c, skipctx;
    __device__ __forceinline__ bool next(int i, pg8::Unit& u) const { u.aux = 0; int pm, pn; if (!pg8::static_next(i, G, c, skipctx ? 64 : 72, 4, pm, pn)) return false; u.pm = skipctx ? (pm >> 3) * 9 + 1 + (pm & 7) : pm; u.pn = pn; return true; }
    __device__ __forceinline__ void a_off(const pg8::Unit& u, const int (&Rs)[2], const int (&Cs)[2], unsigned (&off)[2][2]) const {
#pragma unroll
        for (int h = 0; h < 2; ++h)
#pragma unroll
            for (int i = 0; i < 2; ++i) off[h][i] = (unsigned)((u.pm * 256 + h * 128 + Rs[i]) * D + Cs[i]) * 2u; }
    __device__ __forceinline__ const char* b_ptr(const pg8::Unit& u, int t) const { return Bt + (size_t)u.pn * 256 * D * 2 + (size_t)t * 128; }
    __device__ __forceinline__ void epi(const pg8::f32x4 (&acc)[2][2][4][2], const pg8::Unit& u, int wr, int wc, int fr, int fq) const {
        const int row0 = u.pm * 256 + wr * 64 + fr, col0 = u.pn * 256 + wc * 32 + 4 * fq;
        const float* gt = MODl + (size_t)row_mi(u.pm * 256) * 6 * D + 2 * D + col0;
        pg8::f32x4 gv[2][2];
#pragma unroll
        for (int bj = 0; bj < 2; ++bj)
#pragma unroll
            for (int n = 0; n < 2; ++n) gv[bj][n] = *(const pg8::f32x4*)(gt + bj * 128 + n * 16);
#pragma unroll
        for (int ai = 0; ai < 2; ++ai)
#pragma unroll
            for (int m = 0; m < 4; ++m) { float* rowp = X + (size_t)(row0 + ai * 128 + m * 16) * D + col0;
#pragma unroll
                for (int bj = 0; bj < 2; ++bj)
#pragma unroll
                    for (int n = 0; n < 2; ++n) { pg8::f32x4* xp = (pg8::f32x4*)(rowp + bj * 128 + n * 16); *xp = *xp + gv[bj][n] * acc[ai][bj][m][n]; } }
    }
};

__device__ __forceinline__ void moe_tiles_setup(const P& p, int l, ALAS int* tb) {
    const unsigned* CNT = (const unsigned*)(p.ws + WS_CNT) + l * 32;
    __syncthreads();
    if (p.wid == 0 && fresh_lane() == 0) { int acc = 0; for (int q = 0; q < 24; ++q) { const int c = (int)__hip_atomic_load(CNT + q, __ATOMIC_RELAXED, __HIP_MEMORY_SCOPE_AGENT); tb[q] = c; tb[32 + q] = acc; acc += (c + 255) >> 8; } tb[32 + 24] = acc; }
    __syncthreads();
}
__device__ __forceinline__ void pair_experts(int pr, int& e0, int& e1) { const int g4 = (pr / 6) * 4, q = pr % 6; const int a = q < 3 ? 0 : (q < 5 ? 1 : 2), b = q < 3 ? q + 1 : (q < 5 ? q - 1 : 3); e0 = g4 + a; e1 = g4 + b; }

struct PB_Moe1 {
    static constexpr bool PERM = false;
    const char* A; int ldb, nt; const char* W13; bf16_t* HE; const int* LISTP; const float2* GP; const ALAS int* tb; int G, c;
    __device__ __forceinline__ bool next(int i, pg8::Unit& u) const {
        if (!pg8::static_next(i, G, c, tb[32 + 24], 8, u.pm, u.pn)) return false;
        int pr = 0;
        for (int q = 1; q < 24; ++q) if (tb[32 + q] <= u.pm) pr = q;
        u.aux = pr; return true; }
    __device__ __forceinline__ void a_off(const pg8::Unit& u, const int (&Rs)[2], const int (&Cs)[2], unsigned (&off)[2][2]) const {
        const int pr = u.aux, cnt = tb[pr], r0 = (u.pm - tb[32 + pr]) * 256; const int* lp = LISTP + (size_t)pr * R;
#pragma unroll
        for (int h = 0; h < 2; ++h)
#pragma unroll
            for (int i = 0; i < 2; ++i) { int rk = r0 + h * 128 + Rs[i]; rk = rk < cnt ? rk : cnt - 1; off[h][i] = (unsigned)(lp[rk] * D + Cs[i]) * 2u; } }
    __device__ __forceinline__ const char* b_ptr(const pg8::Unit& u, int t) const { int e0, e1; pair_experts(u.aux, e0, e1); const int e = u.pn < 4 ? e0 : e1;
        return W13 + ((size_t)e * 1024 + (size_t)(u.pn & 3) * 256) * D * 2 + (size_t)t * 128; }
    __device__ __forceinline__ void epi(const pg8::f32x4 (&acc)[2][2][4][2], const pg8::Unit& u, int wr, int wc, int fr, int fq) const {
        const int pr = u.aux, cnt = tb[pr], r0 = (u.pm - tb[32 + pr]) * 256; const int* lp = LISTP + (size_t)pr * R;
        const int colh = (u.pn < 4 ? 0 : 512) + (u.pn & 3) * 128 + wc * 16 + 4 * fq;
#pragma unroll
        for (int ai = 0; ai < 2; ++ai)
#pragma unroll
            for (int m = 0; m < 4; ++m) { const int x = ai * 128 + wr * 64 + m * 16 + fr; int rk = r0 + x; rk = rk < cnt ? rk : cnt - 1;
                const float2 gg = GP[lp[rk]]; const float gate = u.pn < 4 ? gg.x : gg.y;
                bf16_t* rowp = HE + (size_t)(u.pm * 256 + x) * 1024 + colh;
#pragma unroll
                for (int bj = 0; bj < 2; ++bj) { const pg8::f32x4 a = acc[ai][bj][m][0], b = acc[ai][bj][m][1]; float o[4];
#pragma unroll
                    for (int j = 0; j < 4; ++j) o[j] = a[j] / (1.f + __expf(-a[j])) * b[j] * gate;
                    *(uint2*)(rowp + bj * 64) = make_uint2(pg8::cvt_pk_bf16(o[0], o[1]), pg8::cvt_pk_bf16(o[2], o[3])); } }
    }
};
struct PB_Moe2 {
    static constexpr bool PERM = false;
    const char* A; int ldb, nt; const char* W2; float* X; const float* MODl; const int* LISTP; const ALAS int* tb; int G, c;
    __device__ __forceinline__ bool next(int i, pg8::Unit& u) const {
        if (!pg8::static_next(i, G, c, tb[32 + 24], 4, u.pm, u.pn)) return false;
        int pr = 0;
        for (int q = 1; q < 24; ++q) if (tb[32 + q] <= u.pm) pr = q;
        u.aux = pr; return true; }
    __device__ __forceinline__ void a_off(const pg8::Unit& u, const int (&Rs)[2], const int (&Cs)[2], unsigned (&off)[2][2]) const {
#pragma unroll
        for (int h = 0; h < 2; ++h)
#pragma unroll
            for (int i = 0; i < 2; ++i) off[h][i] = (unsigned)((u.pm * 256 + h * 128 + Rs[i]) * 1024 + Cs[i]) * 2u; }
    __device__ __forceinline__ const char* b_ptr(const pg8::Unit& u, int t) const { int e0, e1; pair_experts(u.aux, e0, e1); const int e = t < 8 ? e0 : e1;
        return W2 + ((size_t)e * 1024 + (size_t)u.pn * 256) * DE * 2 + (size_t)(t & 7) * 128; }
    __device__ __forceinline__ void epi(const pg8::f32x4 (&acc)[2][2][4][2], const pg8::Unit& u, int wr, int wc, int fr, int fq) const {
        const int pr = u.aux, cnt = tb[pr], r0 = (u.pm - tb[32 + pr]) * 256; const int* lp = LISTP + (size_t)pr * R;
        const int col0 = u.pn * 256 + wc * 32 + 4 * fq;
#pragma unroll
        for (int ai = 0; ai < 2; ++ai)
#pragma unroll
            for (int m = 0; m < 4; ++m) { const int rk = r0 + ai * 128 + wr * 64 + m * 16 + fr;
                if (rk < cnt) { const int tok = lp[rk]; float* rowp = X + (size_t)tok * D + col0; const float* gt = MODl + (size_t)row_mi(tok) * 6 * D + 5 * D + col0;
#pragma unroll
                    for (int bj = 0; bj < 2; ++bj)
#pragma unroll
                        for (int n = 0; n < 2; ++n) { pg8::f32x4* xp = (pg8::f32x4*)(rowp + bj * 128 + n * 16); *xp = *xp + *(const pg8::f32x4*)(gt + bj * 128 + n * 16) * acc[ai][bj][m][n]; } } }
    }
};

template <int MAP  >
__device__ __forceinline__ void transpose_item(const float* W, int K, int N, bf16_t* WT, PG8_LAS float* scr, int item, int lane) {
    const int nblk = N / 32, kb = item / nblk, nb = item % nblk, k0 = 64 * kb, n0 = 32 * nb;
#pragma unroll 8
    for (int i = 0; i < 32; ++i) { const int kk = 2 * i + (lane >> 5); scr[kk * 33 + (lane & 31)] = W[(size_t)(k0 + kk) * N + n0 + (lane & 31)]; }
    asm volatile("s_waitcnt lgkmcnt(0)" ::: "memory");
    const int c = lane & 7;
#pragma unroll
    for (int j = 0; j < 4; ++j) { const int n = (lane >> 3) + 8 * j; const PG8_LAS float* sp = scr + (8 * c) * 33 + n;
        uint4 o; o.x = (unsigned)f2bf(sp[0 * 33]) | ((unsigned)f2bf(sp[1 * 33]) << 16); o.y = (unsigned)f2bf(sp[2 * 33]) | ((unsigned)f2bf(sp[3 * 33]) << 16);
        o.z = (unsigned)f2bf(sp[4 * 33]) | ((unsigned)f2bf(sp[5 * 33]) << 16); o.w = (unsigned)f2bf(sp[6 * 33]) | ((unsigned)f2bf(sp[7 * 33]) << 16);
        const int ng = n0 + n; const int row = MAP == 0 ? ng : (32 * (ng >> 4) + (ng & 15) + (MAP == 2 ? 16 : 0));
        *(uint4*)(WT + (size_t)row * K + k0 + 8 * c) = o; }
    asm volatile("s_waitcnt lgkmcnt(0)" ::: "memory");
}
__device__ __forceinline__ void ph_prep_weights(const P& p, unsigned char* lds) {
    const int tidx = p.wid * 64 + fresh_lane();
    const int lane = tidx & 63, wv = tidx >> 6;
    PG8_LAS float* scr = (PG8_LAS float*)((PG8_LAS unsigned char*)lds + wv * 16384);
    const int gw = blockIdx.x * NWV + wv, NGW = gridDim.x * NWV;
    constexpr int I_IN = (D / 64) * (NZ / 32), I_OUT = (D / 64) * (D / 32);
    for (int it = gw; it < 2 * (I_IN + I_OUT); it += NGW) { const int l = it / (I_IN + I_OUT), r = it % (I_IN + I_OUT);
        if (r < I_IN) transpose_item<0>(p.in[I_WIN] + (size_t)l * D * NZ, D, NZ, (bf16_t*)(p.ws + WS_WIN) + (size_t)l * NZ * D, scr, r, lane);
        else transpose_item<0>(p.in[I_WOUT] + (size_t)l * D * D, D, D, (bf16_t*)(p.ws + WS_WOUT) + (size_t)l * D * D, scr, r - I_IN, lane); }
    { bf16_t* SGWo = (bf16_t*)(p.ws + WS_SGW); for (int it = blockIdx.x * NT + tidx; it < 2 * 4 * 128 * 128; it += gridDim.x * NT) SGWo[it] = f2bf(p.in[I_SGW][it]); }
    { bf16_t* WT = (bf16_t*)(p.ws + WS_LRUWT);
      for (int it = blockIdx.x * NT + tidx; it < 2 * 2 * 2 * 4 * 64 * 64; it += gridDim.x * NT) { const int i = it & 63, j = (it >> 6) & 63, hh = (it >> 12) & 3, gate = (it >> 14) & 1, ld = it >> 15;
          const float* src = (gate ? p.in[I_WI] : p.in[I_WR]) + (((size_t)ld * 4 + hh) * 64 + i) * 64 + j; WT[it] = f2bf(*src); } }
}
__device__ __forceinline__ void ph_prep_moe(const P& p, int l, unsigned char* lds) {
    const int tidx = p.wid * 64 + fresh_lane();
    const int lane = tidx & 63, wv = tidx >> 6;
    PG8_LAS float* scr = (PG8_LAS float*)((PG8_LAS unsigned char*)lds + wv * 16384);
    const int gw = blockIdx.x * NWV + wv, NGW = gridDim.x * NWV;
    constexpr int I_13 = (D / 64) * (DE / 32), I_2 = (DE / 64) * (D / 32), PER_E = 2 * I_13 + I_2;
    for (int it = gw; it < NE * PER_E; it += NGW) { const int e = it / PER_E, r = it % PER_E;
        bf16_t* w13 = (bf16_t*)(p.ws + WS_W13) + (size_t)e * 1024 * D; bf16_t* w2 = (bf16_t*)(p.ws + WS_W2) + (size_t)e * D * DE;
        if (r < I_13) transpose_item<1>(p.in[I_W1] + ((size_t)l * NE + e) * D * DE, D, DE, w13, scr, r, lane);
        else if (r < 2 * I_13) transpose_item<2>(p.in[I_W3] + ((size_t)l * NE + e) * D * DE, D, DE, w13, scr, r - I_13, lane);
        else transpose_item<0>(p.in[I_W2] + ((size_t)l * NE + e) * DE * D, DE, D, w2, scr, r - 2 * I_13, lane); }
}

#define XB_TMO      128
#define XB_XCNT(j)  (256  + 64 * (j))
#define XB_XSUB(j)  (1280 + 64 * (j))
#define XB_XGEN(j)  (2304 + 64 * (j))
#define XB_TOP      3328
#define XB_TOPGEN   3392
#define XCD_BAR_WORDS 3456
#define XB_SPIN_CAP (1u << 18)
__device__ __forceinline__ unsigned xb_ld(unsigned* q) { return __hip_atomic_load(q, __ATOMIC_RELAXED, __HIP_MEMORY_SCOPE_AGENT); }
__device__ __forceinline__ unsigned xb_add(unsigned* q, unsigned v) { return __hip_atomic_fetch_add(q, v, __ATOMIC_RELAXED, __HIP_MEMORY_SCOPE_AGENT); }
__device__ __forceinline__ unsigned xb_xcc_id() { return (unsigned)__builtin_amdgcn_s_getreg((3 << 11) | 20) & 0xFu; }
#define XB_SPIN(cond, bar) do { unsigned _sp = 0; while (cond) { __builtin_amdgcn_s_sleep(1); \
    if ((++_sp & 255u) == 0u) { if (xb_ld(&(bar)[XB_TMO])) break; if (_sp > XB_SPIN_CAP) { atomicAdd(&(bar)[XB_TMO], 1u); break; } } } } while (0)
struct XcdBarrier { unsigned* bar; unsigned x; volatile ALAS unsigned* st; int wid; };
__device__ __forceinline__ XcdBarrier xcd_barrier_post(unsigned* bar, volatile ALAS unsigned* st, int wid) {
    XcdBarrier b; b.bar = bar; b.x = xb_xcc_id(); b.st = st; b.wid = wid;
    if (wid == 0 && fresh_lane() == 0) (void)xb_add(&bar[XB_XCNT(b.x)], 1u);
    return b;
}
__device__ __forceinline__ void xcd_barrier_complete(unsigned* bar, unsigned x, unsigned& nloc, unsigned& nx) {
    const unsigned G = gridDim.x * gridDim.y * gridDim.z;
    unsigned sum, cnt, mine, sp = 0u;
    for (;;) {
        sum = 0u; cnt = 0u; mine = 0u;
#pragma unroll
        for (unsigned j = 0; j < 16; ++j) { const unsigned c = xb_ld(&bar[XB_XCNT(j)]); sum += c; cnt += (c > 0u) ? 1u : 0u; mine = (j == x) ? c : mine; }
        if (sum == G) break;
        __builtin_amdgcn_s_sleep(1);
        if ((++sp & 255u) == 0u) { if (xb_ld(&bar[XB_TMO])) break; if (sp > XB_SPIN_CAP) { atomicAdd(&bar[XB_TMO], 1u); break; } }
    }
    nloc = mine > 0u ? mine : 1u; nx = cnt > 0u ? cnt : 1u;
}
__device__ __forceinline__ void xcd_barrier(const XcdBarrier& b) {
    asm volatile("s_waitcnt vmcnt(0)" ::: "memory");
    __syncthreads();
    if (b.wid == 0 && fresh_lane() == 0) {
        unsigned* bar = b.bar; asm volatile("" : "+s"(bar));
        __builtin_amdgcn_s_waitcnt(0);
        unsigned nloc = b.st[0], nx = b.st[1];
        if (nloc == 0u) { xcd_barrier_complete(bar, b.x, nloc, nx); b.st[0] = nloc; b.st[1] = nx; }
        const unsigned old = xb_add(&bar[XB_XSUB(b.x)], 1u);
        const unsigned gen = old / nloc;
        if (old + 1u == (gen + 1u) * nloc) {
            __builtin_amdgcn_fence(__ATOMIC_RELEASE, "agent");
            asm volatile("s_waitcnt vmcnt(0)" ::: "memory");
            const unsigned og = xb_add(&bar[XB_TOP], 1u);
            const unsigned tg = og / nx;
            if (og + 1u == (tg + 1u) * nx) xb_add(&bar[XB_TOPGEN], 1u);
            else XB_SPIN(xb_ld(&bar[XB_TOPGEN]) == tg, bar);
            __builtin_amdgcn_fence(__ATOMIC_ACQUIRE, "agent");
            xb_add(&bar[XB_XGEN(b.x)], 1u);
            asm volatile("s_waitcnt vmcnt(0)" ::: "memory");
        } else {
            XB_SPIN(xb_ld(&bar[XB_XGEN(b.x)]) == gen, bar);
            __builtin_amdgcn_fence(__ATOMIC_ACQUIRE, "agent");
            asm volatile("s_waitcnt vmcnt(0)" ::: "memory");
        }
    }
    __syncthreads();
}

#define PROBE_DUP 0
constexpr int LDS_BYTES = 163840;
typedef const __attribute__((address_space(4))) P* kargp_t;
#define GETP() P p; { kargp_t kq_ = kp; int w_ = wid; asm volatile("" : "+s"(kq_), "+s"(w_)); p = *(const P*)kq_; p.wid = w_; }
__global__ void __launch_bounds__(NT, 2) fwd_kernel(P p_in) {
    const int wid = __builtin_amdgcn_readfirstlane((int)(threadIdx.x >> 6));
    kargp_t kp = (kargp_t)__builtin_amdgcn_kernarg_segment_ptr();
    extern __shared__ __attribute__((aligned(16))) unsigned char lds[];
    float* sm = (float*)lds;
    { volatile ALAS unsigned* stw = (volatile ALAS unsigned*)((ALAS unsigned char*)lds + LDS_MISC + 2048); if (threadIdx.x < 2) stw[threadIdx.x] = 0u; }
    __syncthreads();
    { GETP(); (void)xcd_barrier_post((unsigned*)(p.ws + WS_CNT + 1024), (volatile ALAS unsigned*)((ALAS unsigned char*)lds + LDS_MISC + 2048), wid); }
#define GBAR() do { GETP(); XcdBarrier gb_; gb_.bar = (unsigned*)(p.ws + WS_CNT + 1024); gb_.x = xb_xcc_id(); gb_.st = (volatile ALAS unsigned*)((ALAS unsigned char*)lds + LDS_MISC + 2048); gb_.wid = wid; xcd_barrier(gb_); } while (0)
    { GETP(); ph_init(p); }
    { GETP(); ph_mod(p, sm); }
    { GETP(); ph_rope_table(p); }
    { GETP(); ph_prep_weights(p, lds); }
    if (PROBE_DUP == 1) { GETP(); ph_init(p); ph_mod(p, sm); ph_rope_table(p); ph_prep_weights(p, lds); }
    if (PROBE_DUP == 12) { GBAR(); GBAR(); GBAR(); GBAR(); GBAR(); GBAR(); GBAR(); GBAR(); GBAR(); GBAR(); }
    GBAR();
#pragma unroll 1
    for (int l = 0; l < 2; ++l) {
        { GETP(); ph_norm1(p, l); if (PROBE_DUP == 2) ph_norm1(p, l); }
        { GETP(); ph_prep_moe(p, l, lds); if (PROBE_DUP == 13) ph_prep_moe(p, l, lds); }
        GBAR();
        { GETP(); PB_InProj pb; pb.A = (const char*)(p.ws + WS_H); pb.ldb = D; pb.nt = D / 64; pb.Bt = (const char*)(p.ws + WS_WIN) + (size_t)l * NZ * D * 2; pb.Zo = (bf16_t*)(p.ws + WS_Z); pb.G = gridDim.x; pb.c = blockIdx.x;
          pg8::gemm_phase<PB_InProj, true>((PG8_LAS unsigned char*)lds, pb, wid);
          if (PROBE_DUP == 3) pg8::gemm_phase<PB_InProj, true>((PG8_LAS unsigned char*)lds, pb, wid); }
        GBAR();
        { GETP(); ph_rope(p, l); }
        { GETP(); ph_sg(p, l, lds); if (PROBE_DUP == 4) ph_sg(p, l, lds); }
        { GETP(); ph_lru_m1(p, l, lds); if (PROBE_DUP == 7) ph_lru_m1(p, l, lds); }
        { GETP(); ph_hg<1>(p, l, lds); if (PROBE_DUP == 9) ph_hg<1>(p, l, lds); }
        GBAR();
        { GETP(); ph_attn(p, l, lds); if (PROBE_DUP == 5) ph_attn(p, l, lds); }
        { GETP(); ph_lru_m2(p, l, lds); if (PROBE_DUP == 6) ph_lru_m2(p, l, lds); }
        { GETP(); ph_hg<2>(p, l, lds); if (PROBE_DUP == 10) ph_hg<2>(p, l, lds); }
        GBAR();
        { GETP(); PB_OutProj pb; pb.A = (const char*)(p.ws + WS_Y); pb.ldb = D; pb.nt = D / 64; pb.Bt = (const char*)(p.ws + WS_WOUT) + (size_t)l * D * D * 2; pb.X = (float*)(p.ws + WS_X);
          pb.MODl = (const float*)(p.ws + WS_MOD) + (size_t)l * 9 * 6 * D; pb.G = gridDim.x; pb.c = blockIdx.x; pb.skipctx = (l == 1);
          pg8::gemm_phase<PB_OutProj, true>((PG8_LAS unsigned char*)lds, pb, wid); }
        GBAR();
        { GETP(); if (PROBE_DUP == 11) ph_router(p, l, lds + LDS_MISC, true); ph_router(p, l, lds + LDS_MISC); }
        GBAR();
        { GETP(); ALAS int* tb = (ALAS int*)(lds + LDS_MISC + 1024); moe_tiles_setup(p, l, tb);
          PB_Moe1 pb; pb.A = (const char*)(p.ws + WS_H); pb.ldb = D; pb.nt = D / 64; pb.W13 = (const char*)(p.ws + WS_W13); pb.HE = (bf16_t*)(p.ws + WS_Z); pb.LISTP = (const int*)(p.ws + WS_LISTP);
          pb.GP = (const float2*)(p.ws + WS_GP); pb.tb = tb; pb.G = gridDim.x; pb.c = blockIdx.x;
          pg8::gemm_phase<PB_Moe1, true>((PG8_LAS unsigned char*)lds, pb, wid);
          if (PROBE_DUP == 8) pg8::gemm_phase<PB_Moe1, true>((PG8_LAS unsigned char*)lds, pb, wid); }
        GBAR();
        { GETP(); ALAS int* tb = (ALAS int*)(lds + LDS_MISC + 1024);
          PB_Moe2 pb; pb.A = (const char*)(p.ws + WS_Z); pb.ldb = DE; pb.nt = 16; pb.W2 = (const char*)(p.ws + WS_W2); pb.X = (float*)(p.ws + WS_X);
          pb.MODl = (const float*)(p.ws + WS_MOD) + (size_t)l * 9 * 6 * D; pb.LISTP = (const int*)(p.ws + WS_LISTP); pb.tb = tb; pb.G = gridDim.x; pb.c = blockIdx.x;
          pg8::gemm_phase<PB_Moe2, true>((PG8_LAS unsigned char*)lds, pb, wid); }
        GBAR();
    }
    { GETP(); ph_final(p); }
}

extern "C" void kernel_launch(void* const* d_in, const int* in_sizes, int n_in, void* d_out, int out_size, void* d_ws, size_t ws_size, hipStream_t stream) {
    if (n_in != N_IN || ws_size < WS_END) { fprintf(stderr, "kernel_launch: bad n_in %d or ws %zu < %zu\n", n_in, ws_size, (size_t)WS_END); return; }
    P p{};
    for (int i = 0; i < N_IN; ++i) p.in[i] = (const float*)d_in[i];
    p.out = (float*)d_out; p.ws = (unsigned char*)d_ws;
    (void)hipMemsetAsync((char*)d_ws + WS_CNT, 0, 16384, stream);
    void* args[] = {&p};
    static bool attr_set = false;
    if (!attr_set) { (void)hipFuncSetAttribute((const void*)fwd_kernel, hipFuncAttributeMaxDynamicSharedMemorySize, LDS_BYTES); attr_set = true; }
    hipError_t e = hipLaunchCooperativeKernel((void*)fwd_kernel, dim3(256), dim3(NT), args, LDS_BYTES, stream);
    if (e != hipSuccess) fprintf(stderr, "cooperative launch failed: %s\n", hipGetErrorString(e));
}
```

```cpp
#include <hip/hip_runtime.h>
#include <cstdio>
#include <cstdint>

constexpr int D = 1024, NB = 8, T = 2048, TC = 256, LB = T + TC  , R = NB * LB  ;
constexpr int NZ = 3072, NE = 16, DE = 512;
constexpr float EPS = 1e-6f;
constexpr int ZA_X = 0, ZA_G = 256, ZB_Q = 512, ZB_K = 768, ZB_V = 1024, ZC_U = 1280, ZC_V = 1536, ZD_Q = 1792, ZD_FF = 2048, ZD_FB = 2304, ZD_I = 2560, ZD_G = 2816;
enum { I_X = 0, I_C, I_CTX, I_CCTX, I_WADA, I_BADA, I_N1G, I_N2G, I_WIN, I_WOUT, I_CONVW, I_CONVB, I_WR, I_BR, I_WI, I_BI, I_LAM,
       I_DALAM, I_DASUB, I_SGNG, I_SGW, I_SGB, I_HGLB, I_HGNG, I_RW, I_RB, I_W1, I_W3, I_W2, I_FNG, N_IN };

typedef unsigned short bf16_t;
#define ALAS __attribute__((address_space(3)))
constexpr size_t MiB = 1u << 20;
constexpr size_t WS_MOD = 0;
constexpr size_t WS_CNT = 512 * 1024;
constexpr size_t WS_GP = 1 * MiB;
constexpr size_t WS_LISTP = WS_GP + (size_t)R * 8;
constexpr size_t WS_LRUWT = 768 * 1024;
constexpr size_t WS_ROPE = 4 * MiB + 512 * 1024;
constexpr size_t WS_SGW = 5 * MiB;
constexpr size_t WS_LRUAGG = 3 * MiB;
constexpr size_t WS_X = 8 * MiB;
constexpr size_t WS_H = WS_X + (size_t)R * D * 4;
constexpr size_t WS_Z = WS_H + (size_t)R * D * 2;
constexpr size_t WS_D1 = WS_Z + 64 * MiB;
constexpr size_t WS_Y = WS_Z + (size_t)R * NZ * 2;
constexpr size_t WS_D2 = WS_Y;
constexpr size_t WS_WIN = WS_Y + (size_t)R * D * 2;
constexpr size_t WS_WOUT = WS_WIN + 2 * (size_t)NZ * D * 2;
constexpr size_t WS_W13 = WS_WOUT + 2 * (size_t)D * D * 2;
constexpr size_t WS_W2 = WS_W13 + (size_t)NE * 1024 * D * 2;
constexpr size_t WS_END = WS_W2 + (size_t)NE * D * DE * 2;
constexpr int MPAD = R + 24 * 256;

struct P { const float* in[N_IN]; float* out; unsigned char* ws; int wid; int pad; };
__device__ __forceinline__ int fresh_lane() { int l_; asm volatile("v_mbcnt_lo_u32_b32 %0, -1, 0\n\tv_mbcnt_hi_u32_b32 %0, -1, %0" : "=v"(l_)); return l_; }


__device__ __forceinline__ float bf2f(bf16_t v) { return __uint_as_float(((unsigned)v) << 16); }
typedef float f32x2h_t __attribute__((ext_vector_type(2))); typedef __bf16 bf16x2h_t __attribute__((ext_vector_type(2)));
__device__ __forceinline__ unsigned pk2bf(float lo, float hi) { f32x2h_t v = {lo, hi}; bf16x2h_t b = __builtin_convertvector(v, bf16x2h_t); return __builtin_bit_cast(unsigned, b); }
__device__ __forceinline__ bf16_t f2bf(float f) { return (bf16_t)(pk2bf(f, f) & 0xffffu); }
__device__ __forceinline__ float sigmoidf_(float x) { return __builtin_amdgcn_rcpf(1.f + __expf(-x)); }
__device__ __forceinline__ float siluf_(float x) { return x * __builtin_amdgcn_rcpf(1.f + __expf(-x)); }
__device__ __forceinline__ float geluf_(float x) { const float u = 1.5957691216057308f * (x + 0.044715f * x * x * x); return x * __builtin_amdgcn_rcpf(1.f + __expf(-u)); }
__device__ __forceinline__ float wave_sum(float v) {
#pragma unroll
    for (int o = 1; o < 64; o <<= 1) v += __shfl_xor(v, o);
    return v;
}
__device__ __forceinline__ int row_mi(int r) { const int b = r / LB, j = r - b * LB; return j < TC ? 8 : b; }

#define NT 512
__device__ __forceinline__ const float* xin_row(const float* xin, const float* cin, int r) { const int b = r / LB, j = r - b * LB; return j < TC ? cin + ((size_t)b * TC + j) * D : xin + ((size_t)b * T + (j - TC)) * D; }
__device__ __forceinline__ int ustart(int off) { const int G = gridDim.x, b = blockIdx.x; const int v = (G % 8 == 0) ? (b % 8) * (G / 8) + b / 8 : b; return (v + off) % G; }
#define NWV 8
__device__ __forceinline__ void add_bf4(float (&x)[4], uint2 d) { x[0] += __uint_as_float(d.x << 16); x[1] += __uint_as_float(d.x & 0xffff0000u); x[2] += __uint_as_float(d.y << 16); x[3] += __uint_as_float(d.y & 0xffff0000u); }

__device__ __forceinline__ void ph_init(const P& p) {
    const int tidx = p.wid * 64 + fresh_lane();
    float* X = (float*)(p.ws + WS_X);
    const size_t n4 = (size_t)R * D / 4;
    const size_t stride = (size_t)gridDim.x * NT;
    const float* xin = p.in[I_X]; const float* cin = p.in[I_CTX];
#define INIT_SRC(i_) ({ const size_t e_ = (i_) * 4; const int r_ = (int)(e_ / D), c_ = (int)(e_ % D); const int b_ = r_ / LB, j_ = r_ - b_ * LB; \
        const size_t oc_ = ((size_t)b_ * TC + j_) * D + c_, ox_ = ((size_t)b_ * T + (j_ - TC)) * D + c_; (const float4*)((j_ < TC) ? (cin + oc_) : (xin + ox_)); })
    size_t i = (size_t)blockIdx.x * NT + tidx;
    for (; i + 3 * stride < n4; i += 4 * stride) {
        const float4 v0 = *INIT_SRC(i), v1 = *INIT_SRC(i + stride), v2 = *INIT_SRC(i + 2 * stride), v3 = *INIT_SRC(i + 3 * stride);
        *(float4*)(X + i * 4) = v0; *(float4*)(X + (i + stride) * 4) = v1; *(float4*)(X + (i + 2 * stride) * 4) = v2; *(float4*)(X + (i + 3 * stride) * 4) = v3;
    }
    for (; i < n4; i += stride) *(float4*)(X + i * 4) = *INIT_SRC(i);
#undef INIT_SRC
}

__device__ __forceinline__ void ph_mod(const P& p, float* sm_) {
    const int tidx = p.wid * 64 + fresh_lane();
    float* MOD = (float*)(p.ws + WS_MOD);
    ALAS float* sm = (ALAS float*)sm_; ALAS float* red = sm + 9 * D;
    for (int i = tidx; i < 9 * D; i += NT) { const int mi = i / D, k = i % D; const float c = mi < 8 ? p.in[I_C][mi * D + k] : p.in[I_CCTX][k]; sm[i] = siluf_(c); }
    __syncthreads();
    const int col = tidx & 63, part = tidx >> 6;
    for (int it = blockIdx.x; it < 2 * 96; it += gridDim.x) {
        const int l = it / 96, n0 = (it % 96) * 64;
        const float* W = p.in[I_WADA] + (size_t)l * D * 6 * D + (size_t)(part * 128) * 6 * D + n0 + col;
        float acc[9];
#pragma unroll
        for (int m = 0; m < 9; ++m) acc[m] = 0.f;
#pragma unroll 8
        for (int k = 0; k < 128; ++k) { const float w = W[(size_t)k * 6 * D];
#pragma unroll
            for (int m = 0; m < 9; ++m) acc[m] += sm[m * D + part * 128 + k] * w; }
#pragma unroll
        for (int m = 0; m < 9; ++m) red[(part * 9 + m) * 64 + col] = acc[m];
        __syncthreads();
        for (int o = tidx; o < 9 * 64; o += NT) { const int m = o >> 6, cc = o & 63; float v = p.in[I_BADA][l * 6 * D + n0 + cc];
#pragma unroll
            for (int q = 0; q < 8; ++q) v += red[(q * 9 + m) * 64 + cc];
            MOD[((size_t)l * 9 + m) * 6 * D + n0 + cc] = v; }
        __syncthreads();
    }
}

__device__ __forceinline__ void ph_norm1(const P& p, int l) {
    const int tidx = p.wid * 64 + fresh_lane();
    float* X = (float*)(p.ws + WS_X); bf16_t* H = (bf16_t*)(p.ws + WS_H); const float* xin = p.in[I_X]; const float* cin = p.in[I_CTX];
    const bf16_t* D1 = (const bf16_t*)(p.ws + WS_D1); const bf16_t* D2 = (const bf16_t*)(p.ws + WS_D2);
    const float* MOD = (const float*)(p.ws + WS_MOD) + (size_t)l * 9 * 6 * D; const float* g = p.in[I_N1G] + l * D;
    const int lane = tidx & 63, wv = tidx >> 6;
    const int stride = gridDim.x * NWV; const int r0 = blockIdx.x * NWV + wv;
    float4 gq[4];
#pragma unroll
    for (int q = 0; q < 4; ++q) gq[q] = *(const float4*)(g + (lane + 64 * q) * 4);
    for (int rb = r0; rb < R; rb += 9 * stride) {
        float4 vb[3][4]; uint2 d1b[3][4], d2b[3][4];
#define N1_LOAD(slot, k_) do { int rr_ = rb + (k_) * stride; rr_ = rr_ < R ? rr_ : rb; _Pragma("unroll") for (int q = 0; q < 4; ++q) { vb[slot][q] = *(const float4*)(xin_row(xin, cin, rr_) + (lane + 64 * q) * 4); \
            if (l == 1) { d1b[slot][q] = *(const uint2*)(D1 + (size_t)rr_ * D + (lane + 64 * q) * 4); d2b[slot][q] = *(const uint2*)(D2 + (size_t)rr_ * D + (lane + 64 * q) * 4); } } } while (0)
        N1_LOAD(0, 0); N1_LOAD(1, 1);
#pragma unroll
        for (int k = 0; k < 9; ++k) {
            const int r = rb + k * stride; const int sl = k % 3;
            const float* m = MOD + (size_t)row_mi(r < R ? r : rb) * 6 * D; float4 scq[4], shq[4];
#pragma unroll
            for (int q = 0; q < 4; ++q) { scq[q] = *(const float4*)(m + D + (lane + 64 * q) * 4); shq[q] = *(const float4*)(m + (lane + 64 * q) * 4); }
            if (k + 2 < 9) N1_LOAD((k + 2) % 3, k + 2);
            if (r < R) {
                float xv[4][4]; float ss = 0.f;
#pragma unroll
                for (int q = 0; q < 4; ++q) { xv[q][0] = vb[sl][q].x; xv[q][1] = vb[sl][q].y; xv[q][2] = vb[sl][q].z; xv[q][3] = vb[sl][q].w; if (l == 1) { add_bf4(xv[q], d1b[sl][q]); add_bf4(xv[q], d2b[sl][q]); } }
#pragma unroll
                for (int q = 0; q < 4; ++q) ss += xv[q][0] * xv[q][0] + xv[q][1] * xv[q][1] + xv[q][2] * xv[q][2] + xv[q][3] * xv[q][3];
                const float rs = rsqrtf(wave_sum(ss) * (1.f / D) + EPS);
#pragma unroll
                for (int q = 0; q < 4; ++q) { const int c = (lane + 64 * q) * 4; bf16_t o[4];
                    if (l == 1) *(float4*)(X + (size_t)r * D + c) = make_float4(xv[q][0], xv[q][1], xv[q][2], xv[q][3]);
                    const float4 g4 = gq[q], sc4 = scq[q], sh4 = shq[q];
                    const float gv[4] = {g4.x, g4.y, g4.z, g4.w}, scv[4] = {sc4.x, sc4.y, sc4.z, sc4.w}, shv[4] = {sh4.x, sh4.y, sh4.z, sh4.w};
#pragma unroll
                    for (int i = 0; i < 4; ++i) o[i] = f2bf(xv[q][i] * rs * gv[i] * (1.f + scv[i]) + shv[i]);
                    *(uint2*)(H + (size_t)r * D + c) = make_uint2((unsigned)o[0] | ((unsigned)o[1] << 16), (unsigned)o[2] | ((unsigned)o[3] << 16)); }
            }
        }
#undef N1_LOAD
    }
}

constexpr float QSCALE = 0.17677669529663687f * 1.4426950408889634f;
__device__ __forceinline__ void ph_rope_table(const P& p) {
    const int tidx = p.wid * 64 + fresh_lane();
    float2* TAB = (float2*)(p.ws + WS_ROPE);
    for (int it = blockIdx.x * NT + tidx; it < T * 16; it += gridDim.x * NT) { const int f = it & 7, a = (it >> 3) & 1, t = it >> 4;
        const float pos = (float)(a == 0 ? (t / 64) : (t % 64)); const float freq = expf(-(float)f * 0.125f * 9.210340371976184f); const float ang = pos * freq;
        TAB[it] = make_float2(cosf(ang), sinf(ang)); }
}
__device__ __forceinline__ void ph_rope(const P& p, int l) {
    const int tidx = p.wid * 64 + fresh_lane();
    bf16_t* Z = (bf16_t*)(p.ws + WS_Z); const float2* TAB = (const float2*)(p.ws + WS_ROPE);
    const int total = NB * T * 32;
    for (int it = blockIdx.x * NT + tidx; it < total; it += gridDim.x * NT) {
        const int pr = it & 31, rt = it >> 5; const int b = rt / T, t = rt % T;
        const int a = pr & 1, n = (pr >> 1) & 1, h = (pr >> 2) & 3, qk = pr >> 4;
        bf16_t* zp = Z + (size_t)(b * LB + TC + t) * NZ + (qk ? ZB_K : ZB_Q) + h * 64 + n * 32 + a * 16;
        const uint4 v1 = *(const uint4*)zp, v2 = *(const uint4*)(zp + 8); const unsigned w1[4] = {v1.x, v1.y, v1.z, v1.w}, w2[4] = {v2.x, v2.y, v2.z, v2.w};
        const float2* tb = TAB + (size_t)(t * 2 + a) * 8; const float sc = qk ? 1.f : QSCALE; unsigned o1[4], o2[4];
#pragma unroll
        for (int i = 0; i < 4; ++i) { const float2 cs0 = tb[2 * i], cs1 = tb[2 * i + 1];
            const float x1a = __uint_as_float(w1[i] << 16), x1b = __uint_as_float(w1[i] & 0xffff0000u), x2a = __uint_as_float(w2[i] << 16), x2b = __uint_as_float(w2[i] & 0xffff0000u);
            o1[i] = pk2bf((x1a * cs0.x - x2a * cs0.y) * sc, (x1b * cs1.x - x2b * cs1.y) * sc);
            o2[i] = pk2bf((x2a * cs0.x + x1a * cs0.y) * sc, (x2b * cs1.x + x1b * cs1.y) * sc); }
        *(uint4*)zp = make_uint4(o1[0], o1[1], o1[2], o1[3]); *(uint4*)(zp + 8) = make_uint4(o2[0], o2[1], o2[2], o2[3]);
    }
    if (l == 0) {
        const int totc = NB * TC * 256;
        for (int it = blockIdx.x * NT + tidx; it < totc; it += gridDim.x * NT) {
            const int c = it & 255, rt = it >> 8; const int b = rt / TC, j = rt % TC;
            bf16_t* zp = Z + (size_t)(b * LB + j) * NZ + ZB_Q + c; zp[0] = f2bf(bf2f(zp[0]) * QSCALE);
        }
    }
}

namespace lru {
typedef short bf16x8 __attribute__((ext_vector_type(8)));
typedef float f32x4 __attribute__((ext_vector_type(4)));
constexpr int UROW = 264;
__device__ __forceinline__ void comp(float& A, float& B, float a, float b) { B = a * B + b; A = a * A; }
}
__device__ __forceinline__ void ph_lru_m1(const P& p, int l, unsigned char* ldsb) {
    using namespace lru;
    const int lane = fresh_lane(), wid = p.wid, tid = wid * 64 + lane;
    const bf16_t* Z = (const bf16_t*)(p.ws + WS_Z); bf16_t* G = (bf16_t*)(p.ws + WS_H); float2* AGG = (float2*)(p.ws + WS_LRUAGG);
    const bf16_t* WT = (const bf16_t*)(p.ws + WS_LRUWT);
    const float* cw = p.in[I_CONVW] + l * 4 * 256; const float* cb = p.in[I_CONVB] + l * 256;
    ALAS bf16_t* U = (ALAS bf16_t*)ldsb;
    const int h = wid & 3, d = wid >> 2, l15 = lane & 15, g4 = lane >> 4;
    float spv[4], brv[4], biv[4];
#pragma unroll
    for (int jt = 0; jt < 4; ++jt) { const int w = h * 64 + jt * 16 + l15; spv[jt] = log1pf(expf(-p.in[I_LAM][(l * 2 + d) * 256 + w])); brv[jt] = p.in[I_BR][(l * 2 + d) * 256 + w]; biv[jt] = p.in[I_BI][(l * 2 + d) * 256 + w]; }
    for (int unit = ustart(192); unit < NB * 36; unit += gridDim.x) {
        const int b = unit / 36, c = unit % 36, r0 = b * LB + c * 64; const int lo = c < 4 ? 0 : TC, hi = c < 4 ? TC : LB;
        {
            uint4 zv[4][4];
#pragma unroll
            for (int it4 = 0; it4 < 4; ++it4) { const int item = tid + it4 * NT; const int t = item >> 5, cg = item & 31, j = c * 64 + t;
#pragma unroll
                for (int q = 0; q < 4; ++q) { int jj = j + q - 2; jj = jj < lo ? lo : (jj >= hi ? hi - 1 : jj); zv[it4][q] = *(const uint4*)(Z + (size_t)(b * LB + jj) * NZ + ZA_X + cg * 8); } }
#pragma unroll
            for (int it4 = 0; it4 < 4; ++it4) { const int item = tid + it4 * NT; const int t = item >> 5, cg = item & 31, j = c * 64 + t; float acc[8];
#pragma unroll
                for (int i = 0; i < 8; ++i) acc[i] = cb[cg * 8 + i];
#pragma unroll
                for (int q = 0; q < 4; ++q) { const int jj = j + q - 2; const float msk = (jj >= lo && jj < hi) ? 1.f : 0.f; const unsigned zw[4] = {zv[it4][q].x, zv[it4][q].y, zv[it4][q].z, zv[it4][q].w};
                    const float4 w0 = *(const float4*)(cw + q * 256 + cg * 8), w1 = *(const float4*)(cw + q * 256 + cg * 8 + 4); const float wv8[8] = {w0.x, w0.y, w0.z, w0.w, w1.x, w1.y, w1.z, w1.w};
#pragma unroll
                    for (int i = 0; i < 4; ++i) { acc[2 * i] += __uint_as_float(zw[i] << 16) * (wv8[2 * i] * msk); acc[2 * i + 1] += __uint_as_float(zw[i] & 0xffff0000u) * (wv8[2 * i + 1] * msk); } }
                uint4 o; o.x = pk2bf(acc[0], acc[1]); o.y = pk2bf(acc[2], acc[3]); o.z = pk2bf(acc[4], acc[5]); o.w = pk2bf(acc[6], acc[7]);
                { typedef unsigned u32x4_t __attribute__((ext_vector_type(4))); u32x4_t ov = {o.x, o.y, o.z, o.w}; *(ALAS u32x4_t*)(U + t * UROW + cg * 8) = ov; } }
        }
        __syncthreads();
        bf16x8 af[4][2];
#pragma unroll
        for (int tt = 0; tt < 4; ++tt)
#pragma unroll
            for (int ks = 0; ks < 2; ++ks) af[tt][ks] = *(const ALAS bf16x8*)(U + (16 * tt + l15) * UROW + h * 64 + 32 * ks + 8 * g4);
#pragma unroll 1
        for (int jt = 0; jt < 4; ++jt) {
            const float spj = jt == 0 ? spv[0] : jt == 1 ? spv[1] : jt == 2 ? spv[2] : spv[3], brj = jt == 0 ? brv[0] : jt == 1 ? brv[1] : jt == 2 ? brv[2] : brv[3], bij = jt == 0 ? biv[0] : jt == 1 ? biv[1] : jt == 2 ? biv[2] : biv[3];
            f32x4 ar[4], ai[4];
#pragma unroll
            for (int tt = 0; tt < 4; ++tt) { ar[tt] = (f32x4){0.f, 0.f, 0.f, 0.f}; ai[tt] = (f32x4){0.f, 0.f, 0.f, 0.f}; }
#pragma unroll
            for (int ks = 0; ks < 2; ++ks) { const bf16_t* wp = WT + ((size_t)(((l * 2 + d) * 2 + 0) * 4 + h) * 64 + 16 * jt + l15) * 64 + 32 * ks + 8 * g4; const bf16x8 wr = *(const bf16x8*)wp, wi = *(const bf16x8*)(wp + 4 * 64 * 64);
#pragma unroll
                for (int tt = 0; tt < 4; ++tt) { ar[tt] = __builtin_amdgcn_mfma_f32_16x16x32_bf16(af[tt][ks], wr, ar[tt], 0, 0, 0); ai[tt] = __builtin_amdgcn_mfma_f32_16x16x32_bf16(af[tt][ks], wi, ai[tt], 0, 0, 0); } }
            const int w = h * 64 + jt * 16 + l15; float mA[4], mB[4];
#pragma unroll
            for (int tt = 0; tt < 4; ++tt) { float A = 1.f, Bv = 0.f; float av[4], bv[4];
#pragma unroll
                for (int rg = 0; rg < 4; ++rg) { const int t = 16 * tt + 4 * g4 + rg;
                    const float rgt = sigmoidf_(ar[tt][rg] + brj), igt = sigmoidf_(ai[tt][rg] + bij);
                    const bf16_t lab = f2bf(-8.f * rgt * spj); const float a = __expf(bf2f(lab));
                    const float uu = bf2f(U[t * UROW + w]); const float bc = __builtin_amdgcn_sqrtf(fmaxf(1.f - a * a, 0.f)) * igt * uu;
                    const bf16_t bcb = f2bf(bc);
                    G[((size_t)(d * 2 + 0) * R + r0 + t) * 256 + w] = lab; G[((size_t)(d * 2 + 1) * R + r0 + t) * 256 + w] = bcb;
                    av[rg] = a; bv[rg] = bf2f(bcb); }
                if (d == 0) { comp(A, Bv, av[0], bv[0]); comp(A, Bv, av[1], bv[1]); comp(A, Bv, av[2], bv[2]); comp(A, Bv, av[3], bv[3]); }
                else { comp(A, Bv, av[3], bv[3]); comp(A, Bv, av[2], bv[2]); comp(A, Bv, av[1], bv[1]); comp(A, Bv, av[0], bv[0]); }
                mA[tt] = A; mB[tt] = Bv; }
            float A = 1.f, Bv = 0.f;
#pragma unroll
            for (int s4 = 0; s4 < 4; ++s4) { const int tt = d == 0 ? s4 : 3 - s4; const float ma = d == 0 ? mA[s4] : mA[3 - s4], mb = d == 0 ? mB[s4] : mB[3 - s4]; (void)tt;
#pragma unroll
                for (int gs = 0; gs < 4; ++gs) { const int gg = d == 0 ? gs : 3 - gs; const float a = __shfl(ma, gg * 16 + l15), bq = __shfl(mb, gg * 16 + l15); comp(A, Bv, a, bq); } }
            if (g4 == 0) AGG[((size_t)(b * 2 + d) * 36 + c) * 256 + w] = make_float2(A, Bv);
        }
        __syncthreads();
    }
}
__device__ __forceinline__ void ph_lru_m2(const P& p, int l, unsigned char* ldsb) {
    const int lane = fresh_lane(), wid = p.wid, tid = wid * 64 + lane;
    const bf16_t* Z = (const bf16_t*)(p.ws + WS_Z); const bf16_t* G = (const bf16_t*)(p.ws + WS_H); bf16_t* Y = (bf16_t*)(p.ws + WS_Y); const float2* AGG = (const float2*)(p.ws + WS_LRUAGG);
    ALAS float* HS = (ALAS float*)ldsb;
    const int d = tid >> 8, w = tid & 255;
    const int ncb = l == 1 ? 32 : 36, nun = NB * ncb;
    const int vme = ustart(0);
    for (int pass = 0; pass < 2; ++pass) {
        int unit;
        if (l == 1) unit = pass == 0 ? vme : -1;
        else if (pass == 0) unit = (vme >= 64 && vme < 96) ? -1 : (vme < 64 ? vme : vme - 32);
        else unit = (vme >= 96 && vme < 160) ? 224 + (vme - 96) : -1;
        if (unit < 0 || unit >= nun) continue;
        const int b = unit / ncb, c = (36 - ncb) + unit % ncb, r0 = b * LB + c * 64;
        float hst = 0.f; const float2* ag = AGG + (size_t)(b * 2 + d) * 36 * 256 + w;
        {
            const int pos = d == 0 ? c : (c < 4 ? 3 - c : 4 + (35 - c));
            float mx[36], my[36];
#pragma unroll
            for (int k = 0; k < 36; ++k) { const int cc = d == 0 ? k : (k < 4 ? 3 - k : 39 - k); const float2 m = ag[cc * 256]; mx[k] = m.x; my[k] = m.y; }
#pragma unroll
            for (int k = 0; k < 36; ++k) { const bool vf = k < pos; const float a = vf ? mx[k] : 1.f, bq = vf ? my[k] : 0.f; hst = __builtin_fmaf(a, hst, bq); }
        }
        const bf16_t* gl = G + ((size_t)(d * 2 + 0) * R + r0) * 256 + w; const bf16_t* gb = G + ((size_t)(d * 2 + 1) * R + r0) * 256 + w;
#pragma unroll 1
        for (int s0 = 0; s0 < 64; s0 += 32) {
            bf16_t la[32], lb[32];
#pragma unroll
            for (int i = 0; i < 32; ++i) { const int t = d == 0 ? (s0 + i) : 63 - (s0 + i); la[i] = gl[t * 256]; lb[i] = gb[t * 256]; }
#pragma unroll
            for (int i = 0; i < 32; ++i) { const int t = d == 0 ? (s0 + i) : 63 - (s0 + i); hst = __expf(bf2f(la[i])) * hst + bf2f(lb[i]); HS[(d * 64 + t) * 256 + w] = hst; }
        }
        __syncthreads();
#pragma unroll
        for (int q = 0; q < 4; ++q) { const int it = tid + q * NT; const int t = it >> 5, c8 = (it & 31) * 8;
            const uint4 zv = *(const uint4*)(Z + (size_t)(r0 + t) * NZ + ZA_G + c8); const unsigned zw[4] = {zv.x, zv.y, zv.z, zv.w}; unsigned o[4];
#pragma unroll
            for (int i = 0; i < 4; ++i) { const float h0 = HS[t * 256 + c8 + 2 * i] + HS[(64 + t) * 256 + c8 + 2 * i], h1 = HS[t * 256 + c8 + 2 * i + 1] + HS[(64 + t) * 256 + c8 + 2 * i + 1];
                o[i] = pk2bf(h0 * geluf_(__uint_as_float(zw[i] << 16)), h1 * geluf_(__uint_as_float(zw[i] & 0xffff0000u))); }
            *(uint4*)(Y + (size_t)(r0 + t) * D + c8) = make_uint4(o[0], o[1], o[2], o[3]); }
        __syncthreads();
    }
}

__device__ __forceinline__ void ph_sg(const P& p, int l, unsigned char* ldsb) {
    typedef short bf16x8 __attribute__((ext_vector_type(8))); typedef float f32x16 __attribute__((ext_vector_type(16)));
    const int lane = fresh_lane(), wid = p.wid, tid = wid * 64 + lane, r32 = lane & 31, hi = lane >> 5;
    const bf16_t* Z = (const bf16_t*)(p.ws + WS_Z); bf16_t* Y = (bf16_t*)(p.ws + WS_Y); const bf16_t* SGW = (const bf16_t*)(p.ws + WS_SGW) + (size_t)l * 4 * 128 * 128;
    const float* ng = p.in[I_SGNG] + l * 256;
    ALAS bf16_t* VT = (ALAS bf16_t*)ldsb;
    constexpr int VROW = 136;
    const int q = tid >> 2, part = tid & 3, ptile = wid & 3, chalf = wid >> 2;
    const int nck = l == 1 ? 16 : 18;
    const int vme = ustart(0), nun_sg = NB * nck * 4;
    for (int pass = 0; pass < 3; ++pass) {
        int unit;
        if (pass == 0) unit = vme;
        else if (pass == 1) unit = (vme >= 64 && vme < 96) ? -1 : 256 + (vme < 64 ? vme : vme - 32);
        else unit = (vme >= 160 && vme < 192) ? 480 + (vme - 160) : (vme < 64 ? 512 + vme : -1);
        if (unit < 0 || unit >= nun_sg) continue;
        const int h = unit & 3, bc = unit >> 2, b = bc / nck, ck = (18 - nck) + bc % nck;
        const int r0 = b * LB + ck * 128;
        bf16x8 wf[8];
        { const bf16_t* wp = SGW + ((size_t)h * 128 + 32 * ptile + r32) * 128 + 8 * hi;
#pragma unroll
          for (int ks = 0; ks < 8; ++ks) wf[ks] = *(const bf16x8*)(wp + 16 * ks); }
        { const bf16_t* zv = Z + (size_t)(r0 + q) * NZ + ZC_V + part * 64; uint4 raw[8]; float ss = 0.f;
#pragma unroll
          for (int i = 0; i < 8; ++i) raw[i] = *(const uint4*)(zv + 8 * i);
#pragma unroll
          for (int i = 0; i < 8; ++i) { const unsigned w4[4] = {raw[i].x, raw[i].y, raw[i].z, raw[i].w};
#pragma unroll
              for (int k = 0; k < 4; ++k) { const float g0 = geluf_(__uint_as_float(w4[k] << 16)), g1 = geluf_(__uint_as_float(w4[k] & 0xffff0000u)); ss += g0 * g0 + g1 * g1; } }
          ss += __shfl_xor(ss, 1); ss += __shfl_xor(ss, 2);
          const float rs = rsqrtf(ss * (1.f / 256.f) + EPS);
          if (part == h) {
#pragma unroll
              for (int i = 0; i < 8; ++i) { const unsigned w4[4] = {raw[i].x, raw[i].y, raw[i].z, raw[i].w};
#pragma unroll
                  for (int k = 0; k < 4; ++k) { const int c = 8 * i + 2 * k;
                      VT[c * VROW + q] = f2bf(geluf_(__uint_as_float(w4[k] << 16)) * rs * ng[h * 64 + c]);
                      VT[(c + 1) * VROW + q] = f2bf(geluf_(__uint_as_float(w4[k] & 0xffff0000u)) * rs * ng[h * 64 + c + 1]); } } } }
        __syncthreads();
        f32x16 acc = f32x16{};
#pragma unroll
        for (int ks = 0; ks < 8; ++ks) { const bf16x8 vf = *(const ALAS bf16x8*)(VT + (32 * chalf + r32) * VROW + 16 * ks + 8 * hi); acc = __builtin_amdgcn_mfma_f32_32x32x16_bf16(wf[ks], vf, acc, 0, 0, 0); }
        { const float* bsp = p.in[I_SGB] + (l * 4 + h) * 128 + 32 * ptile + 4 * hi; bf16_t zu[16];
          const size_t rb = (size_t)(r0 + 32 * ptile + 4 * hi);
#pragma unroll
          for (int r = 0; r < 16; ++r) { const int pr = (r & 3) + 8 * (r >> 2); zu[r] = Z[(rb + pr) * NZ + ZC_U + h * 64 + 32 * chalf + r32]; }
#pragma unroll
          for (int r = 0; r < 16; ++r) { const int pr = (r & 3) + 8 * (r >> 2); Y[(rb + pr) * D + 512 + h * 64 + 32 * chalf + r32] = f2bf(geluf_(bf2f(zu[r])) * (acc[r] + bsp[pr])); } }
        __syncthreads();
    }
}

namespace att {
typedef short bf16x8 __attribute__((ext_vector_type(8)));
typedef short s16x4 __attribute__((ext_vector_type(4)));
typedef float f32x16 __attribute__((ext_vector_type(16)));
typedef float f32x2_t __attribute__((ext_vector_type(2))); typedef __bf16 bf16x2_t __attribute__((ext_vector_type(2)));
constexpr int SLOTB = 8192, NSLOT = 3, L_K = 0, L_V = NSLOT * SLOTB, L_WS = 2 * NSLOT * SLOTB, L_OST = L_WS + 8 * 2 * 32 * 4, OST_W = 32 * 66 * 4;
constexpr float THR = 8.f;
__device__ __forceinline__ int crow(int r, int hi) { return (r & 3) + 8 * (r >> 2) + 4 * hi; }
__device__ __forceinline__ unsigned cvtpk(float lo, float hi) { f32x2_t v = {lo, hi}; bf16x2_t b = __builtin_convertvector(v, bf16x2_t); return __builtin_bit_cast(unsigned, b); }
__device__ __forceinline__ float max3f(float a, float b, float c) { float r; asm("v_max3_f32 %0, %1, %2, %3" : "=v"(r) : "v"(a), "v"(b), "v"(c)); return r; }
__device__ __forceinline__ float swapmax(float m) { auto rr = __builtin_amdgcn_permlane32_swap(__float_as_uint(m), __float_as_uint(m), false, false); return fmaxf(__uint_as_float(rr[0]), __uint_as_float(rr[1])); }
__device__ __forceinline__ float swapadd(float m) { auto rr = __builtin_amdgcn_permlane32_swap(__float_as_uint(m), __float_as_uint(m), false, false); return __uint_as_float(rr[0]) + __uint_as_float(rr[1]); }
typedef short v4i16_t __attribute__((ext_vector_type(4)));
__device__ __forceinline__ void glds16(const void* gsrc, unsigned lds_dst) { unsigned keep;
  asm volatile("s_mov_b32 %0, m0\n\ts_mov_b32 m0, %2\n\ts_nop 0\n\tglobal_load_lds_dwordx4 %1, off\n\ts_mov_b32 m0, %0" : "=&s"(keep) : "v"(gsrc), "s"(lds_dst) : "memory"); }
__device__ __forceinline__ s16x4 vtr(const ALAS char* q) { return __builtin_bit_cast(s16x4, __builtin_amdgcn_ds_read_tr16_b64_v4i16((ALAS v4i16_t*)q)); }
}
__device__ __forceinline__ void ph_attn(const P& p, int l, unsigned char* ldsb) {
    using namespace att;
    const int lane = fresh_lane(), wid = p.wid, r32 = lane & 31, hi = lane >> 5;
    const bf16_t* Z = (const bf16_t*)(p.ws + WS_Z); bf16_t* Y = (bf16_t*)(p.ws + WS_Y);
    const float lam_init = l == 0 ? 0.2f : (0.8f - 0.6f * 0.7408182206817179f);
    const float* dl_ = p.in[I_DALAM] + l * 4 * 32; float s01 = 0.f, s23 = 0.f;
    for (int i = 0; i < 32; ++i) { s01 += dl_[i] * dl_[32 + i]; s23 += dl_[64 + i] * dl_[96 + i]; }
    const float lam = expf(s01) - expf(s23) + lam_init;
    const float* subg = p.in[I_DASUB] + l * 64;
    const int G = gridDim.x, bx = blockIdx.x, vcu = (G % 8 == 0) ? (bx % 8) * (G / 8) + bx / 8 : bx;
    const int nun = 256 + (l == 0 ? 32 : 0);
    ALAS char* L3 = (ALAS char*)ldsb; const unsigned lds0 = (unsigned)(size_t)L3;
    ALAS float* wsf = (ALAS float*)(L3 + L_WS) + wid * 64;
    ALAS float* stg = (ALAS float*)(L3 + L_OST + wid * OST_W);
    const ALAS char* kp0 = L3 + L_K + hi * 1024 + r32 * 16;
    const ALAS char* vp0 = L3 + L_V + ((lane >> 4) & 1) * 32 + (lane & 3) * 8 + (4 * hi + ((lane & 15) >> 2)) * 64;
    for (int u = vcu; u < nun; u += G) {
        int b, h, q0row, nt;
        if (u < 256) { b = u >> 5; h = (u >> 3) & 3; q0row = b * LB + TC + (u & 7) * 256; nt = LB / 64; } else { const int v = u - 256; b = v >> 2; h = v & 3; q0row = b * LB; nt = TC / 64; }
        const bf16_t* ksrc = Z + (size_t)(b * LB + lane) * NZ + ZB_K + h * 64 + wid * 8;
        const bf16_t* vsrc = Z + (size_t)(b * LB + 16 * (wid & 3) + (lane >> 2)) * NZ + ZB_V + h * 64 + (wid >> 2) * 32 + (lane & 3) * 8;
#define ATT_DMA(t, slot) do { att::glds16(ksrc + (size_t)(t) * 64 * NZ, (unsigned)__builtin_amdgcn_readfirstlane((int)(lds0 + L_K + (slot) * SLOTB + wid * 1024))); \
                              att::glds16(vsrc + (size_t)(t) * 64 * NZ, (unsigned)__builtin_amdgcn_readfirstlane((int)(lds0 + L_V + (slot) * SLOTB + wid * 1024))); } while (0)
        ATT_DMA(0, 0); ATT_DMA(1, 1);
        bf16x8 qr[4];
        { const bf16_t* qp = Z + (size_t)(q0row + wid * 32 + r32) * NZ + ZB_Q + h * 64 + hi * 8;
#pragma unroll
          for (int d0 = 0; d0 < 4; ++d0) qr[d0] = *(const bf16x8*)(qp + d0 * 16); }
        f32x16 o[2][2], negm[2]; float mrun[2] = {0.f, 0.f}, lsum[2] = {0.f, 0.f};
#pragma unroll
        for (int n = 0; n < 2; ++n) { negm[n] = f32x16{}; o[n][0] = f32x16{}; o[n][1] = f32x16{}; }
        asm volatile("s_waitcnt vmcnt(0)" : "+v"(qr[0]), "+v"(qr[1]), "+v"(qr[2]), "+v"(qr[3]) :: "memory"); __syncthreads();
        int slot = 0; int t = 0;
#define ATT_TILE(FIRST) do { \
            if (t + 2 < nt) { const int s2 = slot == 0 ? 2 : slot - 1; ATT_DMA(t + 2, s2); } \
            const int so = slot * SLOTB; \
            f32x16 cc[2][2]; \
            _Pragma("unroll") \
            for (int n = 0; n < 2; ++n) { \
                const bf16x8 k00 = *(const ALAS bf16x8*)(kp0 + so + (2 * n) * 2048), k01 = *(const ALAS bf16x8*)(kp0 + so + (2 * n) * 2048 + 512); \
                const bf16x8 k10 = *(const ALAS bf16x8*)(kp0 + so + (2 * n + 1) * 2048), k11 = *(const ALAS bf16x8*)(kp0 + so + (2 * n + 1) * 2048 + 512); \
                cc[n][0] = __builtin_amdgcn_mfma_f32_32x32x16_bf16(k00, qr[2 * n], negm[n], 0, 0, 0); \
                cc[n][1] = __builtin_amdgcn_mfma_f32_32x32x16_bf16(k01, qr[2 * n], negm[n], 0, 0, 0); \
                cc[n][0] = __builtin_amdgcn_mfma_f32_32x32x16_bf16(k10, qr[2 * n + 1], cc[n][0], 0, 0, 0); \
                cc[n][1] = __builtin_amdgcn_mfma_f32_32x32x16_bf16(k11, qr[2 * n + 1], cc[n][1], 0, 0, 0); \
            } \
            _Pragma("unroll") \
            for (int n = 0; n < 2; ++n) { \
                bf16x8 pa[4]; \
                f32x16 c0 = cc[n][0], c1 = cc[n][1]; \
                asm volatile("s_nop 15\n\ts_nop 7" : "+v"(c0), "+v"(c1));      \
                float rm = max3f(c0[0], c1[0], c0[1]), rm2 = max3f(c1[1], c0[2], c1[2]); \
            _Pragma("unroll") \
                for (int r = 3; r < 15; r += 2) { rm = max3f(rm, c0[r], c1[r]); rm2 = max3f(rm2, c0[r + 1], c1[r + 1]); } \
                rm = max3f(rm, rm2, c0[15]); rm = max3f(rm, c1[15], c1[15]); \
                rm = swapmax(rm); \
                if (FIRST || __builtin_expect(__any(rm > THR), 0)) { \
                    const float dl = FIRST ? rm : fmaxf(rm, 0.f); mrun[n] += dl; \
            _Pragma("unroll") \
                    for (int r = 0; r < 16; ++r) { c0[r] -= dl; c1[r] -= dl; negm[n][r] = -mrun[n]; } \
                    const float f = exp2f(-dl); lsum[n] *= f; \
                    if (hi == 0) wsf[n * 32 + r32] = f; \
            _Pragma("unroll") \
                    for (int r = 0; r < 16; ++r) { const float ff = wsf[n * 32 + crow(r, hi)]; o[n][0][r] *= ff; o[n][1][r] *= ff; } \
                } \
                float sacc = 0.f; \
            _Pragma("unroll") \
                for (int r = 0; r < 16; ++r) { c0[r] = __builtin_amdgcn_exp2f(c0[r]); c1[r] = __builtin_amdgcn_exp2f(c1[r]); sacc += c0[r] + c1[r]; } \
                lsum[n] += sacc; \
            _Pragma("unroll") \
                for (int k = 0; k < 2; ++k) { \
                    uint4 q0 = make_uint4(cvtpk(c0[8 * k], c0[8 * k + 1]), cvtpk(c0[8 * k + 2], c0[8 * k + 3]), cvtpk(c0[8 * k + 4], c0[8 * k + 5]), cvtpk(c0[8 * k + 6], c0[8 * k + 7])); \
                    uint4 q1 = make_uint4(cvtpk(c1[8 * k], c1[8 * k + 1]), cvtpk(c1[8 * k + 2], c1[8 * k + 3]), cvtpk(c1[8 * k + 4], c1[8 * k + 5]), cvtpk(c1[8 * k + 6], c1[8 * k + 7])); \
                    pa[k] = __builtin_bit_cast(bf16x8, q0); pa[2 + k] = __builtin_bit_cast(bf16x8, q1); } \
            _Pragma("unroll") \
                for (int d0 = 0; d0 < 2; ++d0) { \
                    bf16x8 vf[4]; \
            _Pragma("unroll") \
                    for (int k = 0; k < 4; ++k) { const s16x4 lo = vtr(vp0 + so + d0 * 4096 + k * 1024), hh = vtr(vp0 + so + d0 * 4096 + k * 1024 + 512); \
                        vf[k] = (bf16x8){lo[0], lo[1], lo[2], lo[3], hh[0], hh[1], hh[2], hh[3]}; } \
            _Pragma("unroll") \
                    for (int k = 0; k < 4; ++k) o[n][d0] = __builtin_amdgcn_mfma_f32_32x32x16_bf16(pa[k], vf[k], o[n][d0], 0, 0, 0); \
                } \
            } \
            if (t + 2 < nt) asm volatile("s_waitcnt vmcnt(2)" ::: "memory"); else asm volatile("s_waitcnt vmcnt(0)" ::: "memory"); \
            __builtin_amdgcn_s_barrier(); asm volatile("" ::: "memory"); \
            slot = slot == 2 ? 0 : slot + 1; \
        } while (0)
        ATT_TILE(true);
        for (t = 1; t < nt; ++t) ATT_TILE(false);
#undef ATT_TILE
        { const float l1 = swapadd(lsum[0]), l2 = swapadd(lsum[1]);
          const int lane_e = fresh_lane(); const int r32 = lane_e & 31, hi = lane_e >> 5, lane = lane_e;
          ALAS float* wsf = (ALAS float*)(L3 + L_WS) + wid * 64; ALAS float* stg = (ALAS float*)(L3 + L_OST + wid * OST_W);
          if (hi == 0) { wsf[r32] = __builtin_amdgcn_rcpf(l1); wsf[32 + r32] = lam * __builtin_amdgcn_rcpf(l2); }
#pragma unroll
          for (int r = 0; r < 16; ++r) { const int q = crow(r, hi); const float a = wsf[q], bb = wsf[32 + q];
              stg[q * 66 + r32] = o[0][0][r] * a - o[1][0][r] * bb; stg[q * 66 + 32 + r32] = o[0][1][r] * a - o[1][1][r] * bb; }
          const int row = lane >> 1, half = lane & 1; float ov[32]; float ss = 0.f;
#pragma unroll
          for (int i = 0; i < 32; ++i) { ov[i] = stg[row * 66 + half * 32 + i]; ss += ov[i] * ov[i]; }
          ss += __shfl_xor(ss, 1);
          const float rs = rsqrtf(ss * (1.f / 64.f) + EPS) * (1.f - lam_init);
          bf16_t* yo = Y + (size_t)(q0row + wid * 32 + row) * D + 256 + h * 64 + half * 32;
#pragma unroll
          for (int i = 0; i < 4; ++i) { unsigned w[4];
#pragma unroll
              for (int k = 0; k < 4; ++k) w[k] = cvtpk(ov[8 * i + 2 * k] * rs * subg[half * 32 + 8 * i + 2 * k], ov[8 * i + 2 * k + 1] * rs * subg[half * 32 + 8 * i + 2 * k + 1]);
              *(uint4*)(yo + 8 * i) = make_uint4(w[0], w[1], w[2], w[3]); } }
        __syncthreads();
#undef ATT_DMA
    }
}


namespace hg {
typedef short bf16x8 __attribute__((ext_vector_type(8)));
typedef short s16x4 __attribute__((ext_vector_type(4)));
typedef float f32x16 __attribute__((ext_vector_type(16)));
typedef float f32x4v __attribute__((ext_vector_type(4)));
constexpr int QROW = 72;
constexpr int W_Q = 0, W_K = 4608, W_KH = 9216, W_V = 13312, W_BYTES = 17408;
constexpr int L_ST = 8 * W_BYTES;
constexpr int STROW = 68, L_BS = L_ST + 64 * STROW * 4;
constexpr int AGG_FLOATS = 64 * 64 + 64;
__device__ __forceinline__ int img_off(int s, int col) { return ((col >> 5) * 2 + (s >> 4)) * 1024 + (s & 15) * 64 + (col & 31) * 2; }
}
constexpr int LDS_MISC = hg::L_BS + 256;
constexpr int LDS_MISC_HGB = LDS_MISC + 2560;
template <int PASS>
__device__ __forceinline__ void ph_hg(const P& p, int l, unsigned char* ldsb) {
    using namespace hg;
    const int wid = p.wid;
    const bf16_t* Z = (const bf16_t*)(p.ws + WS_Z); bf16_t* Y = (bf16_t*)(p.ws + WS_Y); float* AGG = (float*)p.out;
    ALAS char* L3 = (ALAS char*)ldsb; ALAS char* LW = L3 + wid * W_BYTES;
    ALAS float* ST = (ALAS float*)(L3 + L_ST); ALAS float* BS = (ALAS float*)(L3 + L_BS);
    const float* gn = p.in[I_HGNG] + l * 256;
    const int nsc = (PASS == 2 && l == 1) ? 8 : 9;
    const int nunits = PASS == 1 ? NB * 4 * 9 * 2 : NB * 4 * nsc;
    for (int unit = ustart(PASS == 1 ? 160 : 192); unit < nunits; unit += gridDim.x) {
        const int uu = PASS == 1 ? unit >> 1 : unit; const int d_lo = PASS == 1 ? (unit & 1) : 0, d_hi = PASS == 1 ? (unit & 1) + 1 : 2;
        const int sc = (9 - nsc) + uu % nsc, bh = uu / nsc, h = bh & 3, b = bh >> 2;
        const int lane = fresh_lane();
        const int tid = wid * 64 + lane, r32 = lane & 31, hi = lane >> 5;
        const ALAS char* trb = LW + ((lane >> 4) & 1) * 32 + (lane & 3) * 8 + (4 * hi + ((lane & 15) >> 2)) * 64;
        float* OSG = (float*)p.out + (size_t)4 * 1024 * 1024 + (size_t)blockIdx.x * 16384;
#pragma unroll 1
        for (int d = d_lo; d < d_hi; ++d) {
            float lb = 0.f;
            if (l == 1) { const float* hl = p.in[I_HGLB] + (size_t)d * 2 * 256 + h * 64 + lane; lb = sigmoidf_(hl[256] - hl[0]); }
            const int fcol = (d == 0 ? ZD_FF : ZD_FB) + h * 64 + lane;
            const int jbase = b * LB + sc * 256;
            { const float* ag = AGG + (size_t)((b * 4 + h) * 2 + d) * 9 * AGG_FLOATS; const int dd = tid & 63;
              float sv[8];
#pragma unroll
              for (int i = 0; i < 8; ++i) sv[i] = 0.f;
              if (PASS == 2) {
#pragma unroll
                  for (int k = 0; k < 8; ++k) { const int ai = d == 0 ? k : (k == 0 ? 0 : 9 - k); const bool valid = d == 0 ? (k < sc) : (k == 0 ? (sc > 0) : (ai > sc)); const int ac = valid ? ai : 0;
                      const float dv = valid ? __expf(ag[(size_t)ac * AGG_FLOATS + 4096 + dd]) : 1.f;
#pragma unroll
                      for (int i = 0; i < 8; ++i) { const float s_ = ag[(size_t)ac * AGG_FLOATS + tid + 512 * i]; sv[i] = dv * sv[i] + (valid ? s_ : 0.f); } } }
#pragma unroll
              for (int i = 0; i < 8; ++i) { const int e = tid + 512 * i; ST[(e >> 6) * STROW + (e & 63)] = sv[i]; }
              if (tid < 64) BS[tid] = 0.f; }
            {   typedef unsigned u32x4s __attribute__((ext_vector_type(4)));
                const int tk = lane >> 3, c8 = (lane & 7) * 8;
                u32x4s rv[4], rf[4], rq[4];
#pragma unroll
                for (int g = 0; g < 4; ++g) { const int tau = 8 * g + tk; const int jl = d == 0 ? (32 * wid + tau) : (255 - 32 * wid - tau); const bf16_t* zr = Z + (size_t)(jbase + jl) * NZ + h * 64 + c8;
                    rv[g] = *(const u32x4s*)(zr + ZD_I); rf[g] = *(const u32x4s*)(zr + (d == 0 ? ZD_FF : ZD_FB)); if (PASS == 2) rq[g] = *(const u32x4s*)(zr + ZD_Q); }
#pragma unroll
                for (int g = 0; g < 4; ++g) { const int tau = 8 * g + tk;
                    *(ALAS u32x4s*)(LW + W_V + img_off(tau, c8)) = rv[g];
                    *(ALAS u32x4s*)(LW + W_K + (tau * QROW + c8) * 2) = rf[g];
                    if (PASS == 2) *(ALAS u32x4s*)(LW + W_Q + (tau * QROW + c8) * 2) = rq[g]; }
            }
            float gl[32]; float Btot = 0.f;
#pragma unroll
            for (int tau = 0; tau < 32; ++tau) { const float f = lb + (1.f - lb) * sigmoidf_(bf2f(*(const ALAS bf16_t*)(LW + W_K + (tau * QROW + lane) * 2))); gl[tau] = fmaxf(__logf(f), -80.f); Btot += gl[tau]; }
            { float run = 0.f;
#pragma unroll
              for (int tau = 0; tau < 32; ++tau) { run += gl[tau]; const float kk = 1.f - __expf(gl[tau]);
                *(ALAS bf16_t*)(LW + W_KH + img_off(tau, lane)) = f2bf(kk * __expf(Btot - run));
                if (PASS == 2) { ALAS bf16_t* qp = (ALAS bf16_t*)(LW + W_Q + (tau * QROW + lane) * 2); *qp = f2bf(bf2f(*qp) * 0.125f * __expf(run));
                                 *(ALAS bf16_t*)(LW + W_K + (tau * QROW + lane) * 2) = f2bf(kk * __expf(fminf(-run, 80.f))); } } }
            f32x16 sl[2][2];
#pragma unroll
            for (int cv = 0; cv < 2; ++cv)
#pragma unroll
                for (int cd = 0; cd < 2; ++cd) sl[cv][cd] = f32x16{};
            bf16x8 vfr[2][2];
#pragma unroll
            for (int ks = 0; ks < 2; ++ks)
#pragma unroll
                for (int ch = 0; ch < 2; ++ch) { const s16x4 lo = att::vtr(trb + W_V + (ch * 2 + ks) * 1024), hh = att::vtr(trb + W_V + (ch * 2 + ks) * 1024 + 512);
                    vfr[ks][ch] = (bf16x8){lo[0], lo[1], lo[2], lo[3], hh[0], hh[1], hh[2], hh[3]}; }
#pragma unroll
            for (int ks = 0; ks < 2; ++ks)
#pragma unroll
                for (int cd = 0; cd < 2; ++cd) { const s16x4 lo = att::vtr(trb + W_KH + (cd * 2 + ks) * 1024), hh = att::vtr(trb + W_KH + (cd * 2 + ks) * 1024 + 512);
                    const bf16x8 kf = (bf16x8){lo[0], lo[1], lo[2], lo[3], hh[0], hh[1], hh[2], hh[3]};
#pragma unroll
                    for (int cv = 0; cv < 2; ++cv) sl[cv][cd] = __builtin_amdgcn_mfma_f32_32x32x16_bf16(vfr[ks][cv], kf, sl[cv][cd], 0, 0, 0); }
            f32x16 o[2]; o[0] = f32x16{}; o[1] = f32x16{};
            bf16x8 qf[4];
            if (PASS == 2) {
                f32x16 c = f32x16{};
#pragma unroll
                for (int d0 = 0; d0 < 4; ++d0) { qf[d0] = *(const ALAS bf16x8*)(LW + W_Q + (r32 * QROW + 16 * d0 + 8 * hi) * 2);
                    const bf16x8 kf = *(const ALAS bf16x8*)(LW + W_K + (r32 * QROW + 16 * d0 + 8 * hi) * 2);
                    c = __builtin_amdgcn_mfma_f32_32x32x16_bf16(kf, qf[d0], c, 0, 0, 0); }
#pragma unroll
                for (int r = 0; r < 16; ++r) { const int srow = att::crow(r, hi); if (srow > r32) c[r] = 0.f; }
#pragma unroll
                for (int ks = 0; ks < 2; ++ks) { const uint4 q4 = make_uint4(att::cvtpk(c[8 * ks], c[8 * ks + 1]), att::cvtpk(c[8 * ks + 2], c[8 * ks + 3]), att::cvtpk(c[8 * ks + 4], c[8 * ks + 5]), att::cvtpk(c[8 * ks + 6], c[8 * ks + 7]));
                    const bf16x8 pa = __builtin_bit_cast(bf16x8, q4);
                    o[0] = __builtin_amdgcn_mfma_f32_32x32x16_bf16(pa, vfr[ks][0], o[0], 0, 0, 0); o[1] = __builtin_amdgcn_mfma_f32_32x32x16_bf16(pa, vfr[ks][1], o[1], 0, 0, 0); }
            }
            if constexpr (PASS == 1) {
            __syncthreads();
            ALAS float* SL = (ALAS float*)LW; ALAS float* BARR = (ALAS float*)(L3 + LDS_MISC_HGB); ALAS float* DARR = BARR + 8 * 64;
            float Bacc = Btot;
            int sbase = (4 * hi) * STROW + r32; asm volatile("" : "+v"(sbase));
#pragma unroll
            for (int cv = 0; cv < 2; ++cv)
#pragma unroll
                for (int cd = 0; cd < 2; ++cd)
#pragma unroll
                    for (int r = 0; r < 16; ++r) SL[sbase + (32 * cv + (r & 3) + 8 * (r >> 2)) * STROW + 32 * cd] = sl[cv][cd][r];
            BARR[wid * 64 + lane] = Bacc;
            __syncthreads();
            {
                float spA[16], spB[16]; float bp = 0.f, dkq[2] = {1.f, 1.f};
#define HG_RD(dst, cv_, cd_, sh_) do { if (wid >= (sh_)) { const ALAS float* PS_ = (const ALAS float*)(L3 + (wid - (sh_)) * W_BYTES); _Pragma("unroll") for (int r = 0; r < 16; ++r) \
                    dst[r] = PS_[sbase + (32 * (cv_) + (r & 3) + 8 * (r >> 2)) * STROW + 32 * (cd_)]; } } while (0)
#define HG_WR(src, cv_, cd_, sh_) do { if (wid >= (sh_)) { _Pragma("unroll") for (int r = 0; r < 16; ++r) { sl[cv_][cd_][r] = dkq[cd_] * src[r] + sl[cv_][cd_][r]; \
                    SL[sbase + (32 * (cv_) + (r & 3) + 8 * (r >> 2)) * STROW + 32 * (cd_)] = sl[cv_][cd_][r]; } } } while (0)
#define HG_STEP_BEGIN(sh_) do { if (wid >= (sh_)) { bp = BARR[(wid - (sh_)) * 64 + lane]; const float dk_ = __expf(Bacc); dkq[0] = __shfl(dk_, r32); dkq[1] = __shfl(dk_, 32 + r32); } } while (0)
#define HG_STEP_END(sh_) do { if (wid >= (sh_)) { Bacc += bp; BARR[wid * 64 + lane] = Bacc; } } while (0)
#define HG_STEP(sh_) do { HG_STEP_BEGIN(sh_); HG_RD(spA, 0, 0, sh_); __syncthreads(); \
                HG_WR(spA, 0, 0, sh_); HG_RD(spB, 0, 1, sh_); __syncthreads(); \
                HG_WR(spB, 0, 1, sh_); HG_RD(spA, 1, 0, sh_); __syncthreads(); \
                HG_WR(spA, 1, 0, sh_); HG_RD(spB, 1, 1, sh_); __syncthreads(); \
                HG_WR(spB, 1, 1, sh_); HG_STEP_END(sh_); __syncthreads(); } while (0)
                HG_STEP(1); HG_STEP(2); HG_STEP(4);
#undef HG_STEP
#undef HG_RD
#undef HG_WR
#undef HG_STEP_BEGIN
#undef HG_STEP_END
            }
            if (PASS == 1) {
                float* ag = AGG + ((size_t)((b * 4 + h) * 2 + d) * 9 + sc) * AGG_FLOATS; const ALAS float* S7 = (const ALAS float*)(L3 + 7 * W_BYTES);
                for (int e = tid; e < 4096; e += NT) ag[e] = S7[(e >> 6) * STROW + (e & 63)];
                if (tid < 64) ag[4096 + tid] = BARR[7 * 64 + tid];
                __syncthreads();
            }
            }
            if constexpr (PASS == 2) {
            __syncthreads();
#pragma unroll 1
            for (int step = 0; step < 8; ++step) {
                if (wid == step) {
                    if (PASS == 2) {
#pragma unroll
                        for (int cv = 0; cv < 2; ++cv)
#pragma unroll
                            for (int d0 = 0; d0 < 4; ++d0) { const ALAS float* sp = ST + (32 * cv + r32) * STROW + 16 * d0 + 8 * hi; const f32x4v s0 = *(const ALAS f32x4v*)sp, s1 = *(const ALAS f32x4v*)(sp + 4);
                                const uint4 q4 = make_uint4(att::cvtpk(s0[0], s0[1]), att::cvtpk(s0[2], s0[3]), att::cvtpk(s1[0], s1[1]), att::cvtpk(s1[2], s1[3]));
                                o[cv] = __builtin_amdgcn_mfma_f32_32x32x16_bf16(qf[d0], __builtin_bit_cast(bf16x8, q4), o[cv], 0, 0, 0); }
                    }
                    const float dk = __expf(Btot);
                    int sbase = (4 * hi) * STROW + r32; asm volatile("" : "+v"(sbase));
#pragma unroll
                    for (int cd = 0; cd < 2; ++cd) { const float dkd = __shfl(dk, 32 * cd + r32);
#pragma unroll
                        for (int cv = 0; cv < 2; ++cv)
#pragma unroll
                            for (int r = 0; r < 16; ++r) { ALAS float* sp = ST + sbase + (32 * cv + (r & 3) + 8 * (r >> 2)) * STROW + 32 * cd; *sp = dkd * *sp + sl[cv][cd][r]; } }
                    BS[lane] += Btot;
                }
                __syncthreads();
            }
                if (d == 0) {
                    int base = (32 * wid + 4 * hi) * 64 + r32; asm volatile("" : "+v"(base));
#pragma unroll
                    for (int r = 0; r < 16; ++r) { const int off = base + ((r & 3) + 8 * (r >> 2)) * 64; OSG[off] = o[0][r]; OSG[off + 32] = o[1][r]; }
                }
                else {
                    ALAS float* OS = (ALAS float*)L3;
                    int base = (255 - 32 * wid - 4 * hi) * 64 + r32; asm volatile("" : "+v"(base));
                    float g0[16], g1[16];
#pragma unroll
                    for (int r = 0; r < 16; ++r) { const int off = base - ((r & 3) + 8 * (r >> 2)) * 64; g0[r] = OSG[off]; g1[r] = OSG[off + 32]; }
#pragma unroll
                    for (int r = 0; r < 16; ++r) { const int off = base - ((r & 3) + 8 * (r >> 2)) * 64; OS[off] = o[0][r] + g0[r]; OS[off + 32] = o[1][r] + g1[r]; }
                    __syncthreads();
                    { int tl = 32 * wid + (lane >> 1); asm volatile("" : "+v"(tl)); const int half = lane & 1; float ov[32]; float ss = 0.f;
#pragma unroll
                      for (int i = 0; i < 32; ++i) { ov[i] = OS[tl * 64 + half * 32 + i]; ss += ov[i] * ov[i]; }
                      ss += __shfl_xor(ss, 1);
                      const float rs = rsqrtf(ss * (1.f / 64.f) + EPS);
                      const size_t row = (size_t)(jbase + tl); const bf16_t* zg = Z + row * NZ + ZD_G + h * 64 + half * 32; bf16_t* yo = Y + row * D + 768 + h * 64 + half * 32;
#pragma unroll
                      for (int i = 0; i < 4; ++i) { unsigned w4[4];
#pragma unroll
                          for (int k2 = 0; k2 < 4; ++k2) { const int c0 = 8 * i + 2 * k2; w4[k2] = att::cvtpk(ov[c0] * rs * gn[h * 64 + half * 32 + c0] * siluf_(bf2f(zg[c0])), ov[c0 + 1] * rs * gn[h * 64 + half * 32 + c0 + 1] * siluf_(bf2f(zg[c0 + 1]))); }
                          *(uint4*)(yo + 8 * i) = make_uint4(w4[0], w4[1], w4[2], w4[3]); } }
                    __syncthreads();
                }
            }
        }
    }
}

__device__ __forceinline__ void ph_router(const P& p, int l, unsigned char* ldsb, bool dry = false) {
    const int tidx = p.wid * 64 + fresh_lane();
    const float* X = (const float*)(p.ws + WS_X); bf16_t* H = (bf16_t*)(p.ws + WS_H); const float* xin = p.in[I_X]; const float* cin = p.in[I_CTX]; const bf16_t* D1 = (const bf16_t*)(p.ws + WS_D1);
#define RBASE(r_) (l == 0 ? xin_row(xin, cin, (r_)) : X + (size_t)(r_) * D)
    float2* GP = (float2*)(p.ws + WS_GP); int* LISTP = (int*)(p.ws + WS_LISTP); unsigned* CNT = (unsigned*)(p.ws + WS_CNT) + l * 32;
    const float* MOD = (const float*)(p.ws + WS_MOD) + (size_t)l * 9 * 6 * D; const float* g = p.in[I_N2G] + l * D;
    const float* RW = p.in[I_RW]; const float* RB = p.in[I_RB];
    ALAS int* lc = (ALAS int*)ldsb; ALAS int* lbase = lc + 32; ALAS int* rpair = lc + 64; ALAS int* rrank = lc + 64 + 72;
    const int lane = tidx & 63, wv = tidx >> 6;
    typedef float f32x4r __attribute__((ext_vector_type(4))); ALAS f32x4r* RWs = (ALAS f32x4r*)(ldsb - LDS_MISC);
    { f32x4r rwv[8];
#pragma unroll
      for (int u = 0; u < 8; ++u) { const int idx = tidx + u * NT; const int ln = idx & 63, e4 = (idx >> 6) & 3, i = (idx >> 8) & 3, q = idx >> 10; rwv[u] = *(const f32x4r*)(RW + (size_t)((ln + 64 * q) * 4 + i) * 16 + e4 * 4); }
#pragma unroll
      for (int u = 0; u < 8; ++u) RWs[tidx + u * NT] = rwv[u]; }
    __syncthreads();
    ALAS float* LG = (ALAS float*)(ldsb - LDS_MISC + 65536);
    float4 gq[4];
#pragma unroll
    for (int q = 0; q < 4; ++q) gq[q] = *(const float4*)(g + (lane + 64 * q) * 4);
    for (int chunk = blockIdx.x; chunk < R / 72; chunk += gridDim.x) {
        if (tidx < 32) lc[tidx] = 0;
        const int rbase = chunk * 72 + wv * 9;
        float4 vn[4]; uint2 dn[4];
#pragma unroll
        for (int q = 0; q < 4; ++q) { vn[q] = *(const float4*)(RBASE(rbase) + (lane + 64 * q) * 4); dn[q] = *(const uint2*)(D1 + (size_t)rbase * D + (lane + 64 * q) * 4); }
#pragma unroll 1
        for (int k = 0; k < 9; ++k) {
            const int li = wv * 9 + k, r = rbase + k;
            const float* m = MOD + (size_t)row_mi(r) * 6 * D; float4 scq[4], shq[4];
#pragma unroll
            for (int q = 0; q < 4; ++q) { scq[q] = *(const float4*)(m + 4 * D + (lane + 64 * q) * 4); shq[q] = *(const float4*)(m + 3 * D + (lane + 64 * q) * 4); }
            float4 v[4];
#pragma unroll
            for (int q = 0; q < 4; ++q) { float t4[4] = {vn[q].x, vn[q].y, vn[q].z, vn[q].w}; add_bf4(t4, dn[q]); v[q] = make_float4(t4[0], t4[1], t4[2], t4[3]); }
            { const int rn = rbase + (k < 8 ? k + 1 : 8);
#pragma unroll
              for (int q = 0; q < 4; ++q) { vn[q] = *(const float4*)(RBASE(rn) + (lane + 64 * q) * 4); dn[q] = *(const uint2*)(D1 + (size_t)rn * D + (lane + 64 * q) * 4); } }
            float ss = 0.f;
#pragma unroll
            for (int q = 0; q < 4; ++q) ss += v[q].x * v[q].x + v[q].y * v[q].y + v[q].z * v[q].z + v[q].w * v[q].w;
            const float rs = rsqrtf(wave_sum(ss) * (1.f / D) + EPS);
            float lg[16];
#pragma unroll
            for (int e = 0; e < 16; ++e) lg[e] = 0.f;
#pragma unroll
            for (int q = 0; q < 4; ++q) { const int c = (lane + 64 * q) * 4; const float xv[4] = {v[q].x, v[q].y, v[q].z, v[q].w};
                const float4 g4 = gq[q], sc4 = scq[q], sh4 = shq[q];
                const float gv[4] = {g4.x, g4.y, g4.z, g4.w}, scv[4] = {sc4.x, sc4.y, sc4.z, sc4.w}, shv[4] = {sh4.x, sh4.y, sh4.z, sh4.w}; bf16_t o[4];
#pragma unroll
                for (int i = 0; i < 4; ++i) { const float hv = xv[i] * rs * gv[i] * (1.f + scv[i]) + shv[i]; o[i] = f2bf(hv);
#pragma unroll
                    for (int e4 = 0; e4 < 4; ++e4) { const f32x4r w4 = RWs[((q * 4 + i) * 4 + e4) * 64 + lane]; lg[e4 * 4 + 0] += hv * w4[0]; lg[e4 * 4 + 1] += hv * w4[1]; lg[e4 * 4 + 2] += hv * w4[2]; lg[e4 * 4 + 3] += hv * w4[3]; } }
                *(uint2*)(H + (size_t)r * D + c) = make_uint2((unsigned)o[0] | ((unsigned)o[1] << 16), (unsigned)o[2] | ((unsigned)o[3] << 16));
                __builtin_amdgcn_sched_barrier(0); }
            float a8[8], a4[4], a2[2], a1;
            { const bool hb = (lane & 32) != 0;
#pragma unroll
              for (int i = 0; i < 8; ++i) { const float snd = hb ? lg[i] : lg[8 + i], kp = hb ? lg[8 + i] : lg[i]; a8[i] = kp + __shfl_xor(snd, 32); } }
            { const bool hb = (lane & 16) != 0;
#pragma unroll
              for (int i = 0; i < 4; ++i) { const float snd = hb ? a8[i] : a8[4 + i], kp = hb ? a8[4 + i] : a8[i]; a4[i] = kp + __shfl_xor(snd, 16); } }
            { const bool hb = (lane & 8) != 0;
#pragma unroll
              for (int i = 0; i < 2; ++i) { const float snd = hb ? a4[i] : a4[2 + i], kp = hb ? a4[2 + i] : a4[i]; a2[i] = kp + __shfl_xor(snd, 8); } }
            { const bool hb = (lane & 4) != 0; const float snd = hb ? a2[0] : a2[1], kp = hb ? a2[1] : a2[0]; a1 = kp + __shfl_xor(snd, 4); }
            a1 += __shfl_xor(a1, 2); a1 += __shfl_xor(a1, 1);
            if ((lane & 3) == 0) LG[li * 16 + (lane >> 2)] = a1 + RB[lane >> 2];
        }
        __syncthreads();
        if (tidx < 72) {
            const int r = chunk * 72 + tidx; float lg[16];
#pragma unroll
            for (int e = 0; e < 16; ++e) lg[e] = LG[tidx * 16 + e];
            float mx = lg[0];
#pragma unroll
            for (int e = 1; e < 16; ++e) mx = fmaxf(mx, lg[e]);
            float sc[16], sum = 0.f;
#pragma unroll
            for (int e = 0; e < 16; ++e) { sc[e] = expf(lg[e] - mx); sum += sc[e]; }
            const float inv = 1.f / sum;
#pragma unroll
            for (int e = 0; e < 16; ++e) sc[e] *= inv;
            int gsel = 0; float gbest = -1.f;
#pragma unroll
            for (int gI = 0; gI < 4; ++gI) { const float s0 = sc[gI * 4], s1 = sc[gI * 4 + 1], s2 = sc[gI * 4 + 2], s3 = sc[gI * 4 + 3];
                const float m1 = fmaxf(s0, s1), n1 = fminf(s0, s1), m2 = fmaxf(s2, s3), n2 = fminf(s2, s3);
                const float gs = fmaxf(m1, m2) + fmaxf(fminf(m1, m2), fmaxf(n1, n2)); const bool c = gs > gbest; gbest = c ? gs : gbest; gsel = c ? gI : gsel; }
            float s4[4];
#pragma unroll
            for (int i = 0; i < 4; ++i) s4[i] = gsel == 0 ? sc[i] : (gsel == 1 ? sc[4 + i] : (gsel == 2 ? sc[8 + i] : sc[12 + i]));
            float w1 = s4[0]; int i1 = 0;
#pragma unroll
            for (int i = 1; i < 4; ++i) { const bool c = s4[i] > w1; w1 = c ? s4[i] : w1; i1 = c ? i : i1; }
            float w2 = -1.f; int i2 = 0;
#pragma unroll
            for (int i = 0; i < 4; ++i) { const bool c = (i != i1) && (s4[i] > w2); w2 = c ? s4[i] : w2; i2 = c ? i : i2; }
            const float wn = 1.f / (w1 + w2);
            const int a = i1 < i2 ? i1 : i2, bq = i1 < i2 ? i2 : i1;
            const int q = a == 0 ? bq - 1 : (a == 1 ? bq + 1 : 5);
            const int pr = gsel * 6 + q; const bool skip = (l == 1 && (r % LB) < TC);
            GP[r] = i1 < i2 ? make_float2(w1 * wn, w2 * wn) : make_float2(w2 * wn, w1 * wn);
            rpair[tidx] = skip ? -1 : pr;
            if (!skip) rrank[tidx] = __hip_atomic_fetch_add(&lc[pr], 1, __ATOMIC_RELAXED, __HIP_MEMORY_SCOPE_WORKGROUP);
        }
        __syncthreads();
        if (tidx < 24) lbase[tidx] = (lc[tidx] && !dry) ? (int)atomicAdd(&CNT[tidx], (unsigned)lc[tidx]) : 0;
        __syncthreads();
        if (tidx < 72 && !dry) { const int pr = rpair[tidx]; if (pr >= 0) LISTP[(size_t)pr * R + lbase[pr] + rrank[tidx]] = chunk * 72 + tidx; }
        __syncthreads();
    }
}

__device__ __forceinline__ void ph_final(const P& p) {
    const int tidx = p.wid * 64 + fresh_lane();
    const float* X = (const float*)(p.ws + WS_X); const float* g = p.in[I_FNG]; const bf16_t* D1 = (const bf16_t*)(p.ws + WS_D1); const bf16_t* D2 = (const bf16_t*)(p.ws + WS_D2);
    const int lane = tidx & 63, wv = tidx >> 6;
    const int stride = gridDim.x * NWV; const int i0 = blockIdx.x * NWV + wv;
    float4 gq[4];
#pragma unroll
    for (int q = 0; q < 4; ++q) gq[q] = *(const float4*)(g + (lane + 64 * q) * 4);
#define FROW(i_) ((size_t)(((i_) / T) * LB + TC + ((i_) % T)))
    for (int ib = i0; ib < NB * T; ib += 8 * stride) {
        float4 vb[3][4]; uint2 d1b[3][4], d2b[3][4];
#define FN_LOAD(slot, k_) do { int ii_ = ib + (k_) * stride; ii_ = ii_ < NB * T ? ii_ : ib; const size_t rr_ = FROW(ii_); _Pragma("unroll") for (int q = 0; q < 4; ++q) { vb[slot][q] = *(const float4*)(X + rr_ * D + (lane + 64 * q) * 4); \
            d1b[slot][q] = *(const uint2*)(D1 + rr_ * D + (lane + 64 * q) * 4); d2b[slot][q] = *(const uint2*)(D2 + rr_ * D + (lane + 64 * q) * 4); } } while (0)
        FN_LOAD(0, 0); FN_LOAD(1, 1);
#pragma unroll
        for (int k = 0; k < 8; ++k) {
            const int it = ib + k * stride; const int sl = k % 3;
            if (k + 2 < 8) FN_LOAD((k + 2) % 3, k + 2);
            if (it < NB * T) {
                float xv[4][4]; float ss = 0.f;
#pragma unroll
                for (int q = 0; q < 4; ++q) { xv[q][0] = vb[sl][q].x; xv[q][1] = vb[sl][q].y; xv[q][2] = vb[sl][q].z; xv[q][3] = vb[sl][q].w; add_bf4(xv[q], d1b[sl][q]); add_bf4(xv[q], d2b[sl][q]); }
#pragma unroll
                for (int q = 0; q < 4; ++q) ss += xv[q][0] * xv[q][0] + xv[q][1] * xv[q][1] + xv[q][2] * xv[q][2] + xv[q][3] * xv[q][3];
                const float rs = rsqrtf(wave_sum(ss) * (1.f / D) + EPS);
#pragma unroll
                for (int q = 0; q < 4; ++q) { const int c = (lane + 64 * q) * 4; const float4 gg = gq[q];
                    *(float4*)(p.out + (size_t)it * D + c) = make_float4(xv[q][0] * rs * gg.x, xv[q][1] * rs * gg.y, xv[q][2] * rs * gg.z, xv[q][3] * rs * gg.w); }
            }
        }
#undef FN_LOAD
    }
#undef FROW
}

namespace pg8 {
#define PG8_LAS __attribute__((address_space(3)))
typedef short bf16x8 __attribute__((ext_vector_type(8)));
typedef float f32x4 __attribute__((ext_vector_type(4)));
typedef unsigned u32x4 __attribute__((ext_vector_type(4)));
constexpr int BM = 256, BK = 64, HALF = 128, HTB = HALF * BK * 2, STAGE_BYTES = 8 * HTB, NXCD = 8, WGM = 8;
__host__ __device__ __forceinline__ int lds_byte(int r, int c) { const int st = (r >> 4) * 2 + (c >> 5), rr = r & 15, cc = c & 31, ob = rr * 64 + cc * 2; return st * 1024 + (ob ^ (((ob >> 9) & 1) << 5)); }
__host__ __device__ __forceinline__ void stage_rc(int b, int& R, int& C) { const int st = b / 1024, sb = b % 1024, swz = sb ^ (((sb >> 9) & 1) << 5); R = (st >> 1) * 16 + swz / 64; C = (st & 1) * 32 + (swz % 64) / 2; }
__host__ __device__ __forceinline__ int perm32(int rho) { const int n = rho >> 4, i = rho & 15; return 8 * (i >> 2) + 4 * n + (i & 3); }
__device__ __forceinline__ unsigned cvt_pk_bf16(float lo, float hi) { unsigned r; asm volatile("v_cvt_pk_bf16_f32 %0, %1, %2" : "=v"(r) : "v"(lo), "v"(hi)); return r; }
struct Unit { int pm, pn, aux; };
__device__ __forceinline__ bool static_next(int i, int G, int c, int nM, int nN, int& pm, int& pn) {
    const int nwg = nM * nN; const long L = (long)i * G + c; if (L >= nwg) return false;
    int wgid = (int)L; { const int q = nwg / NXCD, r = nwg % NXCD, xcd = wgid % NXCD, off = wgid / NXCD; wgid = (xcd < r ? xcd * (q + 1) : r * (q + 1) + (xcd - r) * q) + off; }
    const int nig = WGM * nN, gid = wgid / nig, fm = gid * WGM, gsz = (nM - fm) < WGM ? (nM - fm) : WGM;
    pm = fm + ((wgid % nig) % gsz); pn = (wgid % nig) / gsz; return true;
}
template <class PB, bool ALIGN_EPI>
__device__ __forceinline__ void gemm_phase(PG8_LAS unsigned char* lds, const PB& S, const int wid) {
    const int lane = fresh_lane(), tid = wid * 64 + lane, wr = wid >> 2, wc = wid & 3, fr = lane & 15, fq = lane >> 4;
    const int nt = S.nt;
    int Rst[2], Cst[2]; unsigned voffB[2];
#pragma unroll
    for (int i = 0; i < 2; ++i) { int R_, C_; stage_rc(tid * 16 + i * 8192, R_, C_); Rst[i] = R_; Cst[i] = C_; const int Rb = PB::PERM ? ((R_ & ~31) + perm32(R_ & 31)) : R_; voffB[i] = (unsigned)(Rb * S.ldb + C_) * 2u; }
    const size_t kstep = (size_t)(BK * 2);
    const size_t hstepB = (size_t)HALF * S.ldb * 2;
    const unsigned ldsw = (unsigned)wid * 1024u;
    const int aoff = lds_byte(wr * 64 + fr, fq * 8), boff = lds_byte(wc * 32 + fr, fq * 8);
#define PG8_SA(b, h) (((b) * 2 + (h)) * HTB)
#define PG8_SB(b, h) ((4 + (b) * 2 + (h)) * HTB)
#define PG8_STAGE(bufoff, gbase, voff) do { _Pragma("unroll") for (int _i = 0; _i < 2; ++_i) { unsigned _o = (voff)[_i]; asm volatile("" : "+v"(_o)); \
        __builtin_amdgcn_global_load_lds((const unsigned*)((const char*)(gbase) + _o), (PG8_LAS unsigned*)(lds + (bufoff) + ldsw + _i * 8192), 16, 0, 0); } } while (0)
#define PG8_LDA(dst, b, h) do { _Pragma("unroll") for (int m = 0; m < 4; ++m) _Pragma("unroll") for (int k = 0; k < 2; ++k) dst[m][k] = *(const PG8_LAS bf16x8*)(lds + PG8_SA(b, h) + aoff + m * 2048 + k * 1024); } while (0)
#define PG8_LDB(dst, b, h) do { _Pragma("unroll") for (int n = 0; n < 2; ++n) _Pragma("unroll") for (int k = 0; k < 2; ++k) dst[n][k] = *(const PG8_LAS bf16x8*)(lds + PG8_SB(b, h) + boff + n * 2048 + k * 1024); } while (0)
#define PG8_MMA(ai, bj, At, Bt) do { __builtin_amdgcn_s_setprio(1); _Pragma("unroll") for (int m = 0; m < 4; ++m) _Pragma("unroll") for (int n = 0; n < 2; ++n) _Pragma("unroll") for (int k = 0; k < 2; ++k) \
        acc[ai][bj][m][n] = __builtin_amdgcn_mfma_f32_16x16x32_bf16(Bt[n][k], At[m][k], acc[ai][bj][m][n], 0, 0, 0); __builtin_amdgcn_s_setprio(0); } while (0)
#define PG8_WAIT_V(n) asm volatile("s_waitcnt vmcnt(" #n ")" ::: "memory")
#define PG8_WAIT_L(n) asm volatile("s_waitcnt lgkmcnt(" #n ")" ::: "memory")
#define PG8_BAR __builtin_amdgcn_s_barrier()
#define PG8_SCHED __builtin_amdgcn_sched_barrier(0)
    Unit cur, nxt; int ui = 0;
    if (!S.next(0, cur)) return;
    f32x4 acc[2][2][4][2];
#pragma unroll
    for (int a = 0; a < 2; ++a)
#pragma unroll
        for (int b = 0; b < 2; ++b)
#pragma unroll
            for (int m = 0; m < 4; ++m)
#pragma unroll
                for (int n = 0; n < 2; ++n) acc[a][b][m][n] = (f32x4){0.f, 0.f, 0.f, 0.f};
    bf16x8 At[4][2], B0[2][2], B1[2][2];
    unsigned vc[2][2], vn[2][2];
    S.a_off(cur, Rst, Cst, vc); asm volatile("" : "+v"(vc[0][0]), "+v"(vc[0][1]), "+v"(vc[1][0]), "+v"(vc[1][1]));
    const char* gA = S.A;
    { const char* cB = S.b_ptr(cur, 0); const char* cB1 = S.b_ptr(cur, 1);
      PG8_STAGE(PG8_SB(0, 0), cB, voffB); PG8_STAGE(PG8_SB(0, 1), cB + hstepB, voffB); PG8_STAGE(PG8_SA(0, 0), gA, vc[0]); PG8_STAGE(PG8_SA(0, 1), gA, vc[1]);
      if (wr == 1) PG8_BAR;
      PG8_WAIT_V(2); PG8_BAR;
      PG8_STAGE(PG8_SB(1, 0), cB1, voffB); PG8_STAGE(PG8_SA(1, 0), gA + kstep, vc[0]); PG8_STAGE(PG8_SB(1, 1), cB1 + hstepB, voffB);
      PG8_WAIT_V(6); PG8_BAR; }
    for (;;) {
        const bool has_next = S.next(ui + 1, nxt);
        if (has_next) { S.a_off(nxt, Rst, Cst, vn); asm volatile("" : "+v"(vn[0][0]), "+v"(vn[0][1]), "+v"(vn[1][0]), "+v"(vn[1][1])); }
        else { vn[0][0] = vc[0][0]; vn[0][1] = vc[0][1]; vn[1][0] = vc[1][0]; vn[1][1] = vc[1][1]; nxt = cur; }
        for (int t = 0; t < nt; t += 2) {
            const bool last = (t == nt - 2);
            const char* a1 = gA + (size_t)(t + 1) * kstep;
            const char* a2 = last ? gA : gA + (size_t)(t + 2) * kstep; const char* a3 = a2 + kstep;
            const char* b2 = last ? S.b_ptr(nxt, 0) : S.b_ptr(cur, t + 2);
            const char* b3 = last ? S.b_ptr(nxt, 1) : S.b_ptr(cur, t + 3);
            unsigned o2a[2], o2b[2];
            o2a[0] = last ? vn[0][0] : vc[0][0]; o2a[1] = last ? vn[0][1] : vc[0][1]; o2b[0] = last ? vn[1][0] : vc[1][0]; o2b[1] = last ? vn[1][1] : vc[1][1];
            PG8_LDB(B0, 0, 0); PG8_LDB(B1, 0, 1); PG8_SCHED; PG8_LDA(At, 0, 0); PG8_STAGE(PG8_SA(1, 1), a1, vc[1]);
            PG8_WAIT_V(8); PG8_WAIT_L(0); PG8_BAR; PG8_MMA(0, 0, At, B0); PG8_MMA(0, 1, At, B1); PG8_BAR; PG8_SCHED;
            PG8_LDA(At, 0, 1); PG8_STAGE(PG8_SB(0, 0), b2, voffB); PG8_STAGE(PG8_SB(0, 1), b2 + hstepB, voffB); PG8_STAGE(PG8_SA(0, 0), a2, o2a);
            PG8_WAIT_V(8); PG8_WAIT_L(0); PG8_BAR; PG8_MMA(1, 0, At, B0); PG8_MMA(1, 1, At, B1); PG8_BAR; PG8_SCHED;
            PG8_LDB(B0, 1, 0); PG8_LDB(B1, 1, 1); PG8_SCHED; PG8_LDA(At, 1, 0); PG8_STAGE(PG8_SA(0, 1), a2, o2b);
            PG8_WAIT_V(8); PG8_WAIT_L(0); PG8_BAR; PG8_MMA(0, 0, At, B0); PG8_MMA(0, 1, At, B1); PG8_BAR; PG8_SCHED;
            PG8_LDA(At, 1, 1); PG8_STAGE(PG8_SB(1, 0), b3, voffB); PG8_STAGE(PG8_SB(1, 1), b3 + hstepB, voffB); PG8_STAGE(PG8_SA(1, 0), a3, o2a);
            PG8_WAIT_V(8); PG8_WAIT_L(0); PG8_BAR; PG8_MMA(1, 0, At, B0); PG8_MMA(1, 1, At, B1); PG8_BAR; PG8_SCHED;
        }
        if constexpr (ALIGN_EPI) { if (wr == 0) PG8_BAR; }
        S.epi(acc, cur, wr, wc, fr, fq);
        if (!has_next) break;
#pragma unroll
        for (int a = 0; a < 2; ++a)
#pragma unroll
            for (int b = 0; b < 2; ++b)
#pragma unroll
                for (int m = 0; m < 4; ++m)
#pragma unroll
                    for (int n = 0; n < 2; ++n) acc[a][b][m][n] = (f32x4){0.f, 0.f, 0.f, 0.f};
        cur = nxt; vc[0][0] = vn[0][0]; vc[0][1] = vn[0][1]; vc[1][0] = vn[1][0]; vc[1][1] = vn[1][1]; ++ui;
        if constexpr (ALIGN_EPI) { if (wr == 1) PG8_BAR; }
    }
    PG8_WAIT_V(0);
    if constexpr (!ALIGN_EPI) { if (wr == 0) PG8_BAR; }
    PG8_BAR;
#undef PG8_SA
#undef PG8_SB
#undef PG8_STAGE
#undef PG8_LDA
#undef PG8_LDB
#undef PG8_MMA
#undef PG8_WAIT_V
#undef PG8_WAIT_L
#undef PG8_BAR
#undef PG8_SCHED
}
}

struct PB_InProj {
    static constexpr bool PERM = true;
    const char* A; int ldb, nt; const char* Bt; bf16_t* Zo; int G, c;
    __device__ __forceinline__ bool next(int i, pg8::Unit& u) const { u.aux = 0; return pg8::static_next(i, G, c, R / 256, NZ / 256, u.pm, u.pn); }
    __device__ __forceinline__ void a_off(const pg8::Unit& u, const int (&Rs)[2], const int (&Cs)[2], unsigned (&off)[2][2]) const {
#pragma unroll
        for (int h = 0; h < 2; ++h)
#pragma unroll
            for (int i = 0; i < 2; ++i) off[h][i] = (unsigned)((u.pm * 256 + h * 128 + Rs[i]) * D + Cs[i]) * 2u; }
    __device__ __forceinline__ const char* b_ptr(const pg8::Unit& u, int t) const { return Bt + (size_t)u.pn * 256 * D * 2 + (size_t)t * 128; }
    __device__ __forceinline__ void epi(const pg8::f32x4 (&acc)[2][2][4][2], const pg8::Unit& u, int wr, int wc, int fr, int fq) const {
        const int row0 = u.pm * 256 + wr * 64 + fr, col0 = u.pn * 256 + wc * 32 + 8 * fq;
#pragma unroll
        for (int ai = 0; ai < 2; ++ai)
#pragma unroll
            for (int m = 0; m < 4; ++m) { bf16_t* rowp = Zo + (size_t)(row0 + ai * 128 + m * 16) * NZ + col0;
#pragma unroll
                for (int bj = 0; bj < 2; ++bj) { const pg8::f32x4 v0 = acc[ai][bj][m][0], v1 = acc[ai][bj][m][1]; pg8::u32x4 w;
                    w.x = pg8::cvt_pk_bf16(v0[0], v0[1]); w.y = pg8::cvt_pk_bf16(v0[2], v0[3]); w.z = pg8::cvt_pk_bf16(v1[0], v1[1]); w.w = pg8::cvt_pk_bf16(v1[2], v1[3]);
                    *(pg8::u32x4*)(rowp + bj * 128) = w; } }
    }
};


struct PB_OutProj {
    static constexpr bool PERM = true;
    const char* A; int ldb, nt; const char* Bt; bf16_t* D1; const float* MODl; int G, c, skipctx; bool dry;
    __device__ __forceinline__ bool next(int i, pg8::Unit& u) const { u.aux = 0; int pm, pn; if (!pg8::static_next(i, G, c, skipctx ? 64 : 72, 4, pm, pn)) return false; u.pm = skipctx ? (pm >> 3) * 9 + 1 + (pm & 7) : pm; u.pn = pn; return true; }
    __device__ __forceinline__ void a_off(const pg8::Unit& u, const int (&Rs)[2], const int (&Cs)[2], unsigned (&off)[2][2]) const {
#pragma unroll
        for (int h = 0; h < 2; ++h)
#pragma unroll
            for (int i = 0; i < 2; ++i) off[h][i] = (unsigned)((u.pm * 256 + h * 128 + Rs[i]) * D + Cs[i]) * 2u; }
    __device__ __forceinline__ const char* b_ptr(const pg8::Unit& u, int t) const { return Bt + (size_t)u.pn * 256 * D * 2 + (size_t)t * 128; }
    __device__ __forceinline__ void epi(const pg8::f32x4 (&acc)[2][2][4][2], const pg8::Unit& u, int wr, int wc, int fr, int fq) const {
        const int row0 = u.pm * 256 + wr * 64 + fr, col0 = u.pn * 256 + wc * 32 + 8 * fq;
        const float* gt = MODl + (size_t)row_mi(u.pm * 256) * 6 * D + 2 * D + col0;
        pg8::f32x4 gv[2][2];
#pragma unroll
        for (int bj = 0; bj < 2; ++bj)
#pragma unroll
            for (int n = 0; n < 2; ++n) gv[bj][n] = *(const pg8::f32x4*)(gt + bj * 128 + 4 * n);
        if (dry) return;
#pragma unroll
        for (int ai = 0; ai < 2; ++ai)
#pragma unroll
            for (int m = 0; m < 4; ++m) { bf16_t* rowp = D1 + (size_t)(row0 + ai * 128 + m * 16) * D + col0;
#pragma unroll
                for (int bj = 0; bj < 2; ++bj) { const pg8::f32x4 v0 = acc[ai][bj][m][0] * gv[bj][0], v1 = acc[ai][bj][m][1] * gv[bj][1]; pg8::u32x4 w;
                    w.x = pg8::cvt_pk_bf16(v0[0], v0[1]); w.y = pg8::cvt_pk_bf16(v0[2], v0[3]); w.z = pg8::cvt_pk_bf16(v1[0], v1[1]); w.w = pg8::cvt_pk_bf16(v1[2], v1[3]);
                    *(pg8::u32x4*)(rowp + bj * 128) = w; } }
    }
};

__device__ __forceinline__ void moe_tiles_setup(const P& p, int l, ALAS int* tb) {
    const unsigned* CNT = (const unsigned*)(p.ws + WS_CNT) + l * 32;
    __syncthreads();
    if (p.wid == 0 && fresh_lane() == 0) { int acc = 0; for (int q = 0; q < 24; ++q) { const int c = (int)__hip_atomic_load(CNT + q, __ATOMIC_RELAXED, __HIP_MEMORY_SCOPE_AGENT); tb[q] = c; tb[32 + q] = acc; acc += (c + 255) >> 8; } tb[32 + 24] = acc; }
    __syncthreads();
}
__device__ __forceinline__ void pair_experts(int pr, int& e0, int& e1) { const int g4 = (pr / 6) * 4, q = pr % 6; const int a = q < 3 ? 0 : (q < 5 ? 1 : 2), b = q < 3 ? q + 1 : (q < 5 ? q - 1 : 3); e0 = g4 + a; e1 = g4 + b; }

struct PB_Moe1 {
    static constexpr bool PERM = false;
    const char* A; int ldb, nt; const char* W13; bf16_t* HE; const int* LISTP; const float2* GP; const ALAS int* tb; int G, c;
    __device__ __forceinline__ bool next(int i, pg8::Unit& u) const {
        if (!pg8::static_next(i, G, c, tb[32 + 24], 8, u.pm, u.pn)) return false;
        int pr = 0;
        for (int q = 1; q < 24; ++q) if (tb[32 + q] <= u.pm) pr = q;
        u.aux = pr; return true; }
    __device__ __forceinline__ void a_off(const pg8::Unit& u, const int (&Rs)[2], const int (&Cs)[2], unsigned (&off)[2][2]) const {
        const int pr = u.aux, cnt = tb[pr], r0 = (u.pm - tb[32 + pr]) * 256; const int* lp = LISTP + (size_t)pr * R;
#pragma unroll
        for (int h = 0; h < 2; ++h)
#pragma unroll
            for (int i = 0; i < 2; ++i) { int rk = r0 + h * 128 + Rs[i]; rk = rk < cnt ? rk : cnt - 1; off[h][i] = (unsigned)(lp[rk] * D + Cs[i]) * 2u; } }
    __device__ __forceinline__ const char* b_ptr(const pg8::Unit& u, int t) const { int e0, e1; pair_experts(u.aux, e0, e1); const int e = u.pn < 4 ? e0 : e1;
        return W13 + ((size_t)e * 1024 + (size_t)(u.pn & 3) * 256) * D * 2 + (size_t)t * 128; }
    __device__ __forceinline__ void epi(const pg8::f32x4 (&acc)[2][2][4][2], const pg8::Unit& u, int wr, int wc, int fr, int fq) const {
        const int pr = u.aux, cnt = tb[pr], r0 = (u.pm - tb[32 + pr]) * 256; const int* lp = LISTP + (size_t)pr * R;
        const int colh = (u.pn < 4 ? 0 : 512) + (u.pn & 3) * 128 + wc * 16 + 4 * fq;
#pragma unroll
        for (int ai = 0; ai < 2; ++ai)
#pragma unroll
            for (int m = 0; m < 4; ++m) { const int x = ai * 128 + wr * 64 + m * 16 + fr; int rk = r0 + x; rk = rk < cnt ? rk : cnt - 1;
                const float2 gg = GP[lp[rk]]; const float gate = u.pn < 4 ? gg.x : gg.y;
                bf16_t* rowp = HE + (size_t)(u.pm * 256 + x) * 1024 + colh;
#pragma unroll
                for (int bj = 0; bj < 2; ++bj) { const pg8::f32x4 a = acc[ai][bj][m][0], b = acc[ai][bj][m][1]; float o[4];
#pragma unroll
                    for (int j = 0; j < 4; ++j) o[j] = a[j] / (1.f + __expf(-a[j])) * b[j] * gate;
                    *(uint2*)(rowp + bj * 64) = make_uint2(pg8::cvt_pk_bf16(o[0], o[1]), pg8::cvt_pk_bf16(o[2], o[3])); } }
    }
};
struct PB_Moe2 {
    static constexpr bool PERM = true;
    const char* A; int ldb, nt; const char* W2; bf16_t* D2; const float* MODl; const int* LISTP; const ALAS int* tb; int G, c; bool dry;
    __device__ __forceinline__ bool next(int i, pg8::Unit& u) const {
        if (!pg8::static_next(i, G, c, tb[32 + 24], 4, u.pm, u.pn)) return false;
        int pr = 0;
        for (int q = 1; q < 24; ++q) if (tb[32 + q] <= u.pm) pr = q;
        u.aux = pr; return true; }
    __device__ __forceinline__ void a_off(const pg8::Unit& u, const int (&Rs)[2], const int (&Cs)[2], unsigned (&off)[2][2]) const {
#pragma unroll
        for (int h = 0; h < 2; ++h)
#pragma unroll
            for (int i = 0; i < 2; ++i) off[h][i] = (unsigned)((u.pm * 256 + h * 128 + Rs[i]) * 1024 + Cs[i]) * 2u; }
    __device__ __forceinline__ const char* b_ptr(const pg8::Unit& u, int t) const { int e0, e1; pair_experts(u.aux, e0, e1); const int e = t < 8 ? e0 : e1;
        return W2 + ((size_t)e * 1024 + (size_t)u.pn * 256) * DE * 2 + (size_t)(t & 7) * 128; }
    __device__ __forceinline__ void epi(const pg8::f32x4 (&acc)[2][2][4][2], const pg8::Unit& u, int wr, int wc, int fr, int fq) const {
        const int pr = u.aux, cnt = tb[pr], r0 = (u.pm - tb[32 + pr]) * 256; const int* lp = LISTP + (size_t)pr * R;
        const int col0 = u.pn * 256 + wc * 32 + 8 * fq;
        if (dry) return;
        int tok[2][4];
#pragma unroll
        for (int ai = 0; ai < 2; ++ai)
#pragma unroll
            for (int m = 0; m < 4; ++m) { const int rk = r0 + ai * 128 + wr * 64 + m * 16 + fr; tok[ai][m] = rk < cnt ? lp[rk] : -1; }
#pragma unroll
        for (int ai = 0; ai < 2; ++ai)
#pragma unroll
            for (int m = 0; m < 4; ++m) { const int tk = tok[ai][m];
                if (tk >= 0) { bf16_t* rowp = D2 + (size_t)tk * D + col0; const float* gt = MODl + (size_t)row_mi(tk) * 6 * D + 5 * D + col0;
#pragma unroll
                    for (int bj = 0; bj < 2; ++bj) { const pg8::f32x4 v0 = acc[ai][bj][m][0] * *(const pg8::f32x4*)(gt + bj * 128), v1 = acc[ai][bj][m][1] * *(const pg8::f32x4*)(gt + bj * 128 + 4); pg8::u32x4 w;
                        w.x = pg8::cvt_pk_bf16(v0[0], v0[1]); w.y = pg8::cvt_pk_bf16(v0[2], v0[3]); w.z = pg8::cvt_pk_bf16(v1[0], v1[1]); w.w = pg8::cvt_pk_bf16(v1[2], v1[3]);
                        *(pg8::u32x4*)(rowp + bj * 128) = w; } } }
    }
};

template <int MAP  >
__device__ __forceinline__ void transpose_item(const float* W, int K, int N, bf16_t* WT, PG8_LAS float* scr, int item, int lane) {
    const int nblk = N / 32, kb = item / nblk, nb = item % nblk, k0 = 64 * kb, n0 = 32 * nb;
    float wv32[32];
#pragma unroll
    for (int i = 0; i < 32; ++i) { const int kk = 2 * i + (lane >> 5); wv32[i] = W[(size_t)(k0 + kk) * N + n0 + (lane & 31)]; }
#pragma unroll
    for (int i = 0; i < 32; ++i) { const int kk = 2 * i + (lane >> 5); scr[kk * 33 + (lane & 31)] = wv32[i]; }
    asm volatile("s_waitcnt lgkmcnt(0)" ::: "memory");
    const int c = lane & 7;
#pragma unroll
    for (int j = 0; j < 4; ++j) { const int n = (lane >> 3) + 8 * j; const PG8_LAS float* sp = scr + (8 * c) * 33 + n;
        uint4 o; o.x = pk2bf(sp[0 * 33], sp[1 * 33]); o.y = pk2bf(sp[2 * 33], sp[3 * 33]);
        o.z = pk2bf(sp[4 * 33], sp[5 * 33]); o.w = pk2bf(sp[6 * 33], sp[7 * 33]);
        const int ng = n0 + n; const int row = MAP == 0 ? ng : (32 * (ng >> 4) + (ng & 15) + (MAP == 2 ? 16 : 0));
        *(uint4*)(WT + (size_t)row * K + k0 + 8 * c) = o; }
    asm volatile("s_waitcnt lgkmcnt(0)" ::: "memory");
}
__device__ __forceinline__ void ph_prep_weights(const P& p, unsigned char* lds) {
    const int tidx = p.wid * 64 + fresh_lane();
    const int lane = tidx & 63, wv = tidx >> 6;
    PG8_LAS float* scr = (PG8_LAS float*)((PG8_LAS unsigned char*)lds + wv * 16384);
    const int gw = blockIdx.x * NWV + wv, NGW = gridDim.x * NWV;
    constexpr int I_IN = (D / 64) * (NZ / 32), I_OUT = (D / 64) * (D / 32);
    for (int it = gw; it < 2 * (I_IN + I_OUT); it += NGW) { const int l = it / (I_IN + I_OUT), r = it % (I_IN + I_OUT);
        if (r < I_IN) transpose_item<0>(p.in[I_WIN] + (size_t)l * D * NZ, D, NZ, (bf16_t*)(p.ws + WS_WIN) + (size_t)l * NZ * D, scr, r, lane);
        else transpose_item<0>(p.in[I_WOUT] + (size_t)l * D * D, D, D, (bf16_t*)(p.ws + WS_WOUT) + (size_t)l * D * D, scr, r - I_IN, lane); }
    { bf16_t* SGWo = (bf16_t*)(p.ws + WS_SGW); for (int it = blockIdx.x * NT + tidx; it < 2 * 4 * 128 * 128; it += gridDim.x * NT) SGWo[it] = f2bf(p.in[I_SGW][it]); }
    { bf16_t* WT = (bf16_t*)(p.ws + WS_LRUWT);
      for (int it = blockIdx.x * NT + tidx; it < 2 * 2 * 2 * 4 * 64 * 64; it += gridDim.x * NT) { const int i = it & 63, j = (it >> 6) & 63, hh = (it >> 12) & 3, gate = (it >> 14) & 1, ld = it >> 15;
          const float* src = (gate ? p.in[I_WI] : p.in[I_WR]) + (((size_t)ld * 4 + hh) * 64 + i) * 64 + j; WT[it] = f2bf(*src); } }
}
__device__ __forceinline__ void ph_prep_moe(const P& p, int l, unsigned char* lds, int half, int b0) {
    if ((int)blockIdx.x < b0) return;
    const int tidx = p.wid * 64 + fresh_lane();
    const int lane = tidx & 63, wv = tidx >> 6;
    PG8_LAS float* scr = (PG8_LAS float*)((PG8_LAS unsigned char*)lds + wv * 16384);
    const int gw = ((int)blockIdx.x - b0) * NWV + wv, NGW = ((int)gridDim.x - b0) * NWV;
    constexpr int I_13 = (D / 64) * (DE / 32), I_2 = (DE / 64) * (D / 32), PER_E = 2 * I_13 + I_2;
    for (int it = gw + half * (NE / 2) * PER_E; it < (half + 1) * (NE / 2) * PER_E; it += NGW) { const int e = it / PER_E, r = it % PER_E;
        bf16_t* w13 = (bf16_t*)(p.ws + WS_W13) + (size_t)e * 1024 * D; bf16_t* w2 = (bf16_t*)(p.ws + WS_W2) + (size_t)e * D * DE;
        if (r < I_13) transpose_item<1>(p.in[I_W1] + ((size_t)l * NE + e) * D * DE, D, DE, w13, scr, r, lane);
        else if (r < 2 * I_13) transpose_item<2>(p.in[I_W3] + ((size_t)l * NE + e) * D * DE, D, DE, w13, scr, r - I_13, lane);
        else transpose_item<0>(p.in[I_W2] + ((size_t)l * NE + e) * DE * D, DE, D, w2, scr, r - 2 * I_13, lane); }
}

#define XB_TMO      128
#define XB_XCNT(j)  (256  + 64 * (j))
#define XB_XSUB(j)  (1280 + 64 * (j))
#define XB_XGEN(j)  (2304 + 64 * (j))
#define XB_TOP      3328
#define XB_TOPGEN   3392
#define XCD_BAR_WORDS 3456
#define XB_SPIN_CAP (1u << 18)
__device__ __forceinline__ unsigned xb_ld(unsigned* q) { return __hip_atomic_load(q, __ATOMIC_RELAXED, __HIP_MEMORY_SCOPE_AGENT); }
__device__ __forceinline__ unsigned xb_add(unsigned* q, unsigned v) { return __hip_atomic_fetch_add(q, v, __ATOMIC_RELAXED, __HIP_MEMORY_SCOPE_AGENT); }
__device__ __forceinline__ unsigned xb_xcc_id() { return (unsigned)__builtin_amdgcn_s_getreg((3 << 11) | 20) & 0xFu; }
#define XB_SPIN(cond, bar) do { unsigned _sp = 0; while (cond) { __builtin_amdgcn_s_sleep(1); \
    if ((++_sp & 255u) == 0u) { if (xb_ld(&(bar)[XB_TMO])) break; if (_sp > XB_SPIN_CAP) { atomicAdd(&(bar)[XB_TMO], 1u); break; } } } } while (0)
struct XcdBarrier { unsigned* bar; unsigned x; volatile ALAS unsigned* st; int wid; };
__device__ __forceinline__ XcdBarrier xcd_barrier_post(unsigned* bar, volatile ALAS unsigned* st, int wid) {
    XcdBarrier b; b.bar = bar; b.x = xb_xcc_id(); b.st = st; b.wid = wid;
    if (wid == 0 && fresh_lane() == 0) (void)xb_add(&bar[XB_XCNT(b.x)], 1u);
    return b;
}
__device__ __forceinline__ void xcd_barrier_complete(unsigned* bar, unsigned x, unsigned& nloc, unsigned& nx) {
    const unsigned G = gridDim.x * gridDim.y * gridDim.z;
    unsigned sum, cnt, mine, sp = 0u;
    for (;;) {
        sum = 0u; cnt = 0u; mine = 0u;
#pragma unroll
        for (unsigned j = 0; j < 16; ++j) { const unsigned c = xb_ld(&bar[XB_XCNT(j)]); sum += c; cnt += (c > 0u) ? 1u : 0u; mine = (j == x) ? c : mine; }
        if (sum == G) break;
        __builtin_amdgcn_s_sleep(1);
        if ((++sp & 255u) == 0u) { if (xb_ld(&bar[XB_TMO])) break; if (sp > XB_SPIN_CAP) { atomicAdd(&bar[XB_TMO], 1u); break; } }
    }
    nloc = mine > 0u ? mine : 1u; nx = cnt > 0u ? cnt : 1u;
}
__device__ __forceinline__ void xcd_barrier(const XcdBarrier& b) {
    asm volatile("s_waitcnt vmcnt(0)" ::: "memory");
    __syncthreads();
    if (b.wid == 0 && fresh_lane() == 0) {
        unsigned* bar = b.bar; asm volatile("" : "+s"(bar));
        __builtin_amdgcn_s_waitcnt(0);
        unsigned nloc = b.st[0], nx = b.st[1];
        if (nloc == 0u) { xcd_barrier_complete(bar, b.x, nloc, nx); b.st[0] = nloc; b.st[1] = nx; }
        const unsigned old = xb_add(&bar[XB_XSUB(b.x)], 1u);
        const unsigned gen = old / nloc;
        if (old + 1u == (gen + 1u) * nloc) {
            __builtin_amdgcn_fence(__ATOMIC_RELEASE, "agent");
            asm volatile("s_waitcnt vmcnt(0)" ::: "memory");
            const unsigned og = xb_add(&bar[XB_TOP], 1u);
            const unsigned tg = og / nx;
            if (og + 1u == (tg + 1u) * nx) xb_add(&bar[XB_TOPGEN], 1u);
            else XB_SPIN(xb_ld(&bar[XB_TOPGEN]) == tg, bar);
            __builtin_amdgcn_fence(__ATOMIC_ACQUIRE, "agent");
            xb_add(&bar[XB_XGEN(b.x)], 1u);
            asm volatile("s_waitcnt vmcnt(0)" ::: "memory");
        } else {
            XB_SPIN(xb_ld(&bar[XB_XGEN(b.x)]) == gen, bar);
            __builtin_amdgcn_fence(__ATOMIC_ACQUIRE, "agent");
            asm volatile("s_waitcnt vmcnt(0)" ::: "memory");
        }
    }
    __syncthreads();
}

#define PROBE_DUP 0
#define PROBE_T 0
constexpr int LDS_BYTES = 163840;
typedef const __attribute__((address_space(4))) P* kargp_t;
#define GETP() P p; { kargp_t kq_ = kp; int w_ = wid; asm volatile("" : "+s"(kq_), "+s"(w_)); p = *(const P*)kq_; p.wid = w_; }
__global__ void __launch_bounds__(NT, 2) fwd_kernel(P p_in) {
    const int wid = __builtin_amdgcn_readfirstlane((int)(threadIdx.x >> 6));
    kargp_t kp = (kargp_t)__builtin_amdgcn_kernarg_segment_ptr();
    extern __shared__ __attribute__((aligned(16))) unsigned char lds[];
    float* sm = (float*)lds;
    { volatile ALAS unsigned* stw = (volatile ALAS unsigned*)((ALAS unsigned char*)lds + LDS_MISC + 2048); if (threadIdx.x < 2) stw[threadIdx.x] = 0u; }
    __syncthreads();
    { GETP(); (void)xcd_barrier_post((unsigned*)(p.ws + WS_CNT + 1024), (volatile ALAS unsigned*)((ALAS unsigned char*)lds + LDS_MISC + 2048), wid); }
#define GBAR() do { GETP(); XcdBarrier gb_; gb_.bar = (unsigned*)(p.ws + WS_CNT + 1024); gb_.x = xb_xcc_id(); gb_.st = (volatile ALAS unsigned*)((ALAS unsigned char*)lds + LDS_MISC + 2048); gb_.wid = wid; xcd_barrier(gb_); } while (0)
    volatile ALAS unsigned* tl = (volatile ALAS unsigned*)((ALAS unsigned char*)lds + LDS_MISC + 2064);
    if (PROBE_T != 0) { tl[1] = 0u; }
#define TSTART(id) do { if (PROBE_T == (id)) tl[0] = (unsigned)__builtin_amdgcn_s_memrealtime(); } while (0)
#define TSTOP(id) do { if (PROBE_T == (id)) { if (wid == 0 && fresh_lane() == 0) tl[1] = tl[1] + ((unsigned)__builtin_amdgcn_s_memrealtime() - tl[0]); __syncthreads(); } } while (0)
    TSTART(1);
    { GETP(); ph_mod(p, sm); }
    { GETP(); ph_rope_table(p); }
    { GETP(); ph_prep_weights(p, lds); }
    if (PROBE_DUP == 12) { GBAR(); GBAR(); GBAR(); GBAR(); GBAR(); GBAR(); GBAR(); GBAR(); GBAR(); GBAR(); }
    GBAR(); TSTOP(1);
#pragma unroll 1
    for (int l = 0; l < 2; ++l) {
        TSTART(2);
        { GETP(); ph_norm1(p, l); if (PROBE_DUP == 2) ph_norm1(p, l); }
        if (l == 1) { GETP(); ph_prep_moe(p, l, lds, 1, 0); }
        GBAR(); TSTOP(2); TSTART(3);
        { GETP(); PB_InProj pb; pb.A = (const char*)(p.ws + WS_H); pb.ldb = D; pb.nt = D / 64; pb.Bt = (const char*)(p.ws + WS_WIN) + (size_t)l * NZ * D * 2; pb.Zo = (bf16_t*)(p.ws + WS_Z); pb.G = gridDim.x; pb.c = blockIdx.x;
          pg8::gemm_phase<PB_InProj, true>((PG8_LAS unsigned char*)lds, pb, wid);
          if (PROBE_DUP == 3) pg8::gemm_phase<PB_InProj, true>((PG8_LAS unsigned char*)lds, pb, wid); }
        { GETP(); ph_prep_moe(p, l, lds, 0, 96); }
        GBAR(); TSTOP(3); TSTART(4);
        TSTART(14); { GETP(); ph_rope(p, l); } TSTOP(14);
        TSTART(15); { GETP(); ph_sg(p, l, lds); if (PROBE_DUP == 4) ph_sg(p, l, lds); } TSTOP(15);
        TSTART(16); { GETP(); ph_lru_m1(p, l, lds); if (PROBE_DUP == 7) ph_lru_m1(p, l, lds); } TSTOP(16);
        TSTART(17); { GETP(); ph_hg<1>(p, l, lds); if (PROBE_DUP == 9) ph_hg<1>(p, l, lds); } TSTOP(17);
        GBAR(); TSTOP(4); TSTART(5);
        TSTART(11); { GETP(); ph_attn(p, l, lds); if (PROBE_DUP == 5) ph_attn(p, l, lds); } TSTOP(11);
        TSTART(12); { GETP(); ph_lru_m2(p, l, lds); if (PROBE_DUP == 6) ph_lru_m2(p, l, lds); } TSTOP(12);
        TSTART(13); { GETP(); ph_hg<2>(p, l, lds); if (PROBE_DUP == 10) ph_hg<2>(p, l, lds); } TSTOP(13);
        GBAR(); TSTOP(5); TSTART(6);
        { GETP(); PB_OutProj pb; pb.A = (const char*)(p.ws + WS_Y); pb.ldb = D; pb.nt = D / 64; pb.Bt = (const char*)(p.ws + WS_WOUT) + (size_t)l * D * D * 2; pb.D1 = (bf16_t*)(p.ws + WS_D1);
          pb.MODl = (const float*)(p.ws + WS_MOD) + (size_t)l * 9 * 6 * D; pb.G = gridDim.x; pb.c = blockIdx.x; pb.skipctx = (l == 1); pb.dry = false;
          if (PROBE_DUP == 14) { pb.dry = true; pg8::gemm_phase<PB_OutProj, true>((PG8_LAS unsigned char*)lds, pb, wid); pb.dry = false; }
          pg8::gemm_phase<PB_OutProj, true>((PG8_LAS unsigned char*)lds, pb, wid); }
        if (l == 0) { GETP(); ph_prep_moe(p, l, lds, 1, 32); }
        GBAR(); TSTOP(6); TSTART(7);
        { GETP(); if (PROBE_DUP == 11) ph_router(p, l, lds + LDS_MISC, true); ph_router(p, l, lds + LDS_MISC); }
        GBAR(); TSTOP(7); TSTART(8);
        { GETP(); ALAS int* tb = (ALAS int*)(lds + LDS_MISC + 1024); moe_tiles_setup(p, l, tb);
          PB_Moe1 pb; pb.A = (const char*)(p.ws + WS_H); pb.ldb = D; pb.nt = D / 64; pb.W13 = (const char*)(p.ws + WS_W13); pb.HE = (bf16_t*)(p.ws + WS_Z); pb.LISTP = (const int*)(p.ws + WS_LISTP);
          pb.GP = (const float2*)(p.ws + WS_GP); pb.tb = tb; pb.G = gridDim.x; pb.c = blockIdx.x;
          pg8::gemm_phase<PB_Moe1, true>((PG8_LAS unsigned char*)lds, pb, wid);
          if (PROBE_DUP == 8) pg8::gemm_phase<PB_Moe1, true>((PG8_LAS unsigned char*)lds, pb, wid); }
        GBAR(); TSTOP(8); TSTART(9);
        { GETP(); ALAS int* tb = (ALAS int*)(lds + LDS_MISC + 1024);
          PB_Moe2 pb; pb.A = (const char*)(p.ws + WS_Z); pb.ldb = DE; pb.nt = 16; pb.W2 = (const char*)(p.ws + WS_W2); pb.D2 = (bf16_t*)(p.ws + WS_D2);
          pb.MODl = (const float*)(p.ws + WS_MOD) + (size_t)l * 9 * 6 * D; pb.LISTP = (const int*)(p.ws + WS_LISTP); pb.tb = tb; pb.G = gridDim.x; pb.c = blockIdx.x; pb.dry = false;
          if (PROBE_DUP == 15) { pb.dry = true; pg8::gemm_phase<PB_Moe2, true>((PG8_LAS unsigned char*)lds, pb, wid); pb.dry = false; }
          pg8::gemm_phase<PB_Moe2, true>((PG8_LAS unsigned char*)lds, pb, wid); }
        GBAR(); TSTOP(9);
    }
    TSTART(10);
    { GETP(); ph_final(p); }
    TSTOP(10);
    if (PROBE_T != 0 && blockIdx.x == 0 && wid == 0 && fresh_lane() == 0) { const unsigned long long t0 = __builtin_amdgcn_s_memrealtime(); const unsigned long long w = 10ull * tl[1]; while (__builtin_amdgcn_s_memrealtime() - t0 < w) __builtin_amdgcn_s_sleep(8); }
}

extern "C" void kernel_launch(void* const* d_in, const int* in_sizes, int n_in, void* d_out, int out_size, void* d_ws, size_t ws_size, hipStream_t stream) {
    if (n_in != N_IN || ws_size < WS_END) { fprintf(stderr, "kernel_launch: bad n_in %d or ws %zu < %zu\n", n_in, ws_size, (size_t)WS_END); return; }
    P p{};
    for (int i = 0; i < N_IN; ++i) p.in[i] = (const float*)d_in[i];
    p.out = (float*)d_out; p.ws = (unsigned char*)d_ws;
    (void)hipMemsetAsync((char*)d_ws + WS_CNT, 0, 16384, stream);
    void* args[] = {&p};
    static bool attr_set = false;
    if (!attr_set) { (void)hipFuncSetAttribute((const void*)fwd_kernel, hipFuncAttributeMaxDynamicSharedMemorySize, LDS_BYTES); attr_set = true; }
    hipError_t e = hipLaunchCooperativeKernel((void*)fwd_kernel, dim3(256), dim3(NT), args, LDS_BYTES, stream);
    if (e != hipSuccess) fprintf(stderr, "cooperative launch failed: %s\n", hipGetErrorString(e));
}
```

```cpp
#include <hip/hip_runtime.h>
#include <cstdio>
#include <cstdint>

constexpr int D = 1024, NB = 8, T = 2048, TC = 256, LB = T + TC  , R = NB * LB  ;
constexpr int NZ = 3072, NE = 16, DE = 512;
constexpr float EPS = 1e-6f;
constexpr int ZA_X = 0, ZA_G = 256, ZB_Q = 512, ZB_K = 768, ZB_V = 1024, ZC_U = 1280, ZC_V = 1536, ZD_Q = 1792, ZD_FF = 2048, ZD_FB = 2304, ZD_I = 2560, ZD_G = 2816;
enum { I_X = 0, I_C, I_CTX, I_CCTX, I_WADA, I_BADA, I_N1G, I_N2G, I_WIN, I_WOUT, I_CONVW, I_CONVB, I_WR, I_BR, I_WI, I_BI, I_LAM,
       I_DALAM, I_DASUB, I_SGNG, I_SGW, I_SGB, I_HGLB, I_HGNG, I_RW, I_RB, I_W1, I_W3, I_W2, I_FNG, N_IN };

typedef unsigned short bf16_t;
#define ALAS __attribute__((address_space(3)))
constexpr size_t MiB = 1u << 20;
constexpr size_t WS_MOD = 0;
constexpr size_t WS_CNT = 512 * 1024;
constexpr size_t WS_GP = 1 * MiB;
constexpr size_t WS_LISTP = WS_GP + (size_t)R * 8;
constexpr size_t WS_LRUWT = 768 * 1024;
constexpr size_t WS_ROPE = 4 * MiB + 512 * 1024;
constexpr size_t WS_SGW = 5 * MiB;
constexpr size_t WS_LRUAGG = 3 * MiB;
constexpr size_t WS_X = 8 * MiB;
constexpr size_t WS_H = WS_X + (size_t)R * D * 4;
constexpr size_t WS_Z = WS_H + (size_t)R * D * 2;
constexpr size_t WS_D1 = WS_Z + 64 * MiB;
constexpr size_t WS_Y = WS_Z + (size_t)R * NZ * 2;
constexpr size_t WS_D2 = WS_Y;
constexpr size_t WS_WIN = WS_Y + (size_t)R * D * 2;
constexpr size_t WS_WOUT = WS_WIN + 2 * (size_t)NZ * D * 2;
constexpr size_t WS_W13 = WS_WOUT + 2 * (size_t)D * D * 2;
constexpr size_t WS_W2 = WS_W13 + (size_t)NE * 1024 * D * 2;
constexpr size_t WS_END = WS_W2 + (size_t)NE * D * DE * 2;
constexpr int MPAD = R + 24 * 256;

struct P { const float* in[N_IN]; float* out; unsigned char* ws; int wid; int pad; };
__device__ __forceinline__ int fresh_lane() { int l_; asm volatile("v_mbcnt_lo_u32_b32 %0, -1, 0\n\tv_mbcnt_hi_u32_b32 %0, -1, %0" : "=v"(l_)); return l_; }


__device__ __forceinline__ float bf2f(bf16_t v) { return __uint_as_float(((unsigned)v) << 16); }
typedef float f32x2h_t __attribute__((ext_vector_type(2))); typedef __bf16 bf16x2h_t __attribute__((ext_vector_type(2)));
__device__ __forceinline__ unsigned pk2bf(float lo, float hi) { f32x2h_t v = {lo, hi}; bf16x2h_t b = __builtin_convertvector(v, bf16x2h_t); return __builtin_bit_cast(unsigned, b); }
__device__ __forceinline__ bf16_t f2bf(float f) { return (bf16_t)(pk2bf(f, f) & 0xffffu); }
__device__ __forceinline__ float sigmoidf_(float x) { return __builtin_amdgcn_rcpf(1.f + __expf(-x)); }
__device__ __forceinline__ float siluf_(float x) { return x * __builtin_amdgcn_rcpf(1.f + __expf(-x)); }
__device__ __forceinline__ float geluf_(float x) { const float u = 1.5957691216057308f * (x + 0.044715f * x * x * x); return x * __builtin_amdgcn_rcpf(1.f + __expf(-u)); }
__device__ __forceinline__ float wave_sum(float v) {
#pragma unroll
    for (int o = 1; o < 64; o <<= 1) v += __shfl_xor(v, o);
    return v;
}
__device__ __forceinline__ int row_mi(int r) { const int b = r / LB, j = r - b * LB; return j < TC ? 8 : b; }

#define NT 512
__device__ __forceinline__ const float* xin_row(const float* xin, const float* cin, int r) { const int b = r / LB, j = r - b * LB; return j < TC ? cin + ((size_t)b * TC + j) * D : xin + ((size_t)b * T + (j - TC)) * D; }
__device__ __forceinline__ int ustart(int off) { const int G = gridDim.x, b = blockIdx.x; const int v = (G % 8 == 0) ? (b % 8) * (G / 8) + b / 8 : b; return (v + off) % G; }
#define NWV 8
__device__ __forceinline__ void add_bf4(float (&x)[4], uint2 d) { x[0] += __uint_as_float(d.x << 16); x[1] += __uint_as_float(d.x & 0xffff0000u); x[2] += __uint_as_float(d.y << 16); x[3] += __uint_as_float(d.y & 0xffff0000u); }

__device__ __forceinline__ void ph_init(const P& p) {
    const int tidx = p.wid * 64 + fresh_lane();
    float* X = (float*)(p.ws + WS_X);
    const size_t n4 = (size_t)R * D / 4;
    const size_t stride = (size_t)gridDim.x * NT;
    const float* xin = p.in[I_X]; const float* cin = p.in[I_CTX];
#define INIT_SRC(i_) ({ const size_t e_ = (i_) * 4; const int r_ = (int)(e_ / D), c_ = (int)(e_ % D); const int b_ = r_ / LB, j_ = r_ - b_ * LB; \
        const size_t oc_ = ((size_t)b_ * TC + j_) * D + c_, ox_ = ((size_t)b_ * T + (j_ - TC)) * D + c_; (const float4*)((j_ < TC) ? (cin + oc_) : (xin + ox_)); })
    size_t i = (size_t)blockIdx.x * NT + tidx;
    for (; i + 3 * stride < n4; i += 4 * stride) {
        const float4 v0 = *INIT_SRC(i), v1 = *INIT_SRC(i + stride), v2 = *INIT_SRC(i + 2 * stride), v3 = *INIT_SRC(i + 3 * stride);
        *(float4*)(X + i * 4) = v0; *(float4*)(X + (i + stride) * 4) = v1; *(float4*)(X + (i + 2 * stride) * 4) = v2; *(float4*)(X + (i + 3 * stride) * 4) = v3;
    }
    for (; i < n4; i += stride) *(float4*)(X + i * 4) = *INIT_SRC(i);
#undef INIT_SRC
}

__device__ __forceinline__ void ph_mod(const P& p, float* sm_) {
    const int tidx = p.wid * 64 + fresh_lane();
    float* MOD = (float*)(p.ws + WS_MOD);
    ALAS float* sm = (ALAS float*)sm_; ALAS float* red = sm + 9 * D;
    for (int i = tidx; i < 9 * D; i += NT) { const int mi = i / D, k = i % D; const float c = mi < 8 ? p.in[I_C][mi * D + k] : p.in[I_CCTX][k]; sm[i] = siluf_(c); }
    __syncthreads();
    const int col = tidx & 63, part = tidx >> 6;
    for (int it = blockIdx.x; it < 2 * 96; it += gridDim.x) {
        const int l = it / 96, n0 = (it % 96) * 64;
        const float* W = p.in[I_WADA] + (size_t)l * D * 6 * D + (size_t)(part * 128) * 6 * D + n0 + col;
        float acc[9];
#pragma unroll
        for (int m = 0; m < 9; ++m) acc[m] = 0.f;
#pragma unroll 8
        for (int k = 0; k < 128; ++k) { const float w = W[(size_t)k * 6 * D];
#pragma unroll
            for (int m = 0; m < 9; ++m) acc[m] += sm[m * D + part * 128 + k] * w; }
#pragma unroll
        for (int m = 0; m < 9; ++m) red[(part * 9 + m) * 64 + col] = acc[m];
        __syncthreads();
        for (int o = tidx; o < 9 * 64; o += NT) { const int m = o >> 6, cc = o & 63; float v = p.in[I_BADA][l * 6 * D + n0 + cc];
#pragma unroll
            for (int q = 0; q < 8; ++q) v += red[(q * 9 + m) * 64 + cc];
            MOD[((size_t)l * 9 + m) * 6 * D + n0 + cc] = v; }
        __syncthreads();
    }
}

__device__ __forceinline__ void ph_norm1(const P& p, int l) {
    const int tidx = p.wid * 64 + fresh_lane();
    float* X = (float*)(p.ws + WS_X); bf16_t* H = (bf16_t*)(p.ws + WS_H); const float* xin = p.in[I_X]; const float* cin = p.in[I_CTX];
    const bf16_t* D1 = (const bf16_t*)(p.ws + WS_D1); const bf16_t* D2 = (const bf16_t*)(p.ws + WS_D2);
    const float* MOD = (const float*)(p.ws + WS_MOD) + (size_t)l * 9 * 6 * D; const float* g = p.in[I_N1G] + l * D;
    const int lane = tidx & 63, wv = tidx >> 6;
    const int stride = gridDim.x * NWV; const int r0 = blockIdx.x * NWV + wv;
    float4 gq[4];
#pragma unroll
    for (int q = 0; q < 4; ++q) gq[q] = *(const float4*)(g + (lane + 64 * q) * 4);
    for (int rb = r0; rb < R; rb += 9 * stride) {
        float4 vb[3][4]; uint2 d1b[3][4], d2b[3][4];
#define N1_LOAD(slot, k_) do { int rr_ = rb + (k_) * stride; rr_ = rr_ < R ? rr_ : rb; _Pragma("unroll") for (int q = 0; q < 4; ++q) { vb[slot][q] = *(const float4*)(xin_row(xin, cin, rr_) + (lane + 64 * q) * 4); \
            if (l == 1) { d1b[slot][q] = *(const uint2*)(D1 + (size_t)rr_ * D + (lane + 64 * q) * 4); d2b[slot][q] = *(const uint2*)(D2 + (size_t)rr_ * D + (lane + 64 * q) * 4); } } } while (0)
        N1_LOAD(0, 0); N1_LOAD(1, 1);
#pragma unroll
        for (int k = 0; k < 9; ++k) {
            const int r = rb + k * stride; const int sl = k % 3;
            const float* m = MOD + (size_t)row_mi(r < R ? r : rb) * 6 * D; float4 scq[4], shq[4];
#pragma unroll
            for (int q = 0; q < 4; ++q) { scq[q] = *(const float4*)(m + D + (lane + 64 * q) * 4); shq[q] = *(const float4*)(m + (lane + 64 * q) * 4); }
            if (k + 2 < 9) N1_LOAD((k + 2) % 3, k + 2);
            if (r < R) {
                float xv[4][4]; float ss = 0.f;
#pragma unroll
                for (int q = 0; q < 4; ++q) { xv[q][0] = vb[sl][q].x; xv[q][1] = vb[sl][q].y; xv[q][2] = vb[sl][q].z; xv[q][3] = vb[sl][q].w; if (l == 1) { add_bf4(xv[q], d1b[sl][q]); add_bf4(xv[q], d2b[sl][q]); } }
#pragma unroll
                for (int q = 0; q < 4; ++q) ss += xv[q][0] * xv[q][0] + xv[q][1] * xv[q][1] + xv[q][2] * xv[q][2] + xv[q][3] * xv[q][3];
                const float rs = rsqrtf(wave_sum(ss) * (1.f / D) + EPS);
#pragma unroll
                for (int q = 0; q < 4; ++q) { const int c = (lane + 64 * q) * 4; bf16_t o[4];
                    if (l == 1) *(float4*)(X + (size_t)r * D + c) = make_float4(xv[q][0], xv[q][1], xv[q][2], xv[q][3]);
                    const float4 g4 = gq[q], sc4 = scq[q], sh4 = shq[q];
                    const float gv[4] = {g4.x, g4.y, g4.z, g4.w}, scv[4] = {sc4.x, sc4.y, sc4.z, sc4.w}, shv[4] = {sh4.x, sh4.y, sh4.z, sh4.w};
#pragma unroll
                    for (int i = 0; i < 4; ++i) o[i] = f2bf(xv[q][i] * rs * gv[i] * (1.f + scv[i]) + shv[i]);
                    *(uint2*)(H + (size_t)r * D + c) = make_uint2((unsigned)o[0] | ((unsigned)o[1] << 16), (unsigned)o[2] | ((unsigned)o[3] << 16)); }
            }
        }
#undef N1_LOAD
    }
}

constexpr float QSCALE = 0.17677669529663687f * 1.4426950408889634f;
__device__ __forceinline__ void ph_rope_table(const P& p) {
    const int tidx = p.wid * 64 + fresh_lane();
    float2* TAB = (float2*)(p.ws + WS_ROPE);
    for (int it = blockIdx.x * NT + tidx; it < T * 16; it += gridDim.x * NT) { const int f = it & 7, a = (it >> 3) & 1, t = it >> 4;
        const float pos = (float)(a == 0 ? (t / 64) : (t % 64)); const float freq = expf(-(float)f * 0.125f * 9.210340371976184f); const float ang = pos * freq;
        TAB[it] = make_float2(cosf(ang), sinf(ang)); }
}
__device__ __forceinline__ void ph_rope(const P& p, int l) {
    const int tidx = p.wid * 64 + fresh_lane();
    bf16_t* Z = (bf16_t*)(p.ws + WS_Z); const float2* TAB = (const float2*)(p.ws + WS_ROPE);
    const int total = NB * T * 32;
    for (int it = blockIdx.x * NT + tidx; it < total; it += gridDim.x * NT) {
        const int pr = it & 31, rt = it >> 5; const int b = rt / T, t = rt % T;
        const int a = pr & 1, n = (pr >> 1) & 1, h = (pr >> 2) & 3, qk = pr >> 4;
        bf16_t* zp = Z + (size_t)(b * LB + TC + t) * NZ + (qk ? ZB_K : ZB_Q) + h * 64 + n * 32 + a * 16;
        const uint4 v1 = *(const uint4*)zp, v2 = *(const uint4*)(zp + 8); const unsigned w1[4] = {v1.x, v1.y, v1.z, v1.w}, w2[4] = {v2.x, v2.y, v2.z, v2.w};
        const float2* tb = TAB + (size_t)(t * 2 + a) * 8; const float sc = qk ? 1.f : QSCALE; unsigned o1[4], o2[4];
#pragma unroll
        for (int i = 0; i < 4; ++i) { const float2 cs0 = tb[2 * i], cs1 = tb[2 * i + 1];
            const float x1a = __uint_as_float(w1[i] << 16), x1b = __uint_as_float(w1[i] & 0xffff0000u), x2a = __uint_as_float(w2[i] << 16), x2b = __uint_as_float(w2[i] & 0xffff0000u);
            o1[i] = pk2bf((x1a * cs0.x - x2a * cs0.y) * sc, (x1b * cs1.x - x2b * cs1.y) * sc);
            o2[i] = pk2bf((x2a * cs0.x + x1a * cs0.y) * sc, (x2b * cs1.x + x1b * cs1.y) * sc); }
        *(uint4*)zp = make_uint4(o1[0], o1[1], o1[2], o1[3]); *(uint4*)(zp + 8) = make_uint4(o2[0], o2[1], o2[2], o2[3]);
    }
    if (l == 0) {
        const int totc = NB * TC * 256;
        for (int it = blockIdx.x * NT + tidx; it < totc; it += gridDim.x * NT) {
            const int c = it & 255, rt = it >> 8; const int b = rt / TC, j = rt % TC;
            bf16_t* zp = Z + (size_t)(b * LB + j) * NZ + ZB_Q + c; zp[0] = f2bf(bf2f(zp[0]) * QSCALE);
        }
    }
}

namespace lru {
typedef short bf16x8 __attribute__((ext_vector_type(8)));
typedef float f32x4 __attribute__((ext_vector_type(4)));
constexpr int UROW = 264;
__device__ __forceinline__ void comp(float& A, float& B, float a, float b) { B = a * B + b; A = a * A; }
}
__device__ __forceinline__ void ph_lru_m1(const P& p, int l, unsigned char* ldsb) {
    using namespace lru;
    const int lane = fresh_lane(), wid = p.wid, tid = wid * 64 + lane;
    const bf16_t* Z = (const bf16_t*)(p.ws + WS_Z); bf16_t* G = (bf16_t*)(p.ws + WS_H); float2* AGG = (float2*)(p.ws + WS_LRUAGG);
    const bf16_t* WT = (const bf16_t*)(p.ws + WS_LRUWT);
    const float* cw = p.in[I_CONVW] + l * 4 * 256; const float* cb = p.in[I_CONVB] + l * 256;
    ALAS bf16_t* U = (ALAS bf16_t*)ldsb;
    const int h = wid & 3, d = wid >> 2, l15 = lane & 15, g4 = lane >> 4;
    float spv[4], brv[4], biv[4];
#pragma unroll
    for (int jt = 0; jt < 4; ++jt) { const int w = h * 64 + jt * 16 + l15; spv[jt] = log1pf(expf(-p.in[I_LAM][(l * 2 + d) * 256 + w])); brv[jt] = p.in[I_BR][(l * 2 + d) * 256 + w]; biv[jt] = p.in[I_BI][(l * 2 + d) * 256 + w]; }
    for (int unit = ustart(192); unit < NB * 36; unit += gridDim.x) {
        const int b = unit / 36, c = unit % 36, r0 = b * LB + c * 64; const int lo = c < 4 ? 0 : TC, hi = c < 4 ? TC : LB;
        {
            uint4 zv[4][4];
#pragma unroll
            for (int it4 = 0; it4 < 4; ++it4) { const int item = tid + it4 * NT; const int t = item >> 5, cg = item & 31, j = c * 64 + t;
#pragma unroll
                for (int q = 0; q < 4; ++q) { int jj = j + q - 2; jj = jj < lo ? lo : (jj >= hi ? hi - 1 : jj); zv[it4][q] = *(const uint4*)(Z + (size_t)(b * LB + jj) * NZ + ZA_X + cg * 8); } }
#pragma unroll
            for (int it4 = 0; it4 < 4; ++it4) { const int item = tid + it4 * NT; const int t = item >> 5, cg = item & 31, j = c * 64 + t; float acc[8];
#pragma unroll
                for (int i = 0; i < 8; ++i) acc[i] = cb[cg * 8 + i];
#pragma unroll
                for (int q = 0; q < 4; ++q) { const int jj = j + q - 2; const float msk = (jj >= lo && jj < hi) ? 1.f : 0.f; const unsigned zw[4] = {zv[it4][q].x, zv[it4][q].y, zv[it4][q].z, zv[it4][q].w};
                    const float4 w0 = *(const float4*)(cw + q * 256 + cg * 8), w1 = *(const float4*)(cw + q * 256 + cg * 8 + 4); const float wv8[8] = {w0.x, w0.y, w0.z, w0.w, w1.x, w1.y, w1.z, w1.w};
#pragma unroll
                    for (int i = 0; i < 4; ++i) { acc[2 * i] += __uint_as_float(zw[i] << 16) * (wv8[2 * i] * msk); acc[2 * i + 1] += __uint_as_float(zw[i] & 0xffff0000u) * (wv8[2 * i + 1] * msk); } }
                uint4 o; o.x = pk2bf(acc[0], acc[1]); o.y = pk2bf(acc[2], acc[3]); o.z = pk2bf(acc[4], acc[5]); o.w = pk2bf(acc[6], acc[7]);
                { typedef unsigned u32x4_t __attribute__((ext_vector_type(4))); u32x4_t ov = {o.x, o.y, o.z, o.w}; *(ALAS u32x4_t*)(U + t * UROW + cg * 8) = ov; } }
        }
        __syncthreads();
        bf16x8 af[4][2];
#pragma unroll
        for (int tt = 0; tt < 4; ++tt)
#pragma unroll
            for (int ks = 0; ks < 2; ++ks) af[tt][ks] = *(const ALAS bf16x8*)(U + (16 * tt + l15) * UROW + h * 64 + 32 * ks + 8 * g4);
#pragma unroll 1
        for (int jt = 0; jt < 4; ++jt) {
            const float spj = jt == 0 ? spv[0] : jt == 1 ? spv[1] : jt == 2 ? spv[2] : spv[3], brj = jt == 0 ? brv[0] : jt == 1 ? brv[1] : jt == 2 ? brv[2] : brv[3], bij = jt == 0 ? biv[0] : jt == 1 ? biv[1] : jt == 2 ? biv[2] : biv[3];
            f32x4 ar[4], ai[4];
#pragma unroll
            for (int tt = 0; tt < 4; ++tt) { ar[tt] = (f32x4){0.f, 0.f, 0.f, 0.f}; ai[tt] = (f32x4){0.f, 0.f, 0.f, 0.f}; }
#pragma unroll
            for (int ks = 0; ks < 2; ++ks) { const bf16_t* wp = WT + ((size_t)(((l * 2 + d) * 2 + 0) * 4 + h) * 64 + 16 * jt + l15) * 64 + 32 * ks + 8 * g4; const bf16x8 wr = *(const bf16x8*)wp, wi = *(const bf16x8*)(wp + 4 * 64 * 64);
#pragma unroll
                for (int tt = 0; tt < 4; ++tt) { ar[tt] = __builtin_amdgcn_mfma_f32_16x16x32_bf16(af[tt][ks], wr, ar[tt], 0, 0, 0); ai[tt] = __builtin_amdgcn_mfma_f32_16x16x32_bf16(af[tt][ks], wi, ai[tt], 0, 0, 0); } }
            const int w = h * 64 + jt * 16 + l15; float mA[4], mB[4];
#pragma unroll
            for (int tt = 0; tt < 4; ++tt) { float A = 1.f, Bv = 0.f; float av[4], bv[4];
#pragma unroll
                for (int rg = 0; rg < 4; ++rg) { const int t = 16 * tt + 4 * g4 + rg;
                    const float rgt = sigmoidf_(ar[tt][rg] + brj), igt = sigmoidf_(ai[tt][rg] + bij);
                    const bf16_t lab = f2bf(-8.f * rgt * spj); const float a = __expf(bf2f(lab));
                    const float uu = bf2f(U[t * UROW + w]); const float bc = __builtin_amdgcn_sqrtf(fmaxf(1.f - a * a, 0.f)) * igt * uu;
                    const bf16_t bcb = f2bf(bc);
                    G[((size_t)(d * 2 + 0) * R + r0 + t) * 256 + w] = lab; G[((size_t)(d * 2 + 1) * R + r0 + t) * 256 + w] = bcb;
                    av[rg] = a; bv[rg] = bf2f(bcb); }
                if (d == 0) { comp(A, Bv, av[0], bv[0]); comp(A, Bv, av[1], bv[1]); comp(A, Bv, av[2], bv[2]); comp(A, Bv, av[3], bv[3]); }
                else { comp(A, Bv, av[3], bv[3]); comp(A, Bv, av[2], bv[2]); comp(A, Bv, av[1], bv[1]); comp(A, Bv, av[0], bv[0]); }
                mA[tt] = A; mB[tt] = Bv; }
            float A = 1.f, Bv = 0.f;
#pragma unroll
            for (int s4 = 0; s4 < 4; ++s4) { const int tt = d == 0 ? s4 : 3 - s4; const float ma = d == 0 ? mA[s4] : mA[3 - s4], mb = d == 0 ? mB[s4] : mB[3 - s4]; (void)tt;
#pragma unroll
                for (int gs = 0; gs < 4; ++gs) { const int gg = d == 0 ? gs : 3 - gs; const float a = __shfl(ma, gg * 16 + l15), bq = __shfl(mb, gg * 16 + l15); comp(A, Bv, a, bq); } }
            if (g4 == 0) AGG[((size_t)(b * 2 + d) * 36 + c) * 256 + w] = make_float2(A, Bv);
        }
        __syncthreads();
    }
}
__device__ __forceinline__ void ph_lru_m2(const P& p, int l, unsigned char* ldsb) {
    const int lane = fresh_lane(), wid = p.wid, tid = wid * 64 + lane;
    const bf16_t* Z = (const bf16_t*)(p.ws + WS_Z); const bf16_t* G = (const bf16_t*)(p.ws + WS_H); bf16_t* Y = (bf16_t*)(p.ws + WS_Y); const float2* AGG = (const float2*)(p.ws + WS_LRUAGG);
    ALAS float* HS = (ALAS float*)ldsb;
    const int d = tid >> 8, w = tid & 255;
    const int ncb = l == 1 ? 32 : 36, nun = NB * ncb;
    const int vme = ustart(0);
    for (int pass = 0; pass < 2; ++pass) {
        int unit;
        if (l == 1) unit = pass == 0 ? vme : -1;
        else if (pass == 0) unit = (vme >= 64 && vme < 96) ? -1 : (vme < 64 ? vme : vme - 32);
        else unit = (vme >= 96 && vme < 160) ? 224 + (vme - 96) : -1;
        if (unit < 0 || unit >= nun) continue;
        const int b = unit / ncb, c = (36 - ncb) + unit % ncb, r0 = b * LB + c * 64;
        float hst = 0.f; const float2* ag = AGG + (size_t)(b * 2 + d) * 36 * 256 + w;
        {
            const int pos = d == 0 ? c : (c < 4 ? 3 - c : 4 + (35 - c));
            float mx[36], my[36];
#pragma unroll
            for (int k = 0; k < 36; ++k) { const int cc = d == 0 ? k : (k < 4 ? 3 - k : 39 - k); const float2 m = ag[cc * 256]; mx[k] = m.x; my[k] = m.y; }
#pragma unroll
            for (int k = 0; k < 36; ++k) { const bool vf = k < pos; const float a = vf ? mx[k] : 1.f, bq = vf ? my[k] : 0.f; hst = __builtin_fmaf(a, hst, bq); }
        }
        const bf16_t* gl = G + ((size_t)(d * 2 + 0) * R + r0) * 256 + w; const bf16_t* gb = G + ((size_t)(d * 2 + 1) * R + r0) * 256 + w;
#pragma unroll 1
        for (int s0 = 0; s0 < 64; s0 += 32) {
            bf16_t la[32], lb[32];
#pragma unroll
            for (int i = 0; i < 32; ++i) { const int t = d == 0 ? (s0 + i) : 63 - (s0 + i); la[i] = gl[t * 256]; lb[i] = gb[t * 256]; }
#pragma unroll
            for (int i = 0; i < 32; ++i) { const int t = d == 0 ? (s0 + i) : 63 - (s0 + i); hst = __expf(bf2f(la[i])) * hst + bf2f(lb[i]); HS[(d * 64 + t) * 256 + w] = hst; }
        }
        __syncthreads();
#pragma unroll
        for (int q = 0; q < 4; ++q) { const int it = tid + q * NT; const int t = it >> 5, c8 = (it & 31) * 8;
            const uint4 zv = *(const uint4*)(Z + (size_t)(r0 + t) * NZ + ZA_G + c8); const unsigned zw[4] = {zv.x, zv.y, zv.z, zv.w}; unsigned o[4];
#pragma unroll
            for (int i = 0; i < 4; ++i) { const float h0 = HS[t * 256 + c8 + 2 * i] + HS[(64 + t) * 256 + c8 + 2 * i], h1 = HS[t * 256 + c8 + 2 * i + 1] + HS[(64 + t) * 256 + c8 + 2 * i + 1];
                o[i] = pk2bf(h0 * geluf_(__uint_as_float(zw[i] << 16)), h1 * geluf_(__uint_as_float(zw[i] & 0xffff0000u))); }
            *(uint4*)(Y + (size_t)(r0 + t) * D + c8) = make_uint4(o[0], o[1], o[2], o[3]); }
        __syncthreads();
    }
}

__device__ __forceinline__ void ph_sg(const P& p, int l, unsigned char* ldsb) {
    typedef short bf16x8 __attribute__((ext_vector_type(8))); typedef float f32x16 __attribute__((ext_vector_type(16)));
    const int lane = fresh_lane(), wid = p.wid, tid = wid * 64 + lane, r32 = lane & 31, hi = lane >> 5;
    const bf16_t* Z = (const bf16_t*)(p.ws + WS_Z); bf16_t* Y = (bf16_t*)(p.ws + WS_Y); const bf16_t* SGW = (const bf16_t*)(p.ws + WS_SGW) + (size_t)l * 4 * 128 * 128;
    const float* ng = p.in[I_SGNG] + l * 256;
    ALAS bf16_t* VT = (ALAS bf16_t*)ldsb;
    constexpr int VROW = 136;
    const int q = tid >> 2, part = tid & 3, ptile = wid & 3, chalf = wid >> 2;
    const int nck = l == 1 ? 16 : 18;
    const int vme = ustart(0), nun_sg = NB * nck * 4;
    for (int pass = 0; pass < 3; ++pass) {
        int unit;
        if (pass == 0) unit = vme;
        else if (pass == 1) unit = (vme >= 64 && vme < 96) ? -1 : 256 + (vme < 64 ? vme : vme - 32);
        else unit = (vme >= 160 && vme < 192) ? 480 + (vme - 160) : (vme < 64 ? 512 + vme : -1);
        if (unit < 0 || unit >= nun_sg) continue;
        const int h = unit & 3, bc = unit >> 2, b = bc / nck, ck = (18 - nck) + bc % nck;
        const int r0 = b * LB + ck * 128;
        bf16x8 wf[8];
        { const bf16_t* wp = SGW + ((size_t)h * 128 + 32 * ptile + r32) * 128 + 8 * hi;
#pragma unroll
          for (int ks = 0; ks < 8; ++ks) wf[ks] = *(const bf16x8*)(wp + 16 * ks); }
        { const bf16_t* zv = Z + (size_t)(r0 + q) * NZ + ZC_V + part * 64; uint4 raw[8]; float ss = 0.f;
#pragma unroll
          for (int i = 0; i < 8; ++i) raw[i] = *(const uint4*)(zv + 8 * i);
#pragma unroll
          for (int i = 0; i < 8; ++i) { const unsigned w4[4] = {raw[i].x, raw[i].y, raw[i].z, raw[i].w};
#pragma unroll
              for (int k = 0; k < 4; ++k) { const float g0 = geluf_(__uint_as_float(w4[k] << 16)), g1 = geluf_(__uint_as_float(w4[k] & 0xffff0000u)); ss += g0 * g0 + g1 * g1; } }
          ss += __shfl_xor(ss, 1); ss += __shfl_xor(ss, 2);
          const float rs = rsqrtf(ss * (1.f / 256.f) + EPS);
          if (part == h) {
#pragma unroll
              for (int i = 0; i < 8; ++i) { const unsigned w4[4] = {raw[i].x, raw[i].y, raw[i].z, raw[i].w};
#pragma unroll
                  for (int k = 0; k < 4; ++k) { const int c = 8 * i + 2 * k;
                      VT[c * VROW + q] = f2bf(geluf_(__uint_as_float(w4[k] << 16)) * rs * ng[h * 64 + c]);
                      VT[(c + 1) * VROW + q] = f2bf(geluf_(__uint_as_float(w4[k] & 0xffff0000u)) * rs * ng[h * 64 + c + 1]); } } } }
        __syncthreads();
        f32x16 acc = f32x16{};
#pragma unroll
        for (int ks = 0; ks < 8; ++ks) { const bf16x8 vf = *(const ALAS bf16x8*)(VT + (32 * chalf + r32) * VROW + 16 * ks + 8 * hi); acc = __builtin_amdgcn_mfma_f32_32x32x16_bf16(wf[ks], vf, acc, 0, 0, 0); }
        { const float* bsp = p.in[I_SGB] + (l * 4 + h) * 128 + 32 * ptile + 4 * hi; bf16_t zu[16];
          const size_t rb = (size_t)(r0 + 32 * ptile + 4 * hi);
#pragma unroll
          for (int r = 0; r < 16; ++r) { const int pr = (r & 3) + 8 * (r >> 2); zu[r] = Z[(rb + pr) * NZ + ZC_U + h * 64 + 32 * chalf + r32]; }
#pragma unroll
          for (int r = 0; r < 16; ++r) { const int pr = (r & 3) + 8 * (r >> 2); Y[(rb + pr) * D + 512 + h * 64 + 32 * chalf + r32] = f2bf(geluf_(bf2f(zu[r])) * (acc[r] + bsp[pr])); } }
        __syncthreads();
    }
}

namespace att {
typedef short bf16x8 __attribute__((ext_vector_type(8)));
typedef short s16x4 __attribute__((ext_vector_type(4)));
typedef float f32x16 __attribute__((ext_vector_type(16)));
typedef float f32x2_t __attribute__((ext_vector_type(2))); typedef __bf16 bf16x2_t __attribute__((ext_vector_type(2)));
constexpr int SLOTB = 8192, NSLOT = 3, L_K = 0, L_V = NSLOT * SLOTB, L_WS = 2 * NSLOT * SLOTB, L_OST = L_WS + 8 * 2 * 32 * 4, OST_W = 32 * 66 * 4;
constexpr float THR = 8.f;
__device__ __forceinline__ int crow(int r, int hi) { return (r & 3) + 8 * (r >> 2) + 4 * hi; }
__device__ __forceinline__ unsigned cvtpk(float lo, float hi) { f32x2_t v = {lo, hi}; bf16x2_t b = __builtin_convertvector(v, bf16x2_t); return __builtin_bit_cast(unsigned, b); }
__device__ __forceinline__ float max3f(float a, float b, float c) { float r; asm("v_max3_f32 %0, %1, %2, %3" : "=v"(r) : "v"(a), "v"(b), "v"(c)); return r; }
__device__ __forceinline__ float swapmax(float m) { auto rr = __builtin_amdgcn_permlane32_swap(__float_as_uint(m), __float_as_uint(m), false, false); return fmaxf(__uint_as_float(rr[0]), __uint_as_float(rr[1])); }
__device__ __forceinline__ float swapadd(float m) { auto rr = __builtin_amdgcn_permlane32_swap(__float_as_uint(m), __float_as_uint(m), false, false); return __uint_as_float(rr[0]) + __uint_as_float(rr[1]); }
typedef short v4i16_t __attribute__((ext_vector_type(4)));
__device__ __forceinline__ void glds16(const void* gsrc, unsigned lds_dst) { unsigned keep;
  asm volatile("s_mov_b32 %0, m0\n\ts_mov_b32 m0, %2\n\ts_nop 0\n\tglobal_load_lds_dwordx4 %1, off\n\ts_mov_b32 m0, %0" : "=&s"(keep) : "v"(gsrc), "s"(lds_dst) : "memory"); }
__device__ __forceinline__ s16x4 vtr(const ALAS char* q) { return __builtin_bit_cast(s16x4, __builtin_amdgcn_ds_read_tr16_b64_v4i16((ALAS v4i16_t*)q)); }
}
__device__ __forceinline__ void ph_attn(const P& p, int l, unsigned char* ldsb) {
    using namespace att;
    const int lane = fresh_lane(), wid = p.wid, r32 = lane & 31, hi = lane >> 5;
    const bf16_t* Z = (const bf16_t*)(p.ws + WS_Z); bf16_t* Y = (bf16_t*)(p.ws + WS_Y);
    const float lam_init = l == 0 ? 0.2f : (0.8f - 0.6f * 0.7408182206817179f);
    const float* dl_ = p.in[I_DALAM] + l * 4 * 32; float s01 = 0.f, s23 = 0.f;
    for (int i = 0; i < 32; ++i) { s01 += dl_[i] * dl_[32 + i]; s23 += dl_[64 + i] * dl_[96 + i]; }
    const float lam = expf(s01) - expf(s23) + lam_init;
    const float* subg = p.in[I_DASUB] + l * 64;
    const int G = gridDim.x, bx = blockIdx.x, vcu = (G % 8 == 0) ? (bx % 8) * (G / 8) + bx / 8 : bx;
    const int nun = 256 + (l == 0 ? 32 : 0);
    ALAS char* L3 = (ALAS char*)ldsb; const unsigned lds0 = (unsigned)(size_t)L3;
    ALAS float* wsf = (ALAS float*)(L3 + L_WS) + wid * 64;
    ALAS float* stg = (ALAS float*)(L3 + L_OST + wid * OST_W);
    const ALAS char* kp0 = L3 + L_K + hi * 1024 + r32 * 16;
    const ALAS char* vp0 = L3 + L_V + ((lane >> 4) & 1) * 32 + (lane & 3) * 8 + (4 * hi + ((lane & 15) >> 2)) * 64;
    for (int u = vcu; u < nun; u += G) {
        int b, h, q0row, nt;
        if (u < 256) { b = u >> 5; h = (u >> 3) & 3; q0row = b * LB + TC + (u & 7) * 256; nt = LB / 64; } else { const int v = u - 256; b = v >> 2; h = v & 3; q0row = b * LB; nt = TC / 64; }
        const bf16_t* ksrc = Z + (size_t)(b * LB + lane) * NZ + ZB_K + h * 64 + wid * 8;
        const bf16_t* vsrc = Z + (size_t)(b * LB + 16 * (wid & 3) + (lane >> 2)) * NZ + ZB_V + h * 64 + (wid >> 2) * 32 + (lane & 3) * 8;
#define ATT_DMA(t, slot) do { att::glds16(ksrc + (size_t)(t) * 64 * NZ, (unsigned)__builtin_amdgcn_readfirstlane((int)(lds0 + L_K + (slot) * SLOTB + wid * 1024))); \
                              att::glds16(vsrc + (size_t)(t) * 64 * NZ, (unsigned)__builtin_amdgcn_readfirstlane((int)(lds0 + L_V + (slot) * SLOTB + wid * 1024))); } while (0)
        ATT_DMA(0, 0); ATT_DMA(1, 1);
        bf16x8 qr[4];
        { const bf16_t* qp = Z + (size_t)(q0row + wid * 32 + r32) * NZ + ZB_Q + h * 64 + hi * 8;
#pragma unroll
          for (int d0 = 0; d0 < 4; ++d0) qr[d0] = *(const bf16x8*)(qp + d0 * 16); }
        f32x16 o[2][2], negm[2]; float mrun[2] = {0.f, 0.f}, lsum[2] = {0.f, 0.f};
#pragma unroll
        for (int n = 0; n < 2; ++n) { negm[n] = f32x16{}; o[n][0] = f32x16{}; o[n][1] = f32x16{}; }
        asm volatile("s_waitcnt vmcnt(0)" : "+v"(qr[0]), "+v"(qr[1]), "+v"(qr[2]), "+v"(qr[3]) :: "memory"); __syncthreads();
        int slot = 0; int t = 0;
#define ATT_TILE(FIRST) do { \
            if (t + 2 < nt) { const int s2 = slot == 0 ? 2 : slot - 1; ATT_DMA(t + 2, s2); } \
            const int so = slot * SLOTB; \
            f32x16 cc[2][2]; \
            _Pragma("unroll") \
            for (int n = 0; n < 2; ++n) { \
                const bf16x8 k00 = *(const ALAS bf16x8*)(kp0 + so + (2 * n) * 2048), k01 = *(const ALAS bf16x8*)(kp0 + so + (2 * n) * 2048 + 512); \
                const bf16x8 k10 = *(const ALAS bf16x8*)(kp0 + so + (2 * n + 1) * 2048), k11 = *(const ALAS bf16x8*)(kp0 + so + (2 * n + 1) * 2048 + 512); \
                cc[n][0] = __builtin_amdgcn_mfma_f32_32x32x16_bf16(k00, qr[2 * n], negm[n], 0, 0, 0); \
                cc[n][1] = __builtin_amdgcn_mfma_f32_32x32x16_bf16(k01, qr[2 * n], negm[n], 0, 0, 0); \
                cc[n][0] = __builtin_amdgcn_mfma_f32_32x32x16_bf16(k10, qr[2 * n + 1], cc[n][0], 0, 0, 0); \
                cc[n][1] = __builtin_amdgcn_mfma_f32_32x32x16_bf16(k11, qr[2 * n + 1], cc[n][1], 0, 0, 0); \
            } \
            _Pragma("unroll") \
            for (int n = 0; n < 2; ++n) { \
                bf16x8 pa[4]; \
                f32x16 c0 = cc[n][0], c1 = cc[n][1]; \
                asm volatile("s_nop 15\n\ts_nop 7" : "+v"(c0), "+v"(c1));      \
                float rm = max3f(c0[0], c1[0], c0[1]), rm2 = max3f(c1[1], c0[2], c1[2]); \
            _Pragma("unroll") \
                for (int r = 3; r < 15; r += 2) { rm = max3f(rm, c0[r], c1[r]); rm2 = max3f(rm2, c0[r + 1], c1[r + 1]); } \
                rm = max3f(rm, rm2, c0[15]); rm = max3f(rm, c1[15], c1[15]); \
                rm = swapmax(rm); \
                if (FIRST || __builtin_expect(__any(rm > THR), 0)) { \
                    const float dl = FIRST ? rm : fmaxf(rm, 0.f); mrun[n] += dl; \
            _Pragma("unroll") \
                    for (int r = 0; r < 16; ++r) { c0[r] -= dl; c1[r] -= dl; negm[n][r] = -mrun[n]; } \
                    const float f = exp2f(-dl); lsum[n] *= f; \
                    if (hi == 0) wsf[n * 32 + r32] = f; \
            _Pragma("unroll") \
                    for (int r = 0; r < 16; ++r) { const float ff = wsf[n * 32 + crow(r, hi)]; o[n][0][r] *= ff; o[n][1][r] *= ff; } \
                } \
                float sacc = 0.f; \
            _Pragma("unroll") \
                for (int r = 0; r < 16; ++r) { c0[r] = __builtin_amdgcn_exp2f(c0[r]); c1[r] = __builtin_amdgcn_exp2f(c1[r]); sacc += c0[r] + c1[r]; } \
                lsum[n] += sacc; \
            _Pragma("unroll") \
                for (int k = 0; k < 2; ++k) { \
                    uint4 q0 = make_uint4(cvtpk(c0[8 * k], c0[8 * k + 1]), cvtpk(c0[8 * k + 2], c0[8 * k + 3]), cvtpk(c0[8 * k + 4], c0[8 * k + 5]), cvtpk(c0[8 * k + 6], c0[8 * k + 7])); \
                    uint4 q1 = make_uint4(cvtpk(c1[8 * k], c1[8 * k + 1]), cvtpk(c1[8 * k + 2], c1[8 * k + 3]), cvtpk(c1[8 * k + 4], c1[8 * k + 5]), cvtpk(c1[8 * k + 6], c1[8 * k + 7])); \
                    pa[k] = __builtin_bit_cast(bf16x8, q0); pa[2 + k] = __builtin_bit_cast(bf16x8, q1); } \
            _Pragma("unroll") \
                for (int d0 = 0; d0 < 2; ++d0) { \
                    bf16x8 vf[4]; \
            _Pragma("unroll") \
                    for (int k = 0; k < 4; ++k) { const s16x4 lo = vtr(vp0 + so + d0 * 4096 + k * 1024), hh = vtr(vp0 + so + d0 * 4096 + k * 1024 + 512); \
                        vf[k] = (bf16x8){lo[0], lo[1], lo[2], lo[3], hh[0], hh[1], hh[2], hh[3]}; } \
            _Pragma("unroll") \
                    for (int k = 0; k < 4; ++k) o[n][d0] = __builtin_amdgcn_mfma_f32_32x32x16_bf16(pa[k], vf[k], o[n][d0], 0, 0, 0); \
                } \
            } \
            if (t + 2 < nt) asm volatile("s_waitcnt vmcnt(2)" ::: "memory"); else asm volatile("s_waitcnt vmcnt(0)" ::: "memory"); \
            __builtin_amdgcn_s_barrier(); asm volatile("" ::: "memory"); \
            slot = slot == 2 ? 0 : slot + 1; \
        } while (0)
        ATT_TILE(true);
        for (t = 1; t < nt; ++t) ATT_TILE(false);
#undef ATT_TILE
        { const float l1 = swapadd(lsum[0]), l2 = swapadd(lsum[1]);
          const int lane_e = fresh_lane(); const int r32 = lane_e & 31, hi = lane_e >> 5, lane = lane_e;
          ALAS float* wsf = (ALAS float*)(L3 + L_WS) + wid * 64; ALAS float* stg = (ALAS float*)(L3 + L_OST + wid * OST_W);
          if (hi == 0) { wsf[r32] = __builtin_amdgcn_rcpf(l1); wsf[32 + r32] = lam * __builtin_amdgcn_rcpf(l2); }
#pragma unroll
          for (int r = 0; r < 16; ++r) { const int q = crow(r, hi); const float a = wsf[q], bb = wsf[32 + q];
              stg[q * 66 + r32] = o[0][0][r] * a - o[1][0][r] * bb; stg[q * 66 + 32 + r32] = o[0][1][r] * a - o[1][1][r] * bb; }
          const int row = lane >> 1, half = lane & 1; float ov[32]; float ss = 0.f;
#pragma unroll
          for (int i = 0; i < 32; ++i) { ov[i] = stg[row * 66 + half * 32 + i]; ss += ov[i] * ov[i]; }
          ss += __shfl_xor(ss, 1);
          const float rs = rsqrtf(ss * (1.f / 64.f) + EPS) * (1.f - lam_init);
          bf16_t* yo = Y + (size_t)(q0row + wid * 32 + row) * D + 256 + h * 64 + half * 32;
#pragma unroll
          for (int i = 0; i < 4; ++i) { unsigned w[4];
#pragma unroll
              for (int k = 0; k < 4; ++k) w[k] = cvtpk(ov[8 * i + 2 * k] * rs * subg[half * 32 + 8 * i + 2 * k], ov[8 * i + 2 * k + 1] * rs * subg[half * 32 + 8 * i + 2 * k + 1]);
              *(uint4*)(yo + 8 * i) = make_uint4(w[0], w[1], w[2], w[3]); } }
        __syncthreads();
#undef ATT_DMA
    }
}


namespace hg {
typedef short bf16x8 __attribute__((ext_vector_type(8)));
typedef short s16x4 __attribute__((ext_vector_type(4)));
typedef float f32x16 __attribute__((ext_vector_type(16)));
typedef float f32x4v __attribute__((ext_vector_type(4)));
constexpr int QROW = 72;
constexpr int W_Q = 0, W_K = 4608, W_KH = 9216, W_V = 13312, W_BYTES = 17408;
constexpr int L_ST = 8 * W_BYTES;
constexpr int STROW = 68, L_BS = L_ST + 64 * STROW * 4;
constexpr int AGG_FLOATS = 64 * 64 + 64;
__device__ __forceinline__ int img_off(int s, int col) { return ((col >> 5) * 2 + (s >> 4)) * 1024 + (s & 15) * 64 + (col & 31) * 2; }
}
constexpr int LDS_MISC = hg::L_BS + 256;
constexpr int LDS_MISC_HGB = LDS_MISC + 2560;
template <int PASS>
__device__ __forceinline__ void ph_hg(const P& p, int l, unsigned char* ldsb) {
    using namespace hg;
    const int wid = p.wid;
    const bf16_t* Z = (const bf16_t*)(p.ws + WS_Z); bf16_t* Y = (bf16_t*)(p.ws + WS_Y); float* AGG = (float*)p.out;
    ALAS char* L3 = (ALAS char*)ldsb; ALAS char* LW = L3 + wid * W_BYTES;
    ALAS float* ST = (ALAS float*)(L3 + L_ST); ALAS float* BS = (ALAS float*)(L3 + L_BS);
    const float* gn = p.in[I_HGNG] + l * 256;
    const int nsc = (PASS == 2 && l == 1) ? 8 : 9;
    const int nunits = PASS == 1 ? NB * 4 * 9 * 2 : NB * 4 * nsc;
    for (int unit = ustart(PASS == 1 ? 160 : 192); unit < nunits; unit += gridDim.x) {
        const int uu = PASS == 1 ? unit >> 1 : unit; const int d_lo = PASS == 1 ? (unit & 1) : 0, d_hi = PASS == 1 ? (unit & 1) + 1 : 2;
        const int sc = (9 - nsc) + uu % nsc, bh = uu / nsc, h = bh & 3, b = bh >> 2;
        const int lane = fresh_lane();
        const int tid = wid * 64 + lane, r32 = lane & 31, hi = lane >> 5;
        const ALAS char* trb = LW + ((lane >> 4) & 1) * 32 + (lane & 3) * 8 + (4 * hi + ((lane & 15) >> 2)) * 64;
        float* OSG = (float*)p.out + (size_t)4 * 1024 * 1024 + (size_t)blockIdx.x * 16384;
#pragma unroll 1
        for (int d = d_lo; d < d_hi; ++d) {
            float lb = 0.f;
            if (l == 1) { const float* hl = p.in[I_HGLB] + (size_t)d * 2 * 256 + h * 64 + lane; lb = sigmoidf_(hl[256] - hl[0]); }
            const int fcol = (d == 0 ? ZD_FF : ZD_FB) + h * 64 + lane;
            const int jbase = b * LB + sc * 256;
            { const float* ag = AGG + (size_t)((b * 4 + h) * 2 + d) * 9 * AGG_FLOATS; const int dd = tid & 63;
              float sv[8];
#pragma unroll
              for (int i = 0; i < 8; ++i) sv[i] = 0.f;
              if (PASS == 2) {
#pragma unroll
                  for (int k = 0; k < 8; ++k) { const int ai = d == 0 ? k : (k == 0 ? 0 : 9 - k); const bool valid = d == 0 ? (k < sc) : (k == 0 ? (sc > 0) : (ai > sc)); const int ac = valid ? ai : 0;
                      const float dv = valid ? __expf(ag[(size_t)ac * AGG_FLOATS + 4096 + dd]) : 1.f;
#pragma unroll
                      for (int i = 0; i < 8; ++i) { const float s_ = ag[(size_t)ac * AGG_FLOATS + tid + 512 * i]; sv[i] = dv * sv[i] + (valid ? s_ : 0.f); } } }
#pragma unroll
              for (int i = 0; i < 8; ++i) { const int e = tid + 512 * i; ST[(e >> 6) * STROW + (e & 63)] = sv[i]; }
              if (tid < 64) BS[tid] = 0.f; }
            {   typedef unsigned u32x4s __attribute__((ext_vector_type(4)));
                const int tk = lane >> 3, c8 = (lane & 7) * 8;
                u32x4s rv[4], rf[4], rq[4];
#pragma unroll
                for (int g = 0; g < 4; ++g) { const int tau = 8 * g + tk; const int jl = d == 0 ? (32 * wid + tau) : (255 - 32 * wid - tau); const bf16_t* zr = Z + (size_t)(jbase + jl) * NZ + h * 64 + c8;
                    rv[g] = *(const u32x4s*)(zr + ZD_I); rf[g] = *(const u32x4s*)(zr + (d == 0 ? ZD_FF : ZD_FB)); if (PASS == 2) rq[g] = *(const u32x4s*)(zr + ZD_Q); }
#pragma unroll
                for (int g = 0; g < 4; ++g) { const int tau = 8 * g + tk;
                    *(ALAS u32x4s*)(LW + W_V + img_off(tau, c8)) = rv[g];
                    *(ALAS u32x4s*)(LW + W_K + (tau * QROW + c8) * 2) = rf[g];
                    if (PASS == 2) *(ALAS u32x4s*)(LW + W_Q + (tau * QROW + c8) * 2) = rq[g]; }
            }
            float gl[32]; float Btot = 0.f;
#pragma unroll
            for (int tau = 0; tau < 32; ++tau) { const float f = lb + (1.f - lb) * sigmoidf_(bf2f(*(const ALAS bf16_t*)(LW + W_K + (tau * QROW + lane) * 2))); gl[tau] = fmaxf(__logf(f), -80.f); Btot += gl[tau]; }
            { float run = 0.f;
#pragma unroll
              for (int tau = 0; tau < 32; ++tau) { run += gl[tau]; const float kk = 1.f - __expf(gl[tau]);
                *(ALAS bf16_t*)(LW + W_KH + img_off(tau, lane)) = f2bf(kk * __expf(Btot - run));
                if (PASS == 2) { ALAS bf16_t* qp = (ALAS bf16_t*)(LW + W_Q + (tau * QROW + lane) * 2); *qp = f2bf(bf2f(*qp) * 0.125f * __expf(run));
                                 *(ALAS bf16_t*)(LW + W_K + (tau * QROW + lane) * 2) = f2bf(kk * __expf(fminf(-run, 80.f))); } } }
            f32x16 sl[2][2];
#pragma unroll
            for (int cv = 0; cv < 2; ++cv)
#pragma unroll
                for (int cd = 0; cd < 2; ++cd) sl[cv][cd] = f32x16{};
            bf16x8 vfr[2][2];
#pragma unroll
            for (int ks = 0; ks < 2; ++ks)
#pragma unroll
                for (int ch = 0; ch < 2; ++ch) { const s16x4 lo = att::vtr(trb + W_V + (ch * 2 + ks) * 1024), hh = att::vtr(trb + W_V + (ch * 2 + ks) * 1024 + 512);
                    vfr[ks][ch] = (bf16x8){lo[0], lo[1], lo[2], lo[3], hh[0], hh[1], hh[2], hh[3]}; }
#pragma unroll
            for (int ks = 0; ks < 2; ++ks)
#pragma unroll
                for (int cd = 0; cd < 2; ++cd) { const s16x4 lo = att::vtr(trb + W_KH + (cd * 2 + ks) * 1024), hh = att::vtr(trb + W_KH + (cd * 2 + ks) * 1024 + 512);
                    const bf16x8 kf = (bf16x8){lo[0], lo[1], lo[2], lo[3], hh[0], hh[1], hh[2], hh[3]};
#pragma unroll
                    for (int cv = 0; cv < 2; ++cv) sl[cv][cd] = __builtin_amdgcn_mfma_f32_32x32x16_bf16(vfr[ks][cv], kf, sl[cv][cd], 0, 0, 0); }
            f32x16 o[2]; o[0] = f32x16{}; o[1] = f32x16{};
            bf16x8 qf[4];
            if (PASS == 2) {
                f32x16 c = f32x16{};
#pragma unroll
                for (int d0 = 0; d0 < 4; ++d0) { qf[d0] = *(const ALAS bf16x8*)(LW + W_Q + (r32 * QROW + 16 * d0 + 8 * hi) * 2);
                    const bf16x8 kf = *(const ALAS bf16x8*)(LW + W_K + (r32 * QROW + 16 * d0 + 8 * hi) * 2);
                    c = __builtin_amdgcn_mfma_f32_32x32x16_bf16(kf, qf[d0], c, 0, 0, 0); }
#pragma unroll
                for (int r = 0; r < 16; ++r) { const int srow = att::crow(r, hi); if (srow > r32) c[r] = 0.f; }
#pragma unroll
                for (int ks = 0; ks < 2; ++ks) { const uint4 q4 = make_uint4(att::cvtpk(c[8 * ks], c[8 * ks + 1]), att::cvtpk(c[8 * ks + 2], c[8 * ks + 3]), att::cvtpk(c[8 * ks + 4], c[8 * ks + 5]), att::cvtpk(c[8 * ks + 6], c[8 * ks + 7]));
                    const bf16x8 pa = __builtin_bit_cast(bf16x8, q4);
                    o[0] = __builtin_amdgcn_mfma_f32_32x32x16_bf16(pa, vfr[ks][0], o[0], 0, 0, 0); o[1] = __builtin_amdgcn_mfma_f32_32x32x16_bf16(pa, vfr[ks][1], o[1], 0, 0, 0); }
            }
            if constexpr (PASS == 1) {
            __syncthreads();
            ALAS float* SL = (ALAS float*)LW; ALAS float* BARR = (ALAS float*)(L3 + LDS_MISC_HGB); ALAS float* DARR = BARR + 8 * 64;
            float Bacc = Btot;
            int sbase = (4 * hi) * STROW + r32; asm volatile("" : "+v"(sbase));
#pragma unroll
            for (int cv = 0; cv < 2; ++cv)
#pragma unroll
                for (int cd = 0; cd < 2; ++cd)
#pragma unroll
                    for (int r = 0; r < 16; ++r) SL[sbase + (32 * cv + (r & 3) + 8 * (r >> 2)) * STROW + 32 * cd] = sl[cv][cd][r];
            BARR[wid * 64 + lane] = Bacc;
            __syncthreads();
            {
                float spA[16], spB[16]; float bp = 0.f, dkq[2] = {1.f, 1.f};
#define HG_RD(dst, cv_, cd_, sh_) do { if (wid >= (sh_)) { const ALAS float* PS_ = (const ALAS float*)(L3 + (wid - (sh_)) * W_BYTES); _Pragma("unroll") for (int r = 0; r < 16; ++r) \
                    dst[r] = PS_[sbase + (32 * (cv_) + (r & 3) + 8 * (r >> 2)) * STROW + 32 * (cd_)]; } } while (0)
#define HG_WR(src, cv_, cd_, sh_) do { if (wid >= (sh_)) { _Pragma("unroll") for (int r = 0; r < 16; ++r) { sl[cv_][cd_][r] = dkq[cd_] * src[r] + sl[cv_][cd_][r]; \
                    SL[sbase + (32 * (cv_) + (r & 3) + 8 * (r >> 2)) * STROW + 32 * (cd_)] = sl[cv_][cd_][r]; } } } while (0)
#define HG_STEP_BEGIN(sh_) do { if (wid >= (sh_)) { bp = BARR[(wid - (sh_)) * 64 + lane]; const float dk_ = __expf(Bacc); dkq[0] = __shfl(dk_, r32); dkq[1] = __shfl(dk_, 32 + r32); } } while (0)
#define HG_STEP_END(sh_) do { if (wid >= (sh_)) { Bacc += bp; BARR[wid * 64 + lane] = Bacc; } } while (0)
#define HG_STEP(sh_) do { HG_STEP_BEGIN(sh_); HG_RD(spA, 0, 0, sh_); __syncthreads(); \
                HG_WR(spA, 0, 0, sh_); HG_RD(spB, 0, 1, sh_); __syncthreads(); \
                HG_WR(spB, 0, 1, sh_); HG_RD(spA, 1, 0, sh_); __syncthreads(); \
                HG_WR(spA, 1, 0, sh_); HG_RD(spB, 1, 1, sh_); __syncthreads(); \
                HG_WR(spB, 1, 1, sh_); HG_STEP_END(sh_); __syncthreads(); } while (0)
                HG_STEP(1); HG_STEP(2); HG_STEP(4);
#undef HG_STEP
#undef HG_RD
#undef HG_WR
#undef HG_STEP_BEGIN
#undef HG_STEP_END
            }
            if (PASS == 1) {
                float* ag = AGG + ((size_t)((b * 4 + h) * 2 + d) * 9 + sc) * AGG_FLOATS; const ALAS float* S7 = (const ALAS float*)(L3 + 7 * W_BYTES);
                for (int e = tid; e < 4096; e += NT) ag[e] = S7[(e >> 6) * STROW + (e & 63)];
                if (tid < 64) ag[4096 + tid] = BARR[7 * 64 + tid];
                __syncthreads();
            }
            }
            if constexpr (PASS == 2) {
            __syncthreads();
#pragma unroll 1
            for (int step = 0; step < 8; ++step) {
                if (wid == step) {
                    if (PASS == 2) {
#pragma unroll
                        for (int cv = 0; cv < 2; ++cv)
#pragma unroll
                            for (int d0 = 0; d0 < 4; ++d0) { const ALAS float* sp = ST + (32 * cv + r32) * STROW + 16 * d0 + 8 * hi; const f32x4v s0 = *(const ALAS f32x4v*)sp, s1 = *(const ALAS f32x4v*)(sp + 4);
                                const uint4 q4 = make_uint4(att::cvtpk(s0[0], s0[1]), att::cvtpk(s0[2], s0[3]), att::cvtpk(s1[0], s1[1]), att::cvtpk(s1[2], s1[3]));
                                o[cv] = __builtin_amdgcn_mfma_f32_32x32x16_bf16(qf[d0], __builtin_bit_cast(bf16x8, q4), o[cv], 0, 0, 0); }
                    }
                    const float dk = __expf(Btot);
                    int sbase = (4 * hi) * STROW + r32; asm volatile("" : "+v"(sbase));
#pragma unroll
                    for (int cd = 0; cd < 2; ++cd) { const float dkd = __shfl(dk, 32 * cd + r32);
#pragma unroll
                        for (int cv = 0; cv < 2; ++cv)
#pragma unroll
                            for (int r = 0; r < 16; ++r) { ALAS float* sp = ST + sbase + (32 * cv + (r & 3) + 8 * (r >> 2)) * STROW + 32 * cd; *sp = dkd * *sp + sl[cv][cd][r]; } }
                    BS[lane] += Btot;
                }
                __syncthreads();
            }
                if (d == 0) {
                    int base = (32 * wid + 4 * hi) * 64 + r32; asm volatile("" : "+v"(base));
#pragma unroll
                    for (int r = 0; r < 16; ++r) { const int off = base + ((r & 3) + 8 * (r >> 2)) * 64; OSG[off] = o[0][r]; OSG[off + 32] = o[1][r]; }
                }
                else {
                    ALAS float* OS = (ALAS float*)L3;
                    int base = (255 - 32 * wid - 4 * hi) * 64 + r32; asm volatile("" : "+v"(base));
                    float g0[16], g1[16];
#pragma unroll
                    for (int r = 0; r < 16; ++r) { const int off = base - ((r & 3) + 8 * (r >> 2)) * 64; g0[r] = OSG[off]; g1[r] = OSG[off + 32]; }
#pragma unroll
                    for (int r = 0; r < 16; ++r) { const int off = base - ((r & 3) + 8 * (r >> 2)) * 64; OS[off] = o[0][r] + g0[r]; OS[off + 32] = o[1][r] + g1[r]; }
                    __syncthreads();
                    { int tl = 32 * wid + (lane >> 1); asm volatile("" : "+v"(tl)); const int half = lane & 1; float ov[32]; float ss = 0.f;
#pragma unroll
                      for (int i = 0; i < 32; ++i) { ov[i] = OS[tl * 64 + half * 32 + i]; ss += ov[i] * ov[i]; }
                      ss += __shfl_xor(ss, 1);
                      const float rs = rsqrtf(ss * (1.f / 64.f) + EPS);
                      const size_t row = (size_t)(jbase + tl); const bf16_t* zg = Z + row * NZ + ZD_G + h * 64 + half * 32; bf16_t* yo = Y + row * D + 768 + h * 64 + half * 32;
#pragma unroll
                      for (int i = 0; i < 4; ++i) { unsigned w4[4];
#pragma unroll
                          for (int k2 = 0; k2 < 4; ++k2) { const int c0 = 8 * i + 2 * k2; w4[k2] = att::cvtpk(ov[c0] * rs * gn[h * 64 + half * 32 + c0] * siluf_(bf2f(zg[c0])), ov[c0 + 1] * rs * gn[h * 64 + half * 32 + c0 + 1] * siluf_(bf2f(zg[c0 + 1]))); }
                          *(uint4*)(yo + 8 * i) = make_uint4(w4[0], w4[1], w4[2], w4[3]); } }
                    __syncthreads();
                }
            }
        }
    }
}

__device__ __forceinline__ void ph_router(const P& p, int l, unsigned char* ldsb, bool dry = false) {
    const int tidx = p.wid * 64 + fresh_lane();
    const float* X = (const float*)(p.ws + WS_X); bf16_t* H = (bf16_t*)(p.ws + WS_H); const float* xin = p.in[I_X]; const float* cin = p.in[I_CTX]; const bf16_t* D1 = (const bf16_t*)(p.ws + WS_D1);
#define RBASE(r_) (l == 0 ? xin_row(xin, cin, (r_)) : X + (size_t)(r_) * D)
    float2* GP = (float2*)(p.ws + WS_GP); int* LISTP = (int*)(p.ws + WS_LISTP); unsigned* CNT = (unsigned*)(p.ws + WS_CNT) + l * 32;
    const float* MOD = (const float*)(p.ws + WS_MOD) + (size_t)l * 9 * 6 * D; const float* g = p.in[I_N2G] + l * D;
    const float* RW = p.in[I_RW]; const float* RB = p.in[I_RB];
    ALAS int* lc = (ALAS int*)ldsb; ALAS int* lbase = lc + 32; ALAS int* rpair = lc + 64; ALAS int* rrank = lc + 64 + 72;
    const int lane = tidx & 63, wv = tidx >> 6;
    typedef float f32x4r __attribute__((ext_vector_type(4))); ALAS f32x4r* RWs = (ALAS f32x4r*)(ldsb - LDS_MISC);
    { f32x4r rwv[8];
#pragma unroll
      for (int u = 0; u < 8; ++u) { const int idx = tidx + u * NT; const int ln = idx & 63, e4 = (idx >> 6) & 3, i = (idx >> 8) & 3, q = idx >> 10; rwv[u] = *(const f32x4r*)(RW + (size_t)((ln + 64 * q) * 4 + i) * 16 + e4 * 4); }
#pragma unroll
      for (int u = 0; u < 8; ++u) RWs[tidx + u * NT] = rwv[u]; }
    __syncthreads();
    ALAS float* LG = (ALAS float*)(ldsb - LDS_MISC + 65536);
    float4 gq[4];
#pragma unroll
    for (int q = 0; q < 4; ++q) gq[q] = *(const float4*)(g + (lane + 64 * q) * 4);
    for (int chunk = blockIdx.x; chunk < R / 72; chunk += gridDim.x) {
        if (tidx < 32) lc[tidx] = 0;
        const int rbase = chunk * 72 + wv * 9;
        float4 vn[4]; uint2 dn[4];
#pragma unroll
        for (int q = 0; q < 4; ++q) { vn[q] = *(const float4*)(RBASE(rbase) + (lane + 64 * q) * 4); dn[q] = *(const uint2*)(D1 + (size_t)rbase * D + (lane + 64 * q) * 4); }
#pragma unroll 1
        for (int k = 0; k < 9; ++k) {
            const int li = wv * 9 + k, r = rbase + k;
            const float* m = MOD + (size_t)row_mi(r) * 6 * D; float4 scq[4], shq[4];
#pragma unroll
            for (int q = 0; q < 4; ++q) { scq[q] = *(const float4*)(m + 4 * D + (lane + 64 * q) * 4); shq[q] = *(const float4*)(m + 3 * D + (lane + 64 * q) * 4); }
            float4 v[4];
#pragma unroll
            for (int q = 0; q < 4; ++q) { float t4[4] = {vn[q].x, vn[q].y, vn[q].z, vn[q].w}; add_bf4(t4, dn[q]); v[q] = make_float4(t4[0], t4[1], t4[2], t4[3]); }
            { const int rn = rbase + (k < 8 ? k + 1 : 8);
#pragma unroll
              for (int q = 0; q < 4; ++q) { vn[q] = *(const float4*)(RBASE(rn) + (lane + 64 * q) * 4); dn[q] = *(const uint2*)(D1 + (size_t)rn * D + (lane + 64 * q) * 4); } }
            float ss = 0.f;
#pragma unroll
            for (int q = 0; q < 4; ++q) ss += v[q].x * v[q].x + v[q].y * v[q].y + v[q].z * v[q].z + v[q].w * v[q].w;
            const float rs = rsqrtf(wave_sum(ss) * (1.f / D) + EPS);
            float lg[16];
#pragma unroll
            for (int e = 0; e < 16; ++e) lg[e] = 0.f;
#pragma unroll
            for (int q = 0; q < 4; ++q) { const int c = (lane + 64 * q) * 4; const float xv[4] = {v[q].x, v[q].y, v[q].z, v[q].w};
                const float4 g4 = gq[q], sc4 = scq[q], sh4 = shq[q];
                const float gv[4] = {g4.x, g4.y, g4.z, g4.w}, scv[4] = {sc4.x, sc4.y, sc4.z, sc4.w}, shv[4] = {sh4.x, sh4.y, sh4.z, sh4.w}; bf16_t o[4];
#pragma unroll
                for (int i = 0; i < 4; ++i) { const float hv = xv[i] * rs * gv[i] * (1.f + scv[i]) + shv[i]; o[i] = f2bf(hv);
#pragma unroll
                    for (int e4 = 0; e4 < 4; ++e4) { const f32x4r w4 = RWs[((q * 4 + i) * 4 + e4) * 64 + lane]; lg[e4 * 4 + 0] += hv * w4[0]; lg[e4 * 4 + 1] += hv * w4[1]; lg[e4 * 4 + 2] += hv * w4[2]; lg[e4 * 4 + 3] += hv * w4[3]; } }
                *(uint2*)(H + (size_t)r * D + c) = make_uint2((unsigned)o[0] | ((unsigned)o[1] << 16), (unsigned)o[2] | ((unsigned)o[3] << 16));
                __builtin_amdgcn_sched_barrier(0); }
            float a8[8], a4[4], a2[2], a1;
            { const bool hb = (lane & 32) != 0;
#pragma unroll
              for (int i = 0; i < 8; ++i) { const float snd = hb ? lg[i] : lg[8 + i], kp = hb ? lg[8 + i] : lg[i]; a8[i] = kp + __shfl_xor(snd, 32); } }
            { const bool hb = (lane & 16) != 0;
#pragma unroll
              for (int i = 0; i < 4; ++i) { const float snd = hb ? a8[i] : a8[4 + i], kp = hb ? a8[4 + i] : a8[i]; a4[i] = kp + __shfl_xor(snd, 16); } }
            { const bool hb = (lane & 8) != 0;
#pragma unroll
              for (int i = 0; i < 2; ++i) { const float snd = hb ? a4[i] : a4[2 + i], kp = hb ? a4[2 + i] : a4[i]; a2[i] = kp + __shfl_xor(snd, 8); } }
            { const bool hb = (lane & 4) != 0; const float snd = hb ? a2[0] : a2[1], kp = hb ? a2[1] : a2[0]; a1 = kp + __shfl_xor(snd, 4); }
            a1 += __shfl_xor(a1, 2); a1 += __shfl_xor(a1, 1);
            if ((lane & 3) == 0) LG[li * 16 + (lane >> 2)] = a1 + RB[lane >> 2];
        }
        __syncthreads();
        if (tidx < 72) {
            const int r = chunk * 72 + tidx; float lg[16];
#pragma unroll
            for (int e = 0; e < 16; ++e) lg[e] = LG[tidx * 16 + e];
            float mx = lg[0];
#pragma unroll
            for (int e = 1; e < 16; ++e) mx = fmaxf(mx, lg[e]);
            float sc[16], sum = 0.f;
#pragma unroll
            for (int e = 0; e < 16; ++e) { sc[e] = expf(lg[e] - mx); sum += sc[e]; }
            const float inv = 1.f / sum;
#pragma unroll
            for (int e = 0; e < 16; ++e) sc[e] *= inv;
            int gsel = 0; float gbest = -1.f;
#pragma unroll
            for (int gI = 0; gI < 4; ++gI) { const float s0 = sc[gI * 4], s1 = sc[gI * 4 + 1], s2 = sc[gI * 4 + 2], s3 = sc[gI * 4 + 3];
                const float m1 = fmaxf(s0, s1), n1 = fminf(s0, s1), m2 = fmaxf(s2, s3), n2 = fminf(s2, s3);
                const float gs = fmaxf(m1, m2) + fmaxf(fminf(m1, m2), fmaxf(n1, n2)); const bool c = gs > gbest; gbest = c ? gs : gbest; gsel = c ? gI : gsel; }
            float s4[4];
#pragma unroll
            for (int i = 0; i < 4; ++i) s4[i] = gsel == 0 ? sc[i] : (gsel == 1 ? sc[4 + i] : (gsel == 2 ? sc[8 + i] : sc[12 + i]));
            float w1 = s4[0]; int i1 = 0;
#pragma unroll
            for (int i = 1; i < 4; ++i) { const bool c = s4[i] > w1; w1 = c ? s4[i] : w1; i1 = c ? i : i1; }
            float w2 = -1.f; int i2 = 0;
#pragma unroll
            for (int i = 0; i < 4; ++i) { const bool c = (i != i1) && (s4[i] > w2); w2 = c ? s4[i] : w2; i2 = c ? i : i2; }
            const float wn = 1.f / (w1 + w2);
            const int a = i1 < i2 ? i1 : i2, bq = i1 < i2 ? i2 : i1;
            const int q = a == 0 ? bq - 1 : (a == 1 ? bq + 1 : 5);
            const int pr = gsel * 6 + q; const bool skip = (l == 1 && (r % LB) < TC);
            GP[r] = i1 < i2 ? make_float2(w1 * wn, w2 * wn) : make_float2(w2 * wn, w1 * wn);
            rpair[tidx] = skip ? -1 : pr;
            if (!skip) rrank[tidx] = __hip_atomic_fetch_add(&lc[pr], 1, __ATOMIC_RELAXED, __HIP_MEMORY_SCOPE_WORKGROUP);
        }
        __syncthreads();
        if (tidx < 24) lbase[tidx] = (lc[tidx] && !dry) ? (int)atomicAdd(&CNT[tidx], (unsigned)lc[tidx]) : 0;
        __syncthreads();
        if (tidx < 72 && !dry) { const int pr = rpair[tidx]; if (pr >= 0) LISTP[(size_t)pr * R + lbase[pr] + rrank[tidx]] = chunk * 72 + tidx; }
        __syncthreads();
    }
}

__device__ __forceinline__ void ph_final(const P& p) {
    const int tidx = p.wid * 64 + fresh_lane();
    const float* X = (const float*)(p.ws + WS_X); const float* g = p.in[I_FNG]; const bf16_t* D1 = (const bf16_t*)(p.ws + WS_D1); const bf16_t* D2 = (const bf16_t*)(p.ws + WS_D2);
    const int lane = tidx & 63, wv = tidx >> 6;
    const int stride = gridDim.x * NWV; const int i0 = blockIdx.x * NWV + wv;
    float4 gq[4];
#pragma unroll
    for (int q = 0; q < 4; ++q) gq[q] = *(const float4*)(g + (lane + 64 * q) * 4);
#define FROW(i_) ((size_t)(((i_) / T) * LB + TC + ((i_) % T)))
    for (int ib = i0; ib < NB * T; ib += 8 * stride) {
        float4 vb[3][4]; uint2 d1b[3][4], d2b[3][4];
#define FN_LOAD(slot, k_) do { int ii_ = ib + (k_) * stride; ii_ = ii_ < NB * T ? ii_ : ib; const size_t rr_ = FROW(ii_); _Pragma("unroll") for (int q = 0; q < 4; ++q) { vb[slot][q] = *(const float4*)(X + rr_ * D + (lane + 64 * q) * 4); \
            d1b[slot][q] = *(const uint2*)(D1 + rr_ * D + (lane + 64 * q) * 4); d2b[slot][q] = *(const uint2*)(D2 + rr_ * D + (lane + 64 * q) * 4); } } while (0)
        FN_LOAD(0, 0); FN_LOAD(1, 1);
#pragma unroll
        for (int k = 0; k < 8; ++k) {
            const int it = ib + k * stride; const int sl = k % 3;
            if (k + 2 < 8) FN_LOAD((k + 2) % 3, k + 2);
            if (it < NB * T) {
                float xv[4][4]; float ss = 0.f;
#pragma unroll
                for (int q = 0; q < 4; ++q) { xv[q][0] = vb[sl][q].x; xv[q][1] = vb[sl][q].y; xv[q][2] = vb[sl][q].z; xv[q][3] = vb[sl][q].w; add_bf4(xv[q], d1b[sl][q]); add_bf4(xv[q], d2b[sl][q]); }
#pragma unroll
                for (int q = 0; q < 4; ++q) ss += xv[q][0] * xv[q][0] + xv[q][1] * xv[q][1] + xv[q][2] * xv[q][2] + xv[q][3] * xv[q][3];
                const float rs = rsqrtf(wave_sum(ss) * (1.f / D) + EPS);
#pragma unroll
                for (int q = 0; q < 4; ++q) { const int c = (lane + 64 * q) * 4; const float4 gg = gq[q];
                    *(float4*)(p.out + (size_t)it * D + c) = make_float4(xv[q][0] * rs * gg.x, xv[q][1] * rs * gg.y, xv[q][2] * rs * gg.z, xv[q][3] * rs * gg.w); }
            }
        }
#undef FN_LOAD
    }
#undef FROW
}

namespace pg8 {
#define PG8_LAS __attribute__((address_space(3)))
typedef short bf16x8 __attribute__((ext_vector_type(8)));
typedef float f32x4 __attribute__((ext_vector_type(4)));
typedef unsigned u32x4 __attribute__((ext_vector_type(4)));
constexpr int BM = 256, BK = 64, HALF = 128, HTB = HALF * BK * 2, STAGE_BYTES = 8 * HTB, NXCD = 8, WGM = 8;
__host__ __device__ __forceinline__ int lds_byte(int r, int c) { const int st = (r >> 4) * 2 + (c >> 5), rr = r & 15, cc = c & 31, ob = rr * 64 + cc * 2; return st * 1024 + (ob ^ (((ob >> 9) & 1) << 5)); }
__host__ __device__ __forceinline__ void stage_rc(int b, int& R, int& C) { const int st = b / 1024, sb = b % 1024, swz = sb ^ (((sb >> 9) & 1) << 5); R = (st >> 1) * 16 + swz / 64; C = (st & 1) * 32 + (swz % 64) / 2; }
__host__ __device__ __forceinline__ int perm32(int rho) { const int n = rho >> 4, i = rho & 15; return 8 * (i >> 2) + 4 * n + (i & 3); }
__device__ __forceinline__ unsigned cvt_pk_bf16(float lo, float hi) { unsigned r; asm volatile("v_cvt_pk_bf16_f32 %0, %1, %2" : "=v"(r) : "v"(lo), "v"(hi)); return r; }
struct Unit { int pm, pn, aux; };
__device__ __forceinline__ bool static_next(int i, int G, int c, int nM, int nN, int& pm, int& pn) {
    const int nwg = nM * nN; const long L = (long)i * G + c; if (L >= nwg) return false;
    int wgid = (int)L; { const int q = nwg / NXCD, r = nwg % NXCD, xcd = wgid % NXCD, off = wgid / NXCD; wgid = (xcd < r ? xcd * (q + 1) : r * (q + 1) + (xcd - r) * q) + off; }
    const int nig = WGM * nN, gid = wgid / nig, fm = gid * WGM, gsz = (nM - fm) < WGM ? (nM - fm) : WGM;
    pm = fm + ((wgid % nig) % gsz); pn = (wgid % nig) / gsz; return true;
}
template <class PB, bool ALIGN_EPI>
__device__ __forceinline__ void gemm_phase(PG8_LAS unsigned char* lds, const PB& S, const int wid) {
    const int lane = fresh_lane(), tid = wid * 64 + lane, wr = wid >> 2, wc = wid & 3, fr = lane & 15, fq = lane >> 4;
    const int nt = S.nt;
    int Rst[2], Cst[2]; unsigned voffB[2];
#pragma unroll
    for (int i = 0; i < 2; ++i) { int R_, C_; stage_rc(tid * 16 + i * 8192, R_, C_); Rst[i] = R_; Cst[i] = C_; const int Rb = PB::PERM ? ((R_ & ~31) + perm32(R_ & 31)) : R_; voffB[i] = (unsigned)(Rb * S.ldb + C_) * 2u; }
    const size_t kstep = (size_t)(BK * 2);
    const size_t hstepB = (size_t)HALF * S.ldb * 2;
    const unsigned ldsw = (unsigned)wid * 1024u;
    const int aoff = lds_byte(wr * 64 + fr, fq * 8), boff = lds_byte(wc * 32 + fr, fq * 8);
#define PG8_SA(b, h) (((b) * 2 + (h)) * HTB)
#define PG8_SB(b, h) ((4 + (b) * 2 + (h)) * HTB)
#define PG8_STAGE(bufoff, gbase, voff) do { _Pragma("unroll") for (int _i = 0; _i < 2; ++_i) { unsigned _o = (voff)[_i]; asm volatile("" : "+v"(_o)); \
        __builtin_amdgcn_global_load_lds((const unsigned*)((const char*)(gbase) + _o), (PG8_LAS unsigned*)(lds + (bufoff) + ldsw + _i * 8192), 16, 0, 0); } } while (0)
#define PG8_LDA(dst, b, h) do { _Pragma("unroll") for (int m = 0; m < 4; ++m) _Pragma("unroll") for (int k = 0; k < 2; ++k) dst[m][k] = *(const PG8_LAS bf16x8*)(lds + PG8_SA(b, h) + aoff + m * 2048 + k * 1024); } while (0)
#define PG8_LDB(dst, b, h) do { _Pragma("unroll") for (int n = 0; n < 2; ++n) _Pragma("unroll") for (int k = 0; k < 2; ++k) dst[n][k] = *(const PG8_LAS bf16x8*)(lds + PG8_SB(b, h) + boff + n * 2048 + k * 1024); } while (0)
#define PG8_MMA(ai, bj, At, Bt) do { __builtin_amdgcn_s_setprio(1); _Pragma("unroll") for (int m = 0; m < 4; ++m) _Pragma("unroll") for (int n = 0; n < 2; ++n) _Pragma("unroll") for (int k = 0; k < 2; ++k) \
        acc[ai][bj][m][n] = __builtin_amdgcn_mfma_f32_16x16x32_bf16(Bt[n][k], At[m][k], acc[ai][bj][m][n], 0, 0, 0); __builtin_amdgcn_s_setprio(0); } while (0)
#define PG8_WAIT_V(n) asm volatile("s_waitcnt vmcnt(" #n ")" ::: "memory")
#define PG8_WAIT_L(n) asm volatile("s_waitcnt lgkmcnt(" #n ")" ::: "memory")
#define PG8_BAR __builtin_amdgcn_s_barrier()
#define PG8_SCHED __builtin_amdgcn_sched_barrier(0)
    Unit cur, nxt; int ui = 0;
    if (!S.next(0, cur)) return;
    f32x4 acc[2][2][4][2];
#pragma unroll
    for (int a = 0; a < 2; ++a)
#pragma unroll
        for (int b = 0; b < 2; ++b)
#pragma unroll
            for (int m = 0; m < 4; ++m)
#pragma unroll
                for (int n = 0; n < 2; ++n) acc[a][b][m][n] = (f32x4){0.f, 0.f, 0.f, 0.f};
    bf16x8 At[4][2], B0[2][2], B1[2][2];
    unsigned vc[2][2], vn[2][2];
    S.a_off(cur, Rst, Cst, vc); asm volatile("" : "+v"(vc[0][0]), "+v"(vc[0][1]), "+v"(vc[1][0]), "+v"(vc[1][1]));
    const char* gA = S.A;
    { const char* cB = S.b_ptr(cur, 0); const char* cB1 = S.b_ptr(cur, 1);
      PG8_STAGE(PG8_SB(0, 0), cB, voffB); PG8_STAGE(PG8_SB(0, 1), cB + hstepB, voffB); PG8_STAGE(PG8_SA(0, 0), gA, vc[0]); PG8_STAGE(PG8_SA(0, 1), gA, vc[1]);
      if (wr == 1) PG8_BAR;
      PG8_WAIT_V(2); PG8_BAR;
      PG8_STAGE(PG8_SB(1, 0), cB1, voffB); PG8_STAGE(PG8_SA(1, 0), gA + kstep, vc[0]); PG8_STAGE(PG8_SB(1, 1), cB1 + hstepB, voffB);
      PG8_WAIT_V(6); PG8_BAR; }
    for (;;) {
        const bool has_next = S.next(ui + 1, nxt);
        if (has_next) { S.a_off(nxt, Rst, Cst, vn); asm volatile("" : "+v"(vn[0][0]), "+v"(vn[0][1]), "+v"(vn[1][0]), "+v"(vn[1][1])); }
        else { vn[0][0] = vc[0][0]; vn[0][1] = vc[0][1]; vn[1][0] = vc[1][0]; vn[1][1] = vc[1][1]; nxt = cur; }
        for (int t = 0; t < nt; t += 2) {
            const bool last = (t == nt - 2);
            const char* a1 = gA + (size_t)(t + 1) * kstep;
            const char* a2 = last ? gA : gA + (size_t)(t + 2) * kstep; const char* a3 = a2 + kstep;
            const char* b2 = last ? S.b_ptr(nxt, 0) : S.b_ptr(cur, t + 2);
            const char* b3 = last ? S.b_ptr(nxt, 1) : S.b_ptr(cur, t + 3);
            unsigned o2a[2], o2b[2];
            o2a[0] = last ? vn[0][0] : vc[0][0]; o2a[1] = last ? vn[0][1] : vc[0][1]; o2b[0] = last ? vn[1][0] : vc[1][0]; o2b[1] = last ? vn[1][1] : vc[1][1];
            PG8_LDB(B0, 0, 0); PG8_LDB(B1, 0, 1); PG8_SCHED; PG8_LDA(At, 0, 0); PG8_STAGE(PG8_SA(1, 1), a1, vc[1]);
            PG8_WAIT_V(8); PG8_WAIT_L(0); PG8_BAR; PG8_MMA(0, 0, At, B0); PG8_MMA(0, 1, At, B1); PG8_BAR; PG8_SCHED;
            PG8_LDA(At, 0, 1); PG8_STAGE(PG8_SB(0, 0), b2, voffB); PG8_STAGE(PG8_SB(0, 1), b2 + hstepB, voffB); PG8_STAGE(PG8_SA(0, 0), a2, o2a);
            PG8_WAIT_V(8); PG8_WAIT_L(0); PG8_BAR; PG8_MMA(1, 0, At, B0); PG8_MMA(1, 1, At, B1); PG8_BAR; PG8_SCHED;
            PG8_LDB(B0, 1, 0); PG8_LDB(B1, 1, 1); PG8_SCHED; PG8_LDA(At, 1, 0); PG8_STAGE(PG8_SA(0, 1), a2, o2b);
            PG8_WAIT_V(8); PG8_WAIT_L(0); PG8_BAR; PG8_MMA(0, 0, At, B0); PG8_MMA(0, 1, At, B1); PG8_BAR; PG8_SCHED;
            PG8_LDA(At, 1, 1); PG8_STAGE(PG8_SB(1, 0), b3, voffB); PG8_STAGE(PG8_SB(1, 1), b3 + hstepB, voffB); PG8_STAGE(PG8_SA(1, 0), a3, o2a);
            PG8_WAIT_V(8); PG8_WAIT_L(0); PG8_BAR; PG8_MMA(1, 0, At, B0); PG8_MMA(1, 1, At, B1); PG8_BAR; PG8_SCHED;
        }
        if constexpr (ALIGN_EPI) { if (wr == 0) PG8_BAR; }
        S.epi(acc, cur, wr, wc, fr, fq);
        if (!has_next) break;
#pragma unroll
        for (int a = 0; a < 2; ++a)
#pragma unroll
            for (int b = 0; b < 2; ++b)
#pragma unroll
                for (int m = 0; m < 4; ++m)
#pragma unroll
                    for (int n = 0; n < 2; ++n) acc[a][b][m][n] = (f32x4){0.f, 0.f, 0.f, 0.f};
        cur = nxt; vc[0][0] = vn[0][0]; vc[0][1] = vn[0][1]; vc[1][0] = vn[1][0]; vc[1][1] = vn[1][1]; ++ui;
        if constexpr (ALIGN_EPI) { if (wr == 1) PG8_BAR; }
    }
    PG8_WAIT_V(0);
    if constexpr (!ALIGN_EPI) { if (wr == 0) PG8_BAR; }
    PG8_BAR;
#undef PG8_SA
#undef PG8_SB
#undef PG8_STAGE
#undef PG8_LDA
#undef PG8_LDB
#undef PG8_MMA
#undef PG8_WAIT_V
#undef PG8_WAIT_L
#undef PG8_BAR
#undef PG8_SCHED
}
}

struct PB_InProj {
    static constexpr bool PERM = true;
    const char* A; int ldb, nt; const char* Bt; bf16_t* Zo; int G, c;
    __device__ __forceinline__ bool next(int i, pg8::Unit& u) const { u.aux = 0; return pg8::static_next(i, G, c, R / 256, NZ / 256, u.pm, u.pn); }
    __device__ __forceinline__ void a_off(const pg8::Unit& u, const int (&Rs)[2], const int (&Cs)[2], unsigned (&off)[2][2]) const {
#pragma unroll
        for (int h = 0; h < 2; ++h)
#pragma unroll
            for (int i = 0; i < 2; ++i) off[h][i] = (unsigned)((u.pm * 256 + h * 128 + Rs[i]) * D + Cs[i]) * 2u; }
    __device__ __forceinline__ const char* b_ptr(const pg8::Unit& u, int t) const { return Bt + (size_t)u.pn * 256 * D * 2 + (size_t)t * 128; }
    __device__ __forceinline__ void epi(const pg8::f32x4 (&acc)[2][2][4][2], const pg8::Unit& u, int wr, int wc, int fr, int fq) const {
        const int row0 = u.pm * 256 + wr * 64 + fr, col0 = u.pn * 256 + wc * 32 + 8 * fq;
#pragma unroll
        for (int ai = 0; ai < 2; ++ai)
#pragma unroll
            for (int m = 0; m < 4; ++m) { bf16_t* rowp = Zo + (size_t)(row0 + ai * 128 + m * 16) * NZ + col0;
#pragma unroll
                for (int bj = 0; bj < 2; ++bj) { const pg8::f32x4 v0 = acc[ai][bj][m][0], v1 = acc[ai][bj][m][1]; pg8::u32x4 w;
                    w.x = pg8::cvt_pk_bf16(v0[0], v0[1]); w.y = pg8::cvt_pk_bf16(v0[2], v0[3]); w.z = pg8::cvt_pk_bf16(v1[0], v1[1]); w.w = pg8::cvt_pk_bf16(v1[2], v1[3]);
                    *(pg8::u32x4*)(rowp + bj * 128) = w; } }
    }
};


struct PB_OutProj {
    static constexpr bool PERM = true;
    const char* A; int ldb, nt; const char* Bt; bf16_t* D1; const float* MODl; int G, c, skipctx; bool dry;
    __device__ __forceinline__ bool next(int i, pg8::Unit& u) const { u.aux = 0; int pm, pn; if (!pg8::static_next(i, G, c, skipctx ? 64 : 72, 4, pm, pn)) return false; u.pm = skipctx ? (pm >> 3) * 9 + 1 + (pm & 7) : pm; u.pn = pn; return true; }
    __device__ __forceinline__ void a_off(const pg8::Unit& u, const int (&Rs)[2], const int (&Cs)[2], unsigned (&off)[2][2]) const {
#pragma unroll
        for (int h = 0; h < 2; ++h)
#pragma unroll
            for (int i = 0; i < 2; ++i) off[h][i] = (unsigned)((u.pm * 256 + h * 128 + Rs[i]) * D + Cs[i]) * 2u; }
    __device__ __forceinline__ const char* b_ptr(const pg8::Unit& u, int t) const { return Bt + (size_t)u.pn * 256 * D * 2 + (size_t)t * 128; }
    __device__ __forceinline__ void epi(const pg8::f32x4 (&acc)[2][2][4][2], const pg8::Unit& u, int wr, int wc, int fr, int fq) const {
        const int row0 = u.pm * 256 + wr * 64 + fr, col0 = u.pn * 256 + wc * 32 + 8 * fq;
        const float* gt = MODl + (size_t)row_mi(u.pm * 256) * 6 * D + 2 * D + col0;
        pg8::f32x4 gv[2][2];
#pragma unroll
        for (int bj = 0; bj < 2; ++bj)
#pragma unroll
            for (int n = 0; n < 2; ++n) gv[bj][n] = *(const pg8::f32x4*)(gt + bj * 128 + 4 * n);
        if (dry) return;
#pragma unroll
        for (int ai = 0; ai < 2; ++ai)
#pragma unroll
            for (int m = 0; m < 4; ++m) { bf16_t* rowp = D1 + (size_t)(row0 + ai * 128 + m * 16) * D + col0;
#pragma unroll
                for (int bj = 0; bj < 2; ++bj) { const pg8::f32x4 v0 = acc[ai][bj][m][0] * gv[bj][0], v1 = acc[ai][bj][m][1] * gv[bj][1]; pg8::u32x4 w;
                    w.x = pg8::cvt_pk_bf16(v0[0], v0[1]); w.y = pg8::cvt_pk_bf16(v0[2], v0[3]); w.z = pg8::cvt_pk_bf16(v1[0], v1[1]); w.w = pg8::cvt_pk_bf16(v1[2], v1[3]);
                    *(pg8::u32x4*)(rowp + bj * 128) = w; } }
    }
};

__device__ __forceinline__ void moe_tiles_setup(const P& p, int l, ALAS int* tb) {
    const unsigned* CNT = (const unsigned*)(p.ws + WS_CNT) + l * 32;
    __syncthreads();
    if (p.wid == 0 && fresh_lane() == 0) { int acc = 0; for (int q = 0; q < 24; ++q) { const int c = (int)__hip_atomic_load(CNT + q, __ATOMIC_RELAXED, __HIP_MEMORY_SCOPE_AGENT); tb[q] = c; tb[32 + q] = acc; acc += (c + 255) >> 8; } tb[32 + 24] = acc; }
    __syncthreads();
}
__device__ __forceinline__ void pair_experts(int pr, int& e0, int& e1) { const int g4 = (pr / 6) * 4, q = pr % 6; const int a = q < 3 ? 0 : (q < 5 ? 1 : 2), b = q < 3 ? q + 1 : (q < 5 ? q - 1 : 3); e0 = g4 + a; e1 = g4 + b; }

struct PB_Moe1 {
    static constexpr bool PERM = false;
    const char* A; int ldb, nt; const char* W13; bf16_t* HE; const int* LISTP; const float2* GP; const ALAS int* tb; int G, c;
    __device__ __forceinline__ bool next(int i, pg8::Unit& u) const {
        if (!pg8::static_next(i, G, c, tb[32 + 24], 8, u.pm, u.pn)) return false;
        int pr = 0;
        for (int q = 1; q < 24; ++q) if (tb[32 + q] <= u.pm) pr = q;
        u.aux = pr; return true; }
    __device__ __forceinline__ void a_off(const pg8::Unit& u, const int (&Rs)[2], const int (&Cs)[2], unsigned (&off)[2][2]) const {
        const int pr = u.aux, cnt = tb[pr], r0 = (u.pm - tb[32 + pr]) * 256; const int* lp = LISTP + (size_t)pr * R;
#pragma unroll
        for (int h = 0; h < 2; ++h)
#pragma unroll
            for (int i = 0; i < 2; ++i) { int rk = r0 + h * 128 + Rs[i]; rk = rk < cnt ? rk : cnt - 1; off[h][i] = (unsigned)(lp[rk] * D + Cs[i]) * 2u; } }
    __device__ __forceinline__ const char* b_ptr(const pg8::Unit& u, int t) const { int e0, e1; pair_experts(u.aux, e0, e1); const int e = u.pn < 4 ? e0 : e1;
        return W13 + ((size_t)e * 1024 + (size_t)(u.pn & 3) * 256) * D * 2 + (size_t)t * 128; }
    __device__ __forceinline__ void epi(const pg8::f32x4 (&acc)[2][2][4][2], const pg8::Unit& u, int wr, int wc, int fr, int fq) const {
        const int pr = u.aux, cnt = tb[pr], r0 = (u.pm - tb[32 + pr]) * 256; const int* lp = LISTP + (size_t)pr * R;
        const int colh = (u.pn < 4 ? 0 : 512) + (u.pn & 3) * 128 + wc * 16 + 4 * fq;
#pragma unroll
        for (int ai = 0; ai < 2; ++ai)
#pragma unroll
            for (int m = 0; m < 4; ++m) { const int x = ai * 128 + wr * 64 + m * 16 + fr; int rk = r0 + x; rk = rk < cnt ? rk : cnt - 1;
                const float2 gg = GP[lp[rk]]; const float gate = u.pn < 4 ? gg.x : gg.y;
                bf16_t* rowp = HE + (size_t)(u.pm * 256 + x) * 1024 + colh;
#pragma unroll
                for (int bj = 0; bj < 2; ++bj) { const pg8::f32x4 a = acc[ai][bj][m][0], b = acc[ai][bj][m][1]; float o[4];
#pragma unroll
                    for (int j = 0; j < 4; ++j) o[j] = a[j] / (1.f + __expf(-a[j])) * b[j] * gate;
                    *(uint2*)(rowp + bj * 64) = make_uint2(pg8::cvt_pk_bf16(o[0], o[1]), pg8::cvt_pk_bf16(o[2], o[3])); } }
    }
};
struct PB_Moe2 {
    static constexpr bool PERM = true;
    const char* A; int ldb, nt; const char* W2; bf16_t* D2; const float* MODl; const int* LISTP; const ALAS int* tb; int G, c; bool dry;
    __device__ __forceinline__ bool next(int i, pg8::Unit& u) const {
        if (!pg8::static_next(i, G, c, tb[32 + 24], 4, u.pm, u.pn)) return false;
        int pr = 0;
        for (int q = 1; q < 24; ++q) if (tb[32 + q] <= u.pm) pr = q;
        u.aux = pr; return true; }
    __device__ __forceinline__ void a_off(const pg8::Unit& u, const int (&Rs)[2], const int (&Cs)[2], unsigned (&off)[2][2]) const {
#pragma unroll
        for (int h = 0; h < 2; ++h)
#pragma unroll
            for (int i = 0; i < 2; ++i) off[h][i] = (unsigned)((u.pm * 256 + h * 128 + Rs[i]) * 1024 + Cs[i]) * 2u; }
    __device__ __forceinline__ const char* b_ptr(const pg8::Unit& u, int t) const { int e0, e1; pair_experts(u.aux, e0, e1); const int e = t < 8 ? e0 : e1;
        return W2 + ((size_t)e * 1024 + (size_t)u.pn * 256) * DE * 2 + (size_t)(t & 7) * 128; }
    __device__ __forceinline__ void epi(const pg8::f32x4 (&acc)[2][2][4][2], const pg8::Unit& u, int wr, int wc, int fr, int fq) const {
        const int pr = u.aux, cnt = tb[pr], r0 = (u.pm - tb[32 + pr]) * 256; const int* lp = LISTP + (size_t)pr * R;
        const int col0 = u.pn * 256 + wc * 32 + 8 * fq;
        if (dry) return;
        int tok[2][4];
#pragma unroll
        for (int ai = 0; ai < 2; ++ai)
#pragma unroll
            for (int m = 0; m < 4; ++m) { const int rk = r0 + ai * 128 + wr * 64 + m * 16 + fr; tok[ai][m] = rk < cnt ? lp[rk] : -1; }
#pragma unroll
        for (int ai = 0; ai < 2; ++ai)
#pragma unroll
            for (int m = 0; m < 4; ++m) { const int tk = tok[ai][m];
                if (tk >= 0) { bf16_t* rowp = D2 + (size_t)tk * D + col0; const float* gt = MODl + (size_t)row_mi(tk) * 6 * D + 5 * D + col0;
#pragma unroll
                    for (int bj = 0; bj < 2; ++bj) { const pg8::f32x4 v0 = acc[ai][bj][m][0] * *(const pg8::f32x4*)(gt + bj * 128), v1 = acc[ai][bj][m][1] * *(const pg8::f32x4*)(gt + bj * 128 + 4); pg8::u32x4 w;
                        w.x = pg8::cvt_pk_bf16(v0[0], v0[1]); w.y = pg8::cvt_pk_bf16(v0[2], v0[3]); w.z = pg8::cvt_pk_bf16(v1[0], v1[1]); w.w = pg8::cvt_pk_bf16(v1[2], v1[3]);
                        *(pg8::u32x4*)(rowp + bj * 128) = w; } } }
    }
};

template <int MAP  >
__device__ __forceinline__ void transpose_item(const float* W, int K, int N, bf16_t* WT, PG8_LAS float* scr, int item, int lane) {
    const int nblk = N / 32, kb = item / nblk, nb = item % nblk, k0 = 64 * kb, n0 = 32 * nb;
    float wv32[32];
#pragma unroll
    for (int i = 0; i < 32; ++i) { const int kk = 2 * i + (lane >> 5); wv32[i] = W[(size_t)(k0 + kk) * N + n0 + (lane & 31)]; }
#pragma unroll
    for (int i = 0; i < 32; ++i) { const int kk = 2 * i + (lane >> 5); scr[kk * 33 + (lane & 31)] = wv32[i]; }
    asm volatile("s_waitcnt lgkmcnt(0)" ::: "memory");
    const int c = lane & 7;
#pragma unroll
    for (int j = 0; j < 4; ++j) { const int n = (lane >> 3) + 8 * j; const PG8_LAS float* sp = scr + (8 * c) * 33 + n;
        uint4 o; o.x = pk2bf(sp[0 * 33], sp[1 * 33]); o.y = pk2bf(sp[2 * 33], sp[3 * 33]);
        o.z = pk2bf(sp[4 * 33], sp[5 * 33]); o.w = pk2bf(sp[6 * 33], sp[7 * 33]);
        const int ng = n0 + n; const int row = MAP == 0 ? ng : (32 * (ng >> 4) + (ng & 15) + (MAP == 2 ? 16 : 0));
        *(uint4*)(WT + (size_t)row * K + k0 + 8 * c) = o; }
    asm volatile("s_waitcnt lgkmcnt(0)" ::: "memory");
}
__device__ __forceinline__ void ph_prep_weights(const P& p, unsigned char* lds) {
    const int tidx = p.wid * 64 + fresh_lane();
    const int lane = tidx & 63, wv = tidx >> 6;
    PG8_LAS float* scr = (PG8_LAS float*)((PG8_LAS unsigned char*)lds + wv * 16384);
    const int gw = blockIdx.x * NWV + wv, NGW = gridDim.x * NWV;
    constexpr int I_IN = (D / 64) * (NZ / 32), I_OUT = (D / 64) * (D / 32);
    for (int it = gw; it < 2 * (I_IN + I_OUT); it += NGW) { const int l = it / (I_IN + I_OUT), r = it % (I_IN + I_OUT);
        if (r < I_IN) transpose_item<0>(p.in[I_WIN] + (size_t)l * D * NZ, D, NZ, (bf16_t*)(p.ws + WS_WIN) + (size_t)l * NZ * D, scr, r, lane);
        else transpose_item<0>(p.in[I_WOUT] + (size_t)l * D * D, D, D, (bf16_t*)(p.ws + WS_WOUT) + (size_t)l * D * D, scr, r - I_IN, lane); }
    { bf16_t* SGWo = (bf16_t*)(p.ws + WS_SGW); for (int it = blockIdx.x * NT + tidx; it < 2 * 4 * 128 * 128; it += gridDim.x * NT) SGWo[it] = f2bf(p.in[I_SGW][it]); }
    { bf16_t* WT = (bf16_t*)(p.ws + WS_LRUWT);
      for (int it = blockIdx.x * NT + tidx; it < 2 * 2 * 2 * 4 * 64 * 64; it += gridDim.x * NT) { const int i = it & 63, j = (it >> 6) & 63, hh = (it >> 12) & 3, gate = (it >> 14) & 1, ld = it >> 15;
          const float* src = (gate ? p.in[I_WI] : p.in[I_WR]) + (((size_t)ld * 4 + hh) * 64 + i) * 64 + j; WT[it] = f2bf(*src); } }
}
__device__ __forceinline__ void ph_prep_moe(const P& p, int l, unsigned char* lds, int half, int b0) {
    if ((int)blockIdx.x < b0) return;
    const int tidx = p.wid * 64 + fresh_lane();
    const int lane = tidx & 63, wv = tidx >> 6;
    PG8_LAS float* scr = (PG8_LAS float*)((PG8_LAS unsigned char*)lds + wv * 16384);
    const int gw = ((int)blockIdx.x - b0) * NWV + wv, NGW = ((int)gridDim.x - b0) * NWV;
    constexpr int I_13 = (D / 64) * (DE / 32), I_2 = (DE / 64) * (D / 32), PER_E = 2 * I_13 + I_2;
    for (int it = gw + half * (NE / 2) * PER_E; it < (half + 1) * (NE / 2) * PER_E; it += NGW) { const int e = it / PER_E, r = it % PER_E;
        bf16_t* w13 = (bf16_t*)(p.ws + WS_W13) + (size_t)e * 1024 * D; bf16_t* w2 = (bf16_t*)(p.ws + WS_W2) + (size_t)e * D * DE;
        if (r < I_13) transpose_item<1>(p.in[I_W1] + ((size_t)l * NE + e) * D * DE, D, DE, w13, scr, r, lane);
        else if (r < 2 * I_13) transpose_item<2>(p.in[I_W3] + ((size_t)l * NE + e) * D * DE, D, DE, w13, scr, r - I_13, lane);
        else transpose_item<0>(p.in[I_W2] + ((size_t)l * NE + e) * DE * D, DE, D, w2, scr, r - 2 * I_13, lane); }
}

#define XB_TMO      128
#define XB_XCNT(j)  (256  + 64 * (j))
#define XB_XSUB(j)  (1280 + 64 * (j))
#define XB_XGEN(j)  (2304 + 64 * (j))
#define XB_TOP      3328
#define XB_TOPGEN   3392
#define XCD_BAR_WORDS 3456
#define XB_SPIN_CAP (1u << 18)
__device__ __forceinline__ unsigned xb_ld(unsigned* q) { return __hip_atomic_load(q, __ATOMIC_RELAXED, __HIP_MEMORY_SCOPE_AGENT); }
__device__ __forceinline__ unsigned xb_add(unsigned* q, unsigned v) { return __hip_atomic_fetch_add(q, v, __ATOMIC_RELAXED, __HIP_MEMORY_SCOPE_AGENT); }
__device__ __forceinline__ unsigned xb_xcc_id() { return (unsigned)__builtin_amdgcn_s_getreg((3 << 11) | 20) & 0xFu; }
#define XB_SPIN(cond, bar) do { unsigned _sp = 0; while (cond) { __builtin_amdgcn_s_sleep(1); \
    if ((++_sp & 255u) == 0u) { if (xb_ld(&(bar)[XB_TMO])) break; if (_sp > XB_SPIN_CAP) { atomicAdd(&(bar)[XB_TMO], 1u); break; } } } } while (0)
struct XcdBarrier { unsigned* bar; unsigned x; volatile ALAS unsigned* st; int wid; };
__device__ __forceinline__ XcdBarrier xcd_barrier_post(unsigned* bar, volatile ALAS unsigned* st, int wid) {
    XcdBarrier b; b.bar = bar; b.x = xb_xcc_id(); b.st = st; b.wid = wid;
    if (wid == 0 && fresh_lane() == 0) (void)xb_add(&bar[XB_XCNT(b.x)], 1u);
    return b;
}
__device__ __forceinline__ void xcd_barrier_complete(unsigned* bar, unsigned x, unsigned& nloc, unsigned& nx) {
    const unsigned G = gridDim.x * gridDim.y * gridDim.z;
    unsigned sum, cnt, mine, sp = 0u;
    for (;;) {
        sum = 0u; cnt = 0u; mine = 0u;
#pragma unroll
        for (unsigned j = 0; j < 16; ++j) { const unsigned c = xb_ld(&bar[XB_XCNT(j)]); sum += c; cnt += (c > 0u) ? 1u : 0u; mine = (j == x) ? c : mine; }
        if (sum == G) break;
        __builtin_amdgcn_s_sleep(1);
        if ((++sp & 255u) == 0u) { if (xb_ld(&bar[XB_TMO])) break; if (sp > XB_SPIN_CAP) { atomicAdd(&bar[XB_TMO], 1u); break; } }
    }
    nloc = mine > 0u ? mine : 1u; nx = cnt > 0u ? cnt : 1u;
}
__device__ __forceinline__ void xcd_barrier(const XcdBarrier& b) {
    asm volatile("s_waitcnt vmcnt(0)" ::: "memory");
    __syncthreads();
    if (b.wid == 0 && fresh_lane() == 0) {
        unsigned* bar = b.bar; asm volatile("" : "+s"(bar));
        __builtin_amdgcn_s_waitcnt(0);
        unsigned nloc = b.st[0], nx = b.st[1];
        if (nloc == 0u) { xcd_barrier_complete(bar, b.x, nloc, nx); b.st[0] = nloc; b.st[1] = nx; }
        const unsigned old = xb_add(&bar[XB_XSUB(b.x)], 1u);
        const unsigned gen = old / nloc;
        if (old + 1u == (gen + 1u) * nloc) {
            __builtin_amdgcn_fence(__ATOMIC_RELEASE, "agent");
            asm volatile("s_waitcnt vmcnt(0)" ::: "memory");
            const unsigned og = xb_add(&bar[XB_TOP], 1u);
            const unsigned tg = og / nx;
            if (og + 1u == (tg + 1u) * nx) xb_add(&bar[XB_TOPGEN], 1u);
            else XB_SPIN(xb_ld(&bar[XB_TOPGEN]) == tg, bar);
            __builtin_amdgcn_fence(__ATOMIC_ACQUIRE, "agent");
            xb_add(&bar[XB_XGEN(b.x)], 1u);
            asm volatile("s_waitcnt vmcnt(0)" ::: "memory");
        } else {
            XB_SPIN(xb_ld(&bar[XB_XGEN(b.x)]) == gen, bar);
            __builtin_amdgcn_fence(__ATOMIC_ACQUIRE, "agent");
            asm volatile("s_waitcnt vmcnt(0)" ::: "memory");
        }
    }
    __syncthreads();
}

constexpr int LDS_BYTES = 163840;
typedef const __attribute__((address_space(4))) P* kargp_t;
#define GETP() P p; { kargp_t kq_ = kp; int w_ = wid; asm volatile("" : "+s"(kq_), "+s"(w_)); p = *(const P*)kq_; p.wid = w_; }
__global__ void __launch_bounds__(NT, 2) fwd_kernel(P p_in) {
    const int wid = __builtin_amdgcn_readfirstlane((int)(threadIdx.x >> 6));
    kargp_t kp = (kargp_t)__builtin_amdgcn_kernarg_segment_ptr();
    extern __shared__ __attribute__((aligned(16))) unsigned char lds[];
    float* sm = (float*)lds;
    { volatile ALAS unsigned* stw = (volatile ALAS unsigned*)((ALAS unsigned char*)lds + LDS_MISC + 2048); if (threadIdx.x < 2) stw[threadIdx.x] = 0u; }
    __syncthreads();
    { GETP(); (void)xcd_barrier_post((unsigned*)(p.ws + WS_CNT + 1024), (volatile ALAS unsigned*)((ALAS unsigned char*)lds + LDS_MISC + 2048), wid); }
#define GBAR() do { GETP(); XcdBarrier gb_; gb_.bar = (unsigned*)(p.ws + WS_CNT + 1024); gb_.x = xb_xcc_id(); gb_.st = (volatile ALAS unsigned*)((ALAS unsigned char*)lds + LDS_MISC + 2048); gb_.wid = wid; xcd_barrier(gb_); } while (0)

    { GETP(); ph_mod(p, sm); }
    { GETP(); ph_rope_table(p); }
    { GETP(); ph_prep_weights(p, lds); }
    GBAR();
#pragma unroll 1
    for (int l = 0; l < 2; ++l) {

        { GETP(); ph_norm1(p, l); }
        if (l == 1) { GETP(); ph_prep_moe(p, l, lds, 1, 0); }
        GBAR();
        { GETP(); PB_InProj pb; pb.A = (const char*)(p.ws + WS_H); pb.ldb = D; pb.nt = D / 64; pb.Bt = (const char*)(p.ws + WS_WIN) + (size_t)l * NZ * D * 2; pb.Zo = (bf16_t*)(p.ws + WS_Z); pb.G = gridDim.x; pb.c = blockIdx.x;
          pg8::gemm_phase<PB_InProj, true>((PG8_LAS unsigned char*)lds, pb, wid); }
        { GETP(); ph_prep_moe(p, l, lds, 0, 96); }
        GBAR();
        { GETP(); ph_rope(p, l); }
        { GETP(); ph_sg(p, l, lds); }
        { GETP(); ph_lru_m1(p, l, lds); }
        { GETP(); ph_hg<1>(p, l, lds); }
        GBAR();
        { GETP(); ph_attn(p, l, lds); }
        { GETP(); ph_lru_m2(p, l, lds); }
        { GETP(); ph_hg<2>(p, l, lds); }
        GBAR();
        { GETP(); PB_OutProj pb; pb.A = (const char*)(p.ws + WS_Y); pb.ldb = D; pb.nt = D / 64; pb.Bt = (const char*)(p.ws + WS_WOUT) + (size_t)l * D * D * 2; pb.D1 = (bf16_t*)(p.ws + WS_D1);
          pb.MODl = (const float*)(p.ws + WS_MOD) + (size_t)l * 9 * 6 * D; pb.G = gridDim.x; pb.c = blockIdx.x; pb.skipctx = (l == 1); pb.dry = false;
          pg8::gemm_phase<PB_OutProj, true>((PG8_LAS unsigned char*)lds, pb, wid); }
        if (l == 0) { GETP(); ph_prep_moe(p, l, lds, 1, 32); }
        GBAR();
        { GETP(); ph_router(p, l, lds + LDS_MISC); }
        GBAR();
        { GETP(); ALAS int* tb = (ALAS int*)(lds + LDS_MISC + 1024); moe_tiles_setup(p, l, tb);
          PB_Moe1 pb; pb.A = (const char*)(p.ws + WS_H); pb.ldb = D; pb.nt = D / 64; pb.W13 = (const char*)(p.ws + WS_W13); pb.HE = (bf16_t*)(p.ws + WS_Z); pb.LISTP = (const int*)(p.ws + WS_LISTP);
          pb.GP = (const float2*)(p.ws + WS_GP); pb.tb = tb; pb.G = gridDim.x; pb.c = blockIdx.x;
          pg8::gemm_phase<PB_Moe1, true>((PG8_LAS unsigned char*)lds, pb, wid); }
        GBAR();
        { GETP(); ALAS int* tb = (ALAS int*)(lds + LDS_MISC + 1024);
          PB_Moe2 pb; pb.A = (const char*)(p.ws + WS_Z); pb.ldb = DE; pb.nt = 16; pb.W2 = (const char*)(p.ws + WS_W2); pb.D2 = (bf16_t*)(p.ws + WS_D2);
          pb.MODl = (const float*)(p.ws + WS_MOD) + (size_t)l * 9 * 6 * D; pb.LISTP = (const int*)(p.ws + WS_LISTP); pb.tb = tb; pb.G = gridDim.x; pb.c = blockIdx.x; pb.dry = false;
          pg8::gemm_phase<PB_Moe2, true>((PG8_LAS unsigned char*)lds, pb, wid); }
        GBAR();
    }

    { GETP(); ph_final(p); }

}

extern "C" void kernel_launch(void* const* d_in, const int* in_sizes, int n_in, void* d_out, int out_size, void* d_ws, size_t ws_size, hipStream_t stream) {
    if (n_in != N_IN || ws_size < WS_END) { fprintf(stderr, "kernel_launch: bad n_in %d or ws %zu < %zu\n", n_in, ws_size, (size_t)WS_END); return; }
    P p{};
    for (int i = 0; i < N_IN; ++i) p.in[i] = (const float*)d_in[i];
    p.out = (float*)d_out; p.ws = (unsigned char*)d_ws;
    (void)hipMemsetAsync((char*)d_ws + WS_CNT, 0, 16384, stream);
    void* args[] = {&p};
    static bool attr_set = false;
    if (!attr_set) { (void)hipFuncSetAttribute((const void*)fwd_kernel, hipFuncAttributeMaxDynamicSharedMemorySize, LDS_BYTES); attr_set = true; }
    hipError_t e = hipLaunchCooperativeKernel((void*)fwd_kernel, dim3(256), dim3(NT), args, LDS_BYTES, stream);
    if (e != hipSuccess) fprintf(stderr, "cooperative launch failed: %s\n", hipGetErrorString(e));
}
```

```cpp
#include <hip/hip_runtime.h>
#include <cstdio>
#include <cstdint>

constexpr int D = 1024, NB = 8, T = 2048, TC = 256, LB = T + TC  , R = NB * LB  ;
constexpr int NZ = 3072, NE = 16, DE = 512;
constexpr float EPS = 1e-6f;
constexpr int ZA_X = 0, ZA_G = 256, ZB_Q = 512, ZB_K = 768, ZB_V = 1024, ZC_U = 1280, ZC_V = 1536, ZD_Q = 1792, ZD_FF = 2048, ZD_FB = 2304, ZD_I = 2560, ZD_G = 2816;
enum { I_X = 0, I_C, I_CTX, I_CCTX, I_WADA, I_BADA, I_N1G, I_N2G, I_WIN, I_WOUT, I_CONVW, I_CONVB, I_WR, I_BR, I_WI, I_BI, I_LAM,
       I_DALAM, I_DASUB, I_SGNG, I_SGW, I_SGB, I_HGLB, I_HGNG, I_RW, I_RB, I_W1, I_W3, I_W2, I_FNG, N_IN };

typedef unsigned short bf16_t;
#define ALAS __attribute__((address_space(3)))
constexpr size_t MiB = 1u << 20;
constexpr size_t WS_MOD = 0;
constexpr size_t WS_CNT = 512 * 1024;
constexpr size_t WS_GP = 1 * MiB;
constexpr size_t WS_LISTP = WS_GP + (size_t)R * 8;
constexpr size_t WS_LRUWT = 768 * 1024;
constexpr size_t WS_ROPE = 4 * MiB + 512 * 1024;
constexpr size_t WS_SGW = 5 * MiB;
constexpr size_t WS_LRUAGG = 3 * MiB;
constexpr size_t WS_X = 8 * MiB;
constexpr size_t WS_H = WS_X + (size_t)R * D * 4;
constexpr size_t WS_Z = WS_H + (size_t)R * D * 2;
constexpr size_t WS_D1 = WS_Z + 64 * MiB;
constexpr size_t WS_Y = WS_Z + (size_t)R * NZ * 2;
constexpr size_t WS_D2 = WS_Y;
constexpr size_t WS_WIN = WS_Y + (size_t)R * D * 2;
constexpr size_t WS_WOUT = WS_WIN + 2 * (size_t)NZ * D * 2;
constexpr size_t WS_W13 = WS_WOUT + 2 * (size_t)D * D * 2;
constexpr size_t WS_W2 = WS_W13 + (size_t)NE * 1024 * D * 2;
constexpr size_t WS_END = WS_W2 + (size_t)NE * D * DE * 2;
constexpr int MPAD = R + 24 * 256;

struct P { const float* in[N_IN]; float* out; unsigned char* ws; int wid; int pad; };
__device__ __forceinline__ int fresh_lane() { int l_; asm volatile("v_mbcnt_lo_u32_b32 %0, -1, 0\n\tv_mbcnt_hi_u32_b32 %0, -1, %0" : "=v"(l_)); return l_; }


__device__ __forceinline__ float bf2f(bf16_t v) { return __uint_as_float(((unsigned)v) << 16); }
typedef float f32x2h_t __attribute__((ext_vector_type(2))); typedef __bf16 bf16x2h_t __attribute__((ext_vector_type(2)));
__device__ __forceinline__ unsigned pk2bf(float lo, float hi) { f32x2h_t v = {lo, hi}; bf16x2h_t b = __builtin_convertvector(v, bf16x2h_t); return __builtin_bit_cast(unsigned, b); }
__device__ __forceinline__ bf16_t f2bf(float f) { return (bf16_t)(pk2bf(f, f) & 0xffffu); }
__device__ __forceinline__ float sigmoidf_(float x) { return __builtin_amdgcn_rcpf(1.f + __expf(-x)); }
__device__ __forceinline__ float siluf_(float x) { return x * __builtin_amdgcn_rcpf(1.f + __expf(-x)); }
__device__ __forceinline__ float geluf_(float x) { const float u = 1.5957691216057308f * (x + 0.044715f * x * x * x); return x * __builtin_amdgcn_rcpf(1.f + __expf(-u)); }
__device__ __forceinline__ float wave_sum(float v) {
#pragma unroll
    for (int o = 1; o < 64; o <<= 1) v += __shfl_xor(v, o);
    return v;
}
__device__ __forceinline__ int row_mi(int r) { const int b = r / LB, j = r - b * LB; return j < TC ? 8 : b; }

#define NT 512
__device__ __forceinline__ const float* xin_row(const float* xin, const float* cin, int r) { const int b = r / LB, j = r - b * LB; return j < TC ? cin + ((size_t)b * TC + j) * D : xin + ((size_t)b * T + (j - TC)) * D; }
__device__ __forceinline__ int ustart(int off) { const int G = gridDim.x, b = blockIdx.x; const int v = (G % 8 == 0) ? (b % 8) * (G / 8) + b / 8 : b; return (v + off) % G; }
#define NWV 8
__device__ __forceinline__ void add_bf4(float (&x)[4], uint2 d) { x[0] += __uint_as_float(d.x << 16); x[1] += __uint_as_float(d.x & 0xffff0000u); x[2] += __uint_as_float(d.y << 16); x[3] += __uint_as_float(d.y & 0xffff0000u); }

__device__ __forceinline__ void ph_init(const P& p) {
    const int tidx = p.wid * 64 + fresh_lane();
    float* X = (float*)(p.ws + WS_X);
    const size_t n4 = (size_t)R * D / 4;
    const size_t stride = (size_t)gridDim.x * NT;
    const float* xin = p.in[I_X]; const float* cin = p.in[I_CTX];
#define INIT_SRC(i_) ({ const size_t e_ = (i_) * 4; const int r_ = (int)(e_ / D), c_ = (int)(e_ % D); const int b_ = r_ / LB, j_ = r_ - b_ * LB; \
        const size_t oc_ = ((size_t)b_ * TC + j_) * D + c_, ox_ = ((size_t)b_ * T + (j_ - TC)) * D + c_; (const float4*)((j_ < TC) ? (cin + oc_) : (xin + ox_)); })
    size_t i = (size_t)blockIdx.x * NT + tidx;
    for (; i + 3 * stride < n4; i += 4 * stride) {
        const float4 v0 = *INIT_SRC(i), v1 = *INIT_SRC(i + stride), v2 = *INIT_SRC(i + 2 * stride), v3 = *INIT_SRC(i + 3 * stride);
        *(float4*)(X + i * 4) = v0; *(float4*)(X + (i + stride) * 4) = v1; *(float4*)(X + (i + 2 * stride) * 4) = v2; *(float4*)(X + (i + 3 * stride) * 4) = v3;
    }
    for (; i < n4; i += stride) *(float4*)(X + i * 4) = *INIT_SRC(i);
#undef INIT_SRC
}

__device__ __forceinline__ void ph_mod(const P& p, float* sm_) {
    const int tidx = p.wid * 64 + fresh_lane();
    float* MOD = (float*)(p.ws + WS_MOD);
    ALAS float* sm = (ALAS float*)sm_; ALAS float* red = sm + 9 * D;
    for (int i = tidx; i < 9 * D; i += NT) { const int mi = i / D, k = i % D; const float c = mi < 8 ? p.in[I_C][mi * D + k] : p.in[I_CCTX][k]; sm[i] = siluf_(c); }
    __syncthreads();
    const int col = tidx & 63, part = tidx >> 6;
    for (int it = blockIdx.x; it < 2 * 96; it += gridDim.x) {
        const int l = it / 96, n0 = (it % 96) * 64;
        const float* W = p.in[I_WADA] + (size_t)l * D * 6 * D + (size_t)(part * 128) * 6 * D + n0 + col;
        float acc[9];
#pragma unroll
        for (int m = 0; m < 9; ++m) acc[m] = 0.f;
#pragma unroll 8
        for (int k = 0; k < 128; ++k) { const float w = W[(size_t)k * 6 * D];
#pragma unroll
            for (int m = 0; m < 9; ++m) acc[m] += sm[m * D + part * 128 + k] * w; }
#pragma unroll
        for (int m = 0; m < 9; ++m) red[(part * 9 + m) * 64 + col] = acc[m];
        __syncthreads();
        for (int o = tidx; o < 9 * 64; o += NT) { const int m = o >> 6, cc = o & 63; float v = p.in[I_BADA][l * 6 * D + n0 + cc];
#pragma unroll
            for (int q = 0; q < 8; ++q) v += red[(q * 9 + m) * 64 + cc];
            MOD[((size_t)l * 9 + m) * 6 * D + n0 + cc] = v; }
        __syncthreads();
    }
}

__device__ __forceinline__ void ph_norm1(const P& p, int l) {
    const int tidx = p.wid * 64 + fresh_lane();
    float* X = (float*)(p.ws + WS_X); bf16_t* H = (bf16_t*)(p.ws + WS_H); const float* xin = p.in[I_X]; const float* cin = p.in[I_CTX];
    const bf16_t* D1 = (const bf16_t*)(p.ws + WS_D1); const bf16_t* D2 = (const bf16_t*)(p.ws + WS_D2);
    const float* MOD = (const float*)(p.ws + WS_MOD) + (size_t)l * 9 * 6 * D; const float* g = p.in[I_N1G] + l * D;
    const int lane = tidx & 63, wv = tidx >> 6;
    const int stride = gridDim.x * NWV; const int r0 = blockIdx.x * NWV + wv;
    float4 gq[4];
#pragma unroll
    for (int q = 0; q < 4; ++q) gq[q] = *(const float4*)(g + (lane + 64 * q) * 4);
    for (int rb = r0; rb < R; rb += 9 * stride) {
        float4 vb[3][4]; uint2 d1b[3][4], d2b[3][4];
#define N1_LOAD(slot, k_) do { int rr_ = rb + (k_) * stride; rr_ = rr_ < R ? rr_ : rb; _Pragma("unroll") for (int q = 0; q < 4; ++q) { vb[slot][q] = *(const float4*)(xin_row(xin, cin, rr_) + (lane + 64 * q) * 4); \
            if (l == 1) { d1b[slot][q] = *(const uint2*)(D1 + (size_t)rr_ * D + (lane + 64 * q) * 4); d2b[slot][q] = *(const uint2*)(D2 + (size_t)rr_ * D + (lane + 64 * q) * 4); } } } while (0)
        N1_LOAD(0, 0); N1_LOAD(1, 1);
#pragma unroll
        for (int k = 0; k < 9; ++k) {
            const int r = rb + k * stride; const int sl = k % 3;
            const float* m = MOD + (size_t)row_mi(r < R ? r : rb) * 6 * D; float4 scq[4], shq[4];
#pragma unroll
            for (int q = 0; q < 4; ++q) { scq[q] = *(const float4*)(m + D + (lane + 64 * q) * 4); shq[q] = *(const float4*)(m + (lane + 64 * q) * 4); }
            if (k + 2 < 9) N1_LOAD((k + 2) % 3, k + 2);
            if (r < R) {
                float xv[4][4]; float ss = 0.f;
#pragma unroll
                for (int q = 0; q < 4; ++q) { xv[q][0] = vb[sl][q].x; xv[q][1] = vb[sl][q].y; xv[q][2] = vb[sl][q].z; xv[q][3] = vb[sl][q].w; if (l == 1) { add_bf4(xv[q], d1b[sl][q]); add_bf4(xv[q], d2b[sl][q]); } }
#pragma unroll
                for (int q = 0; q < 4; ++q) ss += xv[q][0] * xv[q][0] + xv[q][1] * xv[q][1] + xv[q][2] * xv[q][2] + xv[q][3] * xv[q][3];
                const float rs = rsqrtf(wave_sum(ss) * (1.f / D) + EPS);
#pragma unroll
                for (int q = 0; q < 4; ++q) { const int c = (lane + 64 * q) * 4; bf16_t o[4];
                    if (l == 1) *(float4*)(X + (size_t)r * D + c) = make_float4(xv[q][0], xv[q][1], xv[q][2], xv[q][3]);
                    const float4 g4 = gq[q], sc4 = scq[q], sh4 = shq[q];
                    const float gv[4] = {g4.x, g4.y, g4.z, g4.w}, scv[4] = {sc4.x, sc4.y, sc4.z, sc4.w}, shv[4] = {sh4.x, sh4.y, sh4.z, sh4.w};
#pragma unroll
                    for (int i = 0; i < 4; ++i) o[i] = f2bf(xv[q][i] * rs * gv[i] * (1.f + scv[i]) + shv[i]);
                    *(uint2*)(H + (size_t)r * D + c) = make_uint2((unsigned)o[0] | ((unsigned)o[1] << 16), (unsigned)o[2] | ((unsigned)o[3] << 16)); }
            }
        }
#undef N1_LOAD
    }
}

constexpr float QSCALE = 0.17677669529663687f * 1.4426950408889634f;
__device__ __forceinline__ void ph_rope_table(const P& p) {
    const int tidx = p.wid * 64 + fresh_lane();
    float2* TAB = (float2*)(p.ws + WS_ROPE);
    for (int it = blockIdx.x * NT + tidx; it < T * 16; it += gridDim.x * NT) { const int f = it & 7, a = (it >> 3) & 1, t = it >> 4;
        const float pos = (float)(a == 0 ? (t / 64) : (t % 64)); const float freq = expf(-(float)f * 0.125f * 9.210340371976184f); const float ang = pos * freq;
        TAB[it] = make_float2(cosf(ang), sinf(ang)); }
}
__device__ __forceinline__ void ph_rope(const P& p, int l) {
    const int tidx = p.wid * 64 + fresh_lane();
    bf16_t* Z = (bf16_t*)(p.ws + WS_Z); const float2* TAB = (const float2*)(p.ws + WS_ROPE);
    const int total = NB * T * 32;
    for (int it = blockIdx.x * NT + tidx; it < total; it += gridDim.x * NT) {
        const int pr = it & 31, rt = it >> 5; const int b = rt / T, t = rt % T;
        const int a = pr & 1, n = (pr >> 1) & 1, h = (pr >> 2) & 3, qk = pr >> 4;
        bf16_t* zp = Z + (size_t)(b * LB + TC + t) * NZ + (qk ? ZB_K : ZB_Q) + h * 64 + n * 32 + a * 16;
        const uint4 v1 = *(const uint4*)zp, v2 = *(const uint4*)(zp + 8); const unsigned w1[4] = {v1.x, v1.y, v1.z, v1.w}, w2[4] = {v2.x, v2.y, v2.z, v2.w};
        const float2* tb = TAB + (size_t)(t * 2 + a) * 8; const float sc = qk ? 1.f : QSCALE; unsigned o1[4], o2[4];
#pragma unroll
        for (int i = 0; i < 4; ++i) { const float2 cs0 = tb[2 * i], cs1 = tb[2 * i + 1];
            const float x1a = __uint_as_float(w1[i] << 16), x1b = __uint_as_float(w1[i] & 0xffff0000u), x2a = __uint_as_float(w2[i] << 16), x2b = __uint_as_float(w2[i] & 0xffff0000u);
            o1[i] = pk2bf((x1a * cs0.x - x2a * cs0.y) * sc, (x1b * cs1.x - x2b * cs1.y) * sc);
            o2[i] = pk2bf((x2a * cs0.x + x1a * cs0.y) * sc, (x2b * cs1.x + x1b * cs1.y) * sc); }
        *(uint4*)zp = make_uint4(o1[0], o1[1], o1[2], o1[3]); *(uint4*)(zp + 8) = make_uint4(o2[0], o2[1], o2[2], o2[3]);
    }
    if (l == 0) {
        const int totc = NB * TC * 256;
        for (int it = blockIdx.x * NT + tidx; it < totc; it += gridDim.x * NT) {
            const int c = it & 255, rt = it >> 8; const int b = rt / TC, j = rt % TC;
            bf16_t* zp = Z + (size_t)(b * LB + j) * NZ + ZB_Q + c; zp[0] = f2bf(bf2f(zp[0]) * QSCALE);
        }
    }
}

namespace lru {
typedef short bf16x8 __attribute__((ext_vector_type(8)));
typedef float f32x4 __attribute__((ext_vector_type(4)));
constexpr int UROW = 264;
__device__ __forceinline__ void comp(float& A, float& B, float a, float b) { B = a * B + b; A = a * A; }
}
__device__ __forceinline__ void ph_lru_m1(const P& p, int l, unsigned char* ldsb) {
    using namespace lru;
    const int lane = fresh_lane(), wid = p.wid, tid = wid * 64 + lane;
    const bf16_t* Z = (const bf16_t*)(p.ws + WS_Z); bf16_t* G = (bf16_t*)(p.ws + WS_H); float2* AGG = (float2*)(p.ws + WS_LRUAGG);
    const bf16_t* WT = (const bf16_t*)(p.ws + WS_LRUWT);
    const float* cw = p.in[I_CONVW] + l * 4 * 256; const float* cb = p.in[I_CONVB] + l * 256;
    ALAS bf16_t* U = (ALAS bf16_t*)ldsb;
    const int h = wid & 3, d = wid >> 2, l15 = lane & 15, g4 = lane >> 4;
    float spv[4], brv[4], biv[4];
#pragma unroll
    for (int jt = 0; jt < 4; ++jt) { const int w = h * 64 + jt * 16 + l15; spv[jt] = log1pf(expf(-p.in[I_LAM][(l * 2 + d) * 256 + w])); brv[jt] = p.in[I_BR][(l * 2 + d) * 256 + w]; biv[jt] = p.in[I_BI][(l * 2 + d) * 256 + w]; }
    for (int unit = ustart(192); unit < NB * 36; unit += gridDim.x) {
        const int b = unit / 36, c = unit % 36, r0 = b * LB + c * 64; const int lo = c < 4 ? 0 : TC, hi = c < 4 ? TC : LB;
        {
            uint4 zv[4][4];
#pragma unroll
            for (int it4 = 0; it4 < 4; ++it4) { const int item = tid + it4 * NT; const int t = item >> 5, cg = item & 31, j = c * 64 + t;
#pragma unroll
                for (int q = 0; q < 4; ++q) { int jj = j + q - 2; jj = jj < lo ? lo : (jj >= hi ? hi - 1 : jj); zv[it4][q] = *(const uint4*)(Z + (size_t)(b * LB + jj) * NZ + ZA_X + cg * 8); } }
#pragma unroll
            for (int it4 = 0; it4 < 4; ++it4) { const int item = tid + it4 * NT; const int t = item >> 5, cg = item & 31, j = c * 64 + t; float acc[8];
#pragma unroll
                for (int i = 0; i < 8; ++i) acc[i] = cb[cg * 8 + i];
#pragma unroll
                for (int q = 0; q < 4; ++q) { const int jj = j + q - 2; const float msk = (jj >= lo && jj < hi) ? 1.f : 0.f; const unsigned zw[4] = {zv[it4][q].x, zv[it4][q].y, zv[it4][q].z, zv[it4][q].w};
                    const float4 w0 = *(const float4*)(cw + q * 256 + cg * 8), w1 = *(const float4*)(cw + q * 256 + cg * 8 + 4); const float wv8[8] = {w0.x, w0.y, w0.z, w0.w, w1.x, w1.y, w1.z, w1.w};
#pragma unroll
                    for (int i = 0; i < 4; ++i) { acc[2 * i] += __uint_as_float(zw[i] << 16) * (wv8[2 * i] * msk); acc[2 * i + 1] += __uint_as_float(zw[i] & 0xffff0000u) * (wv8[2 * i + 1] * msk); } }
                uint4 o; o.x = pk2bf(acc[0], acc[1]); o.y = pk2bf(acc[2], acc[3]); o.z = pk2bf(acc[4], acc[5]); o.w = pk2bf(acc[6], acc[7]);
                { typedef unsigned u32x4_t __attribute__((ext_vector_type(4))); u32x4_t ov = {o.x, o.y, o.z, o.w}; *(ALAS u32x4_t*)(U + t * UROW + cg * 8) = ov; } }
        }
        __syncthreads();
        bf16x8 af[4][2];
#pragma unroll
        for (int tt = 0; tt < 4; ++tt)
#pragma unroll
            for (int ks = 0; ks < 2; ++ks) af[tt][ks] = *(const ALAS bf16x8*)(U + (16 * tt + l15) * UROW + h * 64 + 32 * ks + 8 * g4);
#pragma unroll 1
        for (int jt = 0; jt < 4; ++jt) {
            const float spj = jt == 0 ? spv[0] : jt == 1 ? spv[1] : jt == 2 ? spv[2] : spv[3], brj = jt == 0 ? brv[0] : jt == 1 ? brv[1] : jt == 2 ? brv[2] : brv[3], bij = jt == 0 ? biv[0] : jt == 1 ? biv[1] : jt == 2 ? biv[2] : biv[3];
            f32x4 ar[4], ai[4];
#pragma unroll
            for (int tt = 0; tt < 4; ++tt) { ar[tt] = (f32x4){0.f, 0.f, 0.f, 0.f}; ai[tt] = (f32x4){0.f, 0.f, 0.f, 0.f}; }
#pragma unroll
            for (int ks = 0; ks < 2; ++ks) { const bf16_t* wp = WT + ((size_t)(((l * 2 + d) * 2 + 0) * 4 + h) * 64 + 16 * jt + l15) * 64 + 32 * ks + 8 * g4; const bf16x8 wr = *(const bf16x8*)wp, wi = *(const bf16x8*)(wp + 4 * 64 * 64);
#pragma unroll
                for (int tt = 0; tt < 4; ++tt) { ar[tt] = __builtin_amdgcn_mfma_f32_16x16x32_bf16(af[tt][ks], wr, ar[tt], 0, 0, 0); ai[tt] = __builtin_amdgcn_mfma_f32_16x16x32_bf16(af[tt][ks], wi, ai[tt], 0, 0, 0); } }
            const int w = h * 64 + jt * 16 + l15; float mA[4], mB[4];
#pragma unroll
            for (int tt = 0; tt < 4; ++tt) { float A = 1.f, Bv = 0.f; float av[4], bv[4];
#pragma unroll
                for (int rg = 0; rg < 4; ++rg) { const int t = 16 * tt + 4 * g4 + rg;
                    const float rgt = sigmoidf_(ar[tt][rg] + brj), igt = sigmoidf_(ai[tt][rg] + bij);
                    const bf16_t lab = f2bf(-8.f * rgt * spj); const float a = __expf(bf2f(lab));
                    const float uu = bf2f(U[t * UROW + w]); const float bc = __builtin_amdgcn_sqrtf(fmaxf(1.f - a * a, 0.f)) * igt * uu;
                    const bf16_t bcb = f2bf(bc);
                    G[((size_t)(d * 2 + 0) * R + r0 + t) * 256 + w] = lab; G[((size_t)(d * 2 + 1) * R + r0 + t) * 256 + w] = bcb;
                    av[rg] = a; bv[rg] = bf2f(bcb); }
                if (d == 0) { comp(A, Bv, av[0], bv[0]); comp(A, Bv, av[1], bv[1]); comp(A, Bv, av[2], bv[2]); comp(A, Bv, av[3], bv[3]); }
                else { comp(A, Bv, av[3], bv[3]); comp(A, Bv, av[2], bv[2]); comp(A, Bv, av[1], bv[1]); comp(A, Bv, av[0], bv[0]); }
                mA[tt] = A; mB[tt] = Bv; }
            float A = 1.f, Bv = 0.f;
#pragma unroll
            for (int s4 = 0; s4 < 4; ++s4) { const int tt = d == 0 ? s4 : 3 - s4; const float ma = d == 0 ? mA[s4] : mA[3 - s4], mb = d == 0 ? mB[s4] : mB[3 - s4]; (void)tt;
#pragma unroll
                for (int gs = 0; gs < 4; ++gs) { const int gg = d == 0 ? gs : 3 - gs; const float a = __shfl(ma, gg * 16 + l15), bq = __shfl(mb, gg * 16 + l15); comp(A, Bv, a, bq); } }
            if (g4 == 0) AGG[((size_t)(b * 2 + d) * 36 + c) * 256 + w] = make_float2(A, Bv);
        }
        __syncthreads();
    }
}
__device__ __forceinline__ void ph_lru_m2(const P& p, int l, unsigned char* ldsb) {
    const int lane = fresh_lane(), wid = p.wid, tid = wid * 64 + lane;
    const bf16_t* Z = (const bf16_t*)(p.ws + WS_Z); const bf16_t* G = (const bf16_t*)(p.ws + WS_H); bf16_t* Y = (bf16_t*)(p.ws + WS_Y); const float2* AGG = (const float2*)(p.ws + WS_LRUAGG);
    ALAS float* HS = (ALAS float*)ldsb;
    const int d = tid >> 8, w = tid & 255;
    const int ncb = l == 1 ? 32 : 36, nun = NB * ncb;
    const int vme = ustart(0);
    for (int pass = 0; pass < 2; ++pass) {
        int unit;
        if (l == 1) unit = pass == 0 ? vme : -1;
        else if (pass == 0) unit = (vme >= 64 && vme < 96) ? -1 : (vme < 64 ? vme : vme - 32);
        else unit = (vme >= 96 && vme < 160) ? 224 + (vme - 96) : -1;
        if (unit < 0 || unit >= nun) continue;
        const int b = unit / ncb, c = (36 - ncb) + unit % ncb, r0 = b * LB + c * 64;
        float hst = 0.f; const float2* ag = AGG + (size_t)(b * 2 + d) * 36 * 256 + w;
        {
            const int pos = d == 0 ? c : (c < 4 ? 3 - c : 4 + (35 - c));
            float mx[36], my[36];
#pragma unroll
            for (int k = 0; k < 36; ++k) { const int cc = d == 0 ? k : (k < 4 ? 3 - k : 39 - k); const float2 m = ag[cc * 256]; mx[k] = m.x; my[k] = m.y; }
#pragma unroll
            for (int k = 0; k < 36; ++k) { const bool vf = k < pos; const float a = vf ? mx[k] : 1.f, bq = vf ? my[k] : 0.f; hst = __builtin_fmaf(a, hst, bq); }
        }
        const bf16_t* gl = G + ((size_t)(d * 2 + 0) * R + r0) * 256 + w; const bf16_t* gb = G + ((size_t)(d * 2 + 1) * R + r0) * 256 + w;
#pragma unroll 1
        for (int s0 = 0; s0 < 64; s0 += 32) {
            bf16_t la[32], lb[32];
#pragma unroll
            for (int i = 0; i < 32; ++i) { const int t = d == 0 ? (s0 + i) : 63 - (s0 + i); la[i] = gl[t * 256]; lb[i] = gb[t * 256]; }
#pragma unroll
            for (int i = 0; i < 32; ++i) { const int t = d == 0 ? (s0 + i) : 63 - (s0 + i); hst = __expf(bf2f(la[i])) * hst + bf2f(lb[i]); HS[(d * 64 + t) * 256 + w] = hst; }
        }
        __syncthreads();
#pragma unroll
        for (int q = 0; q < 4; ++q) { const int it = tid + q * NT; const int t = it >> 5, c8 = (it & 31) * 8;
            const uint4 zv = *(const uint4*)(Z + (size_t)(r0 + t) * NZ + ZA_G + c8); const unsigned zw[4] = {zv.x, zv.y, zv.z, zv.w}; unsigned o[4];
#pragma unroll
            for (int i = 0; i < 4; ++i) { const float h0 = HS[t * 256 + c8 + 2 * i] + HS[(64 + t) * 256 + c8 + 2 * i], h1 = HS[t * 256 + c8 + 2 * i + 1] + HS[(64 + t) * 256 + c8 + 2 * i + 1];
                o[i] = pk2bf(h0 * geluf_(__uint_as_float(zw[i] << 16)), h1 * geluf_(__uint_as_float(zw[i] & 0xffff0000u))); }
            *(uint4*)(Y + (size_t)(r0 + t) * D + c8) = make_uint4(o[0], o[1], o[2], o[3]); }
        __syncthreads();
    }
}

__device__ __forceinline__ void ph_sg(const P& p, int l, unsigned char* ldsb) {
    typedef short bf16x8 __attribute__((ext_vector_type(8))); typedef float f32x16 __attribute__((ext_vector_type(16)));
    const int lane = fresh_lane(), wid = p.wid, tid = wid * 64 + lane, r32 = lane & 31, hi = lane >> 5;
    const bf16_t* Z = (const bf16_t*)(p.ws + WS_Z); bf16_t* Y = (bf16_t*)(p.ws + WS_Y); const bf16_t* SGW = (const bf16_t*)(p.ws + WS_SGW) + (size_t)l * 4 * 128 * 128;
    const float* ng = p.in[I_SGNG] + l * 256;
    ALAS bf16_t* VT = (ALAS bf16_t*)ldsb;
    constexpr int VROW = 136;
    const int q = tid >> 2, part = tid & 3, ptile = wid & 3, chalf = wid >> 2;
    const int nck = l == 1 ? 16 : 18;
    const int vme = ustart(0), nun_sg = NB * nck * 4;
    for (int pass = 0; pass < 3; ++pass) {
        int unit;
        if (pass == 0) unit = vme;
        else if (pass == 1) unit = (vme >= 64 && vme < 96) ? -1 : 256 + (vme < 64 ? vme : vme - 32);
        else unit = (vme >= 160 && vme < 192) ? 480 + (vme - 160) : (vme < 64 ? 512 + vme : -1);
        if (unit < 0 || unit >= nun_sg) continue;
        const int h = unit & 3, bc = unit >> 2, b = bc / nck, ck = (18 - nck) + bc % nck;
        const int r0 = b * LB + ck * 128;
        bf16x8 wf[8];
        { const bf16_t* wp = SGW + ((size_t)h * 128 + 32 * ptile + r32) * 128 + 8 * hi;
#pragma unroll
          for (int ks = 0; ks < 8; ++ks) wf[ks] = *(const bf16x8*)(wp + 16 * ks); }
        { const bf16_t* zv = Z + (size_t)(r0 + q) * NZ + ZC_V + part * 64; uint4 raw[8]; float ss = 0.f;
#pragma unroll
          for (int i = 0; i < 8; ++i) raw[i] = *(const uint4*)(zv + 8 * i);
#pragma unroll
          for (int i = 0; i < 8; ++i) { const unsigned w4[4] = {raw[i].x, raw[i].y, raw[i].z, raw[i].w};
#pragma unroll
              for (int k = 0; k < 4; ++k) { const float g0 = geluf_(__uint_as_float(w4[k] << 16)), g1 = geluf_(__uint_as_float(w4[k] & 0xffff0000u)); ss += g0 * g0 + g1 * g1; } }
          ss += __shfl_xor(ss, 1); ss += __shfl_xor(ss, 2);
          const float rs = rsqrtf(ss * (1.f / 256.f) + EPS);
          if (part == h) {
#pragma unroll
              for (int i = 0; i < 8; ++i) { const unsigned w4[4] = {raw[i].x, raw[i].y, raw[i].z, raw[i].w};
#pragma unroll
                  for (int k = 0; k < 4; ++k) { const int c = 8 * i + 2 * k;
                      VT[c * VROW + q] = f2bf(geluf_(__uint_as_float(w4[k] << 16)) * rs * ng[h * 64 + c]);
                      VT[(c + 1) * VROW + q] = f2bf(geluf_(__uint_as_float(w4[k] & 0xffff0000u)) * rs * ng[h * 64 + c + 1]); } } } }
        __syncthreads();
        f32x16 acc = f32x16{};
#pragma unroll
        for (int ks = 0; ks < 8; ++ks) { const bf16x8 vf = *(const ALAS bf16x8*)(VT + (32 * chalf + r32) * VROW + 16 * ks + 8 * hi); acc = __builtin_amdgcn_mfma_f32_32x32x16_bf16(wf[ks], vf, acc, 0, 0, 0); }
        { const float* bsp = p.in[I_SGB] + (l * 4 + h) * 128 + 32 * ptile + 4 * hi; bf16_t zu[16];
          const size_t rb = (size_t)(r0 + 32 * ptile + 4 * hi);
#pragma unroll
          for (int r = 0; r < 16; ++r) { const int pr = (r & 3) + 8 * (r >> 2); zu[r] = Z[(rb + pr) * NZ + ZC_U + h * 64 + 32 * chalf + r32]; }
#pragma unroll
          for (int r = 0; r < 16; ++r) { const int pr = (r & 3) + 8 * (r >> 2); Y[(rb + pr) * D + 512 + h * 64 + 32 * chalf + r32] = f2bf(geluf_(bf2f(zu[r])) * (acc[r] + bsp[pr])); } }
        __syncthreads();
    }
}

namespace att {
typedef short bf16x8 __attribute__((ext_vector_type(8)));
typedef short s16x4 __attribute__((ext_vector_type(4)));
typedef float f32x16 __attribute__((ext_vector_type(16)));
typedef float f32x2_t __attribute__((ext_vector_type(2))); typedef __bf16 bf16x2_t __attribute__((ext_vector_type(2)));
constexpr int SLOTB = 8192, NSLOT = 3, L_K = 0, L_V = NSLOT * SLOTB, L_WS = 2 * NSLOT * SLOTB, L_OST = L_WS + 8 * 2 * 32 * 4, OST_W = 32 * 66 * 4;
constexpr float THR = 8.f;
__device__ __forceinline__ int crow(int r, int hi) { return (r & 3) + 8 * (r >> 2) + 4 * hi; }
__device__ __forceinline__ unsigned cvtpk(float lo, float hi) { f32x2_t v = {lo, hi}; bf16x2_t b = __builtin_convertvector(v, bf16x2_t); return __builtin_bit_cast(unsigned, b); }
__device__ __forceinline__ float max3f(float a, float b, float c) { float r; asm("v_max3_f32 %0, %1, %2, %3" : "=v"(r) : "v"(a), "v"(b), "v"(c)); return r; }
__device__ __forceinline__ float swapmax(float m) { auto rr = __builtin_amdgcn_permlane32_swap(__float_as_uint(m), __float_as_uint(m), false, false); return fmaxf(__uint_as_float(rr[0]), __uint_as_float(rr[1])); }
__device__ __forceinline__ float swapadd(float m) { auto rr = __builtin_amdgcn_permlane32_swap(__float_as_uint(m), __float_as_uint(m), false, false); return __uint_as_float(rr[0]) + __uint_as_float(rr[1]); }
typedef short v4i16_t __attribute__((ext_vector_type(4)));
__device__ __forceinline__ void glds16(const void* gsrc, unsigned lds_dst) { unsigned keep;
  asm volatile("s_mov_b32 %0, m0\n\ts_mov_b32 m0, %2\n\ts_nop 0\n\tglobal_load_lds_dwordx4 %1, off\n\ts_mov_b32 m0, %0" : "=&s"(keep) : "v"(gsrc), "s"(lds_dst) : "memory"); }
__device__ __forceinline__ s16x4 vtr(const ALAS char* q) { return __builtin_bit_cast(s16x4, __builtin_amdgcn_ds_read_tr16_b64_v4i16((ALAS v4i16_t*)q)); }
}
__device__ __forceinline__ void ph_attn(const P& p, int l, unsigned char* ldsb) {
    using namespace att;
    const int lane = fresh_lane(), wid = p.wid, r32 = lane & 31, hi = lane >> 5;
    const bf16_t* Z = (const bf16_t*)(p.ws + WS_Z); bf16_t* Y = (bf16_t*)(p.ws + WS_Y);
    const float lam_init = l == 0 ? 0.2f : (0.8f - 0.6f * 0.7408182206817179f);
    const float* dl_ = p.in[I_DALAM] + l * 4 * 32; float s01 = 0.f, s23 = 0.f;
    for (int i = 0; i < 32; ++i) { s01 += dl_[i] * dl_[32 + i]; s23 += dl_[64 + i] * dl_[96 + i]; }
    const float lam = expf(s01) - expf(s23) + lam_init;
    const float* subg = p.in[I_DASUB] + l * 64;
    const int G = gridDim.x, bx = blockIdx.x, vcu = (G % 8 == 0) ? (bx % 8) * (G / 8) + bx / 8 : bx;
    const int nun = 256 + (l == 0 ? 32 : 0);
    ALAS char* L3 = (ALAS char*)ldsb; const unsigned lds0 = (unsigned)(size_t)L3;
    ALAS float* wsf = (ALAS float*)(L3 + L_WS) + wid * 64;
    ALAS float* stg = (ALAS float*)(L3 + L_OST + wid * OST_W);
    const ALAS char* kp0 = L3 + L_K + hi * 1024 + r32 * 16;
    const ALAS char* vp0 = L3 + L_V + ((lane >> 4) & 1) * 32 + (lane & 3) * 8 + (4 * hi + ((lane & 15) >> 2)) * 64;
    for (int u = vcu; u < nun; u += G) {
        int b, h, q0row, nt;
        if (u < 256) { b = u >> 5; h = (u >> 3) & 3; q0row = b * LB + TC + (u & 7) * 256; nt = LB / 64; } else { const int v = u - 256; b = v >> 2; h = v & 3; q0row = b * LB; nt = TC / 64; }
        const bf16_t* ksrc = Z + (size_t)(b * LB + lane) * NZ + ZB_K + h * 64 + wid * 8;
        const bf16_t* vsrc = Z + (size_t)(b * LB + 16 * (wid & 3) + (lane >> 2)) * NZ + ZB_V + h * 64 + (wid >> 2) * 32 + (lane & 3) * 8;
#define ATT_DMA(t, slot) do { att::glds16(ksrc + (size_t)(t) * 64 * NZ, (unsigned)__builtin_amdgcn_readfirstlane((int)(lds0 + L_K + (slot) * SLOTB + wid * 1024))); \
                              att::glds16(vsrc + (size_t)(t) * 64 * NZ, (unsigned)__builtin_amdgcn_readfirstlane((int)(lds0 + L_V + (slot) * SLOTB + wid * 1024))); } while (0)
        ATT_DMA(0, 0); ATT_DMA(1, 1);
        bf16x8 qr[4];
        { const bf16_t* qp = Z + (size_t)(q0row + wid * 32 + r32) * NZ + ZB_Q + h * 64 + hi * 8;
#pragma unroll
          for (int d0 = 0; d0 < 4; ++d0) qr[d0] = *(const bf16x8*)(qp + d0 * 16); }
        f32x16 o[2][2], negm[2]; float mrun[2] = {0.f, 0.f}, lsum[2] = {0.f, 0.f};
#pragma unroll
        for (int n = 0; n < 2; ++n) { negm[n] = f32x16{}; o[n][0] = f32x16{}; o[n][1] = f32x16{}; }
        asm volatile("s_waitcnt vmcnt(0)" : "+v"(qr[0]), "+v"(qr[1]), "+v"(qr[2]), "+v"(qr[3]) :: "memory"); __syncthreads();
        int slot = 0; int t = 0;
#define ATT_TILE(FIRST) do { \
            if (t + 2 < nt) { const int s2 = slot == 0 ? 2 : slot - 1; ATT_DMA(t + 2, s2); } \
            const int so = slot * SLOTB; \
            f32x16 cc[2][2]; \
            _Pragma("unroll") \
            for (int n = 0; n < 2; ++n) { \
                const bf16x8 k00 = *(const ALAS bf16x8*)(kp0 + so + (2 * n) * 2048), k01 = *(const ALAS bf16x8*)(kp0 + so + (2 * n) * 2048 + 512); \
                const bf16x8 k10 = *(const ALAS bf16x8*)(kp0 + so + (2 * n + 1) * 2048), k11 = *(const ALAS bf16x8*)(kp0 + so + (2 * n + 1) * 2048 + 512); \
                cc[n][0] = __builtin_amdgcn_mfma_f32_32x32x16_bf16(k00, qr[2 * n], negm[n], 0, 0, 0); \
                cc[n][1] = __builtin_amdgcn_mfma_f32_32x32x16_bf16(k01, qr[2 * n], negm[n], 0, 0, 0); \
                cc[n][0] = __builtin_amdgcn_mfma_f32_32x32x16_bf16(k10, qr[2 * n + 1], cc[n][0], 0, 0, 0); \
                cc[n][1] = __builtin_amdgcn_mfma_f32_32x32x16_bf16(k11, qr[2 * n + 1], cc[n][1], 0, 0, 0); \
            } \
            _Pragma("unroll") \
            for (int n = 0; n < 2; ++n) { \
                bf16x8 pa[4]; \
                f32x16 c0 = cc[n][0], c1 = cc[n][1]; \
                asm volatile("s_nop 15\n\ts_nop 7" : "+v"(c0), "+v"(c1));      \
                float rm = max3f(c0[0], c1[0], c0[1]), rm2 = max3f(c1[1], c0[2], c1[2]); \
            _Pragma("unroll") \
                for (int r = 3; r < 15; r += 2) { rm = max3f(rm, c0[r], c1[r]); rm2 = max3f(rm2, c0[r + 1], c1[r + 1]); } \
                rm = max3f(rm, rm2, c0[15]); rm = max3f(rm, c1[15], c1[15]); \
                rm = swapmax(rm); \
                if (FIRST || __builtin_expect(__any(rm > THR), 0)) { \
                    const float dl = FIRST ? rm : fmaxf(rm, 0.f); mrun[n] += dl; \
            _Pragma("unroll") \
                    for (int r = 0; r < 16; ++r) { c0[r] -= dl; c1[r] -= dl; negm[n][r] = -mrun[n]; } \
                    const float f = exp2f(-dl); lsum[n] *= f; \
                    if (hi == 0) wsf[n * 32 + r32] = f; \
            _Pragma("unroll") \
                    for (int r = 0; r < 16; ++r) { const float ff = wsf[n * 32 + crow(r, hi)]; o[n][0][r] *= ff; o[n][1][r] *= ff; } \
                } \
                float sacc = 0.f; \
            _Pragma("unroll") \
                for (int r = 0; r < 16; ++r) { c0[r] = __builtin_amdgcn_exp2f(c0[r]); c1[r] = __builtin_amdgcn_exp2f(c1[r]); sacc += c0[r] + c1[r]; } \
                lsum[n] += sacc; \
            _Pragma("unroll") \
                for (int k = 0; k < 2; ++k) { \
                    uint4 q0 = make_uint4(cvtpk(c0[8 * k], c0[8 * k + 1]), cvtpk(c0[8 * k + 2], c0[8 * k + 3]), cvtpk(c0[8 * k + 4], c0[8 * k + 5]), cvtpk(c0[8 * k + 6], c0[8 * k + 7])); \
                    uint4 q1 = make_uint4(cvtpk(c1[8 * k], c1[8 * k + 1]), cvtpk(c1[8 * k + 2], c1[8 * k + 3]), cvtpk(c1[8 * k + 4], c1[8 * k + 5]), cvtpk(c1[8 * k + 6], c1[8 * k + 7])); \
                    pa[k] = __builtin_bit_cast(bf16x8, q0); pa[2 + k] = __builtin_bit_cast(bf16x8, q1); } \
            _Pragma("unroll") \
                for (int d0 = 0; d0 < 2; ++d0) { \
                    bf16x8 vf[4]; \
            _Pragma("unroll") \
                    for (int k = 0; k < 4; ++k) { const s16x4 lo = vtr(vp0 + so + d0 * 4096 + k * 1024), hh = vtr(vp0 + so + d0 * 4096 + k * 1024 + 512); \
                        vf[k] = (bf16x8){lo[0], lo[1], lo[2], lo[3], hh[0], hh[1], hh[2], hh[3]}; } \
            _Pragma("unroll") \
                    for (int k = 0; k < 4; ++k) o[n][d0] = __builtin_amdgcn_mfma_f32_32x32x16_bf16(pa[k], vf[k], o[n][d0], 0, 0, 0); \
                } \
            } \
            if (t + 2 < nt) asm volatile("s_waitcnt vmcnt(2)" ::: "memory"); else asm volatile("s_waitcnt vmcnt(0)" ::: "memory"); \
            __builtin_amdgcn_s_barrier(); asm volatile("" ::: "memory"); \
            slot = slot == 2 ? 0 : slot + 1; \
        } while (0)
        ATT_TILE(true);
        for (t = 1; t < nt; ++t) ATT_TILE(false);
#undef ATT_TILE
        { const float l1 = swapadd(lsum[0]), l2 = swapadd(lsum[1]);
          const int lane_e = fresh_lane(); const int r32 = lane_e & 31, hi = lane_e >> 5, lane = lane_e;
          ALAS float* wsf = (ALAS float*)(L3 + L_WS) + wid * 64; ALAS float* stg = (ALAS float*)(L3 + L_OST + wid * OST_W);
          if (hi == 0) { wsf[r32] = __builtin_amdgcn_rcpf(l1); wsf[32 + r32] = lam * __builtin_amdgcn_rcpf(l2); }
#pragma unroll
          for (int r = 0; r < 16; ++r) { const int q = crow(r, hi); const float a = wsf[q], bb = wsf[32 + q];
              stg[q * 66 + r32] = o[0][0][r] * a - o[1][0][r] * bb; stg[q * 66 + 32 + r32] = o[0][1][r] * a - o[1][1][r] * bb; }
          const int row = lane >> 1, half = lane & 1; float ov[32]; float ss = 0.f;
#pragma unroll
          for (int i = 0; i < 32; ++i) { ov[i] = stg[row * 66 + half * 32 + i]; ss += ov[i] * ov[i]; }
          ss += __shfl_xor(ss, 1);
          const float rs = rsqrtf(ss * (1.f / 64.f) + EPS) * (1.f - lam_init);
          bf16_t* yo = Y + (size_t)(q0row + wid * 32 + row) * D + 256 + h * 64 + half * 32;
#pragma unroll
          for (int i = 0; i < 4; ++i) { unsigned w[4];
#pragma unroll
              for (int k = 0; k < 4; ++k) w[k] = cvtpk(ov[8 * i + 2 * k] * rs * subg[half * 32 + 8 * i + 2 * k], ov[8 * i + 2 * k + 1] * rs * subg[half * 32 + 8 * i + 2 * k + 1]);
              *(uint4*)(yo + 8 * i) = make_uint4(w[0], w[1], w[2], w[3]); } }
        __syncthreads();
#undef ATT_DMA
    }
}


namespace hg {
typedef short bf16x8 __attribute__((ext_vector_type(8)));
typedef short s16x4 __attribute__((ext_vector_type(4)));
typedef float f32x16 __attribute__((ext_vector_type(16)));
typedef float f32x4v __attribute__((ext_vector_type(4)));
constexpr int QROW = 72;
constexpr int W_Q = 0, W_K = 4608, W_KH = 9216, W_V = 13312, W_BYTES = 17408;
constexpr int L_ST = 8 * W_BYTES;
constexpr int STROW = 68, L_BS = L_ST + 64 * STROW * 4;
constexpr int AGG_FLOATS = 64 * 64 + 64;
__device__ __forceinline__ int img_off(int s, int col) { return ((col >> 5) * 2 + (s >> 4)) * 1024 + (s & 15) * 64 + (col & 31) * 2; }
}
constexpr int LDS_MISC = hg::L_BS + 256;
constexpr int LDS_MISC_HGB = LDS_MISC + 2560;
template <int PASS>
__device__ __forceinline__ void ph_hg(const P& p, int l, unsigned char* ldsb) {
    using namespace hg;
    const int wid = p.wid;
    const bf16_t* Z = (const bf16_t*)(p.ws + WS_Z); bf16_t* Y = (bf16_t*)(p.ws + WS_Y); float* AGG = (float*)p.out;
    ALAS char* L3 = (ALAS char*)ldsb; ALAS char* LW = L3 + wid * W_BYTES;
    ALAS float* ST = (ALAS float*)(L3 + L_ST); ALAS float* BS = (ALAS float*)(L3 + L_BS);
    const float* gn = p.in[I_HGNG] + l * 256;
    const int nsc = (PASS == 2 && l == 1) ? 8 : 9;
    const int nunits = PASS == 1 ? NB * 4 * 9 * 2 : NB * 4 * nsc;
    for (int unit = ustart(PASS == 1 ? 160 : 192); unit < nunits; unit += gridDim.x) {
        const int uu = PASS == 1 ? unit >> 1 : unit; const int d_lo = PASS == 1 ? (unit & 1) : 0, d_hi = PASS == 1 ? (unit & 1) + 1 : 2;
        const int sc = (9 - nsc) + uu % nsc, bh = uu / nsc, h = bh & 3, b = bh >> 2;
        const int lane = fresh_lane();
        const int tid = wid * 64 + lane, r32 = lane & 31, hi = lane >> 5;
        const ALAS char* trb = LW + ((lane >> 4) & 1) * 32 + (lane & 3) * 8 + (4 * hi + ((lane & 15) >> 2)) * 64;
        float* OSG = (float*)p.out + (size_t)4 * 1024 * 1024 + (size_t)blockIdx.x * 16384;
#pragma unroll 1
        for (int d = d_lo; d < d_hi; ++d) {
            float lb = 0.f;
            if (l == 1) { const float* hl = p.in[I_HGLB] + (size_t)d * 2 * 256 + h * 64 + lane; lb = sigmoidf_(hl[256] - hl[0]); }
            const int fcol = (d == 0 ? ZD_FF : ZD_FB) + h * 64 + lane;
            const int jbase = b * LB + sc * 256;
            { const float* ag = AGG + (size_t)((b * 4 + h) * 2 + d) * 9 * AGG_FLOATS; const int dd = tid & 63;
              float sv[8];
#pragma unroll
              for (int i = 0; i < 8; ++i) sv[i] = 0.f;
              if (PASS == 2) {
#pragma unroll
                  for (int k = 0; k < 8; ++k) { const int ai = d == 0 ? k : (k == 0 ? 0 : 9 - k); const bool valid = d == 0 ? (k < sc) : (k == 0 ? (sc > 0) : (ai > sc)); const int ac = valid ? ai : 0;
                      const float dv = valid ? __expf(ag[(size_t)ac * AGG_FLOATS + 4096 + dd]) : 1.f;
#pragma unroll
                      for (int i = 0; i < 8; ++i) { const float s_ = ag[(size_t)ac * AGG_FLOATS + tid + 512 * i]; sv[i] = dv * sv[i] + (valid ? s_ : 0.f); } } }
#pragma unroll
              for (int i = 0; i < 8; ++i) { const int e = tid + 512 * i; ST[(e >> 6) * STROW + (e & 63)] = sv[i]; }
              if (tid < 64) BS[tid] = 0.f; }
            {   typedef unsigned u32x4s __attribute__((ext_vector_type(4)));
                const int tk = lane >> 3, c8 = (lane & 7) * 8;
                u32x4s rv[4], rf[4], rq[4];
#pragma unroll
                for (int g = 0; g < 4; ++g) { const int tau = 8 * g + tk; const int jl = d == 0 ? (32 * wid + tau) : (255 - 32 * wid - tau); const bf16_t* zr = Z + (size_t)(jbase + jl) * NZ + h * 64 + c8;
                    rv[g] = *(const u32x4s*)(zr + ZD_I); rf[g] = *(const u32x4s*)(zr + (d == 0 ? ZD_FF : ZD_FB)); if (PASS == 2) rq[g] = *(const u32x4s*)(zr + ZD_Q); }
#pragma unroll
                for (int g = 0; g < 4; ++g) { const int tau = 8 * g + tk;
                    *(ALAS u32x4s*)(LW + W_V + img_off(tau, c8)) = rv[g];
                    *(ALAS u32x4s*)(LW + W_K + (tau * QROW + c8) * 2) = rf[g];
                    if (PASS == 2) *(ALAS u32x4s*)(LW + W_Q + (tau * QROW + c8) * 2) = rq[g]; }
            }
            float gl[32]; float Btot = 0.f;
#pragma unroll
            for (int tau = 0; tau < 32; ++tau) { const float f = lb + (1.f - lb) * sigmoidf_(bf2f(*(const ALAS bf16_t*)(LW + W_K + (tau * QROW + lane) * 2))); gl[tau] = fmaxf(__logf(f), -80.f); Btot += gl[tau]; }
            { float run = 0.f;
#pragma unroll
              for (int tau = 0; tau < 32; ++tau) { run += gl[tau]; const float kk = 1.f - __expf(gl[tau]);
                *(ALAS bf16_t*)(LW + W_KH + img_off(tau, lane)) = f2bf(kk * __expf(Btot - run));
                if (PASS == 2) { ALAS bf16_t* qp = (ALAS bf16_t*)(LW + W_Q + (tau * QROW + lane) * 2); *qp = f2bf(bf2f(*qp) * 0.125f * __expf(run));
                                 *(ALAS bf16_t*)(LW + W_K + (tau * QROW + lane) * 2) = f2bf(kk * __expf(fminf(-run, 80.f))); } } }
            f32x16 sl[2][2];
#pragma unroll
            for (int cv = 0; cv < 2; ++cv)
#pragma unroll
                for (int cd = 0; cd < 2; ++cd) sl[cv][cd] = f32x16{};
            bf16x8 vfr[2][2];
#pragma unroll
            for (int ks = 0; ks < 2; ++ks)
#pragma unroll
                for (int ch = 0; ch < 2; ++ch) { const s16x4 lo = att::vtr(trb + W_V + (ch * 2 + ks) * 1024), hh = att::vtr(trb + W_V + (ch * 2 + ks) * 1024 + 512);
                    vfr[ks][ch] = (bf16x8){lo[0], lo[1], lo[2], lo[3], hh[0], hh[1], hh[2], hh[3]}; }
#pragma unroll
            for (int ks = 0; ks < 2; ++ks)
#pragma unroll
                for (int cd = 0; cd < 2; ++cd) { const s16x4 lo = att::vtr(trb + W_KH + (cd * 2 + ks) * 1024), hh = att::vtr(trb + W_KH + (cd * 2 + ks) * 1024 + 512);
                    const bf16x8 kf = (bf16x8){lo[0], lo[1], lo[2], lo[3], hh[0], hh[1], hh[2], hh[3]};
#pragma unroll
                    for (int cv = 0; cv < 2; ++cv) sl[cv][cd] = __builtin_amdgcn_mfma_f32_32x32x16_bf16(vfr[ks][cv], kf, sl[cv][cd], 0, 0, 0); }
            f32x16 o[2]; o[0] = f32x16{}; o[1] = f32x16{};
            bf16x8 qf[4];
            if (PASS == 2) {
                f32x16 c = f32x16{};
#pragma unroll
                for (int d0 = 0; d0 < 4; ++d0) { qf[d0] = *(const ALAS bf16x8*)(LW + W_Q + (r32 * QROW + 16 * d0 + 8 * hi) * 2);
                    const bf16x8 kf = *(const ALAS bf16x8*)(LW + W_K + (r32 * QROW + 16 * d0 + 8 * hi) * 2);
                    c = __builtin_amdgcn_mfma_f32_32x32x16_bf16(kf, qf[d0], c, 0, 0, 0); }
#pragma unroll
                for (int r = 0; r < 16; ++r) { const int srow = att::crow(r, hi); if (srow > r32) c[r] = 0.f; }
#pragma unroll
                for (int ks = 0; ks < 2; ++ks) { const uint4 q4 = make_uint4(att::cvtpk(c[8 * ks], c[8 * ks + 1]), att::cvtpk(c[8 * ks + 2], c[8 * ks + 3]), att::cvtpk(c[8 * ks + 4], c[8 * ks + 5]), att::cvtpk(c[8 * ks + 6], c[8 * ks + 7]));
                    const bf16x8 pa = __builtin_bit_cast(bf16x8, q4);
                    o[0] = __builtin_amdgcn_mfma_f32_32x32x16_bf16(pa, vfr[ks][0], o[0], 0, 0, 0); o[1] = __builtin_amdgcn_mfma_f32_32x32x16_bf16(pa, vfr[ks][1], o[1], 0, 0, 0); }
            }
            if constexpr (PASS == 1) {
            __syncthreads();
            ALAS float* SL = (ALAS float*)LW; ALAS float* BARR = (ALAS float*)(L3 + LDS_MISC_HGB); ALAS float* DARR = BARR + 8 * 64;
            float Bacc = Btot;
            int sbase = (4 * hi) * STROW + r32; asm volatile("" : "+v"(sbase));
#pragma unroll
            for (int cv = 0; cv < 2; ++cv)
#pragma unroll
                for (int cd = 0; cd < 2; ++cd)
#pragma unroll
                    for (int r = 0; r < 16; ++r) SL[sbase + (32 * cv + (r & 3) + 8 * (r >> 2)) * STROW + 32 * cd] = sl[cv][cd][r];
            BARR[wid * 64 + lane] = Bacc;
            __syncthreads();
            {
                float spA[16], spB[16]; float bp = 0.f, dkq[2] = {1.f, 1.f};
#define HG_RD(dst, cv_, cd_, sh_) do { if (wid >= (sh_)) { const ALAS float* PS_ = (const ALAS float*)(L3 + (wid - (sh_)) * W_BYTES); _Pragma("unroll") for (int r = 0; r < 16; ++r) \
                    dst[r] = PS_[sbase + (32 * (cv_) + (r & 3) + 8 * (r >> 2)) * STROW + 32 * (cd_)]; } } while (0)
#define HG_WR(src, cv_, cd_, sh_) do { if (wid >= (sh_)) { _Pragma("unroll") for (int r = 0; r < 16; ++r) { sl[cv_][cd_][r] = dkq[cd_] * src[r] + sl[cv_][cd_][r]; \
                    SL[sbase + (32 * (cv_) + (r & 3) + 8 * (r >> 2)) * STROW + 32 * (cd_)] = sl[cv_][cd_][r]; } } } while (0)
#define HG_STEP_BEGIN(sh_) do { if (wid >= (sh_)) { bp = BARR[(wid - (sh_)) * 64 + lane]; const float dk_ = __expf(Bacc); dkq[0] = __shfl(dk_, r32); dkq[1] = __shfl(dk_, 32 + r32); } } while (0)
#define HG_STEP_END(sh_) do { if (wid >= (sh_)) { Bacc += bp; BARR[wid * 64 + lane] = Bacc; } } while (0)
#define HG_STEP(sh_) do { HG_STEP_BEGIN(sh_); HG_RD(spA, 0, 0, sh_); __syncthreads(); \
                HG_WR(spA, 0, 0, sh_); HG_RD(spB, 0, 1, sh_); __syncthreads(); \
                HG_WR(spB, 0, 1, sh_); HG_RD(spA, 1, 0, sh_); __syncthreads(); \
                HG_WR(spA, 1, 0, sh_); HG_RD(spB, 1, 1, sh_); __syncthreads(); \
                HG_WR(spB, 1, 1, sh_); HG_STEP_END(sh_); __syncthreads(); } while (0)
                HG_STEP(1); HG_STEP(2); HG_STEP(4);
#undef HG_STEP
#undef HG_RD
#undef HG_WR
#undef HG_STEP_BEGIN
#undef HG_STEP_END
            }
            if (PASS == 1) {
                float* ag = AGG + ((size_t)((b * 4 + h) * 2 + d) * 9 + sc) * AGG_FLOATS; const ALAS float* S7 = (const ALAS float*)(L3 + 7 * W_BYTES);
                for (int e = tid; e < 4096; e += NT) ag[e] = S7[(e >> 6) * STROW + (e & 63)];
                if (tid < 64) ag[4096 + tid] = BARR[7 * 64 + tid];
                __syncthreads();
            }
            }
            if constexpr (PASS == 2) {
            __syncthreads();
#pragma unroll 1
            for (int step = 0; step < 8; ++step) {
                if (wid == step) {
                    if (PASS == 2) {
#pragma unroll
                        for (int cv = 0; cv < 2; ++cv)
#pragma unroll
                            for (int d0 = 0; d0 < 4; ++d0) { const ALAS float* sp = ST + (32 * cv + r32) * STROW + 16 * d0 + 8 * hi; const f32x4v s0 = *(const ALAS f32x4v*)sp, s1 = *(const ALAS f32x4v*)(sp + 4);
                                const uint4 q4 = make_uint4(att::cvtpk(s0[0], s0[1]), att::cvtpk(s0[2], s0[3]), att::cvtpk(s1[0], s1[1]), att::cvtpk(s1[2], s1[3]));
                                o[cv] = __builtin_amdgcn_mfma_f32_32x32x16_bf16(qf[d0], __builtin_bit_cast(bf16x8, q4), o[cv], 0, 0, 0); }
                    }
                    const float dk = __expf(Btot);
                    int sbase = (4 * hi) * STROW + r32; asm volatile("" : "+v"(sbase));
#pragma unroll
                    for (int cd = 0; cd < 2; ++cd) { const float dkd = __shfl(dk, 32 * cd + r32);
#pragma unroll
                        for (int cv = 0; cv < 2; ++cv)
#pragma unroll
                            for (int r = 0; r < 16; ++r) { ALAS float* sp = ST + sbase + (32 * cv + (r & 3) + 8 * (r >> 2)) * STROW + 32 * cd; *sp = dkd * *sp + sl[cv][cd][r]; } }
                    BS[lane] += Btot;
                }
                __syncthreads();
            }
                if (d == 0) {
                    int base = (32 * wid + 4 * hi) * 64 + r32; asm volatile("" : "+v"(base));
#pragma unroll
                    for (int r = 0; r < 16; ++r) { const int off = base + ((r & 3) + 8 * (r >> 2)) * 64; OSG[off] = o[0][r]; OSG[off + 32] = o[1][r]; }
                }
                else {
                    ALAS float* OS = (ALAS float*)L3;
                    int base = (255 - 32 * wid - 4 * hi) * 64 + r32; asm volatile("" : "+v"(base));
                    float g0[16], g1[16];
#pragma unroll
                    for (int r = 0; r < 16; ++r) { const int off = base - ((r & 3) + 8 * (r >> 2)) * 64; g0[r] = OSG[off]; g1[r] = OSG[off + 32]; }
#pragma unroll
                    for (int r = 0; r < 16; ++r) { const int off = base - ((r & 3) + 8 * (r >> 2)) * 64; OS[off] = o[0][r] + g0[r]; OS[off + 32] = o[1][r] + g1[r]; }
                    __syncthreads();
                    { int tl = 32 * wid + (lane >> 1); asm volatile("" : "+v"(tl)); const int half = lane & 1; float ov[32]; float ss = 0.f;
#pragma unroll
                      for (int i = 0; i < 32; ++i) { ov[i] = OS[tl * 64 + half * 32 + i]; ss += ov[i] * ov[i]; }
                      ss += __shfl_xor(ss, 1);
                      const float rs = rsqrtf(ss * (1.f / 64.f) + EPS);
                      const size_t row = (size_t)(jbase + tl); const bf16_t* zg = Z + row * NZ + ZD_G + h * 64 + half * 32; bf16_t* yo = Y + row * D + 768 + h * 64 + half * 32;
#pragma unroll
                      for (int i = 0; i < 4; ++i) { unsigned w4[4];
#pragma unroll
                          for (int k2 = 0; k2 < 4; ++k2) { const int c0 = 8 * i + 2 * k2; w4[k2] = att::cvtpk(ov[c0] * rs * gn[h * 64 + half * 32 + c0] * siluf_(bf2f(zg[c0])), ov[c0 + 1] * rs * gn[h * 64 + half * 32 + c0 + 1] * siluf_(bf2f(zg[c0 + 1]))); }
                          *(uint4*)(yo + 8 * i) = make_uint4(w4[0], w4[1], w4[2], w4[3]); } }
                    __syncthreads();
                }
            }
        }
    }
}

__device__ __forceinline__ void ph_router(const P& p, int l, unsigned char* ldsb, bool dry = false) {
    const int tidx = p.wid * 64 + fresh_lane();
    const float* X = (const float*)(p.ws + WS_X); bf16_t* H = (bf16_t*)(p.ws + WS_H); const float* xin = p.in[I_X]; const float* cin = p.in[I_CTX]; const bf16_t* D1 = (const bf16_t*)(p.ws + WS_D1);
#define RBASE(r_) (l == 0 ? xin_row(xin, cin, (r_)) : X + (size_t)(r_) * D)
    float2* GP = (float2*)(p.ws + WS_GP); int* LISTP = (int*)(p.ws + WS_LISTP); unsigned* CNT = (unsigned*)(p.ws + WS_CNT) + l * 32;
    const float* MOD = (const float*)(p.ws + WS_MOD) + (size_t)l * 9 * 6 * D; const float* g = p.in[I_N2G] + l * D;
    const float* RW = p.in[I_RW]; const float* RB = p.in[I_RB];
    ALAS int* lc = (ALAS int*)ldsb; ALAS int* lbase = lc + 32; ALAS int* rpair = lc + 64; ALAS int* rrank = lc + 64 + 72;
    const int lane = tidx & 63, wv = tidx >> 6;
    typedef float f32x4r __attribute__((ext_vector_type(4))); ALAS f32x4r* RWs = (ALAS f32x4r*)(ldsb - LDS_MISC);
    { f32x4r rwv[8];
#pragma unroll
      for (int u = 0; u < 8; ++u) { const int idx = tidx + u * NT; const int ln = idx & 63, e4 = (idx >> 6) & 3, i = (idx >> 8) & 3, q = idx >> 10; rwv[u] = *(const f32x4r*)(RW + (size_t)((ln + 64 * q) * 4 + i) * 16 + e4 * 4); }
#pragma unroll
      for (int u = 0; u < 8; ++u) RWs[tidx + u * NT] = rwv[u]; }
    __syncthreads();
    ALAS float* LG = (ALAS float*)(ldsb - LDS_MISC + 65536);
    float4 gq[4];
#pragma unroll
    for (int q = 0; q < 4; ++q) gq[q] = *(const float4*)(g + (lane + 64 * q) * 4);
    for (int chunk = blockIdx.x; chunk < R / 72; chunk += gridDim.x) {
        if (tidx < 32) lc[tidx] = 0;
        const int rbase = chunk * 72 + wv * 9;
        float4 vn[4]; uint2 dn[4];
#pragma unroll
        for (int q = 0; q < 4; ++q) { vn[q] = *(const float4*)(RBASE(rbase) + (lane + 64 * q) * 4); dn[q] = *(const uint2*)(D1 + (size_t)rbase * D + (lane + 64 * q) * 4); }
#pragma unroll 1
        for (int k = 0; k < 9; ++k) {
            const int li = wv * 9 + k, r = rbase + k;
            const float* m = MOD + (size_t)row_mi(r) * 6 * D; float4 scq[4], shq[4];
#pragma unroll
            for (int q = 0; q < 4; ++q) { scq[q] = *(const float4*)(m + 4 * D + (lane + 64 * q) * 4); shq[q] = *(const float4*)(m + 3 * D + (lane + 64 * q) * 4); }
            float4 v[4];
#pragma unroll
            for (int q = 0; q < 4; ++q) { float t4[4] = {vn[q].x, vn[q].y, vn[q].z, vn[q].w}; add_bf4(t4, dn[q]); v[q] = make_float4(t4[0], t4[1], t4[2], t4[3]); }
            { const int rn = rbase + (k < 8 ? k + 1 : 8);
#pragma unroll
              for (int q = 0; q < 4; ++q) { vn[q] = *(const float4*)(RBASE(rn) + (lane + 64 * q) * 4); dn[q] = *(const uint2*)(D1 + (size_t)rn * D + (lane + 64 * q) * 4); } }
            float ss = 0.f;
#pragma unroll
            for (int q = 0; q < 4; ++q) ss += v[q].x * v[q].x + v[q].y * v[q].y + v[q].z * v[q].z + v[q].w * v[q].w;
            const float rs = rsqrtf(wave_sum(ss) * (1.f / D) + EPS);
            float lg[16];
#pragma unroll
            for (int e = 0; e < 16; ++e) lg[e] = 0.f;
#pragma unroll
            for (int q = 0; q < 4; ++q) { const int c = (lane + 64 * q) * 4; const float xv[4] = {v[q].x, v[q].y, v[q].z, v[q].w};
                const float4 g4 = gq[q], sc4 = scq[q], sh4 = shq[q];
                const float gv[4] = {g4.x, g4.y, g4.z, g4.w}, scv[4] = {sc4.x, sc4.y, sc4.z, sc4.w}, shv[4] = {sh4.x, sh4.y, sh4.z, sh4.w}; bf16_t o[4];
#pragma unroll
                for (int i = 0; i < 4; ++i) { const float hv = xv[i] * rs * gv[i] * (1.f + scv[i]) + shv[i]; o[i] = f2bf(hv);
#pragma unroll
                    for (int e4 = 0; e4 < 4; ++e4) { const f32x4r w4 = RWs[((q * 4 + i) * 4 + e4) * 64 + lane]; lg[e4 * 4 + 0] += hv * w4[0]; lg[e4 * 4 + 1] += hv * w4[1]; lg[e4 * 4 + 2] += hv * w4[2]; lg[e4 * 4 + 3] += hv * w4[3]; } }
                *(uint2*)(H + (size_t)r * D + c) = make_uint2((unsigned)o[0] | ((unsigned)o[1] << 16), (unsigned)o[2] | ((unsigned)o[3] << 16));
                __builtin_amdgcn_sched_barrier(0); }
            float a8[8], a4[4], a2[2], a1;
            { const bool hb = (lane & 32) != 0;
#pragma unroll
              for (int i = 0; i < 8; ++i) { const float snd = hb ? lg[i] : lg[8 + i], kp = hb ? lg[8 + i] : lg[i]; a8[i] = kp + __shfl_xor(snd, 32); } }
            { const bool hb = (lane & 16) != 0;
#pragma unroll
              for (int i = 0; i < 4; ++i) { const float snd = hb ? a8[i] : a8[4 + i], kp = hb ? a8[4 + i] : a8[i]; a4[i] = kp + __shfl_xor(snd, 16); } }
            { const bool hb = (lane & 8) != 0;
#pragma unroll
              for (int i = 0; i < 2; ++i) { const float snd = hb ? a4[i] : a4[2 + i], kp = hb ? a4[2 + i] : a4[i]; a2[i] = kp + __shfl_xor(snd, 8); } }
            { const bool hb = (lane & 4) != 0; const float snd = hb ? a2[0] : a2[1], kp = hb ? a2[1] : a2[0]; a1 = kp + __shfl_xor(snd, 4); }
            a1 += __shfl_xor(a1, 2); a1 += __shfl_xor(a1, 1);
            if ((lane & 3) == 0) LG[li * 16 + (lane >> 2)] = a1 + RB[lane >> 2];
        }
        __syncthreads();
        if (tidx < 72) {
            const int r = chunk * 72 + tidx; float lg[16];
#pragma unroll
            for (int e = 0; e < 16; ++e) lg[e] = LG[tidx * 16 + e];
            float mx = lg[0];
#pragma unroll
            for (int e = 1; e < 16; ++e) mx = fmaxf(mx, lg[e]);
            float sc[16], sum = 0.f;
#pragma unroll
            for (int e = 0; e < 16; ++e) { sc[e] = expf(lg[e] - mx); sum += sc[e]; }
            const float inv = 1.f / sum;
#pragma unroll
            for (int e = 0; e < 16; ++e) sc[e] *= inv;
            int gsel = 0; float gbest = -1.f;
#pragma unroll
            for (int gI = 0; gI < 4; ++gI) { const float s0 = sc[gI * 4], s1 = sc[gI * 4 + 1], s2 = sc[gI * 4 + 2], s3 = sc[gI * 4 + 3];
                const float m1 = fmaxf(s0, s1), n1 = fminf(s0, s1), m2 = fmaxf(s2, s3), n2 = fminf(s2, s3);
                const float gs = fmaxf(m1, m2) + fmaxf(fminf(m1, m2), fmaxf(n1, n2)); const bool c = gs > gbest; gbest = c ? gs : gbest; gsel = c ? gI : gsel; }
            float s4[4];
#pragma unroll
            for (int i = 0; i < 4; ++i) s4[i] = gsel == 0 ? sc[i] : (gsel == 1 ? sc[4 + i] : (gsel == 2 ? sc[8 + i] : sc[12 + i]));
            float w1 = s4[0]; int i1 = 0;
#pragma unroll
            for (int i = 1; i < 4; ++i) { const bool c = s4[i] > w1; w1 = c ? s4[i] : w1; i1 = c ? i : i1; }
            float w2 = -1.f; int i2 = 0;
#pragma unroll
            for (int i = 0; i < 4; ++i) { const bool c = (i != i1) && (s4[i] > w2); w2 = c ? s4[i] : w2; i2 = c ? i : i2; }
            const float wn = 1.f / (w1 + w2);
            const int a = i1 < i2 ? i1 : i2, bq = i1 < i2 ? i2 : i1;
            const int q = a == 0 ? bq - 1 : (a == 1 ? bq + 1 : 5);
            const int pr = gsel * 6 + q; const bool skip = (l == 1 && (r % LB) < TC);
            GP[r] = i1 < i2 ? make_float2(w1 * wn, w2 * wn) : make_float2(w2 * wn, w1 * wn);
            rpair[tidx] = skip ? -1 : pr;
            if (!skip) rrank[tidx] = __hip_atomic_fetch_add(&lc[pr], 1, __ATOMIC_RELAXED, __HIP_MEMORY_SCOPE_WORKGROUP);
        }
        __syncthreads();
        if (tidx < 24) lbase[tidx] = (lc[tidx] && !dry) ? (int)atomicAdd(&CNT[tidx], (unsigned)lc[tidx]) : 0;
        __syncthreads();
        if (tidx < 72 && !dry) { const int pr = rpair[tidx]; if (pr >= 0) LISTP[(size_t)pr * R + lbase[pr] + rrank[tidx]] = chunk * 72 + tidx; }
        __syncthreads();
    }
}

__device__ __forceinline__ void ph_final(const P& p) {
    const int tidx = p.wid * 64 + fresh_lane();
    const float* X = (const float*)(p.ws + WS_X); const float* g = p.in[I_FNG]; const bf16_t* D1 = (const bf16_t*)(p.ws + WS_D1); const bf16_t* D2 = (const bf16_t*)(p.ws + WS_D2);
    const int lane = tidx & 63, wv = tidx >> 6;
    const int stride = gridDim.x * NWV; const int i0 = blockIdx.x * NWV + wv;
    float4 gq[4];
#pragma unroll
    for (int q = 0; q < 4; ++q) gq[q] = *(const float4*)(g + (lane + 64 * q) * 4);
#define FROW(i_) ((size_t)(((i_) / T) * LB + TC + ((i_) % T)))
    for (int ib = i0; ib < NB * T; ib += 8 * stride) {
        float4 vb[3][4]; uint2 d1b[3][4], d2b[3][4];
#define FN_LOAD(slot, k_) do { int ii_ = ib + (k_) * stride; ii_ = ii_ < NB * T ? ii_ : ib; const size_t rr_ = FROW(ii_); _Pragma("unroll") for (int q = 0; q < 4; ++q) { vb[slot][q] = *(const float4*)(X + rr_ * D + (lane + 64 * q) * 4); \
            d1b[slot][q] = *(const uint2*)(D1 + rr_ * D + (lane + 64 * q) * 4); d2b[slot][q] = *(const uint2*)(D2 + rr_ * D + (lane + 64 * q) * 4); } } while (0)
        FN_LOAD(0, 0); FN_LOAD(1, 1);
#pragma unroll
        for (int k = 0; k < 8; ++k) {
            const int it = ib + k * stride; const int sl = k % 3;
            if (k + 2 < 8) FN_LOAD((k + 2) % 3, k + 2);
            if (it < NB * T) {
                float xv[4][4]; float ss = 0.f;
#pragma unroll
                for (int q = 0; q < 4; ++q) { xv[q][0] = vb[sl][q].x; xv[q][1] = vb[sl][q].y; xv[q][2] = vb[sl][q].z; xv[q][3] = vb[sl][q].w; add_bf4(xv[q], d1b[sl][q]); add_bf4(xv[q], d2b[sl][q]); }
#pragma unroll
                for (int q = 0; q < 4; ++q) ss += xv[q][0] * xv[q][0] + xv[q][1] * xv[q][1] + xv[q][2] * xv[q][2] + xv[q][3] * xv[q][3];
                const float rs = rsqrtf(wave_sum(ss) * (1.f / D) + EPS);
#pragma unroll
                for (int q = 0; q < 4; ++q) { const int c = (lane + 64 * q) * 4; const float4 gg = gq[q];
                    *(float4*)(p.out + (size_t)it * D + c) = make_float4(xv[q][0] * rs * gg.x, xv[q][1] * rs * gg.y, xv[q][2] * rs * gg.z, xv[q][3] * rs * gg.w); }
            }
        }
#undef FN_LOAD
    }
#undef FROW
}

namespace pg8 {
#define PG8_LAS __attribute__((address_space(3)))
typedef short bf16x8 __attribute__((ext_vector_type(8)));
typedef float f32x4 __attribute__((ext_vector_type(4)));
typedef unsigned u32x4 __attribute__((ext_vector_type(4)));
constexpr int BM = 256, BK = 64, HALF = 128, HTB = HALF * BK * 2, STAGE_BYTES = 8 * HTB, NXCD = 8, WGM = 8;
__host__ __device__ __forceinline__ int lds_byte(int r, int c) { const int st = (r >> 4) * 2 + (c >> 5), rr = r & 15, cc = c & 31, ob = rr * 64 + cc * 2; return st * 1024 + (ob ^ (((ob >> 9) & 1) << 5)); }
__host__ __device__ __forceinline__ void stage_rc(int b, int& R, int& C) { const int st = b / 1024, sb = b % 1024, swz = sb ^ (((sb >> 9) & 1) << 5); R = (st >> 1) * 16 + swz / 64; C = (st & 1) * 32 + (swz % 64) / 2; }
__host__ __device__ __forceinline__ int perm32(int rho) { const int n = rho >> 4, i = rho & 15; return 8 * (i >> 2) + 4 * n + (i & 3); }
__device__ __forceinline__ unsigned cvt_pk_bf16(float lo, float hi) { unsigned r; asm volatile("v_cvt_pk_bf16_f32 %0, %1, %2" : "=v"(r) : "v"(lo), "v"(hi)); return r; }
struct Unit { int pm, pn, aux; };
__device__ __forceinline__ void static_unit(int L, int nM, int nN, int& pm, int& pn) {
    const int nwg = nM * nN; int wgid = L; { const int q = nwg / NXCD, r = nwg % NXCD, xcd = wgid % NXCD, off = wgid / NXCD; wgid = (xcd < r ? xcd * (q + 1) : r * (q + 1) + (xcd - r) * q) + off; }
    const int nig = WGM * nN, gid = wgid / nig, fm = gid * WGM, gsz = (nM - fm) < WGM ? (nM - fm) : WGM;
    pm = fm + ((wgid % nig) % gsz); pn = (wgid % nig) / gsz;
}
__device__ __forceinline__ bool static_next(int i, int G, int c, int nM, int nN, int& pm, int& pn) {
    const int nwg = nM * nN; const long L = (long)i * G + c; if (L >= nwg) return false;
    int wgid = (int)L; { const int q = nwg / NXCD, r = nwg % NXCD, xcd = wgid % NXCD, off = wgid / NXCD; wgid = (xcd < r ? xcd * (q + 1) : r * (q + 1) + (xcd - r) * q) + off; }
    const int nig = WGM * nN, gid = wgid / nig, fm = gid * WGM, gsz = (nM - fm) < WGM ? (nM - fm) : WGM;
    pm = fm + ((wgid % nig) % gsz); pn = (wgid % nig) / gsz; return true;
}
template <class PB, bool ALIGN_EPI, bool HN = false>
__device__ __forceinline__ void gemm_phase(PG8_LAS unsigned char* lds, const PB& S, const int wid) {
    const int lane = fresh_lane(), tid = wid * 64 + lane, wr = wid >> 2, wc = wid & 3, fr = lane & 15, fq = lane >> 4;
    const int nt = S.nt;
    int Rst[2], Cst[2]; unsigned voffB[2];
#pragma unroll
    for (int i = 0; i < 2; ++i) { int R_, C_; stage_rc(tid * 16 + i * 8192, R_, C_); Rst[i] = R_; Cst[i] = C_; const int Rb = PB::PERM ? ((R_ & ~31) + perm32(R_ & 31)) : R_; voffB[i] = (unsigned)(Rb * S.ldb + C_) * 2u; }
    const size_t kstep = (size_t)(BK * 2);
    const size_t hstepB = (size_t)HALF * S.ldb * 2;
    const unsigned ldsw = (unsigned)wid * 1024u;
    const int aoff = lds_byte(wr * 64 + fr, fq * 8), boff = lds_byte(wc * 32 + fr, fq * 8);
#define PG8_SA(b, h) (((b) * 2 + (h)) * HTB)
#define PG8_SB(b, h) ((4 + (b) * 2 + (h)) * HTB)
#define PG8_STAGE(bufoff, gbase, voff) do { _Pragma("unroll") for (int _i = 0; _i < 2; ++_i) { unsigned _o = (voff)[_i]; asm volatile("" : "+v"(_o)); \
        __builtin_amdgcn_global_load_lds((const unsigned*)((const char*)(gbase) + _o), (PG8_LAS unsigned*)(lds + (bufoff) + ldsw + _i * 8192), 16, 0, 0); } } while (0)
#define PG8_LDA(dst, b, h) do { _Pragma("unroll") for (int m = 0; m < 4; ++m) _Pragma("unroll") for (int k = 0; k < 2; ++k) dst[m][k] = *(const PG8_LAS bf16x8*)(lds + PG8_SA(b, h) + aoff + m * 2048 + k * 1024); } while (0)
#define PG8_LDB(dst, b, h) do { _Pragma("unroll") for (int n = 0; n < 2; ++n) _Pragma("unroll") for (int k = 0; k < 2; ++k) dst[n][k] = *(const PG8_LAS bf16x8*)(lds + PG8_SB(b, h) + boff + n * 2048 + k * 1024); } while (0)
#define PG8_MMA(ai, bj, At, Bt) do { __builtin_amdgcn_s_setprio(1); _Pragma("unroll") for (int m = 0; m < 4; ++m) _Pragma("unroll") for (int n = 0; n < 2; ++n) _Pragma("unroll") for (int k = 0; k < 2; ++k) \
        acc[ai][bj][m][n] = __builtin_amdgcn_mfma_f32_16x16x32_bf16(Bt[n][k], At[m][k], acc[ai][bj][m][n], 0, 0, 0); __builtin_amdgcn_s_setprio(0); } while (0)
#define PG8_WAIT_V(n) asm volatile("s_waitcnt vmcnt(" #n ")" ::: "memory")
#define PG8_WAIT_L(n) asm volatile("s_waitcnt lgkmcnt(" #n ")" ::: "memory")
#define PG8_BAR __builtin_amdgcn_s_barrier()
#define PG8_SCHED __builtin_amdgcn_sched_barrier(0)
    Unit cur, nxt; int ui = 0;
    if (!S.next(0, cur)) return;
    f32x4 acc[2][2][4][2];
#pragma unroll
    for (int a = 0; a < 2; ++a)
#pragma unroll
        for (int b = 0; b < 2; ++b)
#pragma unroll
            for (int m = 0; m < 4; ++m)
#pragma unroll
                for (int n = 0; n < 2; ++n) acc[a][b][m][n] = (f32x4){0.f, 0.f, 0.f, 0.f};
    bf16x8 At[4][2], B0[2][2], B1[2][2];
    unsigned vc[2][2], vn[2][2];
    S.a_off(cur, Rst, Cst, vc); asm volatile("" : "+v"(vc[0][0]), "+v"(vc[0][1]), "+v"(vc[1][0]), "+v"(vc[1][1]));
    const char* gA = S.A;
    { const char* cB = S.b_ptr(cur, 0); const char* cB1 = S.b_ptr(cur, 1);
      if constexpr (HN) {
      PG8_STAGE(PG8_SB(0, 0), cB, voffB); PG8_STAGE(PG8_SA(0, 0), gA, vc[0]); PG8_STAGE(PG8_SA(0, 1), gA, vc[1]);
      if (wr == 1) PG8_BAR;
      PG8_WAIT_V(2); PG8_BAR;
      PG8_STAGE(PG8_SB(1, 0), cB1, voffB); PG8_STAGE(PG8_SA(1, 0), gA + kstep, vc[0]);
      PG8_WAIT_V(4); PG8_BAR;
      } else {
      PG8_STAGE(PG8_SB(0, 0), cB, voffB); PG8_STAGE(PG8_SB(0, 1), cB + hstepB, voffB); PG8_STAGE(PG8_SA(0, 0), gA, vc[0]); PG8_STAGE(PG8_SA(0, 1), gA, vc[1]);
      if (wr == 1) PG8_BAR;
      PG8_WAIT_V(2); PG8_BAR;
      PG8_STAGE(PG8_SB(1, 0), cB1, voffB); PG8_STAGE(PG8_SA(1, 0), gA + kstep, vc[0]); PG8_STAGE(PG8_SB(1, 1), cB1 + hstepB, voffB);
      PG8_WAIT_V(6); PG8_BAR; } }
    for (;;) {
        const bool has_next = S.next(ui + 1, nxt);
        if (has_next) { S.a_off(nxt, Rst, Cst, vn); asm volatile("" : "+v"(vn[0][0]), "+v"(vn[0][1]), "+v"(vn[1][0]), "+v"(vn[1][1])); }
        else { vn[0][0] = vc[0][0]; vn[0][1] = vc[0][1]; vn[1][0] = vc[1][0]; vn[1][1] = vc[1][1]; nxt = cur; }
        for (int t = 0; t < nt; t += 2) {
            const bool last = (t == nt - 2);
            const char* a1 = gA + (size_t)(t + 1) * kstep;
            const char* a2 = last ? gA : gA + (size_t)(t + 2) * kstep; const char* a3 = a2 + kstep;
            const char* b2 = last ? S.b_ptr(nxt, 0) : S.b_ptr(cur, t + 2);
            const char* b3 = last ? S.b_ptr(nxt, 1) : S.b_ptr(cur, t + 3);
            unsigned o2a[2], o2b[2];
            o2a[0] = last ? vn[0][0] : vc[0][0]; o2a[1] = last ? vn[0][1] : vc[0][1]; o2b[0] = last ? vn[1][0] : vc[1][0]; o2b[1] = last ? vn[1][1] : vc[1][1];
            if constexpr (HN) {
            PG8_LDB(B0, 0, 0); PG8_SCHED; PG8_LDA(At, 0, 0); PG8_STAGE(PG8_SA(1, 1), a1, vc[1]);
            PG8_WAIT_V(6); PG8_WAIT_L(0); PG8_BAR; PG8_MMA(0, 0, At, B0); PG8_BAR; PG8_SCHED;
            PG8_LDA(At, 0, 1); PG8_STAGE(PG8_SB(0, 0), b2, voffB); PG8_STAGE(PG8_SA(0, 0), a2, o2a);
            PG8_WAIT_V(6); PG8_WAIT_L(0); PG8_BAR; PG8_MMA(1, 0, At, B0); PG8_BAR; PG8_SCHED;
            PG8_LDB(B0, 1, 0); PG8_SCHED; PG8_LDA(At, 1, 0); PG8_STAGE(PG8_SA(0, 1), a2, o2b);
            PG8_WAIT_V(6); PG8_WAIT_L(0); PG8_BAR; PG8_MMA(0, 0, At, B0); PG8_BAR; PG8_SCHED;
            PG8_LDA(At, 1, 1); PG8_STAGE(PG8_SB(1, 0), b3, voffB); PG8_STAGE(PG8_SA(1, 0), a3, o2a);
            PG8_WAIT_V(6); PG8_WAIT_L(0); PG8_BAR; PG8_MMA(1, 0, At, B0); PG8_BAR; PG8_SCHED;
            } else {
            PG8_LDB(B0, 0, 0); PG8_LDB(B1, 0, 1); PG8_SCHED; PG8_LDA(At, 0, 0); PG8_STAGE(PG8_SA(1, 1), a1, vc[1]);
            PG8_WAIT_V(8); PG8_WAIT_L(0); PG8_BAR; PG8_MMA(0, 0, At, B0); PG8_MMA(0, 1, At, B1); PG8_BAR; PG8_SCHED;
            PG8_LDA(At, 0, 1); PG8_STAGE(PG8_SB(0, 0), b2, voffB); PG8_STAGE(PG8_SB(0, 1), b2 + hstepB, voffB); PG8_STAGE(PG8_SA(0, 0), a2, o2a);
            PG8_WAIT_V(8); PG8_WAIT_L(0); PG8_BAR; PG8_MMA(1, 0, At, B0); PG8_MMA(1, 1, At, B1); PG8_BAR; PG8_SCHED;
            PG8_LDB(B0, 1, 0); PG8_LDB(B1, 1, 1); PG8_SCHED; PG8_LDA(At, 1, 0); PG8_STAGE(PG8_SA(0, 1), a2, o2b);
            PG8_WAIT_V(8); PG8_WAIT_L(0); PG8_BAR; PG8_MMA(0, 0, At, B0); PG8_MMA(0, 1, At, B1); PG8_BAR; PG8_SCHED;
            PG8_LDA(At, 1, 1); PG8_STAGE(PG8_SB(1, 0), b3, voffB); PG8_STAGE(PG8_SB(1, 1), b3 + hstepB, voffB); PG8_STAGE(PG8_SA(1, 0), a3, o2a);
            PG8_WAIT_V(8); PG8_WAIT_L(0); PG8_BAR; PG8_MMA(1, 0, At, B0); PG8_MMA(1, 1, At, B1); PG8_BAR; PG8_SCHED;
            }
        }
        if constexpr (ALIGN_EPI) { if (wr == 0) PG8_BAR; }
        S.epi(acc, cur, wr, wc, fr, fq);
        if (!has_next) break;
#pragma unroll
        for (int a = 0; a < 2; ++a)
#pragma unroll
            for (int b = 0; b < 2; ++b)
#pragma unroll
                for (int m = 0; m < 4; ++m)
#pragma unroll
                    for (int n = 0; n < 2; ++n) acc[a][b][m][n] = (f32x4){0.f, 0.f, 0.f, 0.f};
        cur = nxt; vc[0][0] = vn[0][0]; vc[0][1] = vn[0][1]; vc[1][0] = vn[1][0]; vc[1][1] = vn[1][1]; ++ui;
        if constexpr (ALIGN_EPI) { if (wr == 1) PG8_BAR; }
    }
    PG8_WAIT_V(0);
    if constexpr (!ALIGN_EPI) { if (wr == 0) PG8_BAR; }
    PG8_BAR;
#undef PG8_SA
#undef PG8_SB
#undef PG8_STAGE
#undef PG8_LDA
#undef PG8_LDB
#undef PG8_MMA
#undef PG8_WAIT_V
#undef PG8_WAIT_L
#undef PG8_BAR
#undef PG8_SCHED
}
}

struct PB_InProj {
    static constexpr bool PERM = true;
    const char* A; int ldb, nt; const char* Bt; bf16_t* Zo; int G, c;
    __device__ __forceinline__ bool next(int i, pg8::Unit& u) const { u.aux = 0; return pg8::static_next(i, G, c, R / 256, NZ / 256, u.pm, u.pn); }
    __device__ __forceinline__ void a_off(const pg8::Unit& u, const int (&Rs)[2], const int (&Cs)[2], unsigned (&off)[2][2]) const {
#pragma unroll
        for (int h = 0; h < 2; ++h)
#pragma unroll
            for (int i = 0; i < 2; ++i) off[h][i] = (unsigned)((u.pm * 256 + h * 128 + Rs[i]) * D + Cs[i]) * 2u; }
    __device__ __forceinline__ const char* b_ptr(const pg8::Unit& u, int t) const { return Bt + (size_t)u.pn * 256 * D * 2 + (size_t)t * 128; }
    __device__ __forceinline__ void epi(const pg8::f32x4 (&acc)[2][2][4][2], const pg8::Unit& u, int wr, int wc, int fr, int fq) const {
        const int row0 = u.pm * 256 + wr * 64 + fr, col0 = u.pn * 256 + wc * 32 + 8 * fq;
#pragma unroll
        for (int ai = 0; ai < 2; ++ai)
#pragma unroll
            for (int m = 0; m < 4; ++m) { bf16_t* rowp = Zo + (size_t)(row0 + ai * 128 + m * 16) * NZ + col0;
#pragma unroll
                for (int bj = 0; bj < 2; ++bj) { const pg8::f32x4 v0 = acc[ai][bj][m][0], v1 = acc[ai][bj][m][1]; pg8::u32x4 w;
                    w.x = pg8::cvt_pk_bf16(v0[0], v0[1]); w.y = pg8::cvt_pk_bf16(v0[2], v0[3]); w.z = pg8::cvt_pk_bf16(v1[0], v1[1]); w.w = pg8::cvt_pk_bf16(v1[2], v1[3]);
                    *(pg8::u32x4*)(rowp + bj * 128) = w; } }
    }
};


struct PB_OutProj {
    static constexpr bool PERM = true;
    const char* A; int ldb, nt; const char* Bt; bf16_t* D1; const float* MODl; int G, c, skipctx; bool dry;
    int tail;
    __device__ __forceinline__ bool next(int i, pg8::Unit& u) const { u.aux = 0; const int nM = skipctx ? 64 : 72, nwg = nM * 4, nfull = (nwg / G) * G, ntail = nwg - nfull; const bool split = ntail > 0 && 2 * ntail <= G;
        int L, half = 0;
        if (tail == 0) { L = i * G + c; if (L >= (split ? nfull : nwg)) return false; }
        else { if (!split || i != 0 || c >= 2 * ntail) return false; L = nfull + (c >> 1); half = c & 1; }
        int pm, pn; pg8::static_unit(L, nM, 4, pm, pn); u.pm = skipctx ? (pm >> 3) * 9 + 1 + (pm & 7) : pm; u.pn = tail ? 2 * pn + half : pn; return true; }
    __device__ __forceinline__ void a_off(const pg8::Unit& u, const int (&Rs)[2], const int (&Cs)[2], unsigned (&off)[2][2]) const {
#pragma unroll
        for (int h = 0; h < 2; ++h)
#pragma unroll
            for (int i = 0; i < 2; ++i) off[h][i] = (unsigned)((u.pm * 256 + h * 128 + Rs[i]) * D + Cs[i]) * 2u; }
    __device__ __forceinline__ const char* b_ptr(const pg8::Unit& u, int t) const { return Bt + (size_t)u.pn * (tail ? 128 : 256) * D * 2 + (size_t)t * 128; }
    __device__ __forceinline__ void epi(const pg8::f32x4 (&acc)[2][2][4][2], const pg8::Unit& u, int wr, int wc, int fr, int fq) const {
        const int row0 = u.pm * 256 + wr * 64 + fr, col0 = u.pn * (tail ? 128 : 256) + wc * 32 + 8 * fq; const int nbj = tail ? 1 : 2;
        const float* gt = MODl + (size_t)row_mi(u.pm * 256) * 6 * D + 2 * D + col0;
        pg8::f32x4 gv[2][2];
#pragma unroll
        for (int bj = 0; bj < 2; ++bj)
#pragma unroll
            for (int n = 0; n < 2; ++n) gv[bj][n] = bj < nbj ? *(const pg8::f32x4*)(gt + bj * 128 + 4 * n) : (pg8::f32x4){0.f, 0.f, 0.f, 0.f};
        if (dry) return;
#pragma unroll
        for (int ai = 0; ai < 2; ++ai)
#pragma unroll
            for (int m = 0; m < 4; ++m) { bf16_t* rowp = D1 + (size_t)(row0 + ai * 128 + m * 16) * D + col0;
#pragma unroll
                for (int bj = 0; bj < 2; ++bj) { if (bj >= nbj) break; const pg8::f32x4 v0 = acc[ai][bj][m][0] * gv[bj][0], v1 = acc[ai][bj][m][1] * gv[bj][1]; pg8::u32x4 w;
                    w.x = pg8::cvt_pk_bf16(v0[0], v0[1]); w.y = pg8::cvt_pk_bf16(v0[2], v0[3]); w.z = pg8::cvt_pk_bf16(v1[0], v1[1]); w.w = pg8::cvt_pk_bf16(v1[2], v1[3]);
                    *(pg8::u32x4*)(rowp + bj * 128) = w; } }
    }
};

__device__ __forceinline__ void moe_tiles_setup(const P& p, int l, ALAS int* tb) {
    const unsigned* CNT = (const unsigned*)(p.ws + WS_CNT) + l * 32;
    __syncthreads();
    if (p.wid == 0 && fresh_lane() == 0) { int acc = 0; for (int q = 0; q < 24; ++q) { const int c = (int)__hip_atomic_load(CNT + q, __ATOMIC_RELAXED, __HIP_MEMORY_SCOPE_AGENT); tb[q] = c; tb[32 + q] = acc; acc += (c + 255) >> 8; } tb[32 + 24] = acc; }
    __syncthreads();
}
__device__ __forceinline__ void pair_experts(int pr, int& e0, int& e1) { const int g4 = (pr / 6) * 4, q = pr % 6; const int a = q < 3 ? 0 : (q < 5 ? 1 : 2), b = q < 3 ? q + 1 : (q < 5 ? q - 1 : 3); e0 = g4 + a; e1 = g4 + b; }

struct PB_Moe1 {
    static constexpr bool PERM = false;
    const char* A; int ldb, nt; const char* W13; bf16_t* HE; const int* LISTP; const float2* GP; const ALAS int* tb; int G, c;
    __device__ __forceinline__ bool next(int i, pg8::Unit& u) const {
        if (!pg8::static_next(i, G, c, tb[32 + 24], 8, u.pm, u.pn)) return false;
        int pr = 0;
        for (int q = 1; q < 24; ++q) if (tb[32 + q] <= u.pm) pr = q;
        u.aux = pr; return true; }
    __device__ __forceinline__ void a_off(const pg8::Unit& u, const int (&Rs)[2], const int (&Cs)[2], unsigned (&off)[2][2]) const {
        const int pr = u.aux, cnt = tb[pr], r0 = (u.pm - tb[32 + pr]) * 256; const int* lp = LISTP + (size_t)pr * R;
#pragma unroll
        for (int h = 0; h < 2; ++h)
#pragma unroll
            for (int i = 0; i < 2; ++i) { int rk = r0 + h * 128 + Rs[i]; rk = rk < cnt ? rk : cnt - 1; off[h][i] = (unsigned)(lp[rk] * D + Cs[i]) * 2u; } }
    __device__ __forceinline__ const char* b_ptr(const pg8::Unit& u, int t) const { int e0, e1; pair_experts(u.aux, e0, e1); const int e = u.pn < 4 ? e0 : e1;
        return W13 + ((size_t)e * 1024 + (size_t)(u.pn & 3) * 256) * D * 2 + (size_t)t * 128; }
    __device__ __forceinline__ void epi(const pg8::f32x4 (&acc)[2][2][4][2], const pg8::Unit& u, int wr, int wc, int fr, int fq) const {
        const int pr = u.aux, cnt = tb[pr], r0 = (u.pm - tb[32 + pr]) * 256; const int* lp = LISTP + (size_t)pr * R;
        const int colh = (u.pn < 4 ? 0 : 512) + (u.pn & 3) * 128 + wc * 16 + 4 * fq;
#pragma unroll
        for (int ai = 0; ai < 2; ++ai)
#pragma unroll
            for (int m = 0; m < 4; ++m) { const int x = ai * 128 + wr * 64 + m * 16 + fr; int rk = r0 + x; rk = rk < cnt ? rk : cnt - 1;
                const float2 gg = GP[lp[rk]]; const float gate = u.pn < 4 ? gg.x : gg.y;
                bf16_t* rowp = HE + (size_t)(u.pm * 256 + x) * 1024 + colh;
#pragma unroll
                for (int bj = 0; bj < 2; ++bj) { const pg8::f32x4 a = acc[ai][bj][m][0], b = acc[ai][bj][m][1]; float o[4];
#pragma unroll
                    for (int j = 0; j < 4; ++j) o[j] = a[j] / (1.f + __expf(-a[j])) * b[j] * gate;
                    *(uint2*)(rowp + bj * 64) = make_uint2(pg8::cvt_pk_bf16(o[0], o[1]), pg8::cvt_pk_bf16(o[2], o[3])); } }
    }
};
struct PB_Moe2 {
    static constexpr bool PERM = true;
    const char* A; int ldb, nt; const char* W2; bf16_t* D2; const float* MODl; const int* LISTP; const ALAS int* tb; int G, c; bool dry;
    int tail;
    __device__ __forceinline__ bool next(int i, pg8::Unit& u) const {
        const int nMt = tb[32 + 24], nwg = nMt * 4, nfull = (nwg / G) * G, ntail = nwg - nfull; const bool split = 2 * ntail <= G;
        int L, half = 0;
        if (tail == 0) { L = i * G + c; if (L >= (split ? nfull : nwg)) return false; }
        else { if (!split || i != 0 || c >= 2 * ntail) return false; L = nfull + (c >> 1); half = c & 1; }
        int pn; pg8::static_unit(L, nMt, 4, u.pm, pn); u.pn = tail ? 2 * pn + half : pn;
        int pr = 0;
        for (int q = 1; q < 24; ++q) if (tb[32 + q] <= u.pm) pr = q;
        u.aux = pr; return true; }
    __device__ __forceinline__ void a_off(const pg8::Unit& u, const int (&Rs)[2], const int (&Cs)[2], unsigned (&off)[2][2]) const {
#pragma unroll
        for (int h = 0; h < 2; ++h)
#pragma unroll
            for (int i = 0; i < 2; ++i) off[h][i] = (unsigned)((u.pm * 256 + h * 128 + Rs[i]) * 1024 + Cs[i]) * 2u; }
    __device__ __forceinline__ const char* b_ptr(const pg8::Unit& u, int t) const { int e0, e1; pair_experts(u.aux, e0, e1); const int e = t < 8 ? e0 : e1;
        return W2 + ((size_t)e * 1024 + (size_t)u.pn * (tail ? 128 : 256)) * DE * 2 + (size_t)(t & 7) * 128; }
    __device__ __forceinline__ void epi(const pg8::f32x4 (&acc)[2][2][4][2], const pg8::Unit& u, int wr, int wc, int fr, int fq) const {
        const int pr = u.aux, cnt = tb[pr], r0 = (u.pm - tb[32 + pr]) * 256; const int* lp = LISTP + (size_t)pr * R;
        const int col0 = u.pn * (tail ? 128 : 256) + wc * 32 + 8 * fq; const int nbj = tail ? 1 : 2;
        if (dry) return;
        int tok[2][4];
#pragma unroll
        for (int ai = 0; ai < 2; ++ai)
#pragma unroll
            for (int m = 0; m < 4; ++m) { const int rk = r0 + ai * 128 + wr * 64 + m * 16 + fr; tok[ai][m] = rk < cnt ? lp[rk] : -1; }
#pragma unroll
        for (int ai = 0; ai < 2; ++ai)
#pragma unroll
            for (int m = 0; m < 4; ++m) { const int tk = tok[ai][m];
                if (tk >= 0) { bf16_t* rowp = D2 + (size_t)tk * D + col0; const float* gt = MODl + (size_t)row_mi(tk) * 6 * D + 5 * D + col0;
#pragma unroll
                    for (int bj = 0; bj < 2; ++bj) { if (bj >= nbj) break; const pg8::f32x4 v0 = acc[ai][bj][m][0] * *(const pg8::f32x4*)(gt + bj * 128), v1 = acc[ai][bj][m][1] * *(const pg8::f32x4*)(gt + bj * 128 + 4); pg8::u32x4 w;
                        w.x = pg8::cvt_pk_bf16(v0[0], v0[1]); w.y = pg8::cvt_pk_bf16(v0[2], v0[3]); w.z = pg8::cvt_pk_bf16(v1[0], v1[1]); w.w = pg8::cvt_pk_bf16(v1[2], v1[3]);
                        *(pg8::u32x4*)(rowp + bj * 128) = w; } } }
    }
};

template <int MAP  >
__device__ __forceinline__ void transpose_item(const float* W, int K, int N, bf16_t* WT, PG8_LAS float* scr, int item, int lane) {
    const int nblk = N / 32, kb = item / nblk, nb = item % nblk, k0 = 64 * kb, n0 = 32 * nb;
    float wv32[32];
#pragma unroll
    for (int i = 0; i < 32; ++i) { const int kk = 2 * i + (lane >> 5); wv32[i] = W[(size_t)(k0 + kk) * N + n0 + (lane & 31)]; }
#pragma unroll
    for (int i = 0; i < 32; ++i) { const int kk = 2 * i + (lane >> 5); scr[kk * 33 + (lane & 31)] = wv32[i]; }
    asm volatile("s_waitcnt lgkmcnt(0)" ::: "memory");
    const int c = lane & 7;
#pragma unroll
    for (int j = 0; j < 4; ++j) { const int n = (lane >> 3) + 8 * j; const PG8_LAS float* sp = scr + (8 * c) * 33 + n;
        uint4 o; o.x = pk2bf(sp[0 * 33], sp[1 * 33]); o.y = pk2bf(sp[2 * 33], sp[3 * 33]);
        o.z = pk2bf(sp[4 * 33], sp[5 * 33]); o.w = pk2bf(sp[6 * 33], sp[7 * 33]);
        const int ng = n0 + n; const int row = MAP == 0 ? ng : (32 * (ng >> 4) + (ng & 15) + (MAP == 2 ? 16 : 0));
        *(uint4*)(WT + (size_t)row * K + k0 + 8 * c) = o; }
    asm volatile("s_waitcnt lgkmcnt(0)" ::: "memory");
}
__device__ __forceinline__ void ph_prep_weights(const P& p, unsigned char* lds) {
    const int tidx = p.wid * 64 + fresh_lane();
    const int lane = tidx & 63, wv = tidx >> 6;
    PG8_LAS float* scr = (PG8_LAS float*)((PG8_LAS unsigned char*)lds + wv * 16384);
    const int gw = blockIdx.x * NWV + wv, NGW = gridDim.x * NWV;
    constexpr int I_IN = (D / 64) * (NZ / 32), I_OUT = (D / 64) * (D / 32);
    for (int it = gw; it < 2 * (I_IN + I_OUT); it += NGW) { const int l = it / (I_IN + I_OUT), r = it % (I_IN + I_OUT);
        if (r < I_IN) transpose_item<0>(p.in[I_WIN] + (size_t)l * D * NZ, D, NZ, (bf16_t*)(p.ws + WS_WIN) + (size_t)l * NZ * D, scr, r, lane);
        else transpose_item<0>(p.in[I_WOUT] + (size_t)l * D * D, D, D, (bf16_t*)(p.ws + WS_WOUT) + (size_t)l * D * D, scr, r - I_IN, lane); }
    { bf16_t* SGWo = (bf16_t*)(p.ws + WS_SGW); for (int it = blockIdx.x * NT + tidx; it < 2 * 4 * 128 * 128; it += gridDim.x * NT) SGWo[it] = f2bf(p.in[I_SGW][it]); }
    { bf16_t* WT = (bf16_t*)(p.ws + WS_LRUWT);
      for (int it = blockIdx.x * NT + tidx; it < 2 * 2 * 2 * 4 * 64 * 64; it += gridDim.x * NT) { const int i = it & 63, j = (it >> 6) & 63, hh = (it >> 12) & 3, gate = (it >> 14) & 1, ld = it >> 15;
          const float* src = (gate ? p.in[I_WI] : p.in[I_WR]) + (((size_t)ld * 4 + hh) * 64 + i) * 64 + j; WT[it] = f2bf(*src); } }
}
__device__ __forceinline__ void ph_prep_moe(const P& p, int l, unsigned char* lds, int half, int b0) {
    if ((int)blockIdx.x < b0) return;
    const int tidx = p.wid * 64 + fresh_lane();
    const int lane = tidx & 63, wv = tidx >> 6;
    PG8_LAS float* scr = (PG8_LAS float*)((PG8_LAS unsigned char*)lds + wv * 16384);
    const int gw = ((int)blockIdx.x - b0) * NWV + wv, NGW = ((int)gridDim.x - b0) * NWV;
    constexpr int I_13 = (D / 64) * (DE / 32), I_2 = (DE / 64) * (D / 32), PER_E = 2 * I_13 + I_2;
    for (int it = gw + half * (NE / 2) * PER_E; it < (half + 1) * (NE / 2) * PER_E; it += NGW) { const int e = it / PER_E, r = it % PER_E;
        bf16_t* w13 = (bf16_t*)(p.ws + WS_W13) + (size_t)e * 1024 * D; bf16_t* w2 = (bf16_t*)(p.ws + WS_W2) + (size_t)e * D * DE;
        if (r < I_13) transpose_item<1>(p.in[I_W1] + ((size_t)l * NE + e) * D * DE, D, DE, w13, scr, r, lane);
        else if (r < 2 * I_13) transpose_item<2>(p.in[I_W3] + ((size_t)l * NE + e) * D * DE, D, DE, w13, scr, r - I_13, lane);
        else transpose_item<0>(p.in[I_W2] + ((size_t)l * NE + e) * DE * D, DE, D, w2, scr, r - 2 * I_13, lane); }
}

#define XB_TMO      128
#define XB_XCNT(j)  (256  + 64 * (j))
#define XB_XSUB(j)  (1280 + 64 * (j))
#define XB_XGEN(j)  (2304 + 64 * (j))
#define XB_TOP      3328
#define XB_TOPGEN   3392
#define XCD_BAR_WORDS 3456
#define XB_SPIN_CAP (1u << 18)
__device__ __forceinline__ unsigned xb_ld(unsigned* q) { return __hip_atomic_load(q, __ATOMIC_RELAXED, __HIP_MEMORY_SCOPE_AGENT); }
__device__ __forceinline__ unsigned xb_add(unsigned* q, unsigned v) { return __hip_atomic_fetch_add(q, v, __ATOMIC_RELAXED, __HIP_MEMORY_SCOPE_AGENT); }
__device__ __forceinline__ unsigned xb_xcc_id() { return (unsigned)__builtin_amdgcn_s_getreg((3 << 11) | 20) & 0xFu; }
#define XB_SPIN(cond, bar) do { unsigned _sp = 0; while (cond) { __builtin_amdgcn_s_sleep(1); \
    if ((++_sp & 255u) == 0u) { if (xb_ld(&(bar)[XB_TMO])) break; if (_sp > XB_SPIN_CAP) { atomicAdd(&(bar)[XB_TMO], 1u); break; } } } } while (0)
struct XcdBarrier { unsigned* bar; unsigned x; volatile ALAS unsigned* st; int wid; };
__device__ __forceinline__ XcdBarrier xcd_barrier_post(unsigned* bar, volatile ALAS unsigned* st, int wid) {
    XcdBarrier b; b.bar = bar; b.x = xb_xcc_id(); b.st = st; b.wid = wid;
    if (wid == 0 && fresh_lane() == 0) (void)xb_add(&bar[XB_XCNT(b.x)], 1u);
    return b;
}
__device__ __forceinline__ void xcd_barrier_complete(unsigned* bar, unsigned x, unsigned& nloc, unsigned& nx) {
    const unsigned G = gridDim.x * gridDim.y * gridDim.z;
    unsigned sum, cnt, mine, sp = 0u;
    for (;;) {
        sum = 0u; cnt = 0u; mine = 0u;
#pragma unroll
        for (unsigned j = 0; j < 16; ++j) { const unsigned c = xb_ld(&bar[XB_XCNT(j)]); sum += c; cnt += (c > 0u) ? 1u : 0u; mine = (j == x) ? c : mine; }
        if (sum == G) break;
        __builtin_amdgcn_s_sleep(1);
        if ((++sp & 255u) == 0u) { if (xb_ld(&bar[XB_TMO])) break; if (sp > XB_SPIN_CAP) { atomicAdd(&bar[XB_TMO], 1u); break; } }
    }
    nloc = mine > 0u ? mine : 1u; nx = cnt > 0u ? cnt : 1u;
}
__device__ __forceinline__ void xcd_barrier(const XcdBarrier& b) {
    asm volatile("s_waitcnt vmcnt(0)" ::: "memory");
    __syncthreads();
    if (b.wid == 0 && fresh_lane() == 0) {
        unsigned* bar = b.bar; asm volatile("" : "+s"(bar));
        __builtin_amdgcn_s_waitcnt(0);
        unsigned nloc = b.st[0], nx = b.st[1];
        if (nloc == 0u) { xcd_barrier_complete(bar, b.x, nloc, nx); b.st[0] = nloc; b.st[1] = nx; }
        const unsigned old = xb_add(&bar[XB_XSUB(b.x)], 1u);
        const unsigned gen = old / nloc;
        if (old + 1u == (gen + 1u) * nloc) {
            __builtin_amdgcn_fence(__ATOMIC_RELEASE, "agent");
            asm volatile("s_waitcnt vmcnt(0)" ::: "memory");
            const unsigned og = xb_add(&bar[XB_TOP], 1u);
            const unsigned tg = og / nx;
            if (og + 1u == (tg + 1u) * nx) xb_add(&bar[XB_TOPGEN], 1u);
            else XB_SPIN(xb_ld(&bar[XB_TOPGEN]) == tg, bar);
            __builtin_amdgcn_fence(__ATOMIC_ACQUIRE, "agent");
            xb_add(&bar[XB_XGEN(b.x)], 1u);
            asm volatile("s_waitcnt vmcnt(0)" ::: "memory");
        } else {
            XB_SPIN(xb_ld(&bar[XB_XGEN(b.x)]) == gen, bar);
            __builtin_amdgcn_fence(__ATOMIC_ACQUIRE, "agent");
            asm volatile("s_waitcnt vmcnt(0)" ::: "memory");
        }
    }
    __syncthreads();
}

constexpr int LDS_BYTES = 163840;
typedef const __attribute__((address_space(4))) P* kargp_t;
#define GETP() P p; { kargp_t kq_ = kp; int w_ = wid; asm volatile("" : "+s"(kq_), "+s"(w_)); p = *(const P*)kq_; p.wid = w_; }
__global__ void __launch_bounds__(NT, 2) fwd_kernel(P p_in) {
    const int wid = __builtin_amdgcn_readfirstlane((int)(threadIdx.x >> 6));
    kargp_t kp = (kargp_t)__builtin_amdgcn_kernarg_segment_ptr();
    extern __shared__ __attribute__((aligned(16))) unsigned char lds[];
    float* sm = (float*)lds;
    { volatile ALAS unsigned* stw = (volatile ALAS unsigned*)((ALAS unsigned char*)lds + LDS_MISC + 2048); if (threadIdx.x < 2) stw[threadIdx.x] = 0u; }
    __syncthreads();
    { GETP(); (void)xcd_barrier_post((unsigned*)(p.ws + WS_CNT + 1024), (volatile ALAS unsigned*)((ALAS unsigned char*)lds + LDS_MISC + 2048), wid); }
#define GBAR() do { GETP(); XcdBarrier gb_; gb_.bar = (unsigned*)(p.ws + WS_CNT + 1024); gb_.x = xb_xcc_id(); gb_.st = (volatile ALAS unsigned*)((ALAS unsigned char*)lds + LDS_MISC + 2048); gb_.wid = wid; xcd_barrier(gb_); } while (0)

    { GETP(); ph_mod(p, sm); }
    { GETP(); ph_rope_table(p); }
    { GETP(); ph_prep_weights(p, lds); }
    GBAR();
#pragma unroll 1
    for (int l = 0; l < 2; ++l) {

        { GETP(); ph_norm1(p, l); }
        if (l == 1) { GETP(); ph_prep_moe(p, l, lds, 1, 0); }
        GBAR();
        { GETP(); PB_InProj pb; pb.A = (const char*)(p.ws + WS_H); pb.ldb = D; pb.nt = D / 64; pb.Bt = (const char*)(p.ws + WS_WIN) + (size_t)l * NZ * D * 2; pb.Zo = (bf16_t*)(p.ws + WS_Z); pb.G = gridDim.x; pb.c = blockIdx.x;
          pg8::gemm_phase<PB_InProj, true>((PG8_LAS unsigned char*)lds, pb, wid); }
        { GETP(); ph_prep_moe(p, l, lds, 0, 96); }
        GBAR();
        { GETP(); ph_rope(p, l); }
        { GETP(); ph_sg(p, l, lds); }
        { GETP(); ph_lru_m1(p, l, lds); }
        { GETP(); ph_hg<1>(p, l, lds); }
        GBAR();
        { GETP(); ph_attn(p, l, lds); }
        { GETP(); ph_lru_m2(p, l, lds); }
        { GETP(); ph_hg<2>(p, l, lds); }
        GBAR();
        { GETP(); PB_OutProj pb; pb.A = (const char*)(p.ws + WS_Y); pb.ldb = D; pb.nt = D / 64; pb.Bt = (const char*)(p.ws + WS_WOUT) + (size_t)l * D * D * 2; pb.D1 = (bf16_t*)(p.ws + WS_D1);
          pb.MODl = (const float*)(p.ws + WS_MOD) + (size_t)l * 9 * 6 * D; pb.G = gridDim.x; pb.c = blockIdx.x; pb.skipctx = (l == 1); pb.dry = false;
          pb.tail = 0; pg8::gemm_phase<PB_OutProj, true>((PG8_LAS unsigned char*)lds, pb, wid);
          pb.tail = 1; pg8::gemm_phase<PB_OutProj, true, true>((PG8_LAS unsigned char*)lds, pb, wid); }
        if (l == 0) { GETP(); ph_prep_moe(p, l, lds, 1, 64); }
        GBAR();
        { GETP(); ph_router(p, l, lds + LDS_MISC); }
        GBAR();
        { GETP(); ALAS int* tb = (ALAS int*)(lds + LDS_MISC + 1024); moe_tiles_setup(p, l, tb);
          PB_Moe1 pb; pb.A = (const char*)(p.ws + WS_H); pb.ldb = D; pb.nt = D / 64; pb.W13 = (const char*)(p.ws + WS_W13); pb.HE = (bf16_t*)(p.ws + WS_Z); pb.LISTP = (const int*)(p.ws + WS_LISTP);
          pb.GP = (const float2*)(p.ws + WS_GP); pb.tb = tb; pb.G = gridDim.x; pb.c = blockIdx.x;
          pg8::gemm_phase<PB_Moe1, true>((PG8_LAS unsigned char*)lds, pb, wid); }
        GBAR();
        { GETP(); ALAS int* tb = (ALAS int*)(lds + LDS_MISC + 1024);
          PB_Moe2 pb; pb.A = (const char*)(p.ws + WS_Z); pb.ldb = DE; pb.nt = 16; pb.W2 = (const char*)(p.ws + WS_W2); pb.D2 = (bf16_t*)(p.ws + WS_D2);
          pb.MODl = (const float*)(p.ws + WS_MOD) + (size_t)l * 9 * 6 * D; pb.LISTP = (const int*)(p.ws + WS_LISTP); pb.tb = tb; pb.G = gridDim.x; pb.c = blockIdx.x; pb.dry = false;
          pb.tail = 0; pg8::gemm_phase<PB_Moe2, true>((PG8_LAS unsigned char*)lds, pb, wid);
          pb.tail = 1; pg8::gemm_phase<PB_Moe2, true, true>((PG8_LAS unsigned char*)lds, pb, wid); }
        GBAR();
    }

    { GETP(); ph_final(p); }

}

extern "C" void kernel_launch(void* const* d_in, const int* in_sizes, int n_in, void* d_out, int out_size, void* d_ws, size_t ws_size, hipStream_t stream) {
    if (n_in != N_IN || ws_size < WS_END) { fprintf(stderr, "kernel_launch: bad n_in %d or ws %zu < %zu\n", n_in, ws_size, (size_t)WS_END); return; }
    P p{};
    for (int i = 0; i < N_IN; ++i) p.in[i] = (const float*)d_in[i];
    p.out = (float*)d_out; p.ws = (unsigned char*)d_ws;
    (void)hipMemsetAsync((char*)d_ws + WS_CNT, 0, 16384, stream);
    void* args[] = {&p};
    static bool attr_set = false;
    if (!attr_set) { (void)hipFuncSetAttribute((const void*)fwd_kernel, hipFuncAttributeMaxDynamicSharedMemorySize, LDS_BYTES); attr_set = true; }
    hipError_t e = hipLaunchCooperativeKernel((void*)fwd_kernel, dim3(256), dim3(NT), args, LDS_BYTES, stream);
    if (e != hipSuccess) fprintf(stderr, "cooperative launch failed: %s\n", hipGetErrorString(e));
}
```

```cpp
#include <hip/hip_runtime.h>
#include <cstdio>
#include <cstdint>

constexpr int D = 1024, NB = 8, T = 2048, TC = 256, LB = T + TC  , R = NB * LB  ;
constexpr int NZ = 3072, NE = 16, DE = 512;
constexpr float EPS = 1e-6f;
constexpr int ZA_X = 0, ZA_G = 256, ZB_Q = 512, ZB_K = 768, ZB_V = 1024, ZC_U = 1280, ZC_V = 1536, ZD_Q = 1792, ZD_FF = 2048, ZD_FB = 2304, ZD_I = 2560, ZD_G = 2816;
enum { I_X = 0, I_C, I_CTX, I_CCTX, I_WADA, I_BADA, I_N1G, I_N2G, I_WIN, I_WOUT, I_CONVW, I_CONVB, I_WR, I_BR, I_WI, I_BI, I_LAM,
       I_DALAM, I_DASUB, I_SGNG, I_SGW, I_SGB, I_HGLB, I_HGNG, I_RW, I_RB, I_W1, I_W3, I_W2, I_FNG, N_IN };

typedef unsigned short bf16_t;
#define ALAS __attribute__((address_space(3)))
constexpr size_t MiB = 1u << 20;
constexpr size_t WS_MOD = 0;
constexpr size_t WS_CNT = 512 * 1024;
constexpr size_t WS_GP = 1 * MiB;
constexpr size_t WS_LISTP = WS_GP + (size_t)R * 8;
constexpr size_t WS_LRUWT = 768 * 1024;
constexpr size_t WS_ROPE = 4 * MiB + 512 * 1024;
constexpr size_t WS_SGW = 5 * MiB;
constexpr size_t WS_LRUAGG = 3 * MiB;
constexpr size_t WS_X = 8 * MiB;
constexpr size_t WS_H = WS_X + (size_t)R * D * 4;
constexpr size_t WS_Z = WS_H + (size_t)R * D * 2;
constexpr size_t WS_D1 = WS_Z + 64 * MiB;
constexpr size_t WS_Y = WS_Z + (size_t)R * NZ * 2;
constexpr size_t WS_D2 = WS_Y;
constexpr size_t WS_WIN = WS_Y + (size_t)R * D * 2;
constexpr size_t WS_WOUT = WS_WIN + 2 * (size_t)NZ * D * 2;
constexpr size_t WS_W13 = WS_WOUT + 2 * (size_t)D * D * 2;
constexpr size_t WS_W2 = WS_W13 + (size_t)NE * 1024 * D * 2;
constexpr size_t WS_END = WS_W2 + (size_t)NE * D * DE * 2;
constexpr int MPAD = R + 24 * 256;

struct P { const float* in[N_IN]; float* out; unsigned char* ws; int wid; int pad; };
__device__ __forceinline__ int fresh_lane() { int l_; asm volatile("v_mbcnt_lo_u32_b32 %0, -1, 0\n\tv_mbcnt_hi_u32_b32 %0, -1, %0" : "=v"(l_)); return l_; }


__device__ __forceinline__ float bf2f(bf16_t v) { return __uint_as_float(((unsigned)v) << 16); }
typedef float f32x2h_t __attribute__((ext_vector_type(2))); typedef __bf16 bf16x2h_t __attribute__((ext_vector_type(2)));
__device__ __forceinline__ unsigned pk2bf(float lo, float hi) { f32x2h_t v = {lo, hi}; bf16x2h_t b = __builtin_convertvector(v, bf16x2h_t); return __builtin_bit_cast(unsigned, b); }
__device__ __forceinline__ bf16_t f2bf(float f) { return (bf16_t)(pk2bf(f, f) & 0xffffu); }
__device__ __forceinline__ float sigmoidf_(float x) { return __builtin_amdgcn_rcpf(1.f + __expf(-x)); }
__device__ __forceinline__ float siluf_(float x) { return x * __builtin_amdgcn_rcpf(1.f + __expf(-x)); }
__device__ __forceinline__ float geluf_(float x) { const float u = 1.5957691216057308f * (x + 0.044715f * x * x * x); return x * __builtin_amdgcn_rcpf(1.f + __expf(-u)); }
__device__ __forceinline__ float wave_sum(float v) {
#pragma unroll
    for (int o = 1; o < 64; o <<= 1) v += __shfl_xor(v, o);
    return v;
}
__device__ __forceinline__ int row_mi(int r) { const int b = r / LB, j = r - b * LB; return j < TC ? 8 : b; }

#define NT 512
__device__ __forceinline__ const float* xin_row(const float* xin, const float* cin, int r) { const int b = r / LB, j = r - b * LB; return j < TC ? cin + ((size_t)b * TC + j) * D : xin + ((size_t)b * T + (j - TC)) * D; }
__device__ __forceinline__ int ustart(int off) { const int G = gridDim.x, b = blockIdx.x; const int v = (G % 8 == 0) ? (b % 8) * (G / 8) + b / 8 : b; return (v + off) % G; }
#define NWV 8
__device__ __forceinline__ void add_bf4(float (&x)[4], uint2 d) { x[0] += __uint_as_float(d.x << 16); x[1] += __uint_as_float(d.x & 0xffff0000u); x[2] += __uint_as_float(d.y << 16); x[3] += __uint_as_float(d.y & 0xffff0000u); }

__device__ __forceinline__ void ph_init(const P& p) {
    const int tidx = p.wid * 64 + fresh_lane();
    float* X = (float*)(p.ws + WS_X);
    const size_t n4 = (size_t)R * D / 4;
    const size_t stride = (size_t)gridDim.x * NT;
    const float* xin = p.in[I_X]; const float* cin = p.in[I_CTX];
#define INIT_SRC(i_) ({ const size_t e_ = (i_) * 4; const int r_ = (int)(e_ / D), c_ = (int)(e_ % D); const int b_ = r_ / LB, j_ = r_ - b_ * LB; \
        const size_t oc_ = ((size_t)b_ * TC + j_) * D + c_, ox_ = ((size_t)b_ * T + (j_ - TC)) * D + c_; (const float4*)((j_ < TC) ? (cin + oc_) : (xin + ox_)); })
    size_t i = (size_t)blockIdx.x * NT + tidx;
    for (; i + 3 * stride < n4; i += 4 * stride) {
        const float4 v0 = *INIT_SRC(i), v1 = *INIT_SRC(i + stride), v2 = *INIT_SRC(i + 2 * stride), v3 = *INIT_SRC(i + 3 * stride);
        *(float4*)(X + i * 4) = v0; *(float4*)(X + (i + stride) * 4) = v1; *(float4*)(X + (i + 2 * stride) * 4) = v2; *(float4*)(X + (i + 3 * stride) * 4) = v3;
    }
    for (; i < n4; i += stride) *(float4*)(X + i * 4) = *INIT_SRC(i);
#undef INIT_SRC
}

__device__ __forceinline__ void ph_mod(const P& p, float* sm_) {
    const int tidx = p.wid * 64 + fresh_lane();
    float* MOD = (float*)(p.ws + WS_MOD);
    ALAS float* sm = (ALAS float*)sm_; ALAS float* red = sm + 9 * D;
    for (int i = tidx; i < 9 * D; i += NT) { const int mi = i / D, k = i % D; const float c = mi < 8 ? p.in[I_C][mi * D + k] : p.in[I_CCTX][k]; sm[i] = siluf_(c); }
    __syncthreads();
    const int col = tidx & 63, part = tidx >> 6;
    for (int it = blockIdx.x; it < 2 * 96; it += gridDim.x) {
        const int l = it / 96, n0 = (it % 96) * 64;
        const float* W = p.in[I_WADA] + (size_t)l * D * 6 * D + (size_t)(part * 128) * 6 * D + n0 + col;
        float acc[9];
#pragma unroll
        for (int m = 0; m < 9; ++m) acc[m] = 0.f;
#pragma unroll 8
        for (int k = 0; k < 128; ++k) { const float w = W[(size_t)k * 6 * D];
#pragma unroll
            for (int m = 0; m < 9; ++m) acc[m] += sm[m * D + part * 128 + k] * w; }
#pragma unroll
        for (int m = 0; m < 9; ++m) red[(part * 9 + m) * 64 + col] = acc[m];
        __syncthreads();
        for (int o = tidx; o < 9 * 64; o += NT) { const int m = o >> 6, cc = o & 63; float v = p.in[I_BADA][l * 6 * D + n0 + cc];
#pragma unroll
            for (int q = 0; q < 8; ++q) v += red[(q * 9 + m) * 64 + cc];
            MOD[((size_t)l * 9 + m) * 6 * D + n0 + cc] = v; }
        __syncthreads();
    }
}

__device__ __forceinline__ void ph_norm1(const P& p, int l) {
    const int tidx = p.wid * 64 + fresh_lane();
    float* X = (float*)(p.ws + WS_X); bf16_t* H = (bf16_t*)(p.ws + WS_H); const float* xin = p.in[I_X]; const float* cin = p.in[I_CTX];
    const bf16_t* D1 = (const bf16_t*)(p.ws + WS_D1); const bf16_t* D2 = (const bf16_t*)(p.ws + WS_D2);
    const float* MOD = (const float*)(p.ws + WS_MOD) + (size_t)l * 9 * 6 * D; const float* g = p.in[I_N1G] + l * D;
    const int lane = tidx & 63, wv = tidx >> 6;
    const int stride = gridDim.x * NWV; const int r0 = blockIdx.x * NWV + wv;
    float4 gq[4];
#pragma unroll
    for (int q = 0; q < 4; ++q) gq[q] = *(const float4*)(g + (lane + 64 * q) * 4);
    for (int rb = r0; rb < R; rb += 9 * stride) {
        float4 vb[3][4]; uint2 d1b[3][4], d2b[3][4];
#define N1_LOAD(slot, k_) do { int rr_ = rb + (k_) * stride; rr_ = rr_ < R ? rr_ : rb; _Pragma("unroll") for (int q = 0; q < 4; ++q) { vb[slot][q] = *(const float4*)(xin_row(xin, cin, rr_) + (lane + 64 * q) * 4); \
            if (l == 1) { d1b[slot][q] = *(const uint2*)(D1 + (size_t)rr_ * D + (lane + 64 * q) * 4); d2b[slot][q] = *(const uint2*)(D2 + (size_t)rr_ * D + (lane + 64 * q) * 4); } } } while (0)
        N1_LOAD(0, 0); N1_LOAD(1, 1);
#pragma unroll
        for (int k = 0; k < 9; ++k) {
            const int r = rb + k * stride; const int sl = k % 3;
            const float* m = MOD + (size_t)row_mi(r < R ? r : rb) * 6 * D; float4 scq[4], shq[4];
#pragma unroll
            for (int q = 0; q < 4; ++q) { scq[q] = *(const float4*)(m + D + (lane + 64 * q) * 4); shq[q] = *(const float4*)(m + (lane + 64 * q) * 4); }
            if (k + 2 < 9) N1_LOAD((k + 2) % 3, k + 2);
            if (r < R) {
                float xv[4][4]; float ss = 0.f;
#pragma unroll
                for (int q = 0; q < 4; ++q) { xv[q][0] = vb[sl][q].x; xv[q][1] = vb[sl][q].y; xv[q][2] = vb[sl][q].z; xv[q][3] = vb[sl][q].w; if (l == 1) { add_bf4(xv[q], d1b[sl][q]); add_bf4(xv[q], d2b[sl][q]); } }
#pragma unroll
                for (int q = 0; q < 4; ++q) ss += xv[q][0] * xv[q][0] + xv[q][1] * xv[q][1] + xv[q][2] * xv[q][2] + xv[q][3] * xv[q][3];
                const float rs = rsqrtf(wave_sum(ss) * (1.f / D) + EPS);
#pragma unroll
                for (int q = 0; q < 4; ++q) { const int c = (lane + 64 * q) * 4; bf16_t o[4];
                    if (l == 1) *(float4*)(X + (size_t)r * D + c) = make_float4(xv[q][0], xv[q][1], xv[q][2], xv[q][3]);
                    const float4 g4 = gq[q], sc4 = scq[q], sh4 = shq[q];
                    const float gv[4] = {g4.x, g4.y, g4.z, g4.w}, scv[4] = {sc4.x, sc4.y, sc4.z, sc4.w}, shv[4] = {sh4.x, sh4.y, sh4.z, sh4.w};
#pragma unroll
                    for (int i = 0; i < 4; ++i) o[i] = f2bf(xv[q][i] * rs * gv[i] * (1.f + scv[i]) + shv[i]);
                    *(uint2*)(H + (size_t)r * D + c) = make_uint2((unsigned)o[0] | ((unsigned)o[1] << 16), (unsigned)o[2] | ((unsigned)o[3] << 16)); }
            }
        }
#undef N1_LOAD
    }
}

constexpr float QSCALE = 0.17677669529663687f * 1.4426950408889634f;
__device__ __forceinline__ void ph_rope_table(const P& p) {
    const int tidx = p.wid * 64 + fresh_lane();
    float2* TAB = (float2*)(p.ws + WS_ROPE);
    for (int it = blockIdx.x * NT + tidx; it < T * 16; it += gridDim.x * NT) { const int f = it & 7, a = (it >> 3) & 1, t = it >> 4;
        const float pos = (float)(a == 0 ? (t / 64) : (t % 64)); const float freq = expf(-(float)f * 0.125f * 9.210340371976184f); const float ang = pos * freq;
        TAB[it] = make_float2(cosf(ang), sinf(ang)); }
}
__device__ __forceinline__ void ph_rope(const P& p, int l) {
    const int tidx = p.wid * 64 + fresh_lane();
    bf16_t* Z = (bf16_t*)(p.ws + WS_Z); const float2* TAB = (const float2*)(p.ws + WS_ROPE);
    const int total = NB * T * 32;
    for (int it = blockIdx.x * NT + tidx; it < total; it += gridDim.x * NT) {
        const int pr = it & 31, rt = it >> 5; const int b = rt / T, t = rt % T;
        const int a = pr & 1, n = (pr >> 1) & 1, h = (pr >> 2) & 3, qk = pr >> 4;
        bf16_t* zp = Z + (size_t)(b * LB + TC + t) * NZ + (qk ? ZB_K : ZB_Q) + h * 64 + n * 32 + a * 16;
        const uint4 v1 = *(const uint4*)zp, v2 = *(const uint4*)(zp + 8); const unsigned w1[4] = {v1.x, v1.y, v1.z, v1.w}, w2[4] = {v2.x, v2.y, v2.z, v2.w};
        const float2* tb = TAB + (size_t)(t * 2 + a) * 8; const float sc = qk ? 1.f : QSCALE; unsigned o1[4], o2[4];
#pragma unroll
        for (int i = 0; i < 4; ++i) { const float2 cs0 = tb[2 * i], cs1 = tb[2 * i + 1];
            const float x1a = __uint_as_float(w1[i] << 16), x1b = __uint_as_float(w1[i] & 0xffff0000u), x2a = __uint_as_float(w2[i] << 16), x2b = __uint_as_float(w2[i] & 0xffff0000u);
            o1[i] = pk2bf((x1a * cs0.x - x2a * cs0.y) * sc, (x1b * cs1.x - x2b * cs1.y) * sc);
            o2[i] = pk2bf((x2a * cs0.x + x1a * cs0.y) * sc, (x2b * cs1.x + x1b * cs1.y) * sc); }
        *(uint4*)zp = make_uint4(o1[0], o1[1], o1[2], o1[3]); *(uint4*)(zp + 8) = make_uint4(o2[0], o2[1], o2[2], o2[3]);
    }
    if (l == 0) {
        const int totc = NB * TC * 256;
        for (int it = blockIdx.x * NT + tidx; it < totc; it += gridDim.x * NT) {
            const int c = it & 255, rt = it >> 8; const int b = rt / TC, j = rt % TC;
            bf16_t* zp = Z + (size_t)(b * LB + j) * NZ + ZB_Q + c; zp[0] = f2bf(bf2f(zp[0]) * QSCALE);
        }
    }
}

namespace lru {
typedef short bf16x8 __attribute__((ext_vector_type(8)));
typedef float f32x4 __attribute__((ext_vector_type(4)));
constexpr int UROW = 264;
__device__ __forceinline__ void comp(float& A, float& B, float a, float b) { B = a * B + b; A = a * A; }
}
__device__ __forceinline__ void ph_lru_m1(const P& p, int l, unsigned char* ldsb) {
    using namespace lru;
    const int lane = fresh_lane(), wid = p.wid, tid = wid * 64 + lane;
    const bf16_t* Z = (const bf16_t*)(p.ws + WS_Z); bf16_t* G = (bf16_t*)(p.ws + WS_H); float2* AGG = (float2*)(p.ws + WS_LRUAGG);
    const bf16_t* WT = (const bf16_t*)(p.ws + WS_LRUWT);
    const float* cw = p.in[I_CONVW] + l * 4 * 256; const float* cb = p.in[I_CONVB] + l * 256;
    ALAS bf16_t* U = (ALAS bf16_t*)ldsb;
    const int h = wid & 3, d = wid >> 2, l15 = lane & 15, g4 = lane >> 4;
    float spv[4], brv[4], biv[4];
#pragma unroll
    for (int jt = 0; jt < 4; ++jt) { const int w = h * 64 + jt * 16 + l15; spv[jt] = log1pf(expf(-p.in[I_LAM][(l * 2 + d) * 256 + w])); brv[jt] = p.in[I_BR][(l * 2 + d) * 256 + w]; biv[jt] = p.in[I_BI][(l * 2 + d) * 256 + w]; }
    for (int unit = ustart(192); unit < NB * 36; unit += gridDim.x) {
        const int b = unit / 36, c = unit % 36, r0 = b * LB + c * 64; const int lo = c < 4 ? 0 : TC, hi = c < 4 ? TC : LB;
        {
            uint4 zv[4][4];
#pragma unroll
            for (int it4 = 0; it4 < 4; ++it4) { const int item = tid + it4 * NT; const int t = item >> 5, cg = item & 31, j = c * 64 + t;
#pragma unroll
                for (int q = 0; q < 4; ++q) { int jj = j + q - 2; jj = jj < lo ? lo : (jj >= hi ? hi - 1 : jj); zv[it4][q] = *(const uint4*)(Z + (size_t)(b * LB + jj) * NZ + ZA_X + cg * 8); } }
#pragma unroll
            for (int it4 = 0; it4 < 4; ++it4) { const int item = tid + it4 * NT; const int t = item >> 5, cg = item & 31, j = c * 64 + t; float acc[8];
#pragma unroll
                for (int i = 0; i < 8; ++i) acc[i] = cb[cg * 8 + i];
#pragma unroll
                for (int q = 0; q < 4; ++q) { const int jj = j + q - 2; const float msk = (jj >= lo && jj < hi) ? 1.f : 0.f; const unsigned zw[4] = {zv[it4][q].x, zv[it4][q].y, zv[it4][q].z, zv[it4][q].w};
                    const float4 w0 = *(const float4*)(cw + q * 256 + cg * 8), w1 = *(const float4*)(cw + q * 256 + cg * 8 + 4); const float wv8[8] = {w0.x, w0.y, w0.z, w0.w, w1.x, w1.y, w1.z, w1.w};
#pragma unroll
                    for (int i = 0; i < 4; ++i) { acc[2 * i] += __uint_as_float(zw[i] << 16) * (wv8[2 * i] * msk); acc[2 * i + 1] += __uint_as_float(zw[i] & 0xffff0000u) * (wv8[2 * i + 1] * msk); } }
                uint4 o; o.x = pk2bf(acc[0], acc[1]); o.y = pk2bf(acc[2], acc[3]); o.z = pk2bf(acc[4], acc[5]); o.w = pk2bf(acc[6], acc[7]);
                { typedef unsigned u32x4_t __attribute__((ext_vector_type(4))); u32x4_t ov = {o.x, o.y, o.z, o.w}; *(ALAS u32x4_t*)(U + t * UROW + cg * 8) = ov; } }
        }
        __syncthreads();
        bf16x8 af[4][2];
#pragma unroll
        for (int tt = 0; tt < 4; ++tt)
#pragma unroll
            for (int ks = 0; ks < 2; ++ks) af[tt][ks] = *(const ALAS bf16x8*)(U + (16 * tt + l15) * UROW + h * 64 + 32 * ks + 8 * g4);
#pragma unroll 1
        for (int jt = 0; jt < 4; ++jt) {
            const float spj = jt == 0 ? spv[0] : jt == 1 ? spv[1] : jt == 2 ? spv[2] : spv[3], brj = jt == 0 ? brv[0] : jt == 1 ? brv[1] : jt == 2 ? brv[2] : brv[3], bij = jt == 0 ? biv[0] : jt == 1 ? biv[1] : jt == 2 ? biv[2] : biv[3];
            f32x4 ar[4], ai[4];
#pragma unroll
            for (int tt = 0; tt < 4; ++tt) { ar[tt] = (f32x4){0.f, 0.f, 0.f, 0.f}; ai[tt] = (f32x4){0.f, 0.f, 0.f, 0.f}; }
#pragma unroll
            for (int ks = 0; ks < 2; ++ks) { const bf16_t* wp = WT + ((size_t)(((l * 2 + d) * 2 + 0) * 4 + h) * 64 + 16 * jt + l15) * 64 + 32 * ks + 8 * g4; const bf16x8 wr = *(const bf16x8*)wp, wi = *(const bf16x8*)(wp + 4 * 64 * 64);
#pragma unroll
                for (int tt = 0; tt < 4; ++tt) { ar[tt] = __builtin_amdgcn_mfma_f32_16x16x32_bf16(af[tt][ks], wr, ar[tt], 0, 0, 0); ai[tt] = __builtin_amdgcn_mfma_f32_16x16x32_bf16(af[tt][ks], wi, ai[tt], 0, 0, 0); } }
            const int w = h * 64 + jt * 16 + l15; float mA[4], mB[4];
#pragma unroll
            for (int tt = 0; tt < 4; ++tt) { float A = 1.f, Bv = 0.f; float av[4], bv[4];
#pragma unroll
                for (int rg = 0; rg < 4; ++rg) { const int t = 16 * tt + 4 * g4 + rg;
                    const float rgt = sigmoidf_(ar[tt][rg] + brj), igt = sigmoidf_(ai[tt][rg] + bij);
                    const bf16_t lab = f2bf(-8.f * rgt * spj); const float a = __expf(bf2f(lab));
                    const float uu = bf2f(U[t * UROW + w]); const float bc = __builtin_amdgcn_sqrtf(fmaxf(1.f - a * a, 0.f)) * igt * uu;
                    const bf16_t bcb = f2bf(bc);
                    G[((size_t)(d * 2 + 0) * R + r0 + t) * 256 + w] = lab; G[((size_t)(d * 2 + 1) * R + r0 + t) * 256 + w] = bcb;
                    av[rg] = a; bv[rg] = bf2f(bcb); }
                if (d == 0) { comp(A, Bv, av[0], bv[0]); comp(A, Bv, av[1], bv[1]); comp(A, Bv, av[2], bv[2]); comp(A, Bv, av[3], bv[3]); }
                else { comp(A, Bv, av[3], bv[3]); comp(A, Bv, av[2], bv[2]); comp(A, Bv, av[1], bv[1]); comp(A, Bv, av[0], bv[0]); }
                mA[tt] = A; mB[tt] = Bv; }
            float A = 1.f, Bv = 0.f;
#pragma unroll
            for (int s4 = 0; s4 < 4; ++s4) { const int tt = d == 0 ? s4 : 3 - s4; const float ma = d == 0 ? mA[s4] : mA[3 - s4], mb = d == 0 ? mB[s4] : mB[3 - s4]; (void)tt;
#pragma unroll
                for (int gs = 0; gs < 4; ++gs) { const int gg = d == 0 ? gs : 3 - gs; const float a = __shfl(ma, gg * 16 + l15), bq = __shfl(mb, gg * 16 + l15); comp(A, Bv, a, bq); } }
            if (g4 == 0) AGG[((size_t)(b * 2 + d) * 36 + c) * 256 + w] = make_float2(A, Bv);
        }
        __syncthreads();
    }
}
__device__ __forceinline__ void ph_lru_m2(const P& p, int l, unsigned char* ldsb) {
    const int lane = fresh_lane(), wid = p.wid, tid = wid * 64 + lane;
    const bf16_t* Z = (const bf16_t*)(p.ws + WS_Z); const bf16_t* G = (const bf16_t*)(p.ws + WS_H); bf16_t* Y = (bf16_t*)(p.ws + WS_Y); const float2* AGG = (const float2*)(p.ws + WS_LRUAGG);
    ALAS float* HS = (ALAS float*)ldsb;
    const int d = tid >> 8, w = tid & 255;
    const int ncb = l == 1 ? 32 : 36, nun = NB * ncb;
    const int vme = ustart(0);
    for (int pass = 0; pass < 2; ++pass) {
        int unit;
        if (l == 1) unit = pass == 0 ? vme : -1;
        else if (pass == 0) unit = (vme >= 64 && vme < 96) ? -1 : (vme < 64 ? vme : vme - 32);
        else unit = (vme >= 96 && vme < 160) ? 224 + (vme - 96) : -1;
        if (unit < 0 || unit >= nun) continue;
        const int b = unit / ncb, c = (36 - ncb) + unit % ncb, r0 = b * LB + c * 64;
        float hst = 0.f; const float2* ag = AGG + (size_t)(b * 2 + d) * 36 * 256 + w;
        {
            const int pos = d == 0 ? c : (c < 4 ? 3 - c : 4 + (35 - c));
            float mx[36], my[36];
#pragma unroll
            for (int k = 0; k < 36; ++k) { const int cc = d == 0 ? k : (k < 4 ? 3 - k : 39 - k); const float2 m = ag[cc * 256]; mx[k] = m.x; my[k] = m.y; }
#pragma unroll
            for (int k = 0; k < 36; ++k) { const bool vf = k < pos; const float a = vf ? mx[k] : 1.f, bq = vf ? my[k] : 0.f; hst = __builtin_fmaf(a, hst, bq); }
        }
        const bf16_t* gl = G + ((size_t)(d * 2 + 0) * R + r0) * 256 + w; const bf16_t* gb = G + ((size_t)(d * 2 + 1) * R + r0) * 256 + w;
#pragma unroll 1
        for (int s0 = 0; s0 < 64; s0 += 32) {
            bf16_t la[32], lb[32];
#pragma unroll
            for (int i = 0; i < 32; ++i) { const int t = d == 0 ? (s0 + i) : 63 - (s0 + i); la[i] = gl[t * 256]; lb[i] = gb[t * 256]; }
#pragma unroll
            for (int i = 0; i < 32; ++i) { const int t = d == 0 ? (s0 + i) : 63 - (s0 + i); hst = __expf(bf2f(la[i])) * hst + bf2f(lb[i]); HS[(d * 64 + t) * 256 + w] = hst; }
        }
        __syncthreads();
#pragma unroll
        for (int q = 0; q < 4; ++q) { const int it = tid + q * NT; const int t = it >> 5, c8 = (it & 31) * 8;
            const uint4 zv = *(const uint4*)(Z + (size_t)(r0 + t) * NZ + ZA_G + c8); const unsigned zw[4] = {zv.x, zv.y, zv.z, zv.w}; unsigned o[4];
#pragma unroll
            for (int i = 0; i < 4; ++i) { const float h0 = HS[t * 256 + c8 + 2 * i] + HS[(64 + t) * 256 + c8 + 2 * i], h1 = HS[t * 256 + c8 + 2 * i + 1] + HS[(64 + t) * 256 + c8 + 2 * i + 1];
                o[i] = pk2bf(h0 * geluf_(__uint_as_float(zw[i] << 16)), h1 * geluf_(__uint_as_float(zw[i] & 0xffff0000u))); }
            *(uint4*)(Y + (size_t)(r0 + t) * D + c8) = make_uint4(o[0], o[1], o[2], o[3]); }
        __syncthreads();
    }
}

__device__ __forceinline__ void ph_sg(const P& p, int l, unsigned char* ldsb) {
    typedef short bf16x8 __attribute__((ext_vector_type(8))); typedef float f32x16 __attribute__((ext_vector_type(16)));
    const int lane = fresh_lane(), wid = p.wid, tid = wid * 64 + lane, r32 = lane & 31, hi = lane >> 5;
    const bf16_t* Z = (const bf16_t*)(p.ws + WS_Z); bf16_t* Y = (bf16_t*)(p.ws + WS_Y); const bf16_t* SGW = (const bf16_t*)(p.ws + WS_SGW) + (size_t)l * 4 * 128 * 128;
    const float* ng = p.in[I_SGNG] + l * 256;
    ALAS bf16_t* VT = (ALAS bf16_t*)ldsb;
    constexpr int VROW = 136;
    const int q = tid >> 2, part = tid & 3, ptile = wid & 3, chalf = wid >> 2;
    const int nck = l == 1 ? 16 : 18;
    const int vme = ustart(0), nun_sg = NB * nck * 4;
    for (int pass = 0; pass < 3; ++pass) {
        int unit;
        if (pass == 0) unit = vme;
        else if (pass == 1) unit = (vme >= 64 && vme < 96) ? -1 : 256 + (vme < 64 ? vme : vme - 32);
        else unit = (vme >= 160 && vme < 192) ? 480 + (vme - 160) : (vme < 64 ? 512 + vme : -1);
        if (unit < 0 || unit >= nun_sg) continue;
        const int h = unit & 3, bc = unit >> 2, b = bc / nck, ck = (18 - nck) + bc % nck;
        const int r0 = b * LB + ck * 128;
        bf16x8 wf[8];
        { const bf16_t* wp = SGW + ((size_t)h * 128 + 32 * ptile + r32) * 128 + 8 * hi;
#pragma unroll
          for (int ks = 0; ks < 8; ++ks) wf[ks] = *(const bf16x8*)(wp + 16 * ks); }
        { const bf16_t* zv = Z + (size_t)(r0 + q) * NZ + ZC_V + part * 64; uint4 raw[8]; float ss = 0.f;
#pragma unroll
          for (int i = 0; i < 8; ++i) raw[i] = *(const uint4*)(zv + 8 * i);
#pragma unroll
          for (int i = 0; i < 8; ++i) { const unsigned w4[4] = {raw[i].x, raw[i].y, raw[i].z, raw[i].w};
#pragma unroll
              for (int k = 0; k < 4; ++k) { const float g0 = geluf_(__uint_as_float(w4[k] << 16)), g1 = geluf_(__uint_as_float(w4[k] & 0xffff0000u)); ss += g0 * g0 + g1 * g1; } }
          ss += __shfl_xor(ss, 1); ss += __shfl_xor(ss, 2);
          const float rs = rsqrtf(ss * (1.f / 256.f) + EPS);
          if (part == h) {
#pragma unroll
              for (int i = 0; i < 8; ++i) { const unsigned w4[4] = {raw[i].x, raw[i].y, raw[i].z, raw[i].w};
#pragma unroll
                  for (int k = 0; k < 4; ++k) { const int c = 8 * i + 2 * k;
                      VT[c * VROW + q] = f2bf(geluf_(__uint_as_float(w4[k] << 16)) * rs * ng[h * 64 + c]);
                      VT[(c + 1) * VROW + q] = f2bf(geluf_(__uint_as_float(w4[k] & 0xffff0000u)) * rs * ng[h * 64 + c + 1]); } } } }
        __syncthreads();
        f32x16 acc = f32x16{};
#pragma unroll
        for (int ks = 0; ks < 8; ++ks) { const bf16x8 vf = *(const ALAS bf16x8*)(VT + (32 * chalf + r32) * VROW + 16 * ks + 8 * hi); acc = __builtin_amdgcn_mfma_f32_32x32x16_bf16(wf[ks], vf, acc, 0, 0, 0); }
        { const float* bsp = p.in[I_SGB] + (l * 4 + h) * 128 + 32 * ptile + 4 * hi; bf16_t zu[16];
          const size_t rb = (size_t)(r0 + 32 * ptile + 4 * hi);
#pragma unroll
          for (int r = 0; r < 16; ++r) { const int pr = (r & 3) + 8 * (r >> 2); zu[r] = Z[(rb + pr) * NZ + ZC_U + h * 64 + 32 * chalf + r32]; }
#pragma unroll
          for (int r = 0; r < 16; ++r) { const int pr = (r & 3) + 8 * (r >> 2); Y[(rb + pr) * D + 512 + h * 64 + 32 * chalf + r32] = f2bf(geluf_(bf2f(zu[r])) * (acc[r] + bsp[pr])); } }
        __syncthreads();
    }
}

namespace att {
typedef short bf16x8 __attribute__((ext_vector_type(8)));
typedef short s16x4 __attribute__((ext_vector_type(4)));
typedef float f32x16 __attribute__((ext_vector_type(16)));
typedef float f32x2_t __attribute__((ext_vector_type(2))); typedef __bf16 bf16x2_t __attribute__((ext_vector_type(2)));
constexpr int SLOTB = 8192, NSLOT = 4, L_K = 0, L_V = NSLOT * SLOTB, L_WS = 2 * NSLOT * SLOTB, L_OST = L_WS + 8 * 2 * 32 * 4, OST_W = 32 * 66 * 4;
constexpr float THR = 8.f;
__device__ __forceinline__ int crow(int r, int hi) { return (r & 3) + 8 * (r >> 2) + 4 * hi; }
__device__ __forceinline__ unsigned cvtpk(float lo, float hi) { f32x2_t v = {lo, hi}; bf16x2_t b = __builtin_convertvector(v, bf16x2_t); return __builtin_bit_cast(unsigned, b); }
__device__ __forceinline__ float max3f(float a, float b, float c) { float r; asm("v_max3_f32 %0, %1, %2, %3" : "=v"(r) : "v"(a), "v"(b), "v"(c)); return r; }
__device__ __forceinline__ float swapmax(float m) { auto rr = __builtin_amdgcn_permlane32_swap(__float_as_uint(m), __float_as_uint(m), false, false); return fmaxf(__uint_as_float(rr[0]), __uint_as_float(rr[1])); }
__device__ __forceinline__ float swapadd(float m) { auto rr = __builtin_amdgcn_permlane32_swap(__float_as_uint(m), __float_as_uint(m), false, false); return __uint_as_float(rr[0]) + __uint_as_float(rr[1]); }
typedef short v4i16_t __attribute__((ext_vector_type(4)));
__device__ __forceinline__ void glds16(const void* gsrc, unsigned lds_dst) { unsigned keep;
  asm volatile("s_mov_b32 %0, m0\n\ts_mov_b32 m0, %2\n\ts_nop 0\n\tglobal_load_lds_dwordx4 %1, off\n\ts_mov_b32 m0, %0" : "=&s"(keep) : "v"(gsrc), "s"(lds_dst) : "memory"); }
__device__ __forceinline__ s16x4 vtr(const ALAS char* q) { return __builtin_bit_cast(s16x4, __builtin_amdgcn_ds_read_tr16_b64_v4i16((ALAS v4i16_t*)q)); }
}
__device__ __forceinline__ void ph_attn(const P& p, int l, unsigned char* ldsb) {
    using namespace att;
    const int lane = fresh_lane(), wid = p.wid, r32 = lane & 31, hi = lane >> 5;
    const bf16_t* Z = (const bf16_t*)(p.ws + WS_Z); bf16_t* Y = (bf16_t*)(p.ws + WS_Y);
    const float lam_init = l == 0 ? 0.2f : (0.8f - 0.6f * 0.7408182206817179f);
    const float* dl_ = p.in[I_DALAM] + l * 4 * 32; float s01 = 0.f, s23 = 0.f;
    for (int i = 0; i < 32; ++i) { s01 += dl_[i] * dl_[32 + i]; s23 += dl_[64 + i] * dl_[96 + i]; }
    const float lam = expf(s01) - expf(s23) + lam_init;
    const float* subg = p.in[I_DASUB] + l * 64;
    const int G = gridDim.x, bx = blockIdx.x, vcu = (G % 8 == 0) ? (bx % 8) * (G / 8) + bx / 8 : bx;
    const int nun = 256 + (l == 0 ? 32 : 0);
    ALAS char* L3 = (ALAS char*)ldsb; const unsigned lds0 = (unsigned)(size_t)L3;
    ALAS float* wsf = (ALAS float*)(L3 + L_WS) + wid * 64;
    ALAS float* stg = (ALAS float*)(L3 + L_OST + wid * OST_W);
    const ALAS char* kp0 = L3 + L_K + hi * 1024 + r32 * 16;
    const ALAS char* vp0 = L3 + L_V + ((lane >> 4) & 1) * 32 + (lane & 3) * 8 + (4 * hi + ((lane & 15) >> 2)) * 64;
    for (int u = vcu; u < nun; u += G) {
        int b, h, q0row, nt;
        if (u < 256) { b = u >> 5; h = (u >> 3) & 3; q0row = b * LB + TC + (u & 7) * 256; nt = LB / 64; } else { const int v = u - 256; b = v >> 2; h = v & 3; q0row = b * LB; nt = TC / 64; }
        const bf16_t* ksrc = Z + (size_t)(b * LB + lane) * NZ + ZB_K + h * 64 + wid * 8;
        const bf16_t* vsrc = Z + (size_t)(b * LB + 16 * (wid & 3) + (lane >> 2)) * NZ + ZB_V + h * 64 + (wid >> 2) * 32 + (lane & 3) * 8;
#define ATT_DMA(t, slot) do { att::glds16(ksrc + (size_t)(t) * 64 * NZ, (unsigned)__builtin_amdgcn_readfirstlane((int)(lds0 + L_K + (slot) * SLOTB + wid * 1024))); \
                              att::glds16(vsrc + (size_t)(t) * 64 * NZ, (unsigned)__builtin_amdgcn_readfirstlane((int)(lds0 + L_V + (slot) * SLOTB + wid * 1024))); } while (0)
        ATT_DMA(0, 0); ATT_DMA(1, 1);
        bf16x8 qr[4];
        { const bf16_t* qp = Z + (size_t)(q0row + wid * 32 + r32) * NZ + ZB_Q + h * 64 + hi * 8;
#pragma unroll
          for (int d0 = 0; d0 < 4; ++d0) qr[d0] = *(const bf16x8*)(qp + d0 * 16); }
        f32x16 o[2][2], negm[2]; float mrun[2] = {0.f, 0.f}, lsum[2] = {0.f, 0.f};
#pragma unroll
        for (int n = 0; n < 2; ++n) { negm[n] = f32x16{}; o[n][0] = f32x16{}; o[n][1] = f32x16{}; }
        asm volatile("s_waitcnt vmcnt(0)" : "+v"(qr[0]), "+v"(qr[1]), "+v"(qr[2]), "+v"(qr[3]) :: "memory"); __syncthreads();
        bf16x8 pa[2][4]; f32x16 cc[2][2]; int t = 0;
#define ATT_WAITBAR() do { if (t + 2 < nt) asm volatile("s_waitcnt vmcnt(2)" ::: "memory"); else asm volatile("s_waitcnt vmcnt(0)" ::: "memory"); \
            __builtin_amdgcn_s_barrier(); asm volatile("" ::: "memory"); } while (0)
#define ATT_PV(tv) do { const int sv = ((tv) & 3) * SLOTB; \
            _Pragma("unroll") \
            for (int d0 = 0; d0 < 2; ++d0) { \
                bf16x8 vf[4]; \
                _Pragma("unroll") \
                for (int k = 0; k < 4; ++k) { const s16x4 lo = vtr(vp0 + sv + d0 * 4096 + k * 1024), hh = vtr(vp0 + sv + d0 * 4096 + k * 1024 + 512); \
                    vf[k] = (bf16x8){lo[0], lo[1], lo[2], lo[3], hh[0], hh[1], hh[2], hh[3]}; } \
                _Pragma("unroll") \
                for (int n = 0; n < 2; ++n) { \
                    _Pragma("unroll") \
                    for (int k = 0; k < 4; ++k) o[n][d0] = __builtin_amdgcn_mfma_f32_32x32x16_bf16(pa[n][k], vf[k], o[n][d0], 0, 0, 0); } \
            } } while (0)
#define ATT_QK() do { const int so = (t & 3) * SLOTB; \
            _Pragma("unroll") \
            for (int n = 0; n < 2; ++n) { \
                const bf16x8 k00 = *(const ALAS bf16x8*)(kp0 + so + (2 * n) * 2048), k01 = *(const ALAS bf16x8*)(kp0 + so + (2 * n) * 2048 + 512); \
                const bf16x8 k10 = *(const ALAS bf16x8*)(kp0 + so + (2 * n + 1) * 2048), k11 = *(const ALAS bf16x8*)(kp0 + so + (2 * n + 1) * 2048 + 512); \
                cc[n][0] = __builtin_amdgcn_mfma_f32_32x32x16_bf16(k00, qr[2 * n], negm[n], 0, 0, 0); \
                cc[n][1] = __builtin_amdgcn_mfma_f32_32x32x16_bf16(k01, qr[2 * n], negm[n], 0, 0, 0); \
                cc[n][0] = __builtin_amdgcn_mfma_f32_32x32x16_bf16(k10, qr[2 * n + 1], cc[n][0], 0, 0, 0); \
                cc[n][1] = __builtin_amdgcn_mfma_f32_32x32x16_bf16(k11, qr[2 * n + 1], cc[n][1], 0, 0, 0); \
            } } while (0)
#define ATT_Y(FIRST) do { \
            _Pragma("unroll") \
            for (int n = 0; n < 2; ++n) { \
                f32x16 c0 = cc[n][0], c1 = cc[n][1]; \
                asm volatile("s_nop 15\n\ts_nop 7" : "+v"(c0), "+v"(c1));      \
                float rm = max3f(c0[0], c1[0], c0[1]), rm2 = max3f(c1[1], c0[2], c1[2]); \
                _Pragma("unroll") \
                for (int r = 3; r < 15; r += 2) { rm = max3f(rm, c0[r], c1[r]); rm2 = max3f(rm2, c0[r + 1], c1[r + 1]); } \
                rm = max3f(rm, rm2, c0[15]); rm = max3f(rm, c1[15], c1[15]); \
                rm = swapmax(rm); \
                if (FIRST || __builtin_expect(__any(rm > THR), 0)) { \
                    const float dl = FIRST ? rm : fmaxf(rm, 0.f); mrun[n] += dl; \
                    _Pragma("unroll") \
                    for (int r = 0; r < 16; ++r) { c0[r] -= dl; c1[r] -= dl; negm[n][r] = -mrun[n]; } \
                    const float f = exp2f(-dl); lsum[n] *= f; \
                    if (hi == 0) wsf[n * 32 + r32] = f; \
                    _Pragma("unroll") \
                    for (int r = 0; r < 16; ++r) { const float ff = wsf[n * 32 + crow(r, hi)]; o[n][0][r] *= ff; o[n][1][r] *= ff; } \
                } \
                float sacc = 0.f; \
                _Pragma("unroll") \
                for (int r = 0; r < 16; ++r) { c0[r] = __builtin_amdgcn_exp2f(c0[r]); c1[r] = __builtin_amdgcn_exp2f(c1[r]); sacc += c0[r] + c1[r]; } \
                lsum[n] += sacc; \
                _Pragma("unroll") \
                for (int k = 0; k < 2; ++k) { \
                    uint4 q0 = make_uint4(cvtpk(c0[8 * k], c0[8 * k + 1]), cvtpk(c0[8 * k + 2], c0[8 * k + 3]), cvtpk(c0[8 * k + 4], c0[8 * k + 5]), cvtpk(c0[8 * k + 6], c0[8 * k + 7])); \
                    uint4 q1 = make_uint4(cvtpk(c1[8 * k], c1[8 * k + 1]), cvtpk(c1[8 * k + 2], c1[8 * k + 3]), cvtpk(c1[8 * k + 4], c1[8 * k + 5]), cvtpk(c1[8 * k + 6], c1[8 * k + 7])); \
                    pa[n][k] = __builtin_bit_cast(bf16x8, q0); pa[n][2 + k] = __builtin_bit_cast(bf16x8, q1); } \
            } } while (0)
        if (wid >= 4) { __builtin_amdgcn_s_barrier(); asm volatile("" ::: "memory"); }
        if (2 < nt) ATT_DMA(2, 2);
        ATT_QK(); ATT_WAITBAR();
        ATT_Y(true); ATT_WAITBAR();
        for (t = 1; t < nt; ++t) {
            if (t + 2 < nt) ATT_DMA(t + 2, (t + 2) & 3);
            ATT_PV(t - 1); ATT_QK(); ATT_WAITBAR();
            ATT_Y(false); ATT_WAITBAR();
        }
        ATT_PV(nt - 1);
        if (wid < 4) { __builtin_amdgcn_s_barrier(); asm volatile("" ::: "memory"); }
#undef ATT_WAITBAR
#undef ATT_PV
#undef ATT_QK
#undef ATT_Y
        { const float l1 = swapadd(lsum[0]), l2 = swapadd(lsum[1]);
          const int lane_e = fresh_lane(); const int r32 = lane_e & 31, hi = lane_e >> 5, lane = lane_e;
          ALAS float* wsf = (ALAS float*)(L3 + L_WS) + wid * 64; ALAS float* stg = (ALAS float*)(L3 + L_OST + wid * OST_W);
          if (hi == 0) { wsf[r32] = __builtin_amdgcn_rcpf(l1); wsf[32 + r32] = lam * __builtin_amdgcn_rcpf(l2); }
#pragma unroll
          for (int r = 0; r < 16; ++r) { const int q = crow(r, hi); const float a = wsf[q], bb = wsf[32 + q];
              stg[q * 66 + r32] = o[0][0][r] * a - o[1][0][r] * bb; stg[q * 66 + 32 + r32] = o[0][1][r] * a - o[1][1][r] * bb; }
          const int row = lane >> 1, half = lane & 1; float ov[32]; float ss = 0.f;
#pragma unroll
          for (int i = 0; i < 32; ++i) { ov[i] = stg[row * 66 + half * 32 + i]; ss += ov[i] * ov[i]; }
          ss += __shfl_xor(ss, 1);
          const float rs = rsqrtf(ss * (1.f / 64.f) + EPS) * (1.f - lam_init);
          bf16_t* yo = Y + (size_t)(q0row + wid * 32 + row) * D + 256 + h * 64 + half * 32;
#pragma unroll
          for (int i = 0; i < 4; ++i) { unsigned w[4];
#pragma unroll
              for (int k = 0; k < 4; ++k) w[k] = cvtpk(ov[8 * i + 2 * k] * rs * subg[half * 32 + 8 * i + 2 * k], ov[8 * i + 2 * k + 1] * rs * subg[half * 32 + 8 * i + 2 * k + 1]);
              *(uint4*)(yo + 8 * i) = make_uint4(w[0], w[1], w[2], w[3]); } }
        __syncthreads();
#undef ATT_DMA
    }
}


namespace hg {
typedef short bf16x8 __attribute__((ext_vector_type(8)));
typedef short s16x4 __attribute__((ext_vector_type(4)));
typedef float f32x16 __attribute__((ext_vector_type(16)));
typedef float f32x4v __attribute__((ext_vector_type(4)));
constexpr int QROW = 72;
constexpr int W_Q = 0, W_K = 4608, W_KH = 9216, W_V = 13312, W_BYTES = 17408;
constexpr int L_ST = 8 * W_BYTES;
constexpr int STROW = 68, L_BS = L_ST + 64 * STROW * 4;
constexpr int AGG_FLOATS = 64 * 64 + 64;
__device__ __forceinline__ int img_off(int s, int col) { return ((col >> 5) * 2 + (s >> 4)) * 1024 + (s & 15) * 64 + (col & 31) * 2; }
}
constexpr int LDS_MISC = hg::L_BS + 256;
constexpr int LDS_MISC_HGB = LDS_MISC + 2560;
template <int PASS>
__device__ __forceinline__ void ph_hg(const P& p, int l, unsigned char* ldsb) {
    using namespace hg;
    const int wid = p.wid;
    const bf16_t* Z = (const bf16_t*)(p.ws + WS_Z); bf16_t* Y = (bf16_t*)(p.ws + WS_Y); float* AGG = (float*)p.out;
    ALAS char* L3 = (ALAS char*)ldsb; ALAS char* LW = L3 + wid * W_BYTES;
    ALAS float* ST = (ALAS float*)(L3 + L_ST); ALAS float* BS = (ALAS float*)(L3 + L_BS);
    const float* gn = p.in[I_HGNG] + l * 256;
    const int nsc = (PASS == 2 && l == 1) ? 8 : 9;
    const int nunits = PASS == 1 ? NB * 4 * 9 * 2 : NB * 4 * nsc;
    for (int unit = ustart(PASS == 1 ? 160 : 192); unit < nunits; unit += gridDim.x) {
        const int uu = PASS == 1 ? unit >> 1 : unit; const int d_lo = PASS == 1 ? (unit & 1) : 0, d_hi = PASS == 1 ? (unit & 1) + 1 : 2;
        const int sc = (9 - nsc) + uu % nsc, bh = uu / nsc, h = bh & 3, b = bh >> 2;
        const int lane = fresh_lane();
        const int tid = wid * 64 + lane, r32 = lane & 31, hi = lane >> 5;
        const ALAS char* trb = LW + ((lane >> 4) & 1) * 32 + (lane & 3) * 8 + (4 * hi + ((lane & 15) >> 2)) * 64;
        float* OSG = (float*)p.out + (size_t)4 * 1024 * 1024 + (size_t)blockIdx.x * 16384;
#pragma unroll 1
        for (int d = d_lo; d < d_hi; ++d) {
            float lb = 0.f;
            if (l == 1) { const float* hl = p.in[I_HGLB] + (size_t)d * 2 * 256 + h * 64 + lane; lb = sigmoidf_(hl[256] - hl[0]); }
            const int fcol = (d == 0 ? ZD_FF : ZD_FB) + h * 64 + lane;
            const int jbase = b * LB + sc * 256;
            { const float* ag = AGG + (size_t)((b * 4 + h) * 2 + d) * 9 * AGG_FLOATS; const int dd = tid & 63;
              float sv[8];
#pragma unroll
              for (int i = 0; i < 8; ++i) sv[i] = 0.f;
              if (PASS == 2) {
#pragma unroll
                  for (int k = 0; k < 8; ++k) { const int ai = d == 0 ? k : (k == 0 ? 0 : 9 - k); const bool valid = d == 0 ? (k < sc) : (k == 0 ? (sc > 0) : (ai > sc)); const int ac = valid ? ai : 0;
                      const float dv = valid ? __expf(ag[(size_t)ac * AGG_FLOATS + 4096 + dd]) : 1.f;
#pragma unroll
                      for (int i = 0; i < 8; ++i) { const float s_ = ag[(size_t)ac * AGG_FLOATS + tid + 512 * i]; sv[i] = dv * sv[i] + (valid ? s_ : 0.f); } } }
#pragma unroll
              for (int i = 0; i < 8; ++i) { const int e = tid + 512 * i; ST[(e >> 6) * STROW + (e & 63)] = sv[i]; }
              if (tid < 64) BS[tid] = 0.f; }
            {   typedef unsigned u32x4s __attribute__((ext_vector_type(4)));
                const int tk = lane >> 3, c8 = (lane & 7) * 8;
                u32x4s rv[4], rf[4], rq[4];
#pragma unroll
                for (int g = 0; g < 4; ++g) { const int tau = 8 * g + tk; const int jl = d == 0 ? (32 * wid + tau) : (255 - 32 * wid - tau); const bf16_t* zr = Z + (size_t)(jbase + jl) * NZ + h * 64 + c8;
                    rv[g] = *(const u32x4s*)(zr + ZD_I); rf[g] = *(const u32x4s*)(zr + (d == 0 ? ZD_FF : ZD_FB)); if (PASS == 2) rq[g] = *(const u32x4s*)(zr + ZD_Q); }
#pragma unroll
                for (int g = 0; g < 4; ++g) { const int tau = 8 * g + tk;
                    *(ALAS u32x4s*)(LW + W_V + img_off(tau, c8)) = rv[g];
                    *(ALAS u32x4s*)(LW + W_K + (tau * QROW + c8) * 2) = rf[g];
                    if (PASS == 2) *(ALAS u32x4s*)(LW + W_Q + (tau * QROW + c8) * 2) = rq[g]; }
            }
            float gl[32]; float Btot = 0.f;
#pragma unroll
            for (int tau = 0; tau < 32; ++tau) { const float f = lb + (1.f - lb) * sigmoidf_(bf2f(*(const ALAS bf16_t*)(LW + W_K + (tau * QROW + lane) * 2))); gl[tau] = fmaxf(__logf(f), -80.f); Btot += gl[tau]; }
            { float run = 0.f;
#pragma unroll
              for (int tau = 0; tau < 32; ++tau) { run += gl[tau]; const float kk = 1.f - __expf(gl[tau]);
                *(ALAS bf16_t*)(LW + W_KH + img_off(tau, lane)) = f2bf(kk * __expf(Btot - run));
                if (PASS == 2) { ALAS bf16_t* qp = (ALAS bf16_t*)(LW + W_Q + (tau * QROW + lane) * 2); *qp = f2bf(bf2f(*qp) * 0.125f * __expf(run));
                                 *(ALAS bf16_t*)(LW + W_K + (tau * QROW + lane) * 2) = f2bf(kk * __expf(fminf(-run, 80.f))); } } }
            f32x16 sl[2][2];
#pragma unroll
            for (int cv = 0; cv < 2; ++cv)
#pragma unroll
                for (int cd = 0; cd < 2; ++cd) sl[cv][cd] = f32x16{};
            bf16x8 vfr[2][2];
#pragma unroll
            for (int ks = 0; ks < 2; ++ks)
#pragma unroll
                for (int ch = 0; ch < 2; ++ch) { const s16x4 lo = att::vtr(trb + W_V + (ch * 2 + ks) * 1024), hh = att::vtr(trb + W_V + (ch * 2 + ks) * 1024 + 512);
                    vfr[ks][ch] = (bf16x8){lo[0], lo[1], lo[2], lo[3], hh[0], hh[1], hh[2], hh[3]}; }
#pragma unroll
            for (int ks = 0; ks < 2; ++ks)
#pragma unroll
                for (int cd = 0; cd < 2; ++cd) { const s16x4 lo = att::vtr(trb + W_KH + (cd * 2 + ks) * 1024), hh = att::vtr(trb + W_KH + (cd * 2 + ks) * 1024 + 512);
                    const bf16x8 kf = (bf16x8){lo[0], lo[1], lo[2], lo[3], hh[0], hh[1], hh[2], hh[3]};
#pragma unroll
                    for (int cv = 0; cv < 2; ++cv) sl[cv][cd] = __builtin_amdgcn_mfma_f32_32x32x16_bf16(vfr[ks][cv], kf, sl[cv][cd], 0, 0, 0); }
            f32x16 o[2]; o[0] = f32x16{}; o[1] = f32x16{};
            bf16x8 qf[4];
            if (PASS == 2) {
                f32x16 c = f32x16{};
#pragma unroll
                for (int d0 = 0; d0 < 4; ++d0) { qf[d0] = *(const ALAS bf16x8*)(LW + W_Q + (r32 * QROW + 16 * d0 + 8 * hi) * 2);
                    const bf16x8 kf = *(const ALAS bf16x8*)(LW + W_K + (r32 * QROW + 16 * d0 + 8 * hi) * 2);
                    c = __builtin_amdgcn_mfma_f32_32x32x16_bf16(kf, qf[d0], c, 0, 0, 0); }
#pragma unroll
                for (int r = 0; r < 16; ++r) { const int srow = att::crow(r, hi); if (srow > r32) c[r] = 0.f; }
#pragma unroll
                for (int ks = 0; ks < 2; ++ks) { const uint4 q4 = make_uint4(att::cvtpk(c[8 * ks], c[8 * ks + 1]), att::cvtpk(c[8 * ks + 2], c[8 * ks + 3]), att::cvtpk(c[8 * ks + 4], c[8 * ks + 5]), att::cvtpk(c[8 * ks + 6], c[8 * ks + 7]));
                    const bf16x8 pa = __builtin_bit_cast(bf16x8, q4);
                    o[0] = __builtin_amdgcn_mfma_f32_32x32x16_bf16(pa, vfr[ks][0], o[0], 0, 0, 0); o[1] = __builtin_amdgcn_mfma_f32_32x32x16_bf16(pa, vfr[ks][1], o[1], 0, 0, 0); }
            }
            if constexpr (PASS == 1) {
            __syncthreads();
            ALAS float* SL = (ALAS float*)LW; ALAS float* BARR = (ALAS float*)(L3 + LDS_MISC_HGB); ALAS float* DARR = BARR + 8 * 64;
            float Bacc = Btot;
            int sbase = (4 * hi) * STROW + r32; asm volatile("" : "+v"(sbase));
#pragma unroll
            for (int cv = 0; cv < 2; ++cv)
#pragma unroll
                for (int cd = 0; cd < 2; ++cd)
#pragma unroll
                    for (int r = 0; r < 16; ++r) SL[sbase + (32 * cv + (r & 3) + 8 * (r >> 2)) * STROW + 32 * cd] = sl[cv][cd][r];
            BARR[wid * 64 + lane] = Bacc;
            __syncthreads();
            {
                float spA[16], spB[16]; float bp = 0.f, dkq[2] = {1.f, 1.f};
#define HG_RD(dst, cv_, cd_, sh_) do { if (wid >= (sh_)) { const ALAS float* PS_ = (const ALAS float*)(L3 + (wid - (sh_)) * W_BYTES); _Pragma("unroll") for (int r = 0; r < 16; ++r) \
                    dst[r] = PS_[sbase + (32 * (cv_) + (r & 3) + 8 * (r >> 2)) * STROW + 32 * (cd_)]; } } while (0)
#define HG_WR(src, cv_, cd_, sh_) do { if (wid >= (sh_)) { _Pragma("unroll") for (int r = 0; r < 16; ++r) { sl[cv_][cd_][r] = dkq[cd_] * src[r] + sl[cv_][cd_][r]; \
                    SL[sbase + (32 * (cv_) + (r & 3) + 8 * (r >> 2)) * STROW + 32 * (cd_)] = sl[cv_][cd_][r]; } } } while (0)
#define HG_STEP_BEGIN(sh_) do { if (wid >= (sh_)) { bp = BARR[(wid - (sh_)) * 64 + lane]; const float dk_ = __expf(Bacc); dkq[0] = __shfl(dk_, r32); dkq[1] = __shfl(dk_, 32 + r32); } } while (0)
#define HG_STEP_END(sh_) do { if (wid >= (sh_)) { Bacc += bp; BARR[wid * 64 + lane] = Bacc; } } while (0)
#define HG_STEP(sh_) do { HG_STEP_BEGIN(sh_); HG_RD(spA, 0, 0, sh_); __syncthreads(); \
                HG_WR(spA, 0, 0, sh_); HG_RD(spB, 0, 1, sh_); __syncthreads(); \
                HG_WR(spB, 0, 1, sh_); HG_RD(spA, 1, 0, sh_); __syncthreads(); \
                HG_WR(spA, 1, 0, sh_); HG_RD(spB, 1, 1, sh_); __syncthreads(); \
                HG_WR(spB, 1, 1, sh_); HG_STEP_END(sh_); __syncthreads(); } while (0)
                HG_STEP(1); HG_STEP(2); HG_STEP(4);
#undef HG_STEP
#undef HG_RD
#undef HG_WR
#undef HG_STEP_BEGIN
#undef HG_STEP_END
            }
            if (PASS == 1) {
                float* ag = AGG + ((size_t)((b * 4 + h) * 2 + d) * 9 + sc) * AGG_FLOATS; const ALAS float* S7 = (const ALAS float*)(L3 + 7 * W_BYTES);
                for (int e = tid; e < 4096; e += NT) ag[e] = S7[(e >> 6) * STROW + (e & 63)];
                if (tid < 64) ag[4096 + tid] = BARR[7 * 64 + tid];
                __syncthreads();
            }
            }
            if constexpr (PASS == 2) {
            __syncthreads();
#pragma unroll 1
            for (int step = 0; step < 8; ++step) {
                if (wid == step) {
                    if (PASS == 2) {
#pragma unroll
                        for (int cv = 0; cv < 2; ++cv)
#pragma unroll
                            for (int d0 = 0; d0 < 4; ++d0) { const ALAS float* sp = ST + (32 * cv + r32) * STROW + 16 * d0 + 8 * hi; const f32x4v s0 = *(const ALAS f32x4v*)sp, s1 = *(const ALAS f32x4v*)(sp + 4);
                                const uint4 q4 = make_uint4(att::cvtpk(s0[0], s0[1]), att::cvtpk(s0[2], s0[3]), att::cvtpk(s1[0], s1[1]), att::cvtpk(s1[2], s1[3]));
                                o[cv] = __builtin_amdgcn_mfma_f32_32x32x16_bf16(qf[d0], __builtin_bit_cast(bf16x8, q4), o[cv], 0, 0, 0); }
                    }
                    const float dk = __expf(Btot);
                    int sbase = (4 * hi) * STROW + r32; asm volatile("" : "+v"(sbase));
#pragma unroll
                    for (int cd = 0; cd < 2; ++cd) { const float dkd = __shfl(dk, 32 * cd + r32);
#pragma unroll
                        for (int cv = 0; cv < 2; ++cv)
#pragma unroll
                            for (int r = 0; r < 16; ++r) { ALAS float* sp = ST + sbase + (32 * cv + (r & 3) + 8 * (r >> 2)) * STROW + 32 * cd; *sp = dkd * *sp + sl[cv][cd][r]; } }
                    BS[lane] += Btot;
                }
                __syncthreads();
            }
                if (d == 0) {
                    int base = (32 * wid + 4 * hi) * 64 + r32; asm volatile("" : "+v"(base));
#pragma unroll
                    for (int r = 0; r < 16; ++r) { const int off = base + ((r & 3) + 8 * (r >> 2)) * 64; OSG[off] = o[0][r]; OSG[off + 32] = o[1][r]; }
                }
                else {
                    ALAS float* OS = (ALAS float*)L3;
                    int base = (255 - 32 * wid - 4 * hi) * 64 + r32; asm volatile("" : "+v"(base));
                    float g0[16], g1[16];
#pragma unroll
                    for (int r = 0; r < 16; ++r) { const int off = base - ((r & 3) + 8 * (r >> 2)) * 64; g0[r] = OSG[off]; g1[r] = OSG[off + 32]; }
#pragma unroll
                    for (int r = 0; r < 16; ++r) { const int off = base - ((r & 3) + 8 * (r >> 2)) * 64; OS[off] = o[0][r] + g0[r]; OS[off + 32] = o[1][r] + g1[r]; }
                    __syncthreads();
                    { int tl = 32 * wid + (lane >> 1); asm volatile("" : "+v"(tl)); const int half = lane & 1; float ov[32]; float ss = 0.f;
#pragma unroll
                      for (int i = 0; i < 32; ++i) { ov[i] = OS[tl * 64 + half * 32 + i]; ss += ov[i] * ov[i]; }
                      ss += __shfl_xor(ss, 1);
                      const float rs = rsqrtf(ss * (1.f / 64.f) + EPS);
                      const size_t row = (size_t)(jbase + tl); const bf16_t* zg = Z + row * NZ + ZD_G + h * 64 + half * 32; bf16_t* yo = Y + row * D + 768 + h * 64 + half * 32;
#pragma unroll
                      for (int i = 0; i < 4; ++i) { unsigned w4[4];
#pragma unroll
                          for (int k2 = 0; k2 < 4; ++k2) { const int c0 = 8 * i + 2 * k2; w4[k2] = att::cvtpk(ov[c0] * rs * gn[h * 64 + half * 32 + c0] * siluf_(bf2f(zg[c0])), ov[c0 + 1] * rs * gn[h * 64 + half * 32 + c0 + 1] * siluf_(bf2f(zg[c0 + 1]))); }
                          *(uint4*)(yo + 8 * i) = make_uint4(w4[0], w4[1], w4[2], w4[3]); } }
                    __syncthreads();
                }
            }
        }
    }
}

__device__ __forceinline__ void ph_router(const P& p, int l, unsigned char* ldsb, bool dry = false) {
    const int tidx = p.wid * 64 + fresh_lane();
    const float* X = (const float*)(p.ws + WS_X); bf16_t* H = (bf16_t*)(p.ws + WS_H); const float* xin = p.in[I_X]; const float* cin = p.in[I_CTX]; const bf16_t* D1 = (const bf16_t*)(p.ws + WS_D1);
#define RBASE(r_) (l == 0 ? xin_row(xin, cin, (r_)) : X + (size_t)(r_) * D)
    float2* GP = (float2*)(p.ws + WS_GP); int* LISTP = (int*)(p.ws + WS_LISTP); unsigned* CNT = (unsigned*)(p.ws + WS_CNT) + l * 32;
    const float* MOD = (const float*)(p.ws + WS_MOD) + (size_t)l * 9 * 6 * D; const float* g = p.in[I_N2G] + l * D;
    const float* RW = p.in[I_RW]; const float* RB = p.in[I_RB];
    ALAS int* lc = (ALAS int*)ldsb; ALAS int* lbase = lc + 32; ALAS int* rpair = lc + 64; ALAS int* rrank = lc + 64 + 72;
    const int lane = tidx & 63, wv = tidx >> 6;
    typedef float f32x4r __attribute__((ext_vector_type(4))); ALAS f32x4r* RWs = (ALAS f32x4r*)(ldsb - LDS_MISC);
    { f32x4r rwv[8];
#pragma unroll
      for (int u = 0; u < 8; ++u) { const int idx = tidx + u * NT; const int ln = idx & 63, e4 = (idx >> 6) & 3, i = (idx >> 8) & 3, q = idx >> 10; rwv[u] = *(const f32x4r*)(RW + (size_t)((ln + 64 * q) * 4 + i) * 16 + e4 * 4); }
#pragma unroll
      for (int u = 0; u < 8; ++u) RWs[tidx + u * NT] = rwv[u]; }
    __syncthreads();
    ALAS float* LG = (ALAS float*)(ldsb - LDS_MISC + 65536);
    float4 gq[4];
#pragma unroll
    for (int q = 0; q < 4; ++q) gq[q] = *(const float4*)(g + (lane + 64 * q) * 4);
    for (int chunk = blockIdx.x; chunk < R / 72; chunk += gridDim.x) {
        if (tidx < 32) lc[tidx] = 0;
        const int rbase = chunk * 72 + wv * 9;
        float4 vn[4]; uint2 dn[4];
#pragma unroll
        for (int q = 0; q < 4; ++q) { vn[q] = *(const float4*)(RBASE(rbase) + (lane + 64 * q) * 4); dn[q] = *(const uint2*)(D1 + (size_t)rbase * D + (lane + 64 * q) * 4); }
#pragma unroll 1
        for (int k = 0; k < 9; ++k) {
            const int li = wv * 9 + k, r = rbase + k;
            const float* m = MOD + (size_t)row_mi(r) * 6 * D; float4 scq[4], shq[4];
#pragma unroll
            for (int q = 0; q < 4; ++q) { scq[q] = *(const float4*)(m + 4 * D + (lane + 64 * q) * 4); shq[q] = *(const float4*)(m + 3 * D + (lane + 64 * q) * 4); }
            float4 v[4];
#pragma unroll
            for (int q = 0; q < 4; ++q) { float t4[4] = {vn[q].x, vn[q].y, vn[q].z, vn[q].w}; add_bf4(t4, dn[q]); v[q] = make_float4(t4[0], t4[1], t4[2], t4[3]); }
            { const int rn = rbase + (k < 8 ? k + 1 : 8);
#pragma unroll
              for (int q = 0; q < 4; ++q) { vn[q] = *(const float4*)(RBASE(rn) + (lane + 64 * q) * 4); dn[q] = *(const uint2*)(D1 + (size_t)rn * D + (lane + 64 * q) * 4); } }
            float ss = 0.f;
#pragma unroll
            for (int q = 0; q < 4; ++q) ss += v[q].x * v[q].x + v[q].y * v[q].y + v[q].z * v[q].z + v[q].w * v[q].w;
            const float rs = rsqrtf(wave_sum(ss) * (1.f / D) + EPS);
            float lg[16];
#pragma unroll
            for (int e = 0; e < 16; ++e) lg[e] = 0.f;
#pragma unroll
            for (int q = 0; q < 4; ++q) { const int c = (lane + 64 * q) * 4; const float xv[4] = {v[q].x, v[q].y, v[q].z, v[q].w};
                const float4 g4 = gq[q], sc4 = scq[q], sh4 = shq[q];
                const float gv[4] = {g4.x, g4.y, g4.z, g4.w}, scv[4] = {sc4.x, sc4.y, sc4.z, sc4.w}, shv[4] = {sh4.x, sh4.y, sh4.z, sh4.w}; bf16_t o[4];
#pragma unroll
                for (int i = 0; i < 4; ++i) { const float hv = xv[i] * rs * gv[i] * (1.f + scv[i]) + shv[i]; o[i] = f2bf(hv);
#pragma unroll
                    for (int e4 = 0; e4 < 4; ++e4) { const f32x4r w4 = RWs[((q * 4 + i) * 4 + e4) * 64 + lane]; lg[e4 * 4 + 0] += hv * w4[0]; lg[e4 * 4 + 1] += hv * w4[1]; lg[e4 * 4 + 2] += hv * w4[2]; lg[e4 * 4 + 3] += hv * w4[3]; } }
                *(uint2*)(H + (size_t)r * D + c) = make_uint2((unsigned)o[0] | ((unsigned)o[1] << 16), (unsigned)o[2] | ((unsigned)o[3] << 16));
                __builtin_amdgcn_sched_barrier(0); }
            float a8[8], a4[4], a2[2], a1;
            { const bool hb = (lane & 32) != 0;
#pragma unroll
              for (int i = 0; i < 8; ++i) { const float snd = hb ? lg[i] : lg[8 + i], kp = hb ? lg[8 + i] : lg[i]; a8[i] = kp + __shfl_xor(snd, 32); } }
            { const bool hb = (lane & 16) != 0;
#pragma unroll
              for (int i = 0; i < 4; ++i) { const float snd = hb ? a8[i] : a8[4 + i], kp = hb ? a8[4 + i] : a8[i]; a4[i] = kp + __shfl_xor(snd, 16); } }
            { const bool hb = (lane & 8) != 0;
#pragma unroll
              for (int i = 0; i < 2; ++i) { const float snd = hb ? a4[i] : a4[2 + i], kp = hb ? a4[2 + i] : a4[i]; a2[i] = kp + __shfl_xor(snd, 8); } }
            { const bool hb = (lane & 4) != 0; const float snd = hb ? a2[0] : a2[1], kp = hb ? a2[1] : a2[0]; a1 = kp + __shfl_xor(snd, 4); }
            a1 += __shfl_xor(a1, 2); a1 += __shfl_xor(a1, 1);
            if ((lane & 3) == 0) LG[li * 16 + (lane >> 2)] = a1 + RB[lane >> 2];
        }
        __syncthreads();
        if (tidx < 72) {
            const int r = chunk * 72 + tidx; float lg[16];
#pragma unroll
            for (int e = 0; e < 16; ++e) lg[e] = LG[tidx * 16 + e];
            float mx = lg[0];
#pragma unroll
            for (int e = 1; e < 16; ++e) mx = fmaxf(mx, lg[e]);
            float sc[16], sum = 0.f;
#pragma unroll
            for (int e = 0; e < 16; ++e) { sc[e] = expf(lg[e] - mx); sum += sc[e]; }
            const float inv = 1.f / sum;
#pragma unroll
            for (int e = 0; e < 16; ++e) sc[e] *= inv;
            int gsel = 0; float gbest = -1.f;
#pragma unroll
            for (int gI = 0; gI < 4; ++gI) { const float s0 = sc[gI * 4], s1 = sc[gI * 4 + 1], s2 = sc[gI * 4 + 2], s3 = sc[gI * 4 + 3];
                const float m1 = fmaxf(s0, s1), n1 = fminf(s0, s1), m2 = fmaxf(s2, s3), n2 = fminf(s2, s3);
                const float gs = fmaxf(m1, m2) + fmaxf(fminf(m1, m2), fmaxf(n1, n2)); const bool c = gs > gbest; gbest = c ? gs : gbest; gsel = c ? gI : gsel; }
            float s4[4];
#pragma unroll
            for (int i = 0; i < 4; ++i) s4[i] = gsel == 0 ? sc[i] : (gsel == 1 ? sc[4 + i] : (gsel == 2 ? sc[8 + i] : sc[12 + i]));
            float w1 = s4[0]; int i1 = 0;
#pragma unroll
            for (int i = 1; i < 4; ++i) { const bool c = s4[i] > w1; w1 = c ? s4[i] : w1; i1 = c ? i : i1; }
            float w2 = -1.f; int i2 = 0;
#pragma unroll
            for (int i = 0; i < 4; ++i) { const bool c = (i != i1) && (s4[i] > w2); w2 = c ? s4[i] : w2; i2 = c ? i : i2; }
            const float wn = 1.f / (w1 + w2);
            const int a = i1 < i2 ? i1 : i2, bq = i1 < i2 ? i2 : i1;
            const int q = a == 0 ? bq - 1 : (a == 1 ? bq + 1 : 5);
            const int pr = gsel * 6 + q; const bool skip = (l == 1 && (r % LB) < TC);
            GP[r] = i1 < i2 ? make_float2(w1 * wn, w2 * wn) : make_float2(w2 * wn, w1 * wn);
            rpair[tidx] = skip ? -1 : pr;
            if (!skip) rrank[tidx] = __hip_atomic_fetch_add(&lc[pr], 1, __ATOMIC_RELAXED, __HIP_MEMORY_SCOPE_WORKGROUP);
        }
        __syncthreads();
        if (tidx < 24) lbase[tidx] = (lc[tidx] && !dry) ? (int)atomicAdd(&CNT[tidx], (unsigned)lc[tidx]) : 0;
        __syncthreads();
        if (tidx < 72 && !dry) { const int pr = rpair[tidx]; if (pr >= 0) LISTP[(size_t)pr * R + lbase[pr] + rrank[tidx]] = chunk * 72 + tidx; }
        __syncthreads();
    }
}

__device__ __forceinline__ void ph_final(const P& p) {
    const int tidx = p.wid * 64 + fresh_lane();
    const float* X = (const float*)(p.ws + WS_X); const float* g = p.in[I_FNG]; const bf16_t* D1 = (const bf16_t*)(p.ws + WS_D1); const bf16_t* D2 = (const bf16_t*)(p.ws + WS_D2);
    const int lane = tidx & 63, wv = tidx >> 6;
    const int stride = gridDim.x * NWV; const int i0 = blockIdx.x * NWV + wv;
    float4 gq[4];
#pragma unroll
    for (int q = 0; q < 4; ++q) gq[q] = *(const float4*)(g + (lane + 64 * q) * 4);
#define FROW(i_) ((size_t)(((i_) / T) * LB + TC + ((i_) % T)))
    for (int ib = i0; ib < NB * T; ib += 8 * stride) {
        float4 vb[3][4]; uint2 d1b[3][4], d2b[3][4];
#define FN_LOAD(slot, k_) do { int ii_ = ib + (k_) * stride; ii_ = ii_ < NB * T ? ii_ : ib; const size_t rr_ = FROW(ii_); _Pragma("unroll") for (int q = 0; q < 4; ++q) { vb[slot][q] = *(const float4*)(X + rr_ * D + (lane + 64 * q) * 4); \
            d1b[slot][q] = *(const uint2*)(D1 + rr_ * D + (lane + 64 * q) * 4); d2b[slot][q] = *(const uint2*)(D2 + rr_ * D + (lane + 64 * q) * 4); } } while (0)
        FN_LOAD(0, 0); FN_LOAD(1, 1);
#pragma unroll
        for (int k = 0; k < 8; ++k) {
            const int it = ib + k * stride; const int sl = k % 3;
            if (k + 2 < 8) FN_LOAD((k + 2) % 3, k + 2);
            if (it < NB * T) {
                float xv[4][4]; float ss = 0.f;
#pragma unroll
                for (int q = 0; q < 4; ++q) { xv[q][0] = vb[sl][q].x; xv[q][1] = vb[sl][q].y; xv[q][2] = vb[sl][q].z; xv[q][3] = vb[sl][q].w; add_bf4(xv[q], d1b[sl][q]); add_bf4(xv[q], d2b[sl][q]); }
#pragma unroll
                for (int q = 0; q < 4; ++q) ss += xv[q][0] * xv[q][0] + xv[q][1] * xv[q][1] + xv[q][2] * xv[q][2] + xv[q][3] * xv[q][3];
                const float rs = rsqrtf(wave_sum(ss) * (1.f / D) + EPS);
#pragma unroll
                for (int q = 0; q < 4; ++q) { const int c = (lane + 64 * q) * 4; const float4 gg = gq[q];
                    *(float4*)(p.out + (size_t)it * D + c) = make_float4(xv[q][0] * rs * gg.x, xv[q][1] * rs * gg.y, xv[q][2] * rs * gg.z, xv[q][3] * rs * gg.w); }
            }
        }
#undef FN_LOAD
    }
#undef FROW
}

namespace pg8 {
#define PG8_LAS __attribute__((address_space(3)))
typedef short bf16x8 __attribute__((ext_vector_type(8)));
typedef float f32x4 __attribute__((ext_vector_type(4)));
typedef unsigned u32x4 __attribute__((ext_vector_type(4)));
constexpr int BM = 256, BK = 64, HALF = 128, HTB = HALF * BK * 2, STAGE_BYTES = 8 * HTB, NXCD = 8, WGM = 8;
__host__ __device__ __forceinline__ int lds_byte(int r, int c) { const int st = (r >> 4) * 2 + (c >> 5), rr = r & 15, cc = c & 31, ob = rr * 64 + cc * 2; return st * 1024 + (ob ^ (((ob >> 9) & 1) << 5)); }
__host__ __device__ __forceinline__ void stage_rc(int b, int& R, int& C) { const int st = b / 1024, sb = b % 1024, swz = sb ^ (((sb >> 9) & 1) << 5); R = (st >> 1) * 16 + swz / 64; C = (st & 1) * 32 + (swz % 64) / 2; }
__host__ __device__ __forceinline__ int perm32(int rho) { const int n = rho >> 4, i = rho & 15; return 8 * (i >> 2) + 4 * n + (i & 3); }
__device__ __forceinline__ unsigned cvt_pk_bf16(float lo, float hi) { unsigned r; asm volatile("v_cvt_pk_bf16_f32 %0, %1, %2" : "=v"(r) : "v"(lo), "v"(hi)); return r; }
struct Unit { int pm, pn, aux; };
__device__ __forceinline__ void static_unit(int L, int nM, int nN, int& pm, int& pn) {
    const int nwg = nM * nN; int wgid = L; { const int q = nwg / NXCD, r = nwg % NXCD, xcd = wgid % NXCD, off = wgid / NXCD; wgid = (xcd < r ? xcd * (q + 1) : r * (q + 1) + (xcd - r) * q) + off; }
    const int nig = WGM * nN, gid = wgid / nig, fm = gid * WGM, gsz = (nM - fm) < WGM ? (nM - fm) : WGM;
    pm = fm + ((wgid % nig) % gsz); pn = (wgid % nig) / gsz;
}
__device__ __forceinline__ bool static_next(int i, int G, int c, int nM, int nN, int& pm, int& pn) {
    const int nwg = nM * nN; const long L = (long)i * G + c; if (L >= nwg) return false;
    int wgid = (int)L; { const int q = nwg / NXCD, r = nwg % NXCD, xcd = wgid % NXCD, off = wgid / NXCD; wgid = (xcd < r ? xcd * (q + 1) : r * (q + 1) + (xcd - r) * q) + off; }
    const int nig = WGM * nN, gid = wgid / nig, fm = gid * WGM, gsz = (nM - fm) < WGM ? (nM - fm) : WGM;
    pm = fm + ((wgid % nig) % gsz); pn = (wgid % nig) / gsz; return true;
}
template <class PB, bool ALIGN_EPI, bool HN = false>
__device__ __forceinline__ void gemm_phase(PG8_LAS unsigned char* lds, const PB& S, const int wid) {
    const int lane = fresh_lane(), tid = wid * 64 + lane, wr = wid >> 2, wc = wid & 3, fr = lane & 15, fq = lane >> 4;
    const int nt = S.nt;
    int Rst[2], Cst[2]; unsigned voffB[2];
#pragma unroll
    for (int i = 0; i < 2; ++i) { int R_, C_; stage_rc(tid * 16 + i * 8192, R_, C_); Rst[i] = R_; Cst[i] = C_; const int Rb = PB::PERM ? ((R_ & ~31) + perm32(R_ & 31)) : R_; voffB[i] = (unsigned)(Rb * S.ldb + C_) * 2u; }
    const size_t kstep = (size_t)(BK * 2);
    const size_t hstepB = (size_t)HALF * S.ldb * 2;
    const unsigned ldsw = (unsigned)wid * 1024u;
    const int aoff = lds_byte(wr * 64 + fr, fq * 8), boff = lds_byte(wc * 32 + fr, fq * 8);
#define PG8_SA(b, h) (((b) * 2 + (h)) * HTB)
#define PG8_SB(b, h) ((4 + (b) * 2 + (h)) * HTB)
#define PG8_STAGE(bufoff, gbase, voff) do { _Pragma("unroll") for (int _i = 0; _i < 2; ++_i) { unsigned _o = (voff)[_i]; asm volatile("" : "+v"(_o)); \
        __builtin_amdgcn_global_load_lds((const unsigned*)((const char*)(gbase) + _o), (PG8_LAS unsigned*)(lds + (bufoff) + ldsw + _i * 8192), 16, 0, 0); } } while (0)
#define PG8_LDA(dst, b, h) do { _Pragma("unroll") for (int m = 0; m < 4; ++m) _Pragma("unroll") for (int k = 0; k < 2; ++k) dst[m][k] = *(const PG8_LAS bf16x8*)(lds + PG8_SA(b, h) + aoff + m * 2048 + k * 1024); } while (0)
#define PG8_LDB(dst, b, h) do { _Pragma("unroll") for (int n = 0; n < 2; ++n) _Pragma("unroll") for (int k = 0; k < 2; ++k) dst[n][k] = *(const PG8_LAS bf16x8*)(lds + PG8_SB(b, h) + boff + n * 2048 + k * 1024); } while (0)
#define PG8_MMA(ai, bj, At, Bt) do { __builtin_amdgcn_s_setprio(1); _Pragma("unroll") for (int m = 0; m < 4; ++m) _Pragma("unroll") for (int n = 0; n < 2; ++n) _Pragma("unroll") for (int k = 0; k < 2; ++k) \
        acc[ai][bj][m][n] = __builtin_amdgcn_mfma_f32_16x16x32_bf16(Bt[n][k], At[m][k], acc[ai][bj][m][n], 0, 0, 0); __builtin_amdgcn_s_setprio(0); } while (0)
#define PG8_WAIT_V(n) asm volatile("s_waitcnt vmcnt(" #n ")" ::: "memory")
#define PG8_WAIT_L(n) asm volatile("s_waitcnt lgkmcnt(" #n ")" ::: "memory")
#define PG8_BAR __builtin_amdgcn_s_barrier()
#define PG8_SCHED __builtin_amdgcn_sched_barrier(0)
    Unit cur, nxt; int ui = 0;
    if (!S.next(0, cur)) return;
    f32x4 acc[2][2][4][2];
#pragma unroll
    for (int a = 0; a < 2; ++a)
#pragma unroll
        for (int b = 0; b < 2; ++b)
#pragma unroll
            for (int m = 0; m < 4; ++m)
#pragma unroll
                for (int n = 0; n < 2; ++n) acc[a][b][m][n] = (f32x4){0.f, 0.f, 0.f, 0.f};
    bf16x8 At[4][2], B0[2][2], B1[2][2];
    unsigned vc[2][2], vn[2][2];
    S.a_off(cur, Rst, Cst, vc); asm volatile("" : "+v"(vc[0][0]), "+v"(vc[0][1]), "+v"(vc[1][0]), "+v"(vc[1][1]));
    const char* gA = S.A;
    { const char* cB = S.b_ptr(cur, 0); const char* cB1 = S.b_ptr(cur, 1);
      if constexpr (HN) {
      PG8_STAGE(PG8_SB(0, 0), cB, voffB); PG8_STAGE(PG8_SA(0, 0), gA, vc[0]); PG8_STAGE(PG8_SA(0, 1), gA, vc[1]);
      if (wr == 1) PG8_BAR;
      PG8_WAIT_V(2); PG8_BAR;
      PG8_STAGE(PG8_SB(1, 0), cB1, voffB); PG8_STAGE(PG8_SA(1, 0), gA + kstep, vc[0]);
      PG8_WAIT_V(4); PG8_BAR;
      } else {
      PG8_STAGE(PG8_SB(0, 0), cB, voffB); PG8_STAGE(PG8_SB(0, 1), cB + hstepB, voffB); PG8_STAGE(PG8_SA(0, 0), gA, vc[0]); PG8_STAGE(PG8_SA(0, 1), gA, vc[1]);
      if (wr == 1) PG8_BAR;
      PG8_WAIT_V(2); PG8_BAR;
      PG8_STAGE(PG8_SB(1, 0), cB1, voffB); PG8_STAGE(PG8_SA(1, 0), gA + kstep, vc[0]); PG8_STAGE(PG8_SB(1, 1), cB1 + hstepB, voffB);
      PG8_WAIT_V(6); PG8_BAR; } }
    for (;;) {
        const bool has_next = S.next(ui + 1, nxt);
        if (has_next) { S.a_off(nxt, Rst, Cst, vn); asm volatile("" : "+v"(vn[0][0]), "+v"(vn[0][1]), "+v"(vn[1][0]), "+v"(vn[1][1])); }
        else { vn[0][0] = vc[0][0]; vn[0][1] = vc[0][1]; vn[1][0] = vc[1][0]; vn[1][1] = vc[1][1]; nxt = cur; }
        for (int t = 0; t < nt; t += 2) {
            const bool last = (t == nt - 2);
            const char* a1 = gA + (size_t)(t + 1) * kstep;
            const char* a2 = last ? gA : gA + (size_t)(t + 2) * kstep; const char* a3 = a2 + kstep;
            const char* b2 = last ? S.b_ptr(nxt, 0) : S.b_ptr(cur, t + 2);
            const char* b3 = last ? S.b_ptr(nxt, 1) : S.b_ptr(cur, t + 3);
            unsigned o2a[2], o2b[2];
            o2a[0] = last ? vn[0][0] : vc[0][0]; o2a[1] = last ? vn[0][1] : vc[0][1]; o2b[0] = last ? vn[1][0] : vc[1][0]; o2b[1] = last ? vn[1][1] : vc[1][1];
            if constexpr (HN) {
            PG8_LDB(B0, 0, 0); PG8_SCHED; PG8_LDA(At, 0, 0); PG8_STAGE(PG8_SA(1, 1), a1, vc[1]);
            PG8_WAIT_V(6); PG8_WAIT_L(0); PG8_BAR; PG8_MMA(0, 0, At, B0); PG8_BAR; PG8_SCHED;
            PG8_LDA(At, 0, 1); PG8_STAGE(PG8_SB(0, 0), b2, voffB); PG8_STAGE(PG8_SA(0, 0), a2, o2a);
            PG8_WAIT_V(6); PG8_WAIT_L(0); PG8_BAR; PG8_MMA(1, 0, At, B0); PG8_BAR; PG8_SCHED;
            PG8_LDB(B0, 1, 0); PG8_SCHED; PG8_LDA(At, 1, 0); PG8_STAGE(PG8_SA(0, 1), a2, o2b);
            PG8_WAIT_V(6); PG8_WAIT_L(0); PG8_BAR; PG8_MMA(0, 0, At, B0); PG8_BAR; PG8_SCHED;
            PG8_LDA(At, 1, 1); PG8_STAGE(PG8_SB(1, 0), b3, voffB); PG8_STAGE(PG8_SA(1, 0), a3, o2a);
            PG8_WAIT_V(6); PG8_WAIT_L(0); PG8_BAR; PG8_MMA(1, 0, At, B0); PG8_BAR; PG8_SCHED;
            } else {
            PG8_LDB(B0, 0, 0); PG8_LDB(B1, 0, 1); PG8_SCHED; PG8_LDA(At, 0, 0); PG8_STAGE(PG8_SA(1, 1), a1, vc[1]);
            PG8_WAIT_V(8); PG8_WAIT_L(0); PG8_BAR; PG8_MMA(0, 0, At, B0); PG8_MMA(0, 1, At, B1); PG8_BAR; PG8_SCHED;
            PG8_LDA(At, 0, 1); PG8_STAGE(PG8_SB(0, 0), b2, voffB); PG8_STAGE(PG8_SB(0, 1), b2 + hstepB, voffB); PG8_STAGE(PG8_SA(0, 0), a2, o2a);
            PG8_WAIT_V(8); PG8_WAIT_L(0); PG8_BAR; PG8_MMA(1, 0, At, B0); PG8_MMA(1, 1, At, B1); PG8_BAR; PG8_SCHED;
            PG8_LDB(B0, 1, 0); PG8_LDB(B1, 1, 1); PG8_SCHED; PG8_LDA(At, 1, 0); PG8_STAGE(PG8_SA(0, 1), a2, o2b);
            PG8_WAIT_V(8); PG8_WAIT_L(0); PG8_BAR; PG8_MMA(0, 0, At, B0); PG8_MMA(0, 1, At, B1); PG8_BAR; PG8_SCHED;
            PG8_LDA(At, 1, 1); PG8_STAGE(PG8_SB(1, 0), b3, voffB); PG8_STAGE(PG8_SB(1, 1), b3 + hstepB, voffB); PG8_STAGE(PG8_SA(1, 0), a3, o2a);
            PG8_WAIT_V(8); PG8_WAIT_L(0); PG8_BAR; PG8_MMA(1, 0, At, B0); PG8_MMA(1, 1, At, B1); PG8_BAR; PG8_SCHED;
            }
        }
        if constexpr (ALIGN_EPI) { if (wr == 0) PG8_BAR; }
        S.epi(acc, cur, wr, wc, fr, fq);
        if (!has_next) break;
#pragma unroll
        for (int a = 0; a < 2; ++a)
#pragma unroll
            for (int b = 0; b < 2; ++b)
#pragma unroll
                for (int m = 0; m < 4; ++m)
#pragma unroll
                    for (int n = 0; n < 2; ++n) acc[a][b][m][n] = (f32x4){0.f, 0.f, 0.f, 0.f};
        cur = nxt; vc[0][0] = vn[0][0]; vc[0][1] = vn[0][1]; vc[1][0] = vn[1][0]; vc[1][1] = vn[1][1]; ++ui;
        if constexpr (ALIGN_EPI) { if (wr == 1) PG8_BAR; }
    }
    PG8_WAIT_V(0);
    if constexpr (!ALIGN_EPI) { if (wr == 0) PG8_BAR; }
    PG8_BAR;
#undef PG8_SA
#undef PG8_SB
#undef PG8_STAGE
#undef PG8_LDA
#undef PG8_LDB
#undef PG8_MMA
#undef PG8_WAIT_V
#undef PG8_WAIT_L
#undef PG8_BAR
#undef PG8_SCHED
}
}

struct PB_InProj {
    static constexpr bool PERM = true;
    const char* A; int ldb, nt; const char* Bt; bf16_t* Zo; int G, c;
    __device__ __forceinline__ bool next(int i, pg8::Unit& u) const { u.aux = 0; return pg8::static_next(i, G, c, R / 256, NZ / 256, u.pm, u.pn); }
    __device__ __forceinline__ void a_off(const pg8::Unit& u, const int (&Rs)[2], const int (&Cs)[2], unsigned (&off)[2][2]) const {
#pragma unroll
        for (int h = 0; h < 2; ++h)
#pragma unroll
            for (int i = 0; i < 2; ++i) off[h][i] = (unsigned)((u.pm * 256 + h * 128 + Rs[i]) * D + Cs[i]) * 2u; }
    __device__ __forceinline__ const char* b_ptr(const pg8::Unit& u, int t) const { return Bt + (size_t)u.pn * 256 * D * 2 + (size_t)t * 128; }
    __device__ __forceinline__ void epi(const pg8::f32x4 (&acc)[2][2][4][2], const pg8::Unit& u, int wr, int wc, int fr, int fq) const {
        const int row0 = u.pm * 256 + wr * 64 + fr, col0 = u.pn * 256 + wc * 32 + 8 * fq;
#pragma unroll
        for (int ai = 0; ai < 2; ++ai)
#pragma unroll
            for (int m = 0; m < 4; ++m) { bf16_t* rowp = Zo + (size_t)(row0 + ai * 128 + m * 16) * NZ + col0;
#pragma unroll
                for (int bj = 0; bj < 2; ++bj) { const pg8::f32x4 v0 = acc[ai][bj][m][0], v1 = acc[ai][bj][m][1]; pg8::u32x4 w;
                    w.x = pg8::cvt_pk_bf16(v0[0], v0[1]); w.y = pg8::cvt_pk_bf16(v0[2], v0[3]); w.z = pg8::cvt_pk_bf16(v1[0], v1[1]); w.w = pg8::cvt_pk_bf16(v1[2], v1[3]);
                    *(pg8::u32x4*)(rowp + bj * 128) = w; } }
    }
};


struct PB_OutProj {
    static constexpr bool PERM = true;
    const char* A; int ldb, nt; const char* Bt; bf16_t* D1; const float* MODl; int G, c, skipctx; bool dry;
    int tail;
    __device__ __forceinline__ bool next(int i, pg8::Unit& u) const { u.aux = 0; const int nM = skipctx ? 64 : 72, nwg = nM * 4, nfull = (nwg / G) * G, ntail = nwg - nfull; const bool split = ntail > 0 && 2 * ntail <= G;
        int L, half = 0;
        if (tail == 0) { L = i * G + c; if (L >= (split ? nfull : nwg)) return false; }
        else { if (!split || i != 0 || c >= 2 * ntail) return false; L = nfull + (c >> 1); half = c & 1; }
        int pm, pn; pg8::static_unit(L, nM, 4, pm, pn); u.pm = skipctx ? (pm >> 3) * 9 + 1 + (pm & 7) : pm; u.pn = tail ? 2 * pn + half : pn; return true; }
    __device__ __forceinline__ void a_off(const pg8::Unit& u, const int (&Rs)[2], const int (&Cs)[2], unsigned (&off)[2][2]) const {
#pragma unroll
        for (int h = 0; h < 2; ++h)
#pragma unroll
            for (int i = 0; i < 2; ++i) off[h][i] = (unsigned)((u.pm * 256 + h * 128 + Rs[i]) * D + Cs[i]) * 2u; }
    __device__ __forceinline__ const char* b_ptr(const pg8::Unit& u, int t) const { return Bt + (size_t)u.pn * (tail ? 128 : 256) * D * 2 + (size_t)t * 128; }
    __device__ __forceinline__ void epi(const pg8::f32x4 (&acc)[2][2][4][2], const pg8::Unit& u, int wr, int wc, int fr, int fq) const {
        const int row0 = u.pm * 256 + wr * 64 + fr, col0 = u.pn * (tail ? 128 : 256) + wc * 32 + 8 * fq; const int nbj = tail ? 1 : 2;
        const float* gt = MODl + (size_t)row_mi(u.pm * 256) * 6 * D + 2 * D + col0;
        pg8::f32x4 gv[2][2];
#pragma unroll
        for (int bj = 0; bj < 2; ++bj)
#pragma unroll
            for (int n = 0; n < 2; ++n) gv[bj][n] = bj < nbj ? *(const pg8::f32x4*)(gt + bj * 128 + 4 * n) : (pg8::f32x4){0.f, 0.f, 0.f, 0.f};
        if (dry) return;
#pragma unroll
        for (int ai = 0; ai < 2; ++ai)
#pragma unroll
            for (int m = 0; m < 4; ++m) { bf16_t* rowp = D1 + (size_t)(row0 + ai * 128 + m * 16) * D + col0;
#pragma unroll
                for (int bj = 0; bj < 2; ++bj) { if (bj >= nbj) break; const pg8::f32x4 v0 = acc[ai][bj][m][0] * gv[bj][0], v1 = acc[ai][bj][m][1] * gv[bj][1]; pg8::u32x4 w;
                    w.x = pg8::cvt_pk_bf16(v0[0], v0[1]); w.y = pg8::cvt_pk_bf16(v0[2], v0[3]); w.z = pg8::cvt_pk_bf16(v1[0], v1[1]); w.w = pg8::cvt_pk_bf16(v1[2], v1[3]);
                    *(pg8::u32x4*)(rowp + bj * 128) = w; } }
    }
};

__device__ __forceinline__ void moe_tiles_setup(const P& p, int l, ALAS int* tb) {
    const unsigned* CNT = (const unsigned*)(p.ws + WS_CNT) + l * 32;
    __syncthreads();
    if (p.wid == 0 && fresh_lane() == 0) { int acc = 0; for (int q = 0; q < 24; ++q) { const int c = (int)__hip_atomic_load(CNT + q, __ATOMIC_RELAXED, __HIP_MEMORY_SCOPE_AGENT); tb[q] = c; tb[32 + q] = acc; acc += (c + 255) >> 8; } tb[32 + 24] = acc; }
    __syncthreads();
}
__device__ __forceinline__ void pair_experts(int pr, int& e0, int& e1) { const int g4 = (pr / 6) * 4, q = pr % 6; const int a = q < 3 ? 0 : (q < 5 ? 1 : 2), b = q < 3 ? q + 1 : (q < 5 ? q - 1 : 3); e0 = g4 + a; e1 = g4 + b; }

struct PB_Moe1 {
    static constexpr bool PERM = false;
    const char* A; int ldb, nt; const char* W13; bf16_t* HE; const int* LISTP; const float2* GP; const ALAS int* tb; int G, c;
    __device__ __forceinline__ bool next(int i, pg8::Unit& u) const {
        if (!pg8::static_next(i, G, c, tb[32 + 24], 8, u.pm, u.pn)) return false;
        int pr = 0;
        for (int q = 1; q < 24; ++q) if (tb[32 + q] <= u.pm) pr = q;
        u.aux = pr; return true; }
    __device__ __forceinline__ void a_off(const pg8::Unit& u, const int (&Rs)[2], const int (&Cs)[2], unsigned (&off)[2][2]) const {
        const int pr = u.aux, cnt = tb[pr], r0 = (u.pm - tb[32 + pr]) * 256; const int* lp = LISTP + (size_t)pr * R;
#pragma unroll
        for (int h = 0; h < 2; ++h)
#pragma unroll
            for (int i = 0; i < 2; ++i) { int rk = r0 + h * 128 + Rs[i]; rk = rk < cnt ? rk : cnt - 1; off[h][i] = (unsigned)(lp[rk] * D + Cs[i]) * 2u; } }
    __device__ __forceinline__ const char* b_ptr(const pg8::Unit& u, int t) const { int e0, e1; pair_experts(u.aux, e0, e1); const int e = u.pn < 4 ? e0 : e1;
        return W13 + ((size_t)e * 1024 + (size_t)(u.pn & 3) * 256) * D * 2 + (size_t)t * 128; }
    __device__ __forceinline__ void epi(const pg8::f32x4 (&acc)[2][2][4][2], const pg8::Unit& u, int wr, int wc, int fr, int fq) const {
        const int pr = u.aux, cnt = tb[pr], r0 = (u.pm - tb[32 + pr]) * 256; const int* lp = LISTP + (size_t)pr * R;
        const int colh = (u.pn < 4 ? 0 : 512) + (u.pn & 3) * 128 + wc * 16 + 4 * fq;
#pragma unroll
        for (int ai = 0; ai < 2; ++ai)
#pragma unroll
            for (int m = 0; m < 4; ++m) { const int x = ai * 128 + wr * 64 + m * 16 + fr; int rk = r0 + x; rk = rk < cnt ? rk : cnt - 1;
                const float2 gg = GP[lp[rk]]; const float gate = u.pn < 4 ? gg.x : gg.y;
                bf16_t* rowp = HE + (size_t)(u.pm * 256 + x) * 1024 + colh;
#pragma unroll
                for (int bj = 0; bj < 2; ++bj) { const pg8::f32x4 a = acc[ai][bj][m][0], b = acc[ai][bj][m][1]; float o[4];
#pragma unroll
                    for (int j = 0; j < 4; ++j) o[j] = a[j] / (1.f + __expf(-a[j])) * b[j] * gate;
                    *(uint2*)(rowp + bj * 64) = make_uint2(pg8::cvt_pk_bf16(o[0], o[1]), pg8::cvt_pk_bf16(o[2], o[3])); } }
    }
};
struct PB_Moe2 {
    static constexpr bool PERM = true;
    const char* A; int ldb, nt; const char* W2; bf16_t* D2; const float* MODl; const int* LISTP; const ALAS int* tb; int G, c; bool dry;
    int tail;
    __device__ __forceinline__ bool next(int i, pg8::Unit& u) const {
        const int nMt = tb[32 + 24], nwg = nMt * 4, nfull = (nwg / G) * G, ntail = nwg - nfull; const bool split = 2 * ntail <= G;
        int L, half = 0;
        if (tail == 0) { L = i * G + c; if (L >= (split ? nfull : nwg)) return false; }
        else { if (!split || i != 0 || c >= 2 * ntail) return false; L = nfull + (c >> 1); half = c & 1; }
        int pn; pg8::static_unit(L, nMt, 4, u.pm, pn); u.pn = tail ? 2 * pn + half : pn;
        int pr = 0;
        for (int q = 1; q < 24; ++q) if (tb[32 + q] <= u.pm) pr = q;
        u.aux = pr; return true; }
    __device__ __forceinline__ void a_off(const pg8::Unit& u, const int (&Rs)[2], const int (&Cs)[2], unsigned (&off)[2][2]) const {
#pragma unroll
        for (int h = 0; h < 2; ++h)
#pragma unroll
            for (int i = 0; i < 2; ++i) off[h][i] = (unsigned)((u.pm * 256 + h * 128 + Rs[i]) * 1024 + Cs[i]) * 2u; }
    __device__ __forceinline__ const char* b_ptr(const pg8::Unit& u, int t) const { int e0, e1; pair_experts(u.aux, e0, e1); const int e = t < 8 ? e0 : e1;
        return W2 + ((size_t)e * 1024 + (size_t)u.pn * (tail ? 128 : 256)) * DE * 2 + (size_t)(t & 7) * 128; }
    __device__ __forceinline__ void epi(const pg8::f32x4 (&acc)[2][2][4][2], const pg8::Unit& u, int wr, int wc, int fr, int fq) const {
        const int pr = u.aux, cnt = tb[pr], r0 = (u.pm - tb[32 + pr]) * 256; const int* lp = LISTP + (size_t)pr * R;
        const int col0 = u.pn * (tail ? 128 : 256) + wc * 32 + 8 * fq; const int nbj = tail ? 1 : 2;
        if (dry) return;
        int tok[2][4];
#pragma unroll
        for (int ai = 0; ai < 2; ++ai)
#pragma unroll
            for (int m = 0; m < 4; ++m) { const int rk = r0 + ai * 128 + wr * 64 + m * 16 + fr; tok[ai][m] = rk < cnt ? lp[rk] : -1; }
#pragma unroll
        for (int ai = 0; ai < 2; ++ai)
#pragma unroll
            for (int m = 0; m < 4; ++m) { const int tk = tok[ai][m];
                if (tk >= 0) { bf16_t* rowp = D2 + (size_t)tk * D + col0; const float* gt = MODl + (size_t)row_mi(tk) * 6 * D + 5 * D + col0;
#pragma unroll
                    for (int bj = 0; bj < 2; ++bj) { if (bj >= nbj) break; const pg8::f32x4 v0 = acc[ai][bj][m][0] * *(const pg8::f32x4*)(gt + bj * 128), v1 = acc[ai][bj][m][1] * *(const pg8::f32x4*)(gt + bj * 128 + 4); pg8::u32x4 w;
                        w.x = pg8::cvt_pk_bf16(v0[0], v0[1]); w.y = pg8::cvt_pk_bf16(v0[2], v0[3]); w.z = pg8::cvt_pk_bf16(v1[0], v1[1]); w.w = pg8::cvt_pk_bf16(v1[2], v1[3]);
                        *(pg8::u32x4*)(rowp + bj * 128) = w; } } }
    }
};

template <int MAP  >
__device__ __forceinline__ void transpose_item(const float* W, int K, int N, bf16_t* WT, PG8_LAS float* scr, int item, int lane) {
    const int nblk = N / 32, kb = item / nblk, nb = item % nblk, k0 = 64 * kb, n0 = 32 * nb;
    float wv32[32];
#pragma unroll
    for (int i = 0; i < 32; ++i) { const int kk = 2 * i + (lane >> 5); wv32[i] = W[(size_t)(k0 + kk) * N + n0 + (lane & 31)]; }
#pragma unroll
    for (int i = 0; i < 32; ++i) { const int kk = 2 * i + (lane >> 5); scr[kk * 33 + (lane & 31)] = wv32[i]; }
    asm volatile("s_waitcnt lgkmcnt(0)" ::: "memory");
    const int c = lane & 7;
#pragma unroll
    for (int j = 0; j < 4; ++j) { const int n = (lane >> 3) + 8 * j; const PG8_LAS float* sp = scr + (8 * c) * 33 + n;
        uint4 o; o.x = pk2bf(sp[0 * 33], sp[1 * 33]); o.y = pk2bf(sp[2 * 33], sp[3 * 33]);
        o.z = pk2bf(sp[4 * 33], sp[5 * 33]); o.w = pk2bf(sp[6 * 33], sp[7 * 33]);
        const int ng = n0 + n; const int row = MAP == 0 ? ng : (32 * (ng >> 4) + (ng & 15) + (MAP == 2 ? 16 : 0));
        *(uint4*)(WT + (size_t)row * K + k0 + 8 * c) = o; }
    asm volatile("s_waitcnt lgkmcnt(0)" ::: "memory");
}
__device__ __forceinline__ void ph_prep_weights(const P& p, unsigned char* lds) {
    const int tidx = p.wid * 64 + fresh_lane();
    const int lane = tidx & 63, wv = tidx >> 6;
    PG8_LAS float* scr = (PG8_LAS float*)((PG8_LAS unsigned char*)lds + wv * 16384);
    const int gw = blockIdx.x * NWV + wv, NGW = gridDim.x * NWV;
    constexpr int I_IN = (D / 64) * (NZ / 32), I_OUT = (D / 64) * (D / 32);
    for (int it = gw; it < 2 * (I_IN + I_OUT); it += NGW) { const int l = it / (I_IN + I_OUT), r = it % (I_IN + I_OUT);
        if (r < I_IN) transpose_item<0>(p.in[I_WIN] + (size_t)l * D * NZ, D, NZ, (bf16_t*)(p.ws + WS_WIN) + (size_t)l * NZ * D, scr, r, lane);
        else transpose_item<0>(p.in[I_WOUT] + (size_t)l * D * D, D, D, (bf16_t*)(p.ws + WS_WOUT) + (size_t)l * D * D, scr, r - I_IN, lane); }
    { bf16_t* SGWo = (bf16_t*)(p.ws + WS_SGW); for (int it = blockIdx.x * NT + tidx; it < 2 * 4 * 128 * 128; it += gridDim.x * NT) SGWo[it] = f2bf(p.in[I_SGW][it]); }
    { bf16_t* WT = (bf16_t*)(p.ws + WS_LRUWT);
      for (int it = blockIdx.x * NT + tidx; it < 2 * 2 * 2 * 4 * 64 * 64; it += gridDim.x * NT) { const int i = it & 63, j = (it >> 6) & 63, hh = (it >> 12) & 3, gate = (it >> 14) & 1, ld = it >> 15;
          const float* src = (gate ? p.in[I_WI] : p.in[I_WR]) + (((size_t)ld * 4 + hh) * 64 + i) * 64 + j; WT[it] = f2bf(*src); } }
}
__device__ __forceinline__ void ph_prep_moe(const P& p, int l, unsigned char* lds, int half, int b0) {
    if ((int)blockIdx.x < b0) return;
    const int tidx = p.wid * 64 + fresh_lane();
    const int lane = tidx & 63, wv = tidx >> 6;
    PG8_LAS float* scr = (PG8_LAS float*)((PG8_LAS unsigned char*)lds + wv * 16384);
    const int gw = ((int)blockIdx.x - b0) * NWV + wv, NGW = ((int)gridDim.x - b0) * NWV;
    constexpr int I_13 = (D / 64) * (DE / 32), I_2 = (DE / 64) * (D / 32), PER_E = 2 * I_13 + I_2;
    for (int it = gw + half * (NE / 2) * PER_E; it < (half + 1) * (NE / 2) * PER_E; it += NGW) { const int e = it / PER_E, r = it % PER_E;
        bf16_t* w13 = (bf16_t*)(p.ws + WS_W13) + (size_t)e * 1024 * D; bf16_t* w2 = (bf16_t*)(p.ws + WS_W2) + (size_t)e * D * DE;
        if (r < I_13) transpose_item<1>(p.in[I_W1] + ((size_t)l * NE + e) * D * DE, D, DE, w13, scr, r, lane);
        else if (r < 2 * I_13) transpose_item<2>(p.in[I_W3] + ((size_t)l * NE + e) * D * DE, D, DE, w13, scr, r - I_13, lane);
        else transpose_item<0>(p.in[I_W2] + ((size_t)l * NE + e) * DE * D, DE, D, w2, scr, r - 2 * I_13, lane); }
}

#define XB_TMO      128
#define XB_XCNT(j)  (256  + 64 * (j))
#define XB_XSUB(j)  (1280 + 64 * (j))
#define XB_XGEN(j)  (2304 + 64 * (j))
#define XB_TOP      3328
#define XB_TOPGEN   3392
#define XCD_BAR_WORDS 3456
#define XB_SPIN_CAP (1u << 18)
__device__ __forceinline__ unsigned xb_ld(unsigned* q) { return __hip_atomic_load(q, __ATOMIC_RELAXED, __HIP_MEMORY_SCOPE_AGENT); }
__device__ __forceinline__ unsigned xb_add(unsigned* q, unsigned v) { return __hip_atomic_fetch_add(q, v, __ATOMIC_RELAXED, __HIP_MEMORY_SCOPE_AGENT); }
__device__ __forceinline__ unsigned xb_xcc_id() { return (unsigned)__builtin_amdgcn_s_getreg((3 << 11) | 20) & 0xFu; }
#define XB_SPIN(cond, bar) do { unsigned _sp = 0; while (cond) { __builtin_amdgcn_s_sleep(1); \
    if ((++_sp & 255u) == 0u) { if (xb_ld(&(bar)[XB_TMO])) break; if (_sp > XB_SPIN_CAP) { atomicAdd(&(bar)[XB_TMO], 1u); break; } } } } while (0)
struct XcdBarrier { unsigned* bar; unsigned x; volatile ALAS unsigned* st; int wid; };
__device__ __forceinline__ XcdBarrier xcd_barrier_post(unsigned* bar, volatile ALAS unsigned* st, int wid) {
    XcdBarrier b; b.bar = bar; b.x = xb_xcc_id(); b.st = st; b.wid = wid;
    if (wid == 0 && fresh_lane() == 0) (void)xb_add(&bar[XB_XCNT(b.x)], 1u);
    return b;
}
__device__ __forceinline__ void xcd_barrier_complete(unsigned* bar, unsigned x, unsigned& nloc, unsigned& nx) {
    const unsigned G = gridDim.x * gridDim.y * gridDim.z;
    unsigned sum, cnt, mine, sp = 0u;
    for (;;) {
        sum = 0u; cnt = 0u; mine = 0u;
#pragma unroll
        for (unsigned j = 0; j < 16; ++j) { const unsigned c = xb_ld(&bar[XB_XCNT(j)]); sum += c; cnt += (c > 0u) ? 1u : 0u; mine = (j == x) ? c : mine; }
        if (sum == G) break;
        __builtin_amdgcn_s_sleep(1);
        if ((++sp & 255u) == 0u) { if (xb_ld(&bar[XB_TMO])) break; if (sp > XB_SPIN_CAP) { atomicAdd(&bar[XB_TMO], 1u); break; } }
    }
    nloc = mine > 0u ? mine : 1u; nx = cnt > 0u ? cnt : 1u;
}
__device__ __forceinline__ void xcd_barrier(const XcdBarrier& b) {
    asm volatile("s_waitcnt vmcnt(0)" ::: "memory");
    __syncthreads();
    if (b.wid == 0 && fresh_lane() == 0) {
        unsigned* bar = b.bar; asm volatile("" : "+s"(bar));
        __builtin_amdgcn_s_waitcnt(0);
        unsigned nloc = b.st[0], nx = b.st[1];
        if (nloc == 0u) { xcd_barrier_complete(bar, b.x, nloc, nx); b.st[0] = nloc; b.st[1] = nx; }
        const unsigned old = xb_add(&bar[XB_XSUB(b.x)], 1u);
        const unsigned gen = old / nloc;
        if (old + 1u == (gen + 1u) * nloc) {
            __builtin_amdgcn_fence(__ATOMIC_RELEASE, "agent");
            asm volatile("s_waitcnt vmcnt(0)" ::: "memory");
            const unsigned og = xb_add(&bar[XB_TOP], 1u);
            const unsigned tg = og / nx;
            if (og + 1u == (tg + 1u) * nx) xb_add(&bar[XB_TOPGEN], 1u);
            else XB_SPIN(xb_ld(&bar[XB_TOPGEN]) == tg, bar);
            __builtin_amdgcn_fence(__ATOMIC_ACQUIRE, "agent");
            xb_add(&bar[XB_XGEN(b.x)], 1u);
            asm volatile("s_waitcnt vmcnt(0)" ::: "memory");
        } else {
            XB_SPIN(xb_ld(&bar[XB_XGEN(b.x)]) == gen, bar);
            __builtin_amdgcn_fence(__ATOMIC_ACQUIRE, "agent");
            asm volatile("s_waitcnt vmcnt(0)" ::: "memory");
        }
    }
    __syncthreads();
}

constexpr int LDS_BYTES = 163840;
typedef const __attribute__((address_space(4))) P* kargp_t;
#define GETP() P p; { kargp_t kq_ = kp; int w_ = wid; asm volatile("" : "+s"(kq_), "+s"(w_)); p = *(const P*)kq_; p.wid = w_; }
__global__ void __launch_bounds__(NT, 2) fwd_kernel(P p_in) {
    const int wid = __builtin_amdgcn_readfirstlane((int)(threadIdx.x >> 6));
    kargp_t kp = (kargp_t)__builtin_amdgcn_kernarg_segment_ptr();
    extern __shared__ __attribute__((aligned(16))) unsigned char lds[];
    float* sm = (float*)lds;
    { volatile ALAS unsigned* stw = (volatile ALAS unsigned*)((ALAS unsigned char*)lds + LDS_MISC + 2048); if (threadIdx.x < 2) stw[threadIdx.x] = 0u; }
    __syncthreads();
    { GETP(); (void)xcd_barrier_post((unsigned*)(p.ws + WS_CNT + 1024), (volatile ALAS unsigned*)((ALAS unsigned char*)lds + LDS_MISC + 2048), wid); }
#define GBAR() do { GETP(); XcdBarrier gb_; gb_.bar = (unsigned*)(p.ws + WS_CNT + 1024); gb_.x = xb_xcc_id(); gb_.st = (volatile ALAS unsigned*)((ALAS unsigned char*)lds + LDS_MISC + 2048); gb_.wid = wid; xcd_barrier(gb_); } while (0)

    { GETP(); ph_mod(p, sm); }
    { GETP(); ph_rope_table(p); }
    { GETP(); ph_prep_weights(p, lds); }
    GBAR();
#pragma unroll 1
    for (int l = 0; l < 2; ++l) {

        { GETP(); ph_norm1(p, l); }
        if (l == 1) { GETP(); ph_prep_moe(p, l, lds, 1, 0); }
        GBAR();
        { GETP(); PB_InProj pb; pb.A = (const char*)(p.ws + WS_H); pb.ldb = D; pb.nt = D / 64; pb.Bt = (const char*)(p.ws + WS_WIN) + (size_t)l * NZ * D * 2; pb.Zo = (bf16_t*)(p.ws + WS_Z); pb.G = gridDim.x; pb.c = blockIdx.x;
          pg8::gemm_phase<PB_InProj, true>((PG8_LAS unsigned char*)lds, pb, wid); }
        { GETP(); ph_prep_moe(p, l, lds, 0, 96); }
        GBAR();
        { GETP(); ph_rope(p, l); }
        { GETP(); ph_sg(p, l, lds); }
        { GETP(); ph_lru_m1(p, l, lds); }
        { GETP(); ph_hg<1>(p, l, lds); }
        GBAR();
        { GETP(); ph_attn(p, l, lds); }
        { GETP(); ph_lru_m2(p, l, lds); }
        { GETP(); ph_hg<2>(p, l, lds); }
        GBAR();
        { GETP(); PB_OutProj pb; pb.A = (const char*)(p.ws + WS_Y); pb.ldb = D; pb.nt = D / 64; pb.Bt = (const char*)(p.ws + WS_WOUT) + (size_t)l * D * D * 2; pb.D1 = (bf16_t*)(p.ws + WS_D1);
          pb.MODl = (const float*)(p.ws + WS_MOD) + (size_t)l * 9 * 6 * D; pb.G = gridDim.x; pb.c = blockIdx.x; pb.skipctx = (l == 1); pb.dry = false;
          pb.tail = 0; pg8::gemm_phase<PB_OutProj, true>((PG8_LAS unsigned char*)lds, pb, wid);
          pb.tail = 1; pg8::gemm_phase<PB_OutProj, true, true>((PG8_LAS unsigned char*)lds, pb, wid); }
        if (l == 0) { GETP(); ph_prep_moe(p, l, lds, 1, 64); }
        GBAR();
        { GETP(); ph_router(p, l, lds + LDS_MISC); }
        GBAR();
        { GETP(); ALAS int* tb = (ALAS int*)(lds + LDS_MISC + 1024); moe_tiles_setup(p, l, tb);
          PB_Moe1 pb; pb.A = (const char*)(p.ws + WS_H); pb.ldb = D; pb.nt = D / 64; pb.W13 = (const char*)(p.ws + WS_W13); pb.HE = (bf16_t*)(p.ws + WS_Z); pb.LISTP = (const int*)(p.ws + WS_LISTP);
          pb.GP = (const float2*)(p.ws + WS_GP); pb.tb = tb; pb.G = gridDim.x; pb.c = blockIdx.x;
          pg8::gemm_phase<PB_Moe1, true>((PG8_LAS unsigned char*)lds, pb, wid); }
        GBAR();
        { GETP(); ALAS int* tb = (ALAS int*)(lds + LDS_MISC + 1024);
          PB_Moe2 pb; pb.A = (const char*)(p.ws + WS_Z); pb.ldb = DE; pb.nt = 16; pb.W2 = (const char*)(p.ws + WS_W2); pb.D2 = (bf16_t*)(p.ws + WS_D2);
          pb.MODl = (const float*)(p.ws + WS_MOD) + (size_t)l * 9 * 6 * D; pb.LISTP = (const int*)(p.ws + WS_LISTP); pb.tb = tb; pb.G = gridDim.x; pb.c = blockIdx.x; pb.dry = false;
          pb.tail = 0; pg8::gemm_phase<PB_Moe2, true>((PG8_LAS unsigned char*)lds, pb, wid);
          pb.tail = 1; pg8::gemm_phase<PB_Moe2, true, true>((PG8_LAS unsigned char*)lds, pb, wid); }
        GBAR();
    }

    { GETP(); ph_final(p); }

}

extern "C" void kernel_launch(void* const* d_in, const int* in_sizes, int n_in, void* d_out, int out_size, void* d_ws, size_t ws_size, hipStream_t stream) {
    if (n_in != N_IN || ws_size < WS_END) { fprintf(stderr, "kernel_launch: bad n_in %d or ws %zu < %zu\n", n_in, ws_size, (size_t)WS_END); return; }
    P p{};
    for (int i = 0; i < N_IN; ++i) p.in[i] = (const float*)d_in[i];
    p.out = (float*)d_out; p.ws = (unsigned char*)d_ws;
    (void)hipMemsetAsync((char*)d_ws + WS_CNT, 0, 16384, stream);
    void* args[] = {&p};
    static bool attr_set = false;
    if (!attr_set) { (void)hipFuncSetAttribute((const void*)fwd_kernel, hipFuncAttributeMaxDynamicSharedMemorySize, LDS_BYTES); attr_set = true; }
    hipError_t e = hipLaunchCooperativeKernel((void*)fwd_kernel, dim3(256), dim3(NT), args, LDS_BYTES, stream);
    if (e != hipSuccess) fprintf(stderr, "cooperative launch failed: %s\n", hipGetErrorString(e));
}
```

```cpp
#include <hip/hip_runtime.h>
#include <cstdio>
#include <cstdint>

constexpr int D = 1024, NB = 8, T = 2048, TC = 256, LB = T + TC  , R = NB * LB  ;
constexpr int NZ = 3072, NE = 16, DE = 512;
constexpr float EPS = 1e-6f;
constexpr int ZA_X = 0, ZA_G = 256, ZB_Q = 512, ZB_K = 768, ZB_V = 1024, ZC_U = 1280, ZC_V = 1536, ZD_Q = 1792, ZD_FF = 2048, ZD_FB = 2304, ZD_I = 2560, ZD_G = 2816;
enum { I_X = 0, I_C, I_CTX, I_CCTX, I_WADA, I_BADA, I_N1G, I_N2G, I_WIN, I_WOUT, I_CONVW, I_CONVB, I_WR, I_BR, I_WI, I_BI, I_LAM,
       I_DALAM, I_DASUB, I_SGNG, I_SGW, I_SGB, I_HGLB, I_HGNG, I_RW, I_RB, I_W1, I_W3, I_W2, I_FNG, N_IN };

typedef unsigned short bf16_t;
#define ALAS __attribute__((address_space(3)))
constexpr size_t MiB = 1u << 20;
constexpr size_t WS_MOD = 0;
constexpr size_t WS_CNT = 512 * 1024;
constexpr size_t WS_GP = 1 * MiB;
constexpr size_t WS_LISTP = WS_GP + (size_t)R * 8;
constexpr size_t WS_LRUWT = 768 * 1024;
constexpr size_t WS_ROPE = 4 * MiB + 512 * 1024;
constexpr size_t WS_SGW = 5 * MiB;
constexpr size_t WS_LRUAGG = 3 * MiB;
constexpr size_t WS_X = 8 * MiB;
constexpr size_t WS_H = WS_X + (size_t)R * D * 4;
constexpr size_t WS_Z = WS_H + (size_t)R * D * 2;
constexpr size_t WS_D1 = WS_Z + 64 * MiB;
constexpr size_t WS_Y = WS_Z + (size_t)R * NZ * 2;
constexpr size_t WS_D2 = WS_Y;
constexpr size_t WS_WIN = WS_Y + (size_t)R * D * 2;
constexpr size_t WS_WOUT = WS_WIN + 2 * (size_t)NZ * D * 2;
constexpr size_t WS_W13 = WS_WOUT + 2 * (size_t)D * D * 2;
constexpr size_t WS_W2 = WS_W13 + (size_t)NE * 1024 * D * 2;
constexpr size_t WS_END = WS_W2 + (size_t)NE * D * DE * 2;
constexpr int MPAD = R + 24 * 256;

struct P { const float* in[N_IN]; float* out; unsigned char* ws; int wid; int pad; };
__device__ __forceinline__ int fresh_lane() { int l_; asm volatile("v_mbcnt_lo_u32_b32 %0, -1, 0\n\tv_mbcnt_hi_u32_b32 %0, -1, %0" : "=v"(l_)); return l_; }


__device__ __forceinline__ float bf2f(bf16_t v) { return __uint_as_float(((unsigned)v) << 16); }
typedef float f32x2h_t __attribute__((ext_vector_type(2))); typedef __bf16 bf16x2h_t __attribute__((ext_vector_type(2)));
__device__ __forceinline__ unsigned pk2bf(float lo, float hi) { f32x2h_t v = {lo, hi}; bf16x2h_t b = __builtin_convertvector(v, bf16x2h_t); return __builtin_bit_cast(unsigned, b); }
__device__ __forceinline__ bf16_t f2bf(float f) { return (bf16_t)(pk2bf(f, f) & 0xffffu); }
__device__ __forceinline__ float sigmoidf_(float x) { return __builtin_amdgcn_rcpf(1.f + __expf(-x)); }
__device__ __forceinline__ float siluf_(float x) { return x * __builtin_amdgcn_rcpf(1.f + __expf(-x)); }
__device__ __forceinline__ float geluf_(float x) { const float u = 1.5957691216057308f * (x + 0.044715f * x * x * x); return x * __builtin_amdgcn_rcpf(1.f + __expf(-u)); }
__device__ __forceinline__ float wave_sum(float v) {
#pragma unroll
    for (int o = 1; o < 64; o <<= 1) v += __shfl_xor(v, o);
    return v;
}
__device__ __forceinline__ int row_mi(int r) { const int b = r / LB, j = r - b * LB; return j < TC ? 8 : b; }

#define NT 512
__device__ __forceinline__ const float* xin_row(const float* xin, const float* cin, int r) { const int b = r / LB, j = r - b * LB; return j < TC ? cin + ((size_t)b * TC + j) * D : xin + ((size_t)b * T + (j - TC)) * D; }
__device__ __forceinline__ int ustart(int off) { const int G = gridDim.x, b = blockIdx.x; const int v = (G % 8 == 0) ? (b % 8) * (G / 8) + b / 8 : b; return (v + off) % G; }
#define NWV 8
__device__ __forceinline__ void add_bf4(float (&x)[4], uint2 d) { x[0] += __uint_as_float(d.x << 16); x[1] += __uint_as_float(d.x & 0xffff0000u); x[2] += __uint_as_float(d.y << 16); x[3] += __uint_as_float(d.y & 0xffff0000u); }

__device__ __forceinline__ void ph_mod(const P& p, float* sm_) {
    const int tidx = p.wid * 64 + fresh_lane();
    float* MOD = (float*)(p.ws + WS_MOD);
    ALAS float* sm = (ALAS float*)sm_; ALAS float* red = sm + 9 * D;
    for (int i = tidx; i < 9 * D; i += NT) { const int mi = i / D, k = i % D; const float c = mi < 8 ? p.in[I_C][mi * D + k] : p.in[I_CCTX][k]; sm[i] = siluf_(c); }
    __syncthreads();
    const int col = tidx & 63, part = tidx >> 6;
    for (int it = blockIdx.x; it < 2 * 96; it += gridDim.x) {
        const int l = it / 96, n0 = (it % 96) * 64;
        const float* W = p.in[I_WADA] + (size_t)l * D * 6 * D + (size_t)(part * 128) * 6 * D + n0 + col;
        float acc[9];
#pragma unroll
        for (int m = 0; m < 9; ++m) acc[m] = 0.f;
#pragma unroll 8
        for (int k = 0; k < 128; ++k) { const float w = W[(size_t)k * 6 * D];
#pragma unroll
            for (int m = 0; m < 9; ++m) acc[m] += sm[m * D + part * 128 + k] * w; }
#pragma unroll
        for (int m = 0; m < 9; ++m) red[(part * 9 + m) * 64 + col] = acc[m];
        __syncthreads();
        for (int o = tidx; o < 9 * 64; o += NT) { const int m = o >> 6, cc = o & 63; float v = p.in[I_BADA][l * 6 * D + n0 + cc];
#pragma unroll
            for (int q = 0; q < 8; ++q) v += red[(q * 9 + m) * 64 + cc];
            MOD[((size_t)l * 9 + m) * 6 * D + n0 + cc] = v; }
        __syncthreads();
    }
}

__device__ __forceinline__ void ph_norm1(const P& p, int l) {
    const int tidx = p.wid * 64 + fresh_lane();
    bf16_t* X = (bf16_t*)(p.ws + WS_X); bf16_t* H = (bf16_t*)(p.ws + WS_H); const float* xin = p.in[I_X]; const float* cin = p.in[I_CTX];
    const bf16_t* D1 = (const bf16_t*)(p.ws + WS_D1); const bf16_t* D2 = (const bf16_t*)(p.ws + WS_D2);
    const float* MOD = (const float*)(p.ws + WS_MOD) + (size_t)l * 9 * 6 * D; const float* g = p.in[I_N1G] + l * D;
    const int lane = tidx & 63, wv = tidx >> 6;
    const int stride = gridDim.x * NWV; const int r0 = blockIdx.x * NWV + wv;
    float4 gq[4];
#pragma unroll
    for (int q = 0; q < 4; ++q) gq[q] = *(const float4*)(g + (lane + 64 * q) * 4);
    for (int rb = r0; rb < R; rb += 9 * stride) {
        float4 vb[3][4]; uint2 d1b[3][4], d2b[3][4];
#define N1_LOAD(slot, k_) do { int rr_ = rb + (k_) * stride; rr_ = rr_ < R ? rr_ : rb; _Pragma("unroll") for (int q = 0; q < 4; ++q) { vb[slot][q] = *(const float4*)(xin_row(xin, cin, rr_) + (lane + 64 * q) * 4); \
            if (l == 1) { d1b[slot][q] = *(const uint2*)(D1 + (size_t)rr_ * D + (lane + 64 * q) * 4); d2b[slot][q] = *(const uint2*)(D2 + (size_t)rr_ * D + (lane + 64 * q) * 4); } } } while (0)
        N1_LOAD(0, 0); N1_LOAD(1, 1);
#pragma unroll
        for (int k = 0; k < 9; ++k) {
            const int r = rb + k * stride; const int sl = k % 3;
            const float* m = MOD + (size_t)row_mi(r < R ? r : rb) * 6 * D; float4 scq[4], shq[4];
#pragma unroll
            for (int q = 0; q < 4; ++q) { scq[q] = *(const float4*)(m + D + (lane + 64 * q) * 4); shq[q] = *(const float4*)(m + (lane + 64 * q) * 4); }
            if (k + 2 < 9) N1_LOAD((k + 2) % 3, k + 2);
            if (r < R) {
                float xv[4][4]; float ss = 0.f;
#pragma unroll
                for (int q = 0; q < 4; ++q) { xv[q][0] = vb[sl][q].x; xv[q][1] = vb[sl][q].y; xv[q][2] = vb[sl][q].z; xv[q][3] = vb[sl][q].w; if (l == 1) { add_bf4(xv[q], d1b[sl][q]); add_bf4(xv[q], d2b[sl][q]); } }
#pragma unroll
                for (int q = 0; q < 4; ++q) ss += xv[q][0] * xv[q][0] + xv[q][1] * xv[q][1] + xv[q][2] * xv[q][2] + xv[q][3] * xv[q][3];
                const float rs = rsqrtf(wave_sum(ss) * (1.f / D) + EPS);
#pragma unroll
                for (int q = 0; q < 4; ++q) { const int c = (lane + 64 * q) * 4; bf16_t o[4];
                    if (l == 1) { const bf16_t x0 = f2bf(xv[q][0]), x1 = f2bf(xv[q][1]), x2 = f2bf(xv[q][2]), x3 = f2bf(xv[q][3]); *(uint2*)(X + (size_t)r * D + c) = make_uint2((unsigned)x0 | ((unsigned)x1 << 16), (unsigned)x2 | ((unsigned)x3 << 16)); }
                    const float4 g4 = gq[q], sc4 = scq[q], sh4 = shq[q];
                    const float gv[4] = {g4.x, g4.y, g4.z, g4.w}, scv[4] = {sc4.x, sc4.y, sc4.z, sc4.w}, shv[4] = {sh4.x, sh4.y, sh4.z, sh4.w};
#pragma unroll
                    for (int i = 0; i < 4; ++i) o[i] = f2bf(xv[q][i] * rs * gv[i] * (1.f + scv[i]) + shv[i]);
                    *(uint2*)(H + (size_t)r * D + c) = make_uint2((unsigned)o[0] | ((unsigned)o[1] << 16), (unsigned)o[2] | ((unsigned)o[3] << 16)); }
            }
        }
#undef N1_LOAD
    }
}

constexpr float QSCALE = 0.17677669529663687f * 1.4426950408889634f;
__device__ __forceinline__ void ph_rope_table(const P& p) {
    const int tidx = p.wid * 64 + fresh_lane();
    float2* TAB = (float2*)(p.ws + WS_ROPE);
    for (int it = blockIdx.x * NT + tidx; it < T * 16; it += gridDim.x * NT) { const int f = it & 7, a = (it >> 3) & 1, t = it >> 4;
        const float pos = (float)(a == 0 ? (t / 64) : (t % 64)); const float freq = expf(-(float)f * 0.125f * 9.210340371976184f); const float ang = pos * freq;
        TAB[it] = make_float2(cosf(ang), sinf(ang)); }
}
__device__ __forceinline__ void ph_rope(const P& p, int l) {
    const int tidx = p.wid * 64 + fresh_lane();
    bf16_t* Z = (bf16_t*)(p.ws + WS_Z); const float2* TAB = (const float2*)(p.ws + WS_ROPE);
    const int total = NB * T * 32;
    for (int it = blockIdx.x * NT + tidx; it < total; it += gridDim.x * NT) {
        const int pr = it & 31, rt = it >> 5; const int b = rt / T, t = rt % T;
        const int a = pr & 1, n = (pr >> 1) & 1, h = (pr >> 2) & 3, qk = pr >> 4;
        bf16_t* zp = Z + (size_t)(b * LB + TC + t) * NZ + (qk ? ZB_K : ZB_Q) + h * 64 + n * 32 + a * 16;
        const uint4 v1 = *(const uint4*)zp, v2 = *(const uint4*)(zp + 8); const unsigned w1[4] = {v1.x, v1.y, v1.z, v1.w}, w2[4] = {v2.x, v2.y, v2.z, v2.w};
        const float2* tb = TAB + (size_t)(t * 2 + a) * 8; const float sc = qk ? 1.f : QSCALE; unsigned o1[4], o2[4];
#pragma unroll
        for (int i = 0; i < 4; ++i) { const float2 cs0 = tb[2 * i], cs1 = tb[2 * i + 1];
            const float x1a = __uint_as_float(w1[i] << 16), x1b = __uint_as_float(w1[i] & 0xffff0000u), x2a = __uint_as_float(w2[i] << 16), x2b = __uint_as_float(w2[i] & 0xffff0000u);
            o1[i] = pk2bf((x1a * cs0.x - x2a * cs0.y) * sc, (x1b * cs1.x - x2b * cs1.y) * sc);
            o2[i] = pk2bf((x2a * cs0.x + x1a * cs0.y) * sc, (x2b * cs1.x + x1b * cs1.y) * sc); }
        *(uint4*)zp = make_uint4(o1[0], o1[1], o1[2], o1[3]); *(uint4*)(zp + 8) = make_uint4(o2[0], o2[1], o2[2], o2[3]);
    }
    if (l == 0) {
        const int totc = NB * TC * 256;
        for (int it = blockIdx.x * NT + tidx; it < totc; it += gridDim.x * NT) {
            const int c = it & 255, rt = it >> 8; const int b = rt / TC, j = rt % TC;
            bf16_t* zp = Z + (size_t)(b * LB + j) * NZ + ZB_Q + c; zp[0] = f2bf(bf2f(zp[0]) * QSCALE);
        }
    }
}

namespace lru {
typedef short bf16x8 __attribute__((ext_vector_type(8)));
typedef float f32x4 __attribute__((ext_vector_type(4)));
constexpr int UROW = 264;
__device__ __forceinline__ void comp(float& A, float& B, float a, float b) { B = a * B + b; A = a * A; }
}
__device__ __forceinline__ void ph_lru_m1(const P& p, int l, unsigned char* ldsb) {
    using namespace lru;
    const int lane = fresh_lane(), wid = p.wid, tid = wid * 64 + lane;
    const bf16_t* Z = (const bf16_t*)(p.ws + WS_Z); bf16_t* G = (bf16_t*)(p.ws + WS_H); float2* AGG = (float2*)(p.ws + WS_LRUAGG);
    const bf16_t* WT = (const bf16_t*)(p.ws + WS_LRUWT);
    const float* cw = p.in[I_CONVW] + l * 4 * 256; const float* cb = p.in[I_CONVB] + l * 256;
    ALAS bf16_t* U = (ALAS bf16_t*)ldsb;
    const int h = wid & 3, d = wid >> 2, l15 = lane & 15, g4 = lane >> 4;
    float spv[4], brv[4], biv[4];
#pragma unroll
    for (int jt = 0; jt < 4; ++jt) { const int w = h * 64 + jt * 16 + l15; spv[jt] = log1pf(expf(-p.in[I_LAM][(l * 2 + d) * 256 + w])); brv[jt] = p.in[I_BR][(l * 2 + d) * 256 + w]; biv[jt] = p.in[I_BI][(l * 2 + d) * 256 + w]; }
    for (int unit = ustart(192); unit < NB * 36; unit += gridDim.x) {
        const int b = unit / 36, c = unit % 36, r0 = b * LB + c * 64; const int lo = c < 4 ? 0 : TC, hi = c < 4 ? TC : LB;
        {
            uint4 zv[4][4];
#pragma unroll
            for (int it4 = 0; it4 < 4; ++it4) { const int item = tid + it4 * NT; const int t = item >> 5, cg = item & 31, j = c * 64 + t;
#pragma unroll
                for (int q = 0; q < 4; ++q) { int jj = j + q - 2; jj = jj < lo ? lo : (jj >= hi ? hi - 1 : jj); zv[it4][q] = *(const uint4*)(Z + (size_t)(b * LB + jj) * NZ + ZA_X + cg * 8); } }
#pragma unroll
            for (int it4 = 0; it4 < 4; ++it4) { const int item = tid + it4 * NT; const int t = item >> 5, cg = item & 31, j = c * 64 + t; float acc[8];
#pragma unroll
                for (int i = 0; i < 8; ++i) acc[i] = cb[cg * 8 + i];
#pragma unroll
                for (int q = 0; q < 4; ++q) { const int jj = j + q - 2; const float msk = (jj >= lo && jj < hi) ? 1.f : 0.f; const unsigned zw[4] = {zv[it4][q].x, zv[it4][q].y, zv[it4][q].z, zv[it4][q].w};
                    const float4 w0 = *(const float4*)(cw + q * 256 + cg * 8), w1 = *(const float4*)(cw + q * 256 + cg * 8 + 4); const float wv8[8] = {w0.x, w0.y, w0.z, w0.w, w1.x, w1.y, w1.z, w1.w};
#pragma unroll
                    for (int i = 0; i < 4; ++i) { acc[2 * i] += __uint_as_float(zw[i] << 16) * (wv8[2 * i] * msk); acc[2 * i + 1] += __uint_as_float(zw[i] & 0xffff0000u) * (wv8[2 * i + 1] * msk); } }
                uint4 o; o.x = pk2bf(acc[0], acc[1]); o.y = pk2bf(acc[2], acc[3]); o.z = pk2bf(acc[4], acc[5]); o.w = pk2bf(acc[6], acc[7]);
                { typedef unsigned u32x4_t __attribute__((ext_vector_type(4))); u32x4_t ov = {o.x, o.y, o.z, o.w}; *(ALAS u32x4_t*)(U + t * UROW + cg * 8) = ov; } }
        }
        __syncthreads();
        bf16x8 af[4][2];
#pragma unroll
        for (int tt = 0; tt < 4; ++tt)
#pragma unroll
            for (int ks = 0; ks < 2; ++ks) af[tt][ks] = *(const ALAS bf16x8*)(U + (16 * tt + l15) * UROW + h * 64 + 32 * ks + 8 * g4);
#pragma unroll 1
        for (int jt = 0; jt < 4; ++jt) {
            const float spj = jt == 0 ? spv[0] : jt == 1 ? spv[1] : jt == 2 ? spv[2] : spv[3], brj = jt == 0 ? brv[0] : jt == 1 ? brv[1] : jt == 2 ? brv[2] : brv[3], bij = jt == 0 ? biv[0] : jt == 1 ? biv[1] : jt == 2 ? biv[2] : biv[3];
            f32x4 ar[4], ai[4];
#pragma unroll
            for (int tt = 0; tt < 4; ++tt) { ar[tt] = (f32x4){0.f, 0.f, 0.f, 0.f}; ai[tt] = (f32x4){0.f, 0.f, 0.f, 0.f}; }
#pragma unroll
            for (int ks = 0; ks < 2; ++ks) { const bf16_t* wp = WT + ((size_t)(((l * 2 + d) * 2 + 0) * 4 + h) * 64 + 16 * jt + l15) * 64 + 32 * ks + 8 * g4; const bf16x8 wr = *(const bf16x8*)wp, wi = *(const bf16x8*)(wp + 4 * 64 * 64);
#pragma unroll
                for (int tt = 0; tt < 4; ++tt) { ar[tt] = __builtin_amdgcn_mfma_f32_16x16x32_bf16(af[tt][ks], wr, ar[tt], 0, 0, 0); ai[tt] = __builtin_amdgcn_mfma_f32_16x16x32_bf16(af[tt][ks], wi, ai[tt], 0, 0, 0); } }
            const int w = h * 64 + jt * 16 + l15; float mA[4], mB[4];
#pragma unroll
            for (int tt = 0; tt < 4; ++tt) { float A = 1.f, Bv = 0.f; float av[4], bv[4];
#pragma unroll
                for (int rg = 0; rg < 4; ++rg) { const int t = 16 * tt + 4 * g4 + rg;
                    const float rgt = sigmoidf_(ar[tt][rg] + brj), igt = sigmoidf_(ai[tt][rg] + bij);
                    const bf16_t lab = f2bf(-8.f * rgt * spj); const float a = __expf(bf2f(lab));
                    const float uu = bf2f(U[t * UROW + w]); const float bc = __builtin_amdgcn_sqrtf(fmaxf(1.f - a * a, 0.f)) * igt * uu;
                    const bf16_t bcb = f2bf(bc);
                    G[((size_t)(d * 2 + 0) * R + r0 + t) * 256 + w] = lab; G[((size_t)(d * 2 + 1) * R + r0 + t) * 256 + w] = bcb;
                    av[rg] = a; bv[rg] = bf2f(bcb); }
                if (d == 0) { comp(A, Bv, av[0], bv[0]); comp(A, Bv, av[1], bv[1]); comp(A, Bv, av[2], bv[2]); comp(A, Bv, av[3], bv[3]); }
                else { comp(A, Bv, av[3], bv[3]); comp(A, Bv, av[2], bv[2]); comp(A, Bv, av[1], bv[1]); comp(A, Bv, av[0], bv[0]); }
                mA[tt] = A; mB[tt] = Bv; }
            float A = 1.f, Bv = 0.f;
#pragma unroll
            for (int s4 = 0; s4 < 4; ++s4) { const int tt = d == 0 ? s4 : 3 - s4; const float ma = d == 0 ? mA[s4] : mA[3 - s4], mb = d == 0 ? mB[s4] : mB[3 - s4]; (void)tt;
#pragma unroll
                for (int gs = 0; gs < 4; ++gs) { const int gg = d == 0 ? gs : 3 - gs; const float a = __shfl(ma, gg * 16 + l15), bq = __shfl(mb, gg * 16 + l15); comp(A, Bv, a, bq); } }
            if (g4 == 0) AGG[((size_t)(b * 2 + d) * 36 + c) * 256 + w] = make_float2(A, Bv);
        }
        __syncthreads();
    }
}
__device__ __forceinline__ void ph_lru_m2(const P& p, int l, unsigned char* ldsb) {
    const int lane = fresh_lane(), wid = p.wid, tid = wid * 64 + lane;
    const bf16_t* Z = (const bf16_t*)(p.ws + WS_Z); const bf16_t* G = (const bf16_t*)(p.ws + WS_H); bf16_t* Y = (bf16_t*)(p.ws + WS_Y); const float2* AGG = (const float2*)(p.ws + WS_LRUAGG);
    ALAS float* HS = (ALAS float*)ldsb;
    const int d = tid >> 8, w = tid & 255;
    const int ncb = l == 1 ? 32 : 36, nun = NB * ncb;
    const int vme = ustart(0);
    for (int pass = 0; pass < 2; ++pass) {
        int unit;
        if (l == 1) unit = pass == 0 ? vme : -1;
        else if (pass == 0) unit = (vme >= 64 && vme < 96) ? -1 : (vme < 64 ? vme : vme - 32);
        else unit = (vme >= 96 && vme < 160) ? 224 + (vme - 96) : -1;
        if (unit < 0 || unit >= nun) continue;
        const int b = unit / ncb, c = (36 - ncb) + unit % ncb, r0 = b * LB + c * 64;
        float hst = 0.f; const float2* ag = AGG + (size_t)(b * 2 + d) * 36 * 256 + w;
        {
            const int pos = d == 0 ? c : (c < 4 ? 3 - c : 4 + (35 - c));
            float mx[36], my[36];
#pragma unroll
            for (int k = 0; k < 36; ++k) { const int cc = d == 0 ? k : (k < 4 ? 3 - k : 39 - k); const float2 m = ag[cc * 256]; mx[k] = m.x; my[k] = m.y; }
#pragma unroll
            for (int k = 0; k < 36; ++k) { const bool vf = k < pos; const float a = vf ? mx[k] : 1.f, bq = vf ? my[k] : 0.f; hst = __builtin_fmaf(a, hst, bq); }
        }
        const bf16_t* gl = G + ((size_t)(d * 2 + 0) * R + r0) * 256 + w; const bf16_t* gb = G + ((size_t)(d * 2 + 1) * R + r0) * 256 + w;
#pragma unroll 1
        for (int s0 = 0; s0 < 64; s0 += 32) {
            bf16_t la[32], lb[32];
#pragma unroll
            for (int i = 0; i < 32; ++i) { const int t = d == 0 ? (s0 + i) : 63 - (s0 + i); la[i] = gl[t * 256]; lb[i] = gb[t * 256]; }
#pragma unroll
            for (int i = 0; i < 32; ++i) { const int t = d == 0 ? (s0 + i) : 63 - (s0 + i); hst = __expf(bf2f(la[i])) * hst + bf2f(lb[i]); HS[(d * 64 + t) * 256 + w] = hst; }
        }
        __syncthreads();
#pragma unroll
        for (int q = 0; q < 4; ++q) { const int it = tid + q * NT; const int t = it >> 5, c8 = (it & 31) * 8;
            const uint4 zv = *(const uint4*)(Z + (size_t)(r0 + t) * NZ + ZA_G + c8); const unsigned zw[4] = {zv.x, zv.y, zv.z, zv.w}; unsigned o[4];
#pragma unroll
            for (int i = 0; i < 4; ++i) { const float h0 = HS[t * 256 + c8 + 2 * i] + HS[(64 + t) * 256 + c8 + 2 * i], h1 = HS[t * 256 + c8 + 2 * i + 1] + HS[(64 + t) * 256 + c8 + 2 * i + 1];
                o[i] = pk2bf(h0 * geluf_(__uint_as_float(zw[i] << 16)), h1 * geluf_(__uint_as_float(zw[i] & 0xffff0000u))); }
            *(uint4*)(Y + (size_t)(r0 + t) * D + c8) = make_uint4(o[0], o[1], o[2], o[3]); }
        __syncthreads();
    }
}

__device__ __forceinline__ void ph_sg(const P& p, int l, unsigned char* ldsb) {
    typedef short bf16x8 __attribute__((ext_vector_type(8))); typedef float f32x16 __attribute__((ext_vector_type(16)));
    const int lane = fresh_lane(), wid = p.wid, tid = wid * 64 + lane, r32 = lane & 31, hi = lane >> 5;
    const bf16_t* Z = (const bf16_t*)(p.ws + WS_Z); bf16_t* Y = (bf16_t*)(p.ws + WS_Y); const bf16_t* SGW = (const bf16_t*)(p.ws + WS_SGW) + (size_t)l * 4 * 128 * 128;
    const float* ng = p.in[I_SGNG] + l * 256;
    ALAS bf16_t* VT = (ALAS bf16_t*)ldsb;
    constexpr int VROW = 136;
    const int q = tid >> 2, part = tid & 3, ptile = wid & 3, chalf = wid >> 2;
    const int nck = l == 1 ? 16 : 18;
    const int vme = ustart(0), nun_sg = NB * nck * 4;
    for (int pass = 0; pass < 3; ++pass) {
        int unit;
        if (pass == 0) unit = vme;
        else if (pass == 1) unit = (vme >= 64 && vme < 96) ? -1 : 256 + (vme < 64 ? vme : vme - 32);
        else unit = (vme >= 160 && vme < 192) ? 480 + (vme - 160) : (vme < 64 ? 512 + vme : -1);
        if (unit < 0 || unit >= nun_sg) continue;
        const int h = unit & 3, bc = unit >> 2, b = bc / nck, ck = (18 - nck) + bc % nck;
        const int r0 = b * LB + ck * 128;
        bf16x8 wf[8];
        { const bf16_t* wp = SGW + ((size_t)h * 128 + 32 * ptile + r32) * 128 + 8 * hi;
#pragma unroll
          for (int ks = 0; ks < 8; ++ks) wf[ks] = *(const bf16x8*)(wp + 16 * ks); }
        { const bf16_t* zv = Z + (size_t)(r0 + q) * NZ + ZC_V + part * 64; uint4 raw[8]; float ss = 0.f;
#pragma unroll
          for (int i = 0; i < 8; ++i) raw[i] = *(const uint4*)(zv + 8 * i);
#pragma unroll
          for (int i = 0; i < 8; ++i) { const unsigned w4[4] = {raw[i].x, raw[i].y, raw[i].z, raw[i].w};
#pragma unroll
              for (int k = 0; k < 4; ++k) { const float g0 = geluf_(__uint_as_float(w4[k] << 16)), g1 = geluf_(__uint_as_float(w4[k] & 0xffff0000u)); ss += g0 * g0 + g1 * g1; } }
          ss += __shfl_xor(ss, 1); ss += __shfl_xor(ss, 2);
          const float rs = rsqrtf(ss * (1.f / 256.f) + EPS);
          if (part == h) {
#pragma unroll
              for (int i = 0; i < 8; ++i) { const unsigned w4[4] = {raw[i].x, raw[i].y, raw[i].z, raw[i].w};
#pragma unroll
                  for (int k = 0; k < 4; ++k) { const int c = 8 * i + 2 * k;
                      VT[c * VROW + q] = f2bf(geluf_(__uint_as_float(w4[k] << 16)) * rs * ng[h * 64 + c]);
                      VT[(c + 1) * VROW + q] = f2bf(geluf_(__uint_as_float(w4[k] & 0xffff0000u)) * rs * ng[h * 64 + c + 1]); } } } }
        __syncthreads();
        f32x16 acc = f32x16{};
#pragma unroll
        for (int ks = 0; ks < 8; ++ks) { const bf16x8 vf = *(const ALAS bf16x8*)(VT + (32 * chalf + r32) * VROW + 16 * ks + 8 * hi); acc = __builtin_amdgcn_mfma_f32_32x32x16_bf16(wf[ks], vf, acc, 0, 0, 0); }
        { const float* bsp = p.in[I_SGB] + (l * 4 + h) * 128 + 32 * ptile + 4 * hi; bf16_t zu[16];
          const size_t rb = (size_t)(r0 + 32 * ptile + 4 * hi);
#pragma unroll
          for (int r = 0; r < 16; ++r) { const int pr = (r & 3) + 8 * (r >> 2); zu[r] = Z[(rb + pr) * NZ + ZC_U + h * 64 + 32 * chalf + r32]; }
#pragma unroll
          for (int r = 0; r < 16; ++r) { const int pr = (r & 3) + 8 * (r >> 2); Y[(rb + pr) * D + 512 + h * 64 + 32 * chalf + r32] = f2bf(geluf_(bf2f(zu[r])) * (acc[r] + bsp[pr])); } }
        __syncthreads();
    }
}

namespace att {
typedef short bf16x8 __attribute__((ext_vector_type(8)));
typedef short s16x4 __attribute__((ext_vector_type(4)));
typedef float f32x16 __attribute__((ext_vector_type(16)));
typedef float f32x2_t __attribute__((ext_vector_type(2))); typedef __bf16 bf16x2_t __attribute__((ext_vector_type(2)));
constexpr int SLOTB = 8192, NSLOT = 4, L_K = 0, L_V = NSLOT * SLOTB, L_WS = 2 * NSLOT * SLOTB, L_OST = L_WS + 8 * 2 * 32 * 4, OST_W = 32 * 66 * 4;
constexpr float THR = 8.f;
__device__ __forceinline__ int crow(int r, int hi) { return (r & 3) + 8 * (r >> 2) + 4 * hi; }
__device__ __forceinline__ unsigned cvtpk(float lo, float hi) { f32x2_t v = {lo, hi}; bf16x2_t b = __builtin_convertvector(v, bf16x2_t); return __builtin_bit_cast(unsigned, b); }
__device__ __forceinline__ float max3f(float a, float b, float c) { float r; asm("v_max3_f32 %0, %1, %2, %3" : "=v"(r) : "v"(a), "v"(b), "v"(c)); return r; }
__device__ __forceinline__ float swapmax(float m) { auto rr = __builtin_amdgcn_permlane32_swap(__float_as_uint(m), __float_as_uint(m), false, false); return fmaxf(__uint_as_float(rr[0]), __uint_as_float(rr[1])); }
__device__ __forceinline__ float swapadd(float m) { auto rr = __builtin_amdgcn_permlane32_swap(__float_as_uint(m), __float_as_uint(m), false, false); return __uint_as_float(rr[0]) + __uint_as_float(rr[1]); }
typedef short v4i16_t __attribute__((ext_vector_type(4)));
__device__ __forceinline__ void glds16(const void* gsrc, unsigned lds_dst) { unsigned keep;
  asm volatile("s_mov_b32 %0, m0\n\ts_mov_b32 m0, %2\n\ts_nop 0\n\tglobal_load_lds_dwordx4 %1, off\n\ts_mov_b32 m0, %0" : "=&s"(keep) : "v"(gsrc), "s"(lds_dst) : "memory"); }
__device__ __forceinline__ s16x4 vtr(const ALAS char* q) { return __builtin_bit_cast(s16x4, __builtin_amdgcn_ds_read_tr16_b64_v4i16((ALAS v4i16_t*)q)); }
}
__device__ __forceinline__ void ph_attn(const P& p, int l, unsigned char* ldsb) {
    using namespace att;
    const int lane = fresh_lane(), wid = p.wid, r32 = lane & 31, hi = lane >> 5;
    const bf16_t* Z = (const bf16_t*)(p.ws + WS_Z); bf16_t* Y = (bf16_t*)(p.ws + WS_Y);
    const float lam_init = l == 0 ? 0.2f : (0.8f - 0.6f * 0.7408182206817179f);
    const float* dl_ = p.in[I_DALAM] + l * 4 * 32; float s01 = 0.f, s23 = 0.f;
    for (int i = 0; i < 32; ++i) { s01 += dl_[i] * dl_[32 + i]; s23 += dl_[64 + i] * dl_[96 + i]; }
    const float lam = expf(s01) - expf(s23) + lam_init;
    const float* subg = p.in[I_DASUB] + l * 64;
    const int G = gridDim.x, bx = blockIdx.x, vcu = (G % 8 == 0) ? (bx % 8) * (G / 8) + bx / 8 : bx;
    const int nun = 256 + (l == 0 ? 32 : 0);
    ALAS char* L3 = (ALAS char*)ldsb; const unsigned lds0 = (unsigned)(size_t)L3;
    ALAS float* wsf = (ALAS float*)(L3 + L_WS) + wid * 64;
    ALAS float* stg = (ALAS float*)(L3 + L_OST + wid * OST_W);
    const ALAS char* kp0 = L3 + L_K + hi * 1024 + r32 * 16;
    const ALAS char* vp0 = L3 + L_V + ((lane >> 4) & 1) * 32 + (lane & 3) * 8 + (4 * hi + ((lane & 15) >> 2)) * 64;
    for (int u = vcu; u < nun; u += G) {
        int b, h, q0row, nt;
        if (u < 256) { b = u >> 5; h = (u >> 3) & 3; q0row = b * LB + TC + (u & 7) * 256; nt = LB / 64; } else { const int v = u - 256; b = v >> 2; h = v & 3; q0row = b * LB; nt = TC / 64; }
        const bf16_t* ksrc = Z + (size_t)(b * LB + lane) * NZ + ZB_K + h * 64 + wid * 8;
        const bf16_t* vsrc = Z + (size_t)(b * LB + 16 * (wid & 3) + (lane >> 2)) * NZ + ZB_V + h * 64 + (wid >> 2) * 32 + (lane & 3) * 8;
#define ATT_DMA(t, slot) do { att::glds16(ksrc + (size_t)(t) * 64 * NZ, (unsigned)__builtin_amdgcn_readfirstlane((int)(lds0 + L_K + (slot) * SLOTB + wid * 1024))); \
                              att::glds16(vsrc + (size_t)(t) * 64 * NZ, (unsigned)__builtin_amdgcn_readfirstlane((int)(lds0 + L_V + (slot) * SLOTB + wid * 1024))); } while (0)
        ATT_DMA(0, 0); ATT_DMA(1, 1);
        bf16x8 qr[4];
        { const bf16_t* qp = Z + (size_t)(q0row + wid * 32 + r32) * NZ + ZB_Q + h * 64 + hi * 8;
#pragma unroll
          for (int d0 = 0; d0 < 4; ++d0) qr[d0] = *(const bf16x8*)(qp + d0 * 16); }
        f32x16 o[2][2], negm[2]; float mrun[2] = {0.f, 0.f}, lsum[2] = {0.f, 0.f};
#pragma unroll
        for (int n = 0; n < 2; ++n) { negm[n] = f32x16{}; o[n][0] = f32x16{}; o[n][1] = f32x16{}; }
        asm volatile("s_waitcnt vmcnt(0)" : "+v"(qr[0]), "+v"(qr[1]), "+v"(qr[2]), "+v"(qr[3]) :: "memory"); __syncthreads();
        bf16x8 pa[2][4]; f32x16 cc[2][2]; int t = 0;
#define ATT_WAITBAR() do { if (t + 2 < nt) asm volatile("s_waitcnt vmcnt(2)" ::: "memory"); else asm volatile("s_waitcnt vmcnt(0)" ::: "memory"); \
            __builtin_amdgcn_s_barrier(); asm volatile("" ::: "memory"); } while (0)
#define ATT_PV(tv) do { const int sv = ((tv) & 3) * SLOTB; \
            _Pragma("unroll") \
            for (int d0 = 0; d0 < 2; ++d0) { \
                bf16x8 vf[4]; \
                _Pragma("unroll") \
                for (int k = 0; k < 4; ++k) { const s16x4 lo = vtr(vp0 + sv + d0 * 4096 + k * 1024), hh = vtr(vp0 + sv + d0 * 4096 + k * 1024 + 512); \
                    vf[k] = (bf16x8){lo[0], lo[1], lo[2], lo[3], hh[0], hh[1], hh[2], hh[3]}; } \
                _Pragma("unroll") \
                for (int n = 0; n < 2; ++n) { \
                    _Pragma("unroll") \
                    for (int k = 0; k < 4; ++k) o[n][d0] = __builtin_amdgcn_mfma_f32_32x32x16_bf16(pa[n][k], vf[k], o[n][d0], 0, 0, 0); } \
            } } while (0)
#define ATT_QK() do { const int so = (t & 3) * SLOTB; \
            _Pragma("unroll") \
            for (int n = 0; n < 2; ++n) { \
                const bf16x8 k00 = *(const ALAS bf16x8*)(kp0 + so + (2 * n) * 2048), k01 = *(const ALAS bf16x8*)(kp0 + so + (2 * n) * 2048 + 512); \
                const bf16x8 k10 = *(const ALAS bf16x8*)(kp0 + so + (2 * n + 1) * 2048), k11 = *(const ALAS bf16x8*)(kp0 + so + (2 * n + 1) * 2048 + 512); \
                cc[n][0] = __builtin_amdgcn_mfma_f32_32x32x16_bf16(k00, qr[2 * n], negm[n], 0, 0, 0); \
                cc[n][1] = __builtin_amdgcn_mfma_f32_32x32x16_bf16(k01, qr[2 * n], negm[n], 0, 0, 0); \
                cc[n][0] = __builtin_amdgcn_mfma_f32_32x32x16_bf16(k10, qr[2 * n + 1], cc[n][0], 0, 0, 0); \
                cc[n][1] = __builtin_amdgcn_mfma_f32_32x32x16_bf16(k11, qr[2 * n + 1], cc[n][1], 0, 0, 0); \
            } } while (0)
#define ATT_Y(FIRST) do { \
            _Pragma("unroll") \
            for (int n = 0; n < 2; ++n) { \
                f32x16 c0 = cc[n][0], c1 = cc[n][1]; \
                asm volatile("s_nop 15\n\ts_nop 7" : "+v"(c0), "+v"(c1));      \
                float rm = max3f(c0[0], c1[0], c0[1]), rm2 = max3f(c1[1], c0[2], c1[2]); \
                _Pragma("unroll") \
                for (int r = 3; r < 15; r += 2) { rm = max3f(rm, c0[r], c1[r]); rm2 = max3f(rm2, c0[r + 1], c1[r + 1]); } \
                rm = max3f(rm, rm2, c0[15]); rm = max3f(rm, c1[15], c1[15]); \
                rm = swapmax(rm); \
                if (FIRST || __builtin_expect(__any(rm > THR), 0)) { \
                    const float dl = FIRST ? rm : fmaxf(rm, 0.f); mrun[n] += dl; \
                    _Pragma("unroll") \
                    for (int r = 0; r < 16; ++r) { c0[r] -= dl; c1[r] -= dl; negm[n][r] = -mrun[n]; } \
                    const float f = exp2f(-dl); lsum[n] *= f; \
                    if (hi == 0) wsf[n * 32 + r32] = f; \
                    _Pragma("unroll") \
                    for (int r = 0; r < 16; ++r) { const float ff = wsf[n * 32 + crow(r, hi)]; o[n][0][r] *= ff; o[n][1][r] *= ff; } \
                } \
                float sacc = 0.f; \
                _Pragma("unroll") \
                for (int r = 0; r < 16; ++r) { c0[r] = __builtin_amdgcn_exp2f(c0[r]); c1[r] = __builtin_amdgcn_exp2f(c1[r]); sacc += c0[r] + c1[r]; } \
                lsum[n] += sacc; \
                _Pragma("unroll") \
                for (int k = 0; k < 2; ++k) { \
                    uint4 q0 = make_uint4(cvtpk(c0[8 * k], c0[8 * k + 1]), cvtpk(c0[8 * k + 2], c0[8 * k + 3]), cvtpk(c0[8 * k + 4], c0[8 * k + 5]), cvtpk(c0[8 * k + 6], c0[8 * k + 7])); \
                    uint4 q1 = make_uint4(cvtpk(c1[8 * k], c1[8 * k + 1]), cvtpk(c1[8 * k + 2], c1[8 * k + 3]), cvtpk(c1[8 * k + 4], c1[8 * k + 5]), cvtpk(c1[8 * k + 6], c1[8 * k + 7])); \
                    pa[n][k] = __builtin_bit_cast(bf16x8, q0); pa[n][2 + k] = __builtin_bit_cast(bf16x8, q1); } \
            } } while (0)
        if (wid >= 4) { __builtin_amdgcn_s_barrier(); asm volatile("" ::: "memory"); }
        if (2 < nt) ATT_DMA(2, 2);
        ATT_QK(); ATT_WAITBAR();
        ATT_Y(true); ATT_WAITBAR();
        for (t = 1; t < nt; ++t) {
            if (t + 2 < nt) ATT_DMA(t + 2, (t + 2) & 3);
            ATT_PV(t - 1); ATT_QK(); ATT_WAITBAR();
            ATT_Y(false); ATT_WAITBAR();
        }
        ATT_PV(nt - 1);
        if (wid < 4) { __builtin_amdgcn_s_barrier(); asm volatile("" ::: "memory"); }
#undef ATT_WAITBAR
#undef ATT_PV
#undef ATT_QK
#undef ATT_Y
        { const float l1 = swapadd(lsum[0]), l2 = swapadd(lsum[1]);
          const int lane_e = fresh_lane(); const int r32 = lane_e & 31, hi = lane_e >> 5, lane = lane_e;
          ALAS float* wsf = (ALAS float*)(L3 + L_WS) + wid * 64; ALAS float* stg = (ALAS float*)(L3 + L_OST + wid * OST_W);
          if (hi == 0) { wsf[r32] = __builtin_amdgcn_rcpf(l1); wsf[32 + r32] = lam * __builtin_amdgcn_rcpf(l2); }
#pragma unroll
          for (int r = 0; r < 16; ++r) { const int q = crow(r, hi); const float a = wsf[q], bb = wsf[32 + q];
              stg[q * 66 + r32] = o[0][0][r] * a - o[1][0][r] * bb; stg[q * 66 + 32 + r32] = o[0][1][r] * a - o[1][1][r] * bb; }
          const int row = lane >> 1, half = lane & 1; float ov[32]; float ss = 0.f;
#pragma unroll
          for (int i = 0; i < 32; ++i) { ov[i] = stg[row * 66 + half * 32 + i]; ss += ov[i] * ov[i]; }
          ss += __shfl_xor(ss, 1);
          const float rs = rsqrtf(ss * (1.f / 64.f) + EPS) * (1.f - lam_init);
          bf16_t* yo = Y + (size_t)(q0row + wid * 32 + row) * D + 256 + h * 64 + half * 32;
#pragma unroll
          for (int i = 0; i < 4; ++i) { unsigned w[4];
#pragma unroll
              for (int k = 0; k < 4; ++k) w[k] = cvtpk(ov[8 * i + 2 * k] * rs * subg[half * 32 + 8 * i + 2 * k], ov[8 * i + 2 * k + 1] * rs * subg[half * 32 + 8 * i + 2 * k + 1]);
              *(uint4*)(yo + 8 * i) = make_uint4(w[0], w[1], w[2], w[3]); } }
        __syncthreads();
#undef ATT_DMA
    }
}


namespace hg {
typedef short bf16x8 __attribute__((ext_vector_type(8)));
typedef short s16x4 __attribute__((ext_vector_type(4)));
typedef float f32x16 __attribute__((ext_vector_type(16)));
typedef float f32x4v __attribute__((ext_vector_type(4)));
constexpr int QROW = 72;
constexpr int W_Q = 0, W_K = 4608, W_KH = 9216, W_V = 13312, W_BYTES = 17408;
constexpr int L_ST = 8 * W_BYTES;
constexpr int STROW = 68, L_BS = L_ST + 64 * STROW * 4;
constexpr int AGG_FLOATS = 64 * 64 + 64;
__device__ __forceinline__ int img_off(int s, int col) { return ((col >> 5) * 2 + (s >> 4)) * 1024 + (s & 15) * 64 + (col & 31) * 2; }
}
constexpr int LDS_MISC = hg::L_BS + 256;
constexpr int LDS_MISC_HGB = LDS_MISC + 2560;
template <int PASS>
__device__ __forceinline__ void ph_hg(const P& p, int l, unsigned char* ldsb) {
    using namespace hg;
    const int wid = p.wid;
    const bf16_t* Z = (const bf16_t*)(p.ws + WS_Z); bf16_t* Y = (bf16_t*)(p.ws + WS_Y); float* AGG = (float*)p.out;
    ALAS char* L3 = (ALAS char*)ldsb; ALAS char* LW = L3 + wid * W_BYTES;
    ALAS float* ST = (ALAS float*)(L3 + L_ST); ALAS float* BS = (ALAS float*)(L3 + L_BS);
    const float* gn = p.in[I_HGNG] + l * 256;
    const int nsc = (PASS == 2 && l == 1) ? 8 : 9;
    const int nunits = PASS == 1 ? NB * 4 * 9 * 2 : NB * 4 * nsc;
    for (int unit = ustart(PASS == 1 ? 160 : 192); unit < nunits; unit += gridDim.x) {
        const int uu = PASS == 1 ? unit >> 1 : unit; const int d_lo = PASS == 1 ? (unit & 1) : 0, d_hi = PASS == 1 ? (unit & 1) + 1 : 2;
        const int sc = (9 - nsc) + uu % nsc, bh = uu / nsc, h = bh & 3, b = bh >> 2;
        const int lane = fresh_lane();
        const int tid = wid * 64 + lane, r32 = lane & 31, hi = lane >> 5;
        const ALAS char* trb = LW + ((lane >> 4) & 1) * 32 + (lane & 3) * 8 + (4 * hi + ((lane & 15) >> 2)) * 64;
        float* OSG = (float*)p.out + (size_t)4 * 1024 * 1024 + (size_t)blockIdx.x * 16384;
#pragma unroll 1
        for (int d = d_lo; d < d_hi; ++d) {
            float lb = 0.f;
            if (l == 1) { const float* hl = p.in[I_HGLB] + (size_t)d * 2 * 256 + h * 64 + lane; lb = sigmoidf_(hl[256] - hl[0]); }
            const int fcol = (d == 0 ? ZD_FF : ZD_FB) + h * 64 + lane;
            const int jbase = b * LB + sc * 256;
            { const float* ag = AGG + (size_t)((b * 4 + h) * 2 + d) * 9 * AGG_FLOATS; const int dd = tid & 63;
              float sv[8];
#pragma unroll
              for (int i = 0; i < 8; ++i) sv[i] = 0.f;
              if (PASS == 2) {
#pragma unroll
                  for (int k = 0; k < 8; ++k) { const int ai = d == 0 ? k : (k == 0 ? 0 : 9 - k); const bool valid = d == 0 ? (k < sc) : (k == 0 ? (sc > 0) : (ai > sc)); const int ac = valid ? ai : 0;
                      const float dv = valid ? __expf(ag[(size_t)ac * AGG_FLOATS + 4096 + dd]) : 1.f;
#pragma unroll
                      for (int i = 0; i < 8; ++i) { const float s_ = ag[(size_t)ac * AGG_FLOATS + tid + 512 * i]; sv[i] = dv * sv[i] + (valid ? s_ : 0.f); } } }
#pragma unroll
              for (int i = 0; i < 8; ++i) { const int e = tid + 512 * i; ST[(e >> 6) * STROW + (e & 63)] = sv[i]; }
              if (tid < 64) BS[tid] = 0.f; }
            {   typedef unsigned u32x4s __attribute__((ext_vector_type(4)));
                const int tk = lane >> 3, c8 = (lane & 7) * 8;
                u32x4s rv[4], rf[4], rq[4];
#pragma unroll
                for (int g = 0; g < 4; ++g) { const int tau = 8 * g + tk; const int jl = d == 0 ? (32 * wid + tau) : (255 - 32 * wid - tau); const bf16_t* zr = Z + (size_t)(jbase + jl) * NZ + h * 64 + c8;
                    rv[g] = *(const u32x4s*)(zr + ZD_I); rf[g] = *(const u32x4s*)(zr + (d == 0 ? ZD_FF : ZD_FB)); if (PASS == 2) rq[g] = *(const u32x4s*)(zr + ZD_Q); }
#pragma unroll
                for (int g = 0; g < 4; ++g) { const int tau = 8 * g + tk;
                    *(ALAS u32x4s*)(LW + W_V + img_off(tau, c8)) = rv[g];
                    *(ALAS u32x4s*)(LW + W_K + (tau * QROW + c8) * 2) = rf[g];
                    if (PASS == 2) *(ALAS u32x4s*)(LW + W_Q + (tau * QROW + c8) * 2) = rq[g]; }
            }
            float gl[32]; float Btot = 0.f;
#pragma unroll
            for (int tau = 0; tau < 32; ++tau) { const float f = lb + (1.f - lb) * sigmoidf_(bf2f(*(const ALAS bf16_t*)(LW + W_K + (tau * QROW + lane) * 2))); gl[tau] = fmaxf(__logf(f), -80.f); Btot += gl[tau]; }
            { float run = 0.f;
#pragma unroll
              for (int tau = 0; tau < 32; ++tau) { run += gl[tau]; const float kk = 1.f - __expf(gl[tau]);
                *(ALAS bf16_t*)(LW + W_KH + img_off(tau, lane)) = f2bf(kk * __expf(Btot - run));
                if (PASS == 2) { ALAS bf16_t* qp = (ALAS bf16_t*)(LW + W_Q + (tau * QROW + lane) * 2); *qp = f2bf(bf2f(*qp) * 0.125f * __expf(run));
                                 *(ALAS bf16_t*)(LW + W_K + (tau * QROW + lane) * 2) = f2bf(kk * __expf(fminf(-run, 80.f))); } } }
            f32x16 sl[2][2];
#pragma unroll
            for (int cv = 0; cv < 2; ++cv)
#pragma unroll
                for (int cd = 0; cd < 2; ++cd) sl[cv][cd] = f32x16{};
            bf16x8 vfr[2][2];
#pragma unroll
            for (int ks = 0; ks < 2; ++ks)
#pragma unroll
                for (int ch = 0; ch < 2; ++ch) { const s16x4 lo = att::vtr(trb + W_V + (ch * 2 + ks) * 1024), hh = att::vtr(trb + W_V + (ch * 2 + ks) * 1024 + 512);
                    vfr[ks][ch] = (bf16x8){lo[0], lo[1], lo[2], lo[3], hh[0], hh[1], hh[2], hh[3]}; }
#pragma unroll
            for (int ks = 0; ks < 2; ++ks)
#pragma unroll
                for (int cd = 0; cd < 2; ++cd) { const s16x4 lo = att::vtr(trb + W_KH + (cd * 2 + ks) * 1024), hh = att::vtr(trb + W_KH + (cd * 2 + ks) * 1024 + 512);
                    const bf16x8 kf = (bf16x8){lo[0], lo[1], lo[2], lo[3], hh[0], hh[1], hh[2], hh[3]};
#pragma unroll
                    for (int cv = 0; cv < 2; ++cv) sl[cv][cd] = __builtin_amdgcn_mfma_f32_32x32x16_bf16(vfr[ks][cv], kf, sl[cv][cd], 0, 0, 0); }
            f32x16 o[2]; o[0] = f32x16{}; o[1] = f32x16{};
            bf16x8 qf[4];
            if (PASS == 2) {
                f32x16 c = f32x16{};
#pragma unroll
                for (int d0 = 0; d0 < 4; ++d0) { qf[d0] = *(const ALAS bf16x8*)(LW + W_Q + (r32 * QROW + 16 * d0 + 8 * hi) * 2);
                    const bf16x8 kf = *(const ALAS bf16x8*)(LW + W_K + (r32 * QROW + 16 * d0 + 8 * hi) * 2);
                    c = __builtin_amdgcn_mfma_f32_32x32x16_bf16(kf, qf[d0], c, 0, 0, 0); }
#pragma unroll
                for (int r = 0; r < 16; ++r) { const int srow = att::crow(r, hi); if (srow > r32) c[r] = 0.f; }
#pragma unroll
                for (int ks = 0; ks < 2; ++ks) { const uint4 q4 = make_uint4(att::cvtpk(c[8 * ks], c[8 * ks + 1]), att::cvtpk(c[8 * ks + 2], c[8 * ks + 3]), att::cvtpk(c[8 * ks + 4], c[8 * ks + 5]), att::cvtpk(c[8 * ks + 6], c[8 * ks + 7]));
                    const bf16x8 pa = __builtin_bit_cast(bf16x8, q4);
                    o[0] = __builtin_amdgcn_mfma_f32_32x32x16_bf16(pa, vfr[ks][0], o[0], 0, 0, 0); o[1] = __builtin_amdgcn_mfma_f32_32x32x16_bf16(pa, vfr[ks][1], o[1], 0, 0, 0); }
            }
            if constexpr (PASS == 1) {
            __syncthreads();
            ALAS float* SL = (ALAS float*)LW; ALAS float* BARR = (ALAS float*)(L3 + LDS_MISC_HGB); ALAS float* DARR = BARR + 8 * 64;
            float Bacc = Btot;
            int sbase = (4 * hi) * STROW + r32; asm volatile("" : "+v"(sbase));
#pragma unroll
            for (int cv = 0; cv < 2; ++cv)
#pragma unroll
                for (int cd = 0; cd < 2; ++cd)
#pragma unroll
                    for (int r = 0; r < 16; ++r) SL[sbase + (32 * cv + (r & 3) + 8 * (r >> 2)) * STROW + 32 * cd] = sl[cv][cd][r];
            BARR[wid * 64 + lane] = Bacc;
            __syncthreads();
            {
                float spA[16], spB[16]; float bp = 0.f, dkq[2] = {1.f, 1.f};
#define HG_RD(dst, cv_, cd_, sh_) do { if (wid >= (sh_)) { const ALAS float* PS_ = (const ALAS float*)(L3 + (wid - (sh_)) * W_BYTES); _Pragma("unroll") for (int r = 0; r < 16; ++r) \
                    dst[r] = PS_[sbase + (32 * (cv_) + (r & 3) + 8 * (r >> 2)) * STROW + 32 * (cd_)]; } } while (0)
#define HG_WR(src, cv_, cd_, sh_) do { if (wid >= (sh_)) { _Pragma("unroll") for (int r = 0; r < 16; ++r) { sl[cv_][cd_][r] = dkq[cd_] * src[r] + sl[cv_][cd_][r]; \
                    SL[sbase + (32 * (cv_) + (r & 3) + 8 * (r >> 2)) * STROW + 32 * (cd_)] = sl[cv_][cd_][r]; } } } while (0)
#define HG_STEP_BEGIN(sh_) do { if (wid >= (sh_)) { bp = BARR[(wid - (sh_)) * 64 + lane]; const float dk_ = __expf(Bacc); dkq[0] = __shfl(dk_, r32); dkq[1] = __shfl(dk_, 32 + r32); } } while (0)
#define HG_STEP_END(sh_) do { if (wid >= (sh_)) { Bacc += bp; BARR[wid * 64 + lane] = Bacc; } } while (0)
#define HG_STEP(sh_) do { HG_STEP_BEGIN(sh_); HG_RD(spA, 0, 0, sh_); __syncthreads(); \
                HG_WR(spA, 0, 0, sh_); HG_RD(spB, 0, 1, sh_); __syncthreads(); \
                HG_WR(spB, 0, 1, sh_); HG_RD(spA, 1, 0, sh_); __syncthreads(); \
                HG_WR(spA, 1, 0, sh_); HG_RD(spB, 1, 1, sh_); __syncthreads(); \
                HG_WR(spB, 1, 1, sh_); HG_STEP_END(sh_); __syncthreads(); } while (0)
                HG_STEP(1); HG_STEP(2); HG_STEP(4);
#undef HG_STEP
#undef HG_RD
#undef HG_WR
#undef HG_STEP_BEGIN
#undef HG_STEP_END
            }
            if (PASS == 1) {
                float* ag = AGG + ((size_t)((b * 4 + h) * 2 + d) * 9 + sc) * AGG_FLOATS; const ALAS float* S7 = (const ALAS float*)(L3 + 7 * W_BYTES);
                for (int e = tid; e < 4096; e += NT) ag[e] = S7[(e >> 6) * STROW + (e & 63)];
                if (tid < 64) ag[4096 + tid] = BARR[7 * 64 + tid];
                __syncthreads();
            }
            }
            if constexpr (PASS == 2) {
            __syncthreads();
#pragma unroll 1
            for (int step = 0; step < 8; ++step) {
                if (wid == step) {
                    if (PASS == 2) {
#pragma unroll
                        for (int cv = 0; cv < 2; ++cv)
#pragma unroll
                            for (int d0 = 0; d0 < 4; ++d0) { const ALAS float* sp = ST + (32 * cv + r32) * STROW + 16 * d0 + 8 * hi; const f32x4v s0 = *(const ALAS f32x4v*)sp, s1 = *(const ALAS f32x4v*)(sp + 4);
                                const uint4 q4 = make_uint4(att::cvtpk(s0[0], s0[1]), att::cvtpk(s0[2], s0[3]), att::cvtpk(s1[0], s1[1]), att::cvtpk(s1[2], s1[3]));
                                o[cv] = __builtin_amdgcn_mfma_f32_32x32x16_bf16(qf[d0], __builtin_bit_cast(bf16x8, q4), o[cv], 0, 0, 0); }
                    }
                    const float dk = __expf(Btot);
                    int sbase = (4 * hi) * STROW + r32; asm volatile("" : "+v"(sbase));
#pragma unroll
                    for (int cd = 0; cd < 2; ++cd) { const float dkd = __shfl(dk, 32 * cd + r32);
#pragma unroll
                        for (int cv = 0; cv < 2; ++cv)
#pragma unroll
                            for (int r = 0; r < 16; ++r) { ALAS float* sp = ST + sbase + (32 * cv + (r & 3) + 8 * (r >> 2)) * STROW + 32 * cd; *sp = dkd * *sp + sl[cv][cd][r]; } }
                    BS[lane] += Btot;
                }
                __syncthreads();
            }
                if (d == 0) {
                    int base = (32 * wid + 4 * hi) * 64 + r32; asm volatile("" : "+v"(base));
#pragma unroll
                    for (int r = 0; r < 16; ++r) { const int off = base + ((r & 3) + 8 * (r >> 2)) * 64; OSG[off] = o[0][r]; OSG[off + 32] = o[1][r]; }
                }
                else {
                    ALAS float* OS = (ALAS float*)L3;
                    int base = (255 - 32 * wid - 4 * hi) * 64 + r32; asm volatile("" : "+v"(base));
                    float g0[16], g1[16];
#pragma unroll
                    for (int r = 0; r < 16; ++r) { const int off = base - ((r & 3) + 8 * (r >> 2)) * 64; g0[r] = OSG[off]; g1[r] = OSG[off + 32]; }
#pragma unroll
                    for (int r = 0; r < 16; ++r) { const int off = base - ((r & 3) + 8 * (r >> 2)) * 64; OS[off] = o[0][r] + g0[r]; OS[off + 32] = o[1][r] + g1[r]; }
                    __syncthreads();
                    { int tl = 32 * wid + (lane >> 1); asm volatile("" : "+v"(tl)); const int half = lane & 1; float ov[32]; float ss = 0.f;
#pragma unroll
                      for (int i = 0; i < 32; ++i) { ov[i] = OS[tl * 64 + half * 32 + i]; ss += ov[i] * ov[i]; }
                      ss += __shfl_xor(ss, 1);
                      const float rs = rsqrtf(ss * (1.f / 64.f) + EPS);
                      const size_t row = (size_t)(jbase + tl); const bf16_t* zg = Z + row * NZ + ZD_G + h * 64 + half * 32; bf16_t* yo = Y + row * D + 768 + h * 64 + half * 32;
#pragma unroll
                      for (int i = 0; i < 4; ++i) { unsigned w4[4];
#pragma unroll
                          for (int k2 = 0; k2 < 4; ++k2) { const int c0 = 8 * i + 2 * k2; w4[k2] = att::cvtpk(ov[c0] * rs * gn[h * 64 + half * 32 + c0] * siluf_(bf2f(zg[c0])), ov[c0 + 1] * rs * gn[h * 64 + half * 32 + c0 + 1] * siluf_(bf2f(zg[c0 + 1]))); }
                          *(uint4*)(yo + 8 * i) = make_uint4(w4[0], w4[1], w4[2], w4[3]); } }
                    __syncthreads();
                }
            }
        }
    }
}

__device__ __forceinline__ void ph_router(const P& p, int l, unsigned char* ldsb, bool dry = false) {
    const int tidx = p.wid * 64 + fresh_lane();
    const bf16_t* X = (const bf16_t*)(p.ws + WS_X); bf16_t* H = (bf16_t*)(p.ws + WS_H); const float* xin = p.in[I_X]; const float* cin = p.in[I_CTX]; const bf16_t* D1 = (const bf16_t*)(p.ws + WS_D1);
#define RLOAD(r_) do { _Pragma("unroll") for (int q = 0; q < 4; ++q) { if (l == 0) vn[q] = *(const float4*)(xin_row(xin, cin, (r_)) + (lane + 64 * q) * 4); else xn[q] = *(const uint2*)(X + (size_t)(r_) * D + (lane + 64 * q) * 4); \
            dn[q] = *(const uint2*)(D1 + (size_t)(r_) * D + (lane + 64 * q) * 4); } } while (0)
    float2* GP = (float2*)(p.ws + WS_GP); int* LISTP = (int*)(p.ws + WS_LISTP); unsigned* CNT = (unsigned*)(p.ws + WS_CNT) + l * 32;
    const float* MOD = (const float*)(p.ws + WS_MOD) + (size_t)l * 9 * 6 * D; const float* g = p.in[I_N2G] + l * D;
    const float* RW = p.in[I_RW]; const float* RB = p.in[I_RB];
    ALAS int* lc = (ALAS int*)ldsb; ALAS int* lbase = lc + 32; ALAS int* rpair = lc + 64; ALAS int* rrank = lc + 64 + 72;
    const int lane = tidx & 63, wv = tidx >> 6;
    typedef float f32x4r __attribute__((ext_vector_type(4))); ALAS f32x4r* RWs = (ALAS f32x4r*)(ldsb - LDS_MISC);
    { f32x4r rwv[8];
#pragma unroll
      for (int u = 0; u < 8; ++u) { const int idx = tidx + u * NT; const int ln = idx & 63, e4 = (idx >> 6) & 3, i = (idx >> 8) & 3, q = idx >> 10; rwv[u] = *(const f32x4r*)(RW + (size_t)((ln + 64 * q) * 4 + i) * 16 + e4 * 4); }
#pragma unroll
      for (int u = 0; u < 8; ++u) RWs[tidx + u * NT] = rwv[u]; }
    __syncthreads();
    ALAS float* LG = (ALAS float*)(ldsb - LDS_MISC + 65536);
    float4 gq[4];
#pragma unroll
    for (int q = 0; q < 4; ++q) gq[q] = *(const float4*)(g + (lane + 64 * q) * 4);
    for (int chunk = blockIdx.x; chunk < R / 72; chunk += gridDim.x) {
        if (tidx < 32) lc[tidx] = 0;
        const int rbase = chunk * 72 + wv * 9;
        float4 vn[4]; uint2 dn[4], xn[4];
        RLOAD(rbase);
#pragma unroll 1
        for (int k = 0; k < 9; ++k) {
            const int li = wv * 9 + k, r = rbase + k;
            const float* m = MOD + (size_t)row_mi(r) * 6 * D; float4 scq[4], shq[4];
#pragma unroll
            for (int q = 0; q < 4; ++q) { scq[q] = *(const float4*)(m + 4 * D + (lane + 64 * q) * 4); shq[q] = *(const float4*)(m + 3 * D + (lane + 64 * q) * 4); }
            float4 v[4];
#pragma unroll
            for (int q = 0; q < 4; ++q) { float t4[4] = {0.f, 0.f, 0.f, 0.f}; if (l == 0) { t4[0] = vn[q].x; t4[1] = vn[q].y; t4[2] = vn[q].z; t4[3] = vn[q].w; } else add_bf4(t4, xn[q]); add_bf4(t4, dn[q]); v[q] = make_float4(t4[0], t4[1], t4[2], t4[3]); }
            { const int rn = rbase + (k < 8 ? k + 1 : 8);
              RLOAD(rn); }
            float ss = 0.f;
#pragma unroll
            for (int q = 0; q < 4; ++q) ss += v[q].x * v[q].x + v[q].y * v[q].y + v[q].z * v[q].z + v[q].w * v[q].w;
            const float rs = rsqrtf(wave_sum(ss) * (1.f / D) + EPS);
            float lg[16];
#pragma unroll
            for (int e = 0; e < 16; ++e) lg[e] = 0.f;
#pragma unroll
            for (int q = 0; q < 4; ++q) { const int c = (lane + 64 * q) * 4; const float xv[4] = {v[q].x, v[q].y, v[q].z, v[q].w};
                const float4 g4 = gq[q], sc4 = scq[q], sh4 = shq[q];
                const float gv[4] = {g4.x, g4.y, g4.z, g4.w}, scv[4] = {sc4.x, sc4.y, sc4.z, sc4.w}, shv[4] = {sh4.x, sh4.y, sh4.z, sh4.w}; bf16_t o[4];
#pragma unroll
                for (int i = 0; i < 4; ++i) { const float hv = xv[i] * rs * gv[i] * (1.f + scv[i]) + shv[i]; o[i] = f2bf(hv);
#pragma unroll
                    for (int e4 = 0; e4 < 4; ++e4) { const f32x4r w4 = RWs[((q * 4 + i) * 4 + e4) * 64 + lane]; lg[e4 * 4 + 0] += hv * w4[0]; lg[e4 * 4 + 1] += hv * w4[1]; lg[e4 * 4 + 2] += hv * w4[2]; lg[e4 * 4 + 3] += hv * w4[3]; } }
                *(uint2*)(H + (size_t)r * D + c) = make_uint2((unsigned)o[0] | ((unsigned)o[1] << 16), (unsigned)o[2] | ((unsigned)o[3] << 16));
                __builtin_amdgcn_sched_barrier(0); }
            float a8[8], a4[4], a2[2], a1;
            { const bool hb = (lane & 32) != 0;
#pragma unroll
              for (int i = 0; i < 8; ++i) { const float snd = hb ? lg[i] : lg[8 + i], kp = hb ? lg[8 + i] : lg[i]; a8[i] = kp + __shfl_xor(snd, 32); } }
            { const bool hb = (lane & 16) != 0;
#pragma unroll
              for (int i = 0; i < 4; ++i) { const float snd = hb ? a8[i] : a8[4 + i], kp = hb ? a8[4 + i] : a8[i]; a4[i] = kp + __shfl_xor(snd, 16); } }
            { const bool hb = (lane & 8) != 0;
#pragma unroll
              for (int i = 0; i < 2; ++i) { const float snd = hb ? a4[i] : a4[2 + i], kp = hb ? a4[2 + i] : a4[i]; a2[i] = kp + __shfl_xor(snd, 8); } }
            { const bool hb = (lane & 4) != 0; const float snd = hb ? a2[0] : a2[1], kp = hb ? a2[1] : a2[0]; a1 = kp + __shfl_xor(snd, 4); }
            a1 += __shfl_xor(a1, 2); a1 += __shfl_xor(a1, 1);
            if ((lane & 3) == 0) LG[li * 16 + (lane >> 2)] = a1 + RB[lane >> 2];
        }
        __syncthreads();
        if (tidx < 72) {
            const int r = chunk * 72 + tidx; float lg[16];
#pragma unroll
            for (int e = 0; e < 16; ++e) lg[e] = LG[tidx * 16 + e];
            float mx = lg[0];
#pragma unroll
            for (int e = 1; e < 16; ++e) mx = fmaxf(mx, lg[e]);
            float sc[16], sum = 0.f;
#pragma unroll
            for (int e = 0; e < 16; ++e) { sc[e] = expf(lg[e] - mx); sum += sc[e]; }
            const float inv = 1.f / sum;
#pragma unroll
            for (int e = 0; e < 16; ++e) sc[e] *= inv;
            int gsel = 0; float gbest = -1.f;
#pragma unroll
            for (int gI = 0; gI < 4; ++gI) { const float s0 = sc[gI * 4], s1 = sc[gI * 4 + 1], s2 = sc[gI * 4 + 2], s3 = sc[gI * 4 + 3];
                const float m1 = fmaxf(s0, s1), n1 = fminf(s0, s1), m2 = fmaxf(s2, s3), n2 = fminf(s2, s3);
                const float gs = fmaxf(m1, m2) + fmaxf(fminf(m1, m2), fmaxf(n1, n2)); const bool c = gs > gbest; gbest = c ? gs : gbest; gsel = c ? gI : gsel; }
            float s4[4];
#pragma unroll
            for (int i = 0; i < 4; ++i) s4[i] = gsel == 0 ? sc[i] : (gsel == 1 ? sc[4 + i] : (gsel == 2 ? sc[8 + i] : sc[12 + i]));
            float w1 = s4[0]; int i1 = 0;
#pragma unroll
            for (int i = 1; i < 4; ++i) { const bool c = s4[i] > w1; w1 = c ? s4[i] : w1; i1 = c ? i : i1; }
            float w2 = -1.f; int i2 = 0;
#pragma unroll
            for (int i = 0; i < 4; ++i) { const bool c = (i != i1) && (s4[i] > w2); w2 = c ? s4[i] : w2; i2 = c ? i : i2; }
            const float wn = 1.f / (w1 + w2);
            const int a = i1 < i2 ? i1 : i2, bq = i1 < i2 ? i2 : i1;
            const int q = a == 0 ? bq - 1 : (a == 1 ? bq + 1 : 5);
            const int pr = gsel * 6 + q; const bool skip = (l == 1 && (r % LB) < TC);
            GP[r] = i1 < i2 ? make_float2(w1 * wn, w2 * wn) : make_float2(w2 * wn, w1 * wn);
            rpair[tidx] = skip ? -1 : pr;
            if (!skip) rrank[tidx] = __hip_atomic_fetch_add(&lc[pr], 1, __ATOMIC_RELAXED, __HIP_MEMORY_SCOPE_WORKGROUP);
        }
        __syncthreads();
        if (tidx < 24) lbase[tidx] = (lc[tidx] && !dry) ? (int)atomicAdd(&CNT[tidx], (unsigned)lc[tidx]) : 0;
        __syncthreads();
        if (tidx < 72 && !dry) { const int pr = rpair[tidx]; if (pr >= 0) LISTP[(size_t)pr * R + lbase[pr] + rrank[tidx]] = chunk * 72 + tidx; }
        __syncthreads();
    }
}

__device__ __forceinline__ void ph_final(const P& p) {
    const int tidx = p.wid * 64 + fresh_lane();
    const bf16_t* X = (const bf16_t*)(p.ws + WS_X); const float* g = p.in[I_FNG]; const bf16_t* D1 = (const bf16_t*)(p.ws + WS_D1); const bf16_t* D2 = (const bf16_t*)(p.ws + WS_D2);
    const int lane = tidx & 63, wv = tidx >> 6;
    const int stride = gridDim.x * NWV; const int i0 = blockIdx.x * NWV + wv;
    float4 gq[4];
#pragma unroll
    for (int q = 0; q < 4; ++q) gq[q] = *(const float4*)(g + (lane + 64 * q) * 4);
#define FROW(i_) ((size_t)(((i_) / T) * LB + TC + ((i_) % T)))
    for (int ib = i0; ib < NB * T; ib += 8 * stride) {
        uint2 vb[3][4], d1b[3][4], d2b[3][4];
#define FN_LOAD(slot, k_) do { int ii_ = ib + (k_) * stride; ii_ = ii_ < NB * T ? ii_ : ib; const size_t rr_ = FROW(ii_); _Pragma("unroll") for (int q = 0; q < 4; ++q) { vb[slot][q] = *(const uint2*)(X + rr_ * D + (lane + 64 * q) * 4); \
            d1b[slot][q] = *(const uint2*)(D1 + rr_ * D + (lane + 64 * q) * 4); d2b[slot][q] = *(const uint2*)(D2 + rr_ * D + (lane + 64 * q) * 4); } } while (0)
        FN_LOAD(0, 0); FN_LOAD(1, 1);
#pragma unroll
        for (int k = 0; k < 8; ++k) {
            const int it = ib + k * stride; const int sl = k % 3;
            if (k + 2 < 8) FN_LOAD((k + 2) % 3, k + 2);
            if (it < NB * T) {
                float xv[4][4]; float ss = 0.f;
#pragma unroll
                for (int q = 0; q < 4; ++q) { xv[q][0] = xv[q][1] = xv[q][2] = xv[q][3] = 0.f; add_bf4(xv[q], vb[sl][q]); add_bf4(xv[q], d1b[sl][q]); add_bf4(xv[q], d2b[sl][q]); }
#pragma unroll
                for (int q = 0; q < 4; ++q) ss += xv[q][0] * xv[q][0] + xv[q][1] * xv[q][1] + xv[q][2] * xv[q][2] + xv[q][3] * xv[q][3];
                const float rs = rsqrtf(wave_sum(ss) * (1.f / D) + EPS);
#pragma unroll
                for (int q = 0; q < 4; ++q) { const int c = (lane + 64 * q) * 4; const float4 gg = gq[q];
                    *(float4*)(p.out + (size_t)it * D + c) = make_float4(xv[q][0] * rs * gg.x, xv[q][1] * rs * gg.y, xv[q][2] * rs * gg.z, xv[q][3] * rs * gg.w); }
            }
        }
#undef FN_LOAD
    }
#undef FROW
}

namespace pg8 {
#define PG8_LAS __attribute__((address_space(3)))
typedef short bf16x8 __attribute__((ext_vector_type(8)));
typedef float f32x4 __attribute__((ext_vector_type(4)));
typedef unsigned u32x4 __attribute__((ext_vector_type(4)));
constexpr int BM = 256, BK = 64, HALF = 128, HTB = HALF * BK * 2, STAGE_BYTES = 8 * HTB, NXCD = 8, WGM = 8;
__host__ __device__ __forceinline__ int lds_byte(int r, int c) { const int st = (r >> 4) * 2 + (c >> 5), rr = r & 15, cc = c & 31, ob = rr * 64 + cc * 2; return st * 1024 + (ob ^ (((ob >> 9) & 1) << 5)); }
__host__ __device__ __forceinline__ void stage_rc(int b, int& R, int& C) { const int st = b / 1024, sb = b % 1024, swz = sb ^ (((sb >> 9) & 1) << 5); R = (st >> 1) * 16 + swz / 64; C = (st & 1) * 32 + (swz % 64) / 2; }
__host__ __device__ __forceinline__ int perm32(int rho) { const int n = rho >> 4, i = rho & 15; return 8 * (i >> 2) + 4 * n + (i & 3); }
__device__ __forceinline__ unsigned cvt_pk_bf16(float lo, float hi) { unsigned r; asm volatile("v_cvt_pk_bf16_f32 %0, %1, %2" : "=v"(r) : "v"(lo), "v"(hi)); return r; }
struct Unit { int pm, pn, aux; };
__device__ __forceinline__ void static_unit(int L, int nM, int nN, int& pm, int& pn) {
    const int nwg = nM * nN; int wgid = L; { const int q = nwg / NXCD, r = nwg % NXCD, xcd = wgid % NXCD, off = wgid / NXCD; wgid = (xcd < r ? xcd * (q + 1) : r * (q + 1) + (xcd - r) * q) + off; }
    const int nig = WGM * nN, gid = wgid / nig, fm = gid * WGM, gsz = (nM - fm) < WGM ? (nM - fm) : WGM;
    pm = fm + ((wgid % nig) % gsz); pn = (wgid % nig) / gsz;
}
__device__ __forceinline__ bool static_next(int i, int G, int c, int nM, int nN, int& pm, int& pn) {
    const int nwg = nM * nN; const long L = (long)i * G + c; if (L >= nwg) return false;
    int wgid = (int)L; { const int q = nwg / NXCD, r = nwg % NXCD, xcd = wgid % NXCD, off = wgid / NXCD; wgid = (xcd < r ? xcd * (q + 1) : r * (q + 1) + (xcd - r) * q) + off; }
    const int nig = WGM * nN, gid = wgid / nig, fm = gid * WGM, gsz = (nM - fm) < WGM ? (nM - fm) : WGM;
    pm = fm + ((wgid % nig) % gsz); pn = (wgid % nig) / gsz; return true;
}
template <class PB, bool ALIGN_EPI, bool HN = false>
__device__ __forceinline__ void gemm_phase(PG8_LAS unsigned char* lds, const PB& S, const int wid) {
    const int lane = fresh_lane(), tid = wid * 64 + lane, wr = wid >> 2, wc = wid & 3, fr = lane & 15, fq = lane >> 4;
    const int nt = S.nt;
    int Rst[2], Cst[2]; unsigned voffB[2];
#pragma unroll
    for (int i = 0; i < 2; ++i) { int R_, C_; stage_rc(tid * 16 + i * 8192, R_, C_); Rst[i] = R_; Cst[i] = C_; const int Rb = PB::PERM ? ((R_ & ~31) + perm32(R_ & 31)) : R_; voffB[i] = (unsigned)(Rb * S.ldb + C_) * 2u; }
    const size_t kstep = (size_t)(BK * 2);
    const size_t hstepB = (size_t)HALF * S.ldb * 2;
    const unsigned ldsw = (unsigned)wid * 1024u;
    const int aoff = lds_byte(wr * 64 + fr, fq * 8), boff = lds_byte(wc * 32 + fr, fq * 8);
#define PG8_SA(b, h) (((b) * 2 + (h)) * HTB)
#define PG8_SB(b, h) ((4 + (b) * 2 + (h)) * HTB)
#define PG8_STAGE(bufoff, gbase, voff) do { _Pragma("unroll") for (int _i = 0; _i < 2; ++_i) { unsigned _o = (voff)[_i]; asm volatile("" : "+v"(_o)); \
        __builtin_amdgcn_global_load_lds((const unsigned*)((const char*)(gbase) + _o), (PG8_LAS unsigned*)(lds + (bufoff) + ldsw + _i * 8192), 16, 0, 0); } } while (0)
#define PG8_LDA(dst, b, h) do { _Pragma("unroll") for (int m = 0; m < 4; ++m) _Pragma("unroll") for (int k = 0; k < 2; ++k) dst[m][k] = *(const PG8_LAS bf16x8*)(lds + PG8_SA(b, h) + aoff + m * 2048 + k * 1024); } while (0)
#define PG8_LDB(dst, b, h) do { _Pragma("unroll") for (int n = 0; n < 2; ++n) _Pragma("unroll") for (int k = 0; k < 2; ++k) dst[n][k] = *(const PG8_LAS bf16x8*)(lds + PG8_SB(b, h) + boff + n * 2048 + k * 1024); } while (0)
#define PG8_MMA(ai, bj, At, Bt) do { __builtin_amdgcn_s_setprio(1); _Pragma("unroll") for (int m = 0; m < 4; ++m) _Pragma("unroll") for (int n = 0; n < 2; ++n) _Pragma("unroll") for (int k = 0; k < 2; ++k) \
        acc[ai][bj][m][n] = __builtin_amdgcn_mfma_f32_16x16x32_bf16(Bt[n][k], At[m][k], acc[ai][bj][m][n], 0, 0, 0); __builtin_amdgcn_s_setprio(0); } while (0)
#define PG8_WAIT_V(n) asm volatile("s_waitcnt vmcnt(" #n ")" ::: "memory")
#define PG8_WAIT_L(n) asm volatile("s_waitcnt lgkmcnt(" #n ")" ::: "memory")
#define PG8_BAR __builtin_amdgcn_s_barrier()
#define PG8_SCHED __builtin_amdgcn_sched_barrier(0)
    Unit cur, nxt; int ui = 0;
    if (!S.next(0, cur)) return;
    f32x4 acc[2][2][4][2];
#pragma unroll
    for (int a = 0; a < 2; ++a)
#pragma unroll
        for (int b = 0; b < 2; ++b)
#pragma unroll
            for (int m = 0; m < 4; ++m)
#pragma unroll
                for (int n = 0; n < 2; ++n) acc[a][b][m][n] = (f32x4){0.f, 0.f, 0.f, 0.f};
    bf16x8 At[4][2], B0[2][2], B1[2][2];
    unsigned vc[2][2], vn[2][2];
    S.a_off(cur, Rst, Cst, vc); asm volatile("" : "+v"(vc[0][0]), "+v"(vc[0][1]), "+v"(vc[1][0]), "+v"(vc[1][1]));
    const char* gA = S.A;
    { const char* cB = S.b_ptr(cur, 0); const char* cB1 = S.b_ptr(cur, 1);
      if constexpr (HN) {
      PG8_STAGE(PG8_SB(0, 0), cB, voffB); PG8_STAGE(PG8_SA(0, 0), gA, vc[0]); PG8_STAGE(PG8_SA(0, 1), gA, vc[1]);
      if (wr == 1) PG8_BAR;
      PG8_WAIT_V(2); PG8_BAR;
      PG8_STAGE(PG8_SB(1, 0), cB1, voffB); PG8_STAGE(PG8_SA(1, 0), gA + kstep, vc[0]);
      PG8_WAIT_V(4); PG8_BAR;
      } else {
      PG8_STAGE(PG8_SB(0, 0), cB, voffB); PG8_STAGE(PG8_SB(0, 1), cB + hstepB, voffB); PG8_STAGE(PG8_SA(0, 0), gA, vc[0]); PG8_STAGE(PG8_SA(0, 1), gA, vc[1]);
      if (wr == 1) PG8_BAR;
      PG8_WAIT_V(2); PG8_BAR;
      PG8_STAGE(PG8_SB(1, 0), cB1, voffB); PG8_STAGE(PG8_SA(1, 0), gA + kstep, vc[0]); PG8_STAGE(PG8_SB(1, 1), cB1 + hstepB, voffB);
      PG8_WAIT_V(6); PG8_BAR; } }
    for (;;) {
        const bool has_next = S.next(ui + 1, nxt);
        if (has_next) { S.a_off(nxt, Rst, Cst, vn); asm volatile("" : "+v"(vn[0][0]), "+v"(vn[0][1]), "+v"(vn[1][0]), "+v"(vn[1][1])); }
        else { vn[0][0] = vc[0][0]; vn[0][1] = vc[0][1]; vn[1][0] = vc[1][0]; vn[1][1] = vc[1][1]; nxt = cur; }
        for (int t = 0; t < nt; t += 2) {
            const bool last = (t == nt - 2);
            const char* a1 = gA + (size_t)(t + 1) * kstep;
            const char* a2 = last ? gA : gA + (size_t)(t + 2) * kstep; const char* a3 = a2 + kstep;
            const char* b2 = last ? S.b_ptr(nxt, 0) : S.b_ptr(cur, t + 2);
            const char* b3 = last ? S.b_ptr(nxt, 1) : S.b_ptr(cur, t + 3);
            unsigned o2a[2], o2b[2];
            o2a[0] = last ? vn[0][0] : vc[0][0]; o2a[1] = last ? vn[0][1] : vc[0][1]; o2b[0] = last ? vn[1][0] : vc[1][0]; o2b[1] = last ? vn[1][1] : vc[1][1];
            if constexpr (HN) {
            PG8_LDB(B0, 0, 0); PG8_SCHED; PG8_LDA(At, 0, 0); PG8_STAGE(PG8_SA(1, 1), a1, vc[1]);
            PG8_WAIT_V(6); PG8_WAIT_L(0); PG8_BAR; PG8_MMA(0, 0, At, B0); PG8_BAR; PG8_SCHED;
            PG8_LDA(At, 0, 1); PG8_STAGE(PG8_SB(0, 0), b2, voffB); PG8_STAGE(PG8_SA(0, 0), a2, o2a);
            PG8_WAIT_V(6); PG8_WAIT_L(0); PG8_BAR; PG8_MMA(1, 0, At, B0); PG8_BAR; PG8_SCHED;
            PG8_LDB(B0, 1, 0); PG8_SCHED; PG8_LDA(At, 1, 0); PG8_STAGE(PG8_SA(0, 1), a2, o2b);
            PG8_WAIT_V(6); PG8_WAIT_L(0); PG8_BAR; PG8_MMA(0, 0, At, B0); PG8_BAR; PG8_SCHED;
            PG8_LDA(At, 1, 1); PG8_STAGE(PG8_SB(1, 0), b3, voffB); PG8_STAGE(PG8_SA(1, 0), a3, o2a);
            PG8_WAIT_V(6); PG8_WAIT_L(0); PG8_BAR; PG8_MMA(1, 0, At, B0); PG8_BAR; PG8_SCHED;
            } else {
            PG8_LDB(B0, 0, 0); PG8_LDB(B1, 0, 1); PG8_SCHED; PG8_LDA(At, 0, 0); PG8_STAGE(PG8_SA(1, 1), a1, vc[1]);
            PG8_WAIT_V(8); PG8_WAIT_L(0); PG8_BAR; PG8_MMA(0, 0, At, B0); PG8_MMA(0, 1, At, B1); PG8_BAR; PG8_SCHED;
            PG8_LDA(At, 0, 1); PG8_STAGE(PG8_SB(0, 0), b2, voffB); PG8_STAGE(PG8_SB(0, 1), b2 + hstepB, voffB); PG8_STAGE(PG8_SA(0, 0), a2, o2a);
            PG8_WAIT_V(8); PG8_WAIT_L(0); PG8_BAR; PG8_MMA(1, 0, At, B0); PG8_MMA(1, 1, At, B1); PG8_BAR; PG8_SCHED;
            PG8_LDB(B0, 1, 0); PG8_LDB(B1, 1, 1); PG8_SCHED; PG8_LDA(At, 1, 0); PG8_STAGE(PG8_SA(0, 1), a2, o2b);
            PG8_WAIT_V(8); PG8_WAIT_L(0); PG8_BAR; PG8_MMA(0, 0, At, B0); PG8_MMA(0, 1, At, B1); PG8_BAR; PG8_SCHED;
            PG8_LDA(At, 1, 1); PG8_STAGE(PG8_SB(1, 0), b3, voffB); PG8_STAGE(PG8_SB(1, 1), b3 + hstepB, voffB); PG8_STAGE(PG8_SA(1, 0), a3, o2a);
            PG8_WAIT_V(8); PG8_WAIT_L(0); PG8_BAR; PG8_MMA(1, 0, At, B0); PG8_MMA(1, 1, At, B1); PG8_BAR; PG8_SCHED;
            }
        }
        if constexpr (ALIGN_EPI) { if (wr == 0) PG8_BAR; }
        S.epi(acc, cur, wr, wc, fr, fq);
        if (!has_next) break;
#pragma unroll
        for (int a = 0; a < 2; ++a)
#pragma unroll
            for (int b = 0; b < 2; ++b)
#pragma unroll
                for (int m = 0; m < 4; ++m)
#pragma unroll
                    for (int n = 0; n < 2; ++n) acc[a][b][m][n] = (f32x4){0.f, 0.f, 0.f, 0.f};
        cur = nxt; vc[0][0] = vn[0][0]; vc[0][1] = vn[0][1]; vc[1][0] = vn[1][0]; vc[1][1] = vn[1][1]; ++ui;
        if constexpr (ALIGN_EPI) { if (wr == 1) PG8_BAR; }
    }
    PG8_WAIT_V(0);
    if constexpr (!ALIGN_EPI) { if (wr == 0) PG8_BAR; }
    PG8_BAR;
#undef PG8_SA
#undef PG8_SB
#undef PG8_STAGE
#undef PG8_LDA
#undef PG8_LDB
#undef PG8_MMA
#undef PG8_WAIT_V
#undef PG8_WAIT_L
#undef PG8_BAR
#undef PG8_SCHED
}
}

struct PB_InProj {
    static constexpr bool PERM = true;
    const char* A; int ldb, nt; const char* Bt; bf16_t* Zo; int G, c;
    __device__ __forceinline__ bool next(int i, pg8::Unit& u) const { u.aux = 0; return pg8::static_next(i, G, c, R / 256, NZ / 256, u.pm, u.pn); }
    __device__ __forceinline__ void a_off(const pg8::Unit& u, const int (&Rs)[2], const int (&Cs)[2], unsigned (&off)[2][2]) const {
#pragma unroll
        for (int h = 0; h < 2; ++h)
#pragma unroll
            for (int i = 0; i < 2; ++i) off[h][i] = (unsigned)((u.pm * 256 + h * 128 + Rs[i]) * D + Cs[i]) * 2u; }
    __device__ __forceinline__ const char* b_ptr(const pg8::Unit& u, int t) const { return Bt + (size_t)u.pn * 256 * D * 2 + (size_t)t * 128; }
    __device__ __forceinline__ void epi(const pg8::f32x4 (&acc)[2][2][4][2], const pg8::Unit& u, int wr, int wc, int fr, int fq) const {
        const int row0 = u.pm * 256 + wr * 64 + fr, col0 = u.pn * 256 + wc * 32 + 8 * fq;
#pragma unroll
        for (int ai = 0; ai < 2; ++ai)
#pragma unroll
            for (int m = 0; m < 4; ++m) { bf16_t* rowp = Zo + (size_t)(row0 + ai * 128 + m * 16) * NZ + col0;
#pragma unroll
                for (int bj = 0; bj < 2; ++bj) { const pg8::f32x4 v0 = acc[ai][bj][m][0], v1 = acc[ai][bj][m][1]; pg8::u32x4 w;
                    w.x = pg8::cvt_pk_bf16(v0[0], v0[1]); w.y = pg8::cvt_pk_bf16(v0[2], v0[3]); w.z = pg8::cvt_pk_bf16(v1[0], v1[1]); w.w = pg8::cvt_pk_bf16(v1[2], v1[3]);
                    *(pg8::u32x4*)(rowp + bj * 128) = w; } }
    }
};


struct PB_OutProj {
    static constexpr bool PERM = true;
    const char* A; int ldb, nt; const char* Bt; bf16_t* D1; const float* MODl; int G, c, skipctx; bool dry;
    int tail;
    __device__ __forceinline__ bool next(int i, pg8::Unit& u) const { u.aux = 0; const int nM = skipctx ? 64 : 72, nwg = nM * 4, nfull = (nwg / G) * G, ntail = nwg - nfull; const bool split = ntail > 0 && 2 * ntail <= G;
        int L, half = 0;
        if (tail == 0) { L = i * G + c; if (L >= (split ? nfull : nwg)) return false; }
        else { if (!split || i != 0 || c >= 2 * ntail) return false; L = nfull + (c >> 1); half = c & 1; }
        int pm, pn; pg8::static_unit(L, nM, 4, pm, pn); u.pm = skipctx ? (pm >> 3) * 9 + 1 + (pm & 7) : pm; u.pn = tail ? 2 * pn + half : pn; return true; }
    __device__ __forceinline__ void a_off(const pg8::Unit& u, const int (&Rs)[2], const int (&Cs)[2], unsigned (&off)[2][2]) const {
#pragma unroll
        for (int h = 0; h < 2; ++h)
#pragma unroll
            for (int i = 0; i < 2; ++i) off[h][i] = (unsigned)((u.pm * 256 + h * 128 + Rs[i]) * D + Cs[i]) * 2u; }
    __device__ __forceinline__ const char* b_ptr(const pg8::Unit& u, int t) const { return Bt + (size_t)u.pn * (tail ? 128 : 256) * D * 2 + (size_t)t * 128; }
    __device__ __forceinline__ void epi(const pg8::f32x4 (&acc)[2][2][4][2], const pg8::Unit& u, int wr, int wc, int fr, int fq) const {
        const int row0 = u.pm * 256 + wr * 64 + fr, col0 = u.pn * (tail ? 128 : 256) + wc * 32 + 8 * fq; const int nbj = tail ? 1 : 2;
        const float* gt = MODl + (size_t)row_mi(u.pm * 256) * 6 * D + 2 * D + col0;
        pg8::f32x4 gv[2][2];
#pragma unroll
        for (int bj = 0; bj < 2; ++bj)
#pragma unroll
            for (int n = 0; n < 2; ++n) gv[bj][n] = bj < nbj ? *(const pg8::f32x4*)(gt + bj * 128 + 4 * n) : (pg8::f32x4){0.f, 0.f, 0.f, 0.f};
        if (dry) return;
#pragma unroll
        for (int ai = 0; ai < 2; ++ai)
#pragma unroll
            for (int m = 0; m < 4; ++m) { bf16_t* rowp = D1 + (size_t)(row0 + ai * 128 + m * 16) * D + col0;
#pragma unroll
                for (int bj = 0; bj < 2; ++bj) { if (bj >= nbj) break; const pg8::f32x4 v0 = acc[ai][bj][m][0] * gv[bj][0], v1 = acc[ai][bj][m][1] * gv[bj][1]; pg8::u32x4 w;
                    w.x = pg8::cvt_pk_bf16(v0[0], v0[1]); w.y = pg8::cvt_pk_bf16(v0[2], v0[3]); w.z = pg8::cvt_pk_bf16(v1[0], v1[1]); w.w = pg8::cvt_pk_bf16(v1[2], v1[3]);
                    *(pg8::u32x4*)(rowp + bj * 128) = w; } }
    }
};

__device__ __forceinline__ void moe_tiles_setup(const P& p, int l, ALAS int* tb) {
    const unsigned* CNT = (const unsigned*)(p.ws + WS_CNT) + l * 32;
    __syncthreads();
    if (p.wid == 0 && fresh_lane() == 0) { int acc = 0; for (int q = 0; q < 24; ++q) { const int c = (int)__hip_atomic_load(CNT + q, __ATOMIC_RELAXED, __HIP_MEMORY_SCOPE_AGENT); tb[q] = c; tb[32 + q] = acc; acc += (c + 255) >> 8; } tb[32 + 24] = acc; }
    __syncthreads();
}
__device__ __forceinline__ void pair_experts(int pr, int& e0, int& e1) { const int g4 = (pr / 6) * 4, q = pr % 6; const int a = q < 3 ? 0 : (q < 5 ? 1 : 2), b = q < 3 ? q + 1 : (q < 5 ? q - 1 : 3); e0 = g4 + a; e1 = g4 + b; }

struct PB_Moe1 {
    static constexpr bool PERM = false;
    const char* A; int ldb, nt; const char* W13; bf16_t* HE; const int* LISTP; const float2* GP; const ALAS int* tb; int G, c;
    __device__ __forceinline__ bool next(int i, pg8::Unit& u) const {
        if (!pg8::static_next(i, G, c, tb[32 + 24], 8, u.pm, u.pn)) return false;
        int pr = 0;
        for (int q = 1; q < 24; ++q) if (tb[32 + q] <= u.pm) pr = q;
        u.aux = pr; return true; }
    __device__ __forceinline__ void a_off(const pg8::Unit& u, const int (&Rs)[2], const int (&Cs)[2], unsigned (&off)[2][2]) const {
        const int pr = u.aux, cnt = tb[pr], r0 = (u.pm - tb[32 + pr]) * 256; const int* lp = LISTP + (size_t)pr * R;
#pragma unroll
        for (int h = 0; h < 2; ++h)
#pragma unroll
            for (int i = 0; i < 2; ++i) { int rk = r0 + h * 128 + Rs[i]; rk = rk < cnt ? rk : cnt - 1; off[h][i] = (unsigned)(lp[rk] * D + Cs[i]) * 2u; } }
    __device__ __forceinline__ const char* b_ptr(const pg8::Unit& u, int t) const { int e0, e1; pair_experts(u.aux, e0, e1); const int e = u.pn < 4 ? e0 : e1;
        return W13 + ((size_t)e * 1024 + (size_t)(u.pn & 3) * 256) * D * 2 + (size_t)t * 128; }
    __device__ __forceinline__ void epi(const pg8::f32x4 (&acc)[2][2][4][2], const pg8::Unit& u, int wr, int wc, int fr, int fq) const {
        const int pr = u.aux, cnt = tb[pr], r0 = (u.pm - tb[32 + pr]) * 256; const int* lp = LISTP + (size_t)pr * R;
        const int colh = (u.pn < 4 ? 0 : 512) + (u.pn & 3) * 128 + wc * 16 + 4 * fq;
#pragma unroll
        for (int ai = 0; ai < 2; ++ai)
#pragma unroll
            for (int m = 0; m < 4; ++m) { const int x = ai * 128 + wr * 64 + m * 16 + fr; int rk = r0 + x; rk = rk < cnt ? rk : cnt - 1;
                const float2 gg = GP[lp[rk]]; const float gate = u.pn < 4 ? gg.x : gg.y;
                bf16_t* rowp = HE + (size_t)(u.pm * 256 + x) * 1024 + colh;
#pragma unroll
                for (int bj = 0; bj < 2; ++bj) { const pg8::f32x4 a = acc[ai][bj][m][0], b = acc[ai][bj][m][1]; float o[4];
#pragma unroll
                    for (int j = 0; j < 4; ++j) o[j] = a[j] / (1.f + __expf(-a[j])) * b[j] * gate;
                    *(uint2*)(rowp + bj * 64) = make_uint2(pg8::cvt_pk_bf16(o[0], o[1]), pg8::cvt_pk_bf16(o[2], o[3])); } }
    }
};
struct PB_Moe2 {
    static constexpr bool PERM = true;
    const char* A; int ldb, nt; const char* W2; bf16_t* D2; const float* MODl; const int* LISTP; const ALAS int* tb; int G, c; bool dry;
    int tail;
    __device__ __forceinline__ bool next(int i, pg8::Unit& u) const {
        const int nMt = tb[32 + 24], nwg = nMt * 4, nfull = (nwg / G) * G, ntail = nwg - nfull; const bool split = 2 * ntail <= G;
        int L, half = 0;
        if (tail == 0) { L = i * G + c; if (L >= (split ? nfull : nwg)) return false; }
        else { if (!split || i != 0 || c >= 2 * ntail) return false; L = nfull + (c >> 1); half = c & 1; }
        int pn; pg8::static_unit(L, nMt, 4, u.pm, pn); u.pn = tail ? 2 * pn + half : pn;
        int pr = 0;
        for (int q = 1; q < 24; ++q) if (tb[32 + q] <= u.pm) pr = q;
        u.aux = pr; return true; }
    __device__ __forceinline__ void a_off(const pg8::Unit& u, const int (&Rs)[2], const int (&Cs)[2], unsigned (&off)[2][2]) const {
#pragma unroll
        for (int h = 0; h < 2; ++h)
#pragma unroll
            for (int i = 0; i < 2; ++i) off[h][i] = (unsigned)((u.pm * 256 + h * 128 + Rs[i]) * 1024 + Cs[i]) * 2u; }
    __device__ __forceinline__ const char* b_ptr(const pg8::Unit& u, int t) const { int e0, e1; pair_experts(u.aux, e0, e1); const int e = t < 8 ? e0 : e1;
        return W2 + ((size_t)e * 1024 + (size_t)u.pn * (tail ? 128 : 256)) * DE * 2 + (size_t)(t & 7) * 128; }
    __device__ __forceinline__ void epi(const pg8::f32x4 (&acc)[2][2][4][2], const pg8::Unit& u, int wr, int wc, int fr, int fq) const {
        const int pr = u.aux, cnt = tb[pr], r0 = (u.pm - tb[32 + pr]) * 256; const int* lp = LISTP + (size_t)pr * R;
        const int col0 = u.pn * (tail ? 128 : 256) + wc * 32 + 8 * fq; const int nbj = tail ? 1 : 2;
        if (dry) return;
        int tok[2][4];
#pragma unroll
        for (int ai = 0; ai < 2; ++ai)
#pragma unroll
            for (int m = 0; m < 4; ++m) { const int rk = r0 + ai * 128 + wr * 64 + m * 16 + fr; tok[ai][m] = rk < cnt ? lp[rk] : -1; }
#pragma unroll
        for (int ai = 0; ai < 2; ++ai)
#pragma unroll
            for (int m = 0; m < 4; ++m) { const int tk = tok[ai][m];
                if (tk >= 0) { bf16_t* rowp = D2 + (size_t)tk * D + col0; const float* gt = MODl + (size_t)row_mi(tk) * 6 * D + 5 * D + col0;
#pragma unroll
                    for (int bj = 0; bj < 2; ++bj) { if (bj >= nbj) break; const pg8::f32x4 v0 = acc[ai][bj][m][0] * *(const pg8::f32x4*)(gt + bj * 128), v1 = acc[ai][bj][m][1] * *(const pg8::f32x4*)(gt + bj * 128 + 4); pg8::u32x4 w;
                        w.x = pg8::cvt_pk_bf16(v0[0], v0[1]); w.y = pg8::cvt_pk_bf16(v0[2], v0[3]); w.z = pg8::cvt_pk_bf16(v1[0], v1[1]); w.w = pg8::cvt_pk_bf16(v1[2], v1[3]);
                        *(pg8::u32x4*)(rowp + bj * 128) = w; } } }
    }
};

template <int MAP  >
__device__ __forceinline__ void transpose_item(const float* W, int K, int N, bf16_t* WT, PG8_LAS float* scr, int item, int lane) {
    const int nblk = N / 32, kb = item / nblk, nb = item % nblk, k0 = 64 * kb, n0 = 32 * nb;
    float wv32[32];
#pragma unroll
    for (int i = 0; i < 32; ++i) { const int kk = 2 * i + (lane >> 5); wv32[i] = W[(size_t)(k0 + kk) * N + n0 + (lane & 31)]; }
#pragma unroll
    for (int i = 0; i < 32; ++i) { const int kk = 2 * i + (lane >> 5); scr[kk * 33 + (lane & 31)] = wv32[i]; }
    asm volatile("s_waitcnt lgkmcnt(0)" ::: "memory");
    const int c = lane & 7;
#pragma unroll
    for (int j = 0; j < 4; ++j) { const int n = (lane >> 3) + 8 * j; const PG8_LAS float* sp = scr + (8 * c) * 33 + n;
        uint4 o; o.x = pk2bf(sp[0 * 33], sp[1 * 33]); o.y = pk2bf(sp[2 * 33], sp[3 * 33]);
        o.z = pk2bf(sp[4 * 33], sp[5 * 33]); o.w = pk2bf(sp[6 * 33], sp[7 * 33]);
        const int ng = n0 + n; const int row = MAP == 0 ? ng : (32 * (ng >> 4) + (ng & 15) + (MAP == 2 ? 16 : 0));
        *(uint4*)(WT + (size_t)row * K + k0 + 8 * c) = o; }
    asm volatile("s_waitcnt lgkmcnt(0)" ::: "memory");
}
__device__ __forceinline__ void ph_prep_weights(const P& p, unsigned char* lds) {
    const int tidx = p.wid * 64 + fresh_lane();
    const int lane = tidx & 63, wv = tidx >> 6;
    PG8_LAS float* scr = (PG8_LAS float*)((PG8_LAS unsigned char*)lds + wv * 16384);
    const int gw = blockIdx.x * NWV + wv, NGW = gridDim.x * NWV;
    constexpr int I_IN = (D / 64) * (NZ / 32), I_OUT = (D / 64) * (D / 32);
    for (int it = gw; it < 2 * (I_IN + I_OUT); it += NGW) { const int l = it / (I_IN + I_OUT), r = it % (I_IN + I_OUT);
        if (r < I_IN) transpose_item<0>(p.in[I_WIN] + (size_t)l * D * NZ, D, NZ, (bf16_t*)(p.ws + WS_WIN) + (size_t)l * NZ * D, scr, r, lane);
        else transpose_item<0>(p.in[I_WOUT] + (size_t)l * D * D, D, D, (bf16_t*)(p.ws + WS_WOUT) + (size_t)l * D * D, scr, r - I_IN, lane); }
    { bf16_t* SGWo = (bf16_t*)(p.ws + WS_SGW); for (int it = blockIdx.x * NT + tidx; it < 2 * 4 * 128 * 128; it += gridDim.x * NT) SGWo[it] = f2bf(p.in[I_SGW][it]); }
    { bf16_t* WT = (bf16_t*)(p.ws + WS_LRUWT);
      for (int it = blockIdx.x * NT + tidx; it < 2 * 2 * 2 * 4 * 64 * 64; it += gridDim.x * NT) { const int i = it & 63, j = (it >> 6) & 63, hh = (it >> 12) & 3, gate = (it >> 14) & 1, ld = it >> 15;
          const float* src = (gate ? p.in[I_WI] : p.in[I_WR]) + (((size_t)ld * 4 + hh) * 64 + i) * 64 + j; WT[it] = f2bf(*src); } }
}
__device__ __forceinline__ void ph_prep_moe(const P& p, int l, unsigned char* lds, int half, int b0) {
    if ((int)blockIdx.x < b0) return;
    const int tidx = p.wid * 64 + fresh_lane();
    const int lane = tidx & 63, wv = tidx >> 6;
    PG8_LAS float* scr = (PG8_LAS float*)((PG8_LAS unsigned char*)lds + wv * 16384);
    const int gw = ((int)blockIdx.x - b0) * NWV + wv, NGW = ((int)gridDim.x - b0) * NWV;
    constexpr int I_13 = (D / 64) * (DE / 32), I_2 = (DE / 64) * (D / 32), PER_E = 2 * I_13 + I_2;
    for (int it = gw + half * (NE / 2) * PER_E; it < (half + 1) * (NE / 2) * PER_E; it += NGW) { const int e = it / PER_E, r = it % PER_E;
        bf16_t* w13 = (bf16_t*)(p.ws + WS_W13) + (size_t)e * 1024 * D; bf16_t* w2 = (bf16_t*)(p.ws + WS_W2) + (size_t)e * D * DE;
        if (r < I_13) transpose_item<1>(p.in[I_W1] + ((size_t)l * NE + e) * D * DE, D, DE, w13, scr, r, lane);
        else if (r < 2 * I_13) transpose_item<2>(p.in[I_W3] + ((size_t)l * NE + e) * D * DE, D, DE, w13, scr, r - I_13, lane);
        else transpose_item<0>(p.in[I_W2] + ((size_t)l * NE + e) * DE * D, DE, D, w2, scr, r - 2 * I_13, lane); }
}

#define XB_TMO      128
#define XB_XCNT(j)  (256  + 64 * (j))
#define XB_XSUB(j)  (1280 + 64 * (j))
#define XB_XGEN(j)  (2304 + 64 * (j))
#define XB_TOP      3328
#define XB_TOPGEN   3392
#define XCD_BAR_WORDS 3456
#define XB_SPIN_CAP (1u << 18)
__device__ __forceinline__ unsigned xb_ld(unsigned* q) { return __hip_atomic_load(q, __ATOMIC_RELAXED, __HIP_MEMORY_SCOPE_AGENT); }
__device__ __forceinline__ unsigned xb_add(unsigned* q, unsigned v) { return __hip_atomic_fetch_add(q, v, __ATOMIC_RELAXED, __HIP_MEMORY_SCOPE_AGENT); }
__device__ __forceinline__ unsigned xb_xcc_id() { return (unsigned)__builtin_amdgcn_s_getreg((3 << 11) | 20) & 0xFu; }
#define XB_SPIN(cond, bar) do { unsigned _sp = 0; while (cond) { __builtin_amdgcn_s_sleep(1); \
    if ((++_sp & 255u) == 0u) { if (xb_ld(&(bar)[XB_TMO])) break; if (_sp > XB_SPIN_CAP) { atomicAdd(&(bar)[XB_TMO], 1u); break; } } } } while (0)
struct XcdBarrier { unsigned* bar; unsigned x; volatile ALAS unsigned* st; int wid; };
__device__ __forceinline__ XcdBarrier xcd_barrier_post(unsigned* bar, volatile ALAS unsigned* st, int wid) {
    XcdBarrier b; b.bar = bar; b.x = xb_xcc_id(); b.st = st; b.wid = wid;
    if (wid == 0 && fresh_lane() == 0) (void)xb_add(&bar[XB_XCNT(b.x)], 1u);
    return b;
}
__device__ __forceinline__ void xcd_barrier_complete(unsigned* bar, unsigned x, unsigned& nloc, unsigned& nx) {
    const unsigned G = gridDim.x * gridDim.y * gridDim.z;
    unsigned sum, cnt, mine, sp = 0u;
    for (;;) {
        sum = 0u; cnt = 0u; mine = 0u;
#pragma unroll
        for (unsigned j = 0; j < 16; ++j) { const unsigned c = xb_ld(&bar[XB_XCNT(j)]); sum += c; cnt += (c > 0u) ? 1u : 0u; mine = (j == x) ? c : mine; }
        if (sum == G) break;
        __builtin_amdgcn_s_sleep(1);
        if ((++sp & 255u) == 0u) { if (xb_ld(&bar[XB_TMO])) break; if (sp > XB_SPIN_CAP) { atomicAdd(&bar[XB_TMO], 1u); break; } }
    }
    nloc = mine > 0u ? mine : 1u; nx = cnt > 0u ? cnt : 1u;
}
__device__ __forceinline__ void xcd_barrier(const XcdBarrier& b) {
    asm volatile("s_waitcnt vmcnt(0)" ::: "memory");
    __syncthreads();
    if (b.wid == 0 && fresh_lane() == 0) {
        unsigned* bar = b.bar; asm volatile("" : "+s"(bar));
        __builtin_amdgcn_s_waitcnt(0);
        unsigned nloc = b.st[0], nx = b.st[1];
        if (nloc == 0u) { xcd_barrier_complete(bar, b.x, nloc, nx); b.st[0] = nloc; b.st[1] = nx; }
        const unsigned old = xb_add(&bar[XB_XSUB(b.x)], 1u);
        const unsigned gen = old / nloc;
        if (old + 1u == (gen + 1u) * nloc) {
            __builtin_amdgcn_fence(__ATOMIC_RELEASE, "agent");
            asm volatile("s_waitcnt vmcnt(0)" ::: "memory");
            const unsigned og = xb_add(&bar[XB_TOP], 1u);
            const unsigned tg = og / nx;
            if (og + 1u == (tg + 1u) * nx) xb_add(&bar[XB_TOPGEN], 1u);
            else XB_SPIN(xb_ld(&bar[XB_TOPGEN]) == tg, bar);
            __builtin_amdgcn_fence(__ATOMIC_ACQUIRE, "agent");
            xb_add(&bar[XB_XGEN(b.x)], 1u);
            asm volatile("s_waitcnt vmcnt(0)" ::: "memory");
        } else {
            XB_SPIN(xb_ld(&bar[XB_XGEN(b.x)]) == gen, bar);
            __builtin_amdgcn_fence(__ATOMIC_ACQUIRE, "agent");
            asm volatile("s_waitcnt vmcnt(0)" ::: "memory");
        }
    }
    __syncthreads();
}

constexpr int LDS_BYTES = 163840;
typedef const __attribute__((address_space(4))) P* kargp_t;
#define GETP() P p; { kargp_t kq_ = kp; int w_ = wid; asm volatile("" : "+s"(kq_), "+s"(w_)); p = *(const P*)kq_; p.wid = w_; }
__global__ void __launch_bounds__(NT, 2) fwd_kernel(P p_in) {
    const int wid = __builtin_amdgcn_readfirstlane((int)(threadIdx.x >> 6));
    kargp_t kp = (kargp_t)__builtin_amdgcn_kernarg_segment_ptr();
    extern __shared__ __attribute__((aligned(16))) unsigned char lds[];
    float* sm = (float*)lds;
    { volatile ALAS unsigned* stw = (volatile ALAS unsigned*)((ALAS unsigned char*)lds + LDS_MISC + 2048); if (threadIdx.x < 2) stw[threadIdx.x] = 0u; }
    __syncthreads();
    { GETP(); (void)xcd_barrier_post((unsigned*)(p.ws + WS_CNT + 1024), (volatile ALAS unsigned*)((ALAS unsigned char*)lds + LDS_MISC + 2048), wid); }
#define GBAR() do { GETP(); XcdBarrier gb_; gb_.bar = (unsigned*)(p.ws + WS_CNT + 1024); gb_.x = xb_xcc_id(); gb_.st = (volatile ALAS unsigned*)((ALAS unsigned char*)lds + LDS_MISC + 2048); gb_.wid = wid; xcd_barrier(gb_); } while (0)

    { GETP(); ph_mod(p, sm); }
    { GETP(); ph_rope_table(p); }
    { GETP(); ph_prep_weights(p, lds); }
    GBAR();
#pragma unroll 1
    for (int l = 0; l < 2; ++l) {

        { GETP(); ph_norm1(p, l); }
        if (l == 1) { GETP(); ph_prep_moe(p, l, lds, 1, 0); }
        GBAR();
        { GETP(); PB_InProj pb; pb.A = (const char*)(p.ws + WS_H); pb.ldb = D; pb.nt = D / 64; pb.Bt = (const char*)(p.ws + WS_WIN) + (size_t)l * NZ * D * 2; pb.Zo = (bf16_t*)(p.ws + WS_Z); pb.G = gridDim.x; pb.c = blockIdx.x;
          pg8::gemm_phase<PB_InProj, true>((PG8_LAS unsigned char*)lds, pb, wid); }
        { GETP(); ph_prep_moe(p, l, lds, 0, 96); }
        GBAR();
        { GETP(); ph_rope(p, l); }
        { GETP(); ph_sg(p, l, lds); }
        { GETP(); ph_lru_m1(p, l, lds); }
        { GETP(); ph_hg<1>(p, l, lds); }
        GBAR();
        { GETP(); ph_attn(p, l, lds); }
        { GETP(); ph_lru_m2(p, l, lds); }
        { GETP(); ph_hg<2>(p, l, lds); }
        GBAR();
        { GETP(); PB_OutProj pb; pb.A = (const char*)(p.ws + WS_Y); pb.ldb = D; pb.nt = D / 64; pb.Bt = (const char*)(p.ws + WS_WOUT) + (size_t)l * D * D * 2; pb.D1 = (bf16_t*)(p.ws + WS_D1);
          pb.MODl = (const float*)(p.ws + WS_MOD) + (size_t)l * 9 * 6 * D; pb.G = gridDim.x; pb.c = blockIdx.x; pb.skipctx = (l == 1); pb.dry = false;
          pb.tail = 0; pg8::gemm_phase<PB_OutProj, true>((PG8_LAS unsigned char*)lds, pb, wid);
          pb.tail = 1; pg8::gemm_phase<PB_OutProj, true, true>((PG8_LAS unsigned char*)lds, pb, wid); }
        if (l == 0) { GETP(); ph_prep_moe(p, l, lds, 1, 64); }
        GBAR();
        { GETP(); ph_router(p, l, lds + LDS_MISC); }
        GBAR();
        { GETP(); ALAS int* tb = (ALAS int*)(lds + LDS_MISC + 1024); moe_tiles_setup(p, l, tb);
          PB_Moe1 pb; pb.A = (const char*)(p.ws + WS_H); pb.ldb = D; pb.nt = D / 64; pb.W13 = (const char*)(p.ws + WS_W13); pb.HE = (bf16_t*)(p.ws + WS_Z); pb.LISTP = (const int*)(p.ws + WS_LISTP);
          pb.GP = (const float2*)(p.ws + WS_GP); pb.tb = tb; pb.G = gridDim.x; pb.c = blockIdx.x;
          pg8::gemm_phase<PB_Moe1, true>((PG8_LAS unsigned char*)lds, pb, wid); }
        GBAR();
        { GETP(); ALAS int* tb = (ALAS int*)(lds + LDS_MISC + 1024);
          PB_Moe2 pb; pb.A = (const char*)(p.ws + WS_Z); pb.ldb = DE; pb.nt = 16; pb.W2 = (const char*)(p.ws + WS_W2); pb.D2 = (bf16_t*)(p.ws + WS_D2);
          pb.MODl = (const float*)(p.ws + WS_MOD) + (size_t)l * 9 * 6 * D; pb.LISTP = (const int*)(p.ws + WS_LISTP); pb.tb = tb; pb.G = gridDim.x; pb.c = blockIdx.x; pb.dry = false;
          pb.tail = 0; pg8::gemm_phase<PB_Moe2, true>((PG8_LAS unsigned char*)lds, pb, wid);
          pb.tail = 1; pg8::gemm_phase<PB_Moe2, true, true>((PG8_LAS unsigned char*)lds, pb, wid); }
        GBAR();
    }

    { GETP(); ph_final(p); }

}

extern "C" void kernel_launch(void* const* d_in, const int* in_sizes, int n_in, void* d_out, int out_size, void* d_ws, size_t ws_size, hipStream_t stream) {
    if (n_in != N_IN || ws_size < WS_END) { fprintf(stderr, "kernel_launch: bad n_in %d or ws %zu < %zu\n", n_in, ws_size, (size_t)WS_END); return; }
    P p{};
    for (int i = 0; i < N_IN; ++i) p.in[i] = (const float*)d_in[i];
    p.out = (float*)d_out; p.ws = (unsigned char*)d_ws;
    (void)hipMemsetAsync((char*)d_ws + WS_CNT, 0, 16384, stream);
    void* args[] = {&p};
    static bool attr_set = false;
    if (!attr_set) { (void)hipFuncSetAttribute((const void*)fwd_kernel, hipFuncAttributeMaxDynamicSharedMemorySize, LDS_BYTES); attr_set = true; }
    hipError_t e = hipLaunchCooperativeKernel((void*)fwd_kernel, dim3(256), dim3(NT), args, LDS_BYTES, stream);
    if (e != hipSuccess) fprintf(stderr, "cooperative launch failed: %s\n", hipGetErrorString(e));
}
```
